# Optimizing an MI355X kernel written in HIP

```python
import jax
import jax.numpy as jnp
from jax import lax
import numpy as np

D_MODEL = 1024
BATCH = 8
SEQ = 4096
DEPTH = 2

N_BRANCHES = 4
BRANCH_WIDTH = D_MODEL // N_BRANCHES
LRU_CONV = 4
LRU_BLOCKS = 8
LRU_BLOCK = BRANCH_WIDTH // LRU_BLOCKS
LRU_C = 8.0
POOL_WINDOWS = (2, 4, 8, 16)
POOL_GROUP = BRANCH_WIDTH // len(POOL_WINDOWS)
HGRN_HEADS = 4
HGRN_DK = BRANCH_WIDTH // HGRN_HEADS
HGRN_DV = BRANCH_WIDTH // HGRN_HEADS
HGRN_CHUNK = 64
SCONV_WIDTH = 3
D_FF = 4 * D_MODEL
N_MIX_SLOTS = 10
IN_WIDTH = N_MIX_SLOTS * BRANCH_WIDTH + N_BRANCHES * D_MODEL
EPS = 1e-6

kernel_name = "hybrid_gated_mixer_trunk"


def rms_norm(x, gain):
    xf = x.astype(jnp.float32)
    y = xf * lax.rsqrt(jnp.mean(xf * xf, axis=-1, keepdims=True) + EPS)
    return (y * gain.astype(jnp.float32)).astype(x.dtype)


def causal_depthwise_conv(x, w):
    k = w.shape[0]
    c = x.shape[-1]
    return lax.conv_general_dilated(
        x, w.astype(x.dtype).reshape(k, 1, c), window_strides=(1,),
        padding=[(k - 1, 0)], dimension_numbers=("NWC", "WIO", "NWC"),
        feature_group_count=c)


def block_diag_linear(x, w, b):
    bsz, t, _ = x.shape
    nb, bi, bo = w.shape
    y = jnp.einsum("btnc,ncd->btnd", x.reshape(bsz, t, nb, bi), w.astype(x.dtype))
    return y.reshape(bsz, t, nb * bo) + b.astype(x.dtype)


def rg_lru_branch(x_in, gate_in, conv_w, conv_b, w_a, b_a, w_x, b_x, lam):
    xc = causal_depthwise_conv(x_in, conv_w) + conv_b.astype(x_in.dtype)
    r = jax.nn.sigmoid(block_diag_linear(xc, w_a, b_a).astype(jnp.float32))
    i = jax.nn.sigmoid(block_diag_linear(xc, w_x, b_x).astype(jnp.float32))
    log_a = -LRU_C * r * jax.nn.softplus(-lam.astype(jnp.float32))
    a = jnp.exp(log_a)
    mult = jnp.sqrt(-jnp.expm1(2.0 * log_a))
    u = mult * i * xc.astype(jnp.float32)

    def combine(left, right):
        a_l, h_l = left
        a_r, h_r = right
        return a_l * a_r, a_r * h_l + h_r

    _, h = lax.associative_scan(combine, (a, u), axis=1)
    return (h * jax.nn.gelu(gate_in.astype(jnp.float32))).astype(x_in.dtype)


def pool_branch(x, w, scale):
    bsz, t, _ = x.shape
    xf = x.astype(jnp.float32)
    cs0 = jnp.pad(jnp.cumsum(xf, axis=1), ((0, 0), (1, 0), (0, 0)))
    pos = jnp.arange(1, t + 1, dtype=jnp.float32)[:, None]
    means = []
    for g, win in enumerate(POOL_WINDOWS):
        c = cs0[..., g * POOL_GROUP:(g + 1) * POOL_GROUP]
        window_sum = c[:, 1:] - jnp.pad(c, ((0, 0), (win - 1, 0), (0, 0)))[:, :t]
        means.append(window_sum / jnp.minimum(pos, float(win)))
    d = (jnp.concatenate(means, axis=-1) - xf).astype(x.dtype)
    d = d.reshape(bsz, t, len(POOL_WINDOWS), POOL_GROUP)
    y = jnp.einsum("btgc,gcd->btgd", d, w.astype(x.dtype)).reshape(bsz, t, BRANCH_WIDTH)
    return y * scale.astype(x.dtype)


def hgrn2_chunked(q, log_f, k, v):
    bsz, t, h, dk = q.shape
    dv = v.shape[-1]
    nc = t // HGRN_CHUNK

    def chunks(z):
        return z.reshape(bsz, nc, HGRN_CHUNK, h, z.shape[-1]).transpose(1, 0, 3, 2, 4)

    causal = jnp.tril(jnp.ones((HGRN_CHUNK, HGRN_CHUNK), dtype=bool))[:, :, None]

    def step(state, inp):
        q_c, lf_c, k_c, v_c = inp
        b = jnp.cumsum(lf_c, axis=2)
        diff = b[:, :, :, None, :] - b[:, :, None, :, :]
        decay = jnp.exp(jnp.where(causal, diff, -jnp.inf))
        scores = jnp.einsum("bhtk,bhsk,bhtsk->bhts", q_c, k_c, decay)
        o = (jnp.einsum("bhts,bhsv->bhtv", scores, v_c)
             + jnp.einsum("bhtk,bhkv->bhtv", q_c * jnp.exp(b), state))
        b_last = b[:, :, -1:, :]
        state = (jnp.exp(b_last[:, :, 0, :, None]) * state
                 + jnp.einsum("bhsk,bhsv->bhkv", k_c * jnp.exp(b_last - b), v_c))
        return state, o

    s0 = jnp.zeros((bsz, h, dk, dv), jnp.float32)
    _, o = lax.scan(step, s0, (chunks(q), chunks(log_f), chunks(k), chunks(v)))
    return o.transpose(1, 0, 3, 2, 4).reshape(bsz, t, h, dv)


def hgrn2_branch(hq, hf, hi, hg, lb, norm_gain):
    bsz, t, _ = hq.shape
    shp_k = (bsz, t, HGRN_HEADS, HGRN_DK)
    lb = lb.reshape(HGRN_HEADS, HGRN_DK)
    f = lb + (1.0 - lb) * jax.nn.sigmoid(hf.astype(jnp.float32).reshape(shp_k))
    o = hgrn2_chunked(hq.astype(jnp.float32).reshape(shp_k), jnp.log(f), 1.0 - f,
                      hi.astype(jnp.float32).reshape(bsz, t, HGRN_HEADS, HGRN_DV))
    o = rms_norm(o, norm_gain).reshape(bsz, t, BRANCH_WIDTH)
    return (o * jax.nn.silu(hg.astype(jnp.float32))).astype(hq.dtype)


def short_conv_branch(gate_b, gate_c, xs, w):
    return gate_b * causal_depthwise_conv(gate_c * xs, w)


def setup_inputs(seed: int = 0) -> dict:
    key = jax.random.key(seed)
    ks = jax.random.split(key, 24)
    f32 = jnp.float32
    W = BRANCH_WIDTH

    def nrm(k, shape, scale):
        return jax.random.normal(k, shape, f32) * scale

    def gain(k, shape):
        return 1.0 + 0.05 * jax.random.normal(k, shape, f32)

    u = jax.random.uniform(ks[12], (DEPTH, W), f32, minval=0.9, maxval=0.999)
    s = u ** (1.0 / LRU_C)
    lam = jnp.log(s) - jnp.log1p(-s)
    return {
        "x": jax.random.normal(ks[0], (BATCH, SEQ, D_MODEL), f32),
        "norm_mix_pre": gain(ks[1], (DEPTH, D_MODEL)),
        "norm_mix_post": gain(ks[2], (DEPTH, D_MODEL)),
        "norm_mlp_pre": gain(ks[3], (DEPTH, D_MODEL)),
        "norm_mlp_post": gain(ks[4], (DEPTH, D_MODEL)),
        "w_in": nrm(ks[5], (DEPTH, D_MODEL, IN_WIDTH), D_MODEL ** -0.5),
        "lru_conv_w": nrm(ks[6], (DEPTH, LRU_CONV, W), LRU_CONV ** -0.5),
        "lru_conv_b": nrm(ks[7], (DEPTH, W), 0.02),
        "lru_w_a": nrm(ks[8], (DEPTH, LRU_BLOCKS, LRU_BLOCK, LRU_BLOCK), LRU_BLOCK ** -0.5),
        "lru_b_a": nrm(ks[9], (DEPTH, W), 0.02),
        "lru_w_x": nrm(ks[10], (DEPTH, LRU_BLOCKS, LRU_BLOCK, LRU_BLOCK), LRU_BLOCK ** -0.5),
        "lru_b_x": nrm(ks[11], (DEPTH, W), 0.02),
        "lru_lambda": lam,
        "pool_w": nrm(ks[13], (DEPTH, len(POOL_WINDOWS), POOL_GROUP, POOL_GROUP), POOL_GROUP ** -0.5),
        "pool_scale": 1.0 + 0.1 * jax.random.normal(ks[14], (DEPTH, W), f32),
        "hgrn_lower_bound": nrm(ks[15], (DEPTH, W), 0.5),
        "hgrn_norm": gain(ks[16], (DEPTH, HGRN_DV)),
        "sconv_w": nrm(ks[17], (DEPTH, SCONV_WIDTH, W), SCONV_WIDTH ** -0.5),
        "w_branch": nrm(ks[18], (DEPTH, N_BRANCHES, W, D_MODEL), W ** -0.5),
        "w_out": nrm(ks[19], (DEPTH, D_MODEL, D_MODEL), D_MODEL ** -0.5),
        "w_up": nrm(ks[20], (DEPTH, D_MODEL, D_FF), D_MODEL ** -0.5),
        "w_down": nrm(ks[21], (DEPTH, D_FF, D_MODEL), D_FF ** -0.5),
    }


def reference(x, norm_mix_pre, norm_mix_post, norm_mlp_pre, norm_mlp_post, w_in,
              lru_conv_w, lru_conv_b, lru_w_a, lru_b_a, lru_w_x, lru_b_x, lru_lambda,
              pool_w, pool_scale, hgrn_lower_bound, hgrn_norm, sconv_w,
              w_branch, w_out, w_up, w_down):
    bsz, t, _ = x.shape
    lb_cum = jnp.cumsum(jax.nn.softmax(hgrn_lower_bound.astype(jnp.float32), axis=0), axis=0)
    lower_bounds = lb_cum - lb_cum[0:1]
    split_points = [BRANCH_WIDTH * (j + 1) for j in range(N_MIX_SLOTS)]
    h = x
    for l in range(DEPTH):
        u = rms_norm(h, norm_mix_pre[l])
        proj = jnp.einsum("btd,dp->btp", u, w_in[l])
        (a_x, a_gate, p_x, c_q, c_f, c_i, c_g, s_b, s_c, s_x,
         gate_logits) = jnp.split(proj, split_points, axis=-1)
        y_a = rg_lru_branch(a_x, a_gate, lru_conv_w[l], lru_conv_b[l], lru_w_a[l], lru_b_a[l],
                            lru_w_x[l], lru_b_x[l], lru_lambda[l])
        y_b = pool_branch(p_x, pool_w[l], pool_scale[l])
        y_c = hgrn2_branch(c_q, c_f, c_i, c_g, lower_bounds[l], hgrn_norm[l])
        y_d = short_conv_branch(s_b, s_c, s_x, sconv_w[l])
        ys = jnp.stack([y_a, y_b, y_c, y_d], axis=2)
        branch_out = jnp.einsum("btkc,kcd->btkd", ys, w_branch[l])
        gates = jax.nn.sigmoid(gate_logits.reshape(bsz, t, N_BRANCHES, D_MODEL))
        merged = jnp.sum(gates * branch_out, axis=2)
        mix = jnp.einsum("btd,de->bte", merged, w_out[l])
        h = h + rms_norm(mix, norm_mix_post[l])
        u = rms_norm(h, norm_mlp_pre[l])
        hid = jnp.square(jax.nn.relu(jnp.einsum("btd,df->btf", u, w_up[l])))
        m = jnp.einsum("btf,fd->btd", hid, w_down[l])
        h = h + rms_norm(m, norm_mlp_post[l])
    return h
```

```cpp
#include <hip/hip_runtime.h>
#include <hip/hip_cooperative_groups.h>
#include <cstdio>
#include <cstdint>
namespace cg = cooperative_groups;

#ifndef DBG_ZERO
#define DBG_ZERO -1
#endif
#ifndef MK_PER_PHASE
#define MK_PER_PHASE 0
#endif

#define LAS __attribute__((address_space(3)))
#define GAS __attribute__((address_space(1)))
typedef unsigned short bf16_t;
typedef short bf16x8 __attribute__((ext_vector_type(8)));
typedef float f32x4 __attribute__((ext_vector_type(4)));
typedef float f32x2 __attribute__((ext_vector_type(2)));
typedef unsigned u32x4 __attribute__((ext_vector_type(4)));
typedef unsigned u32x2 __attribute__((ext_vector_type(2)));

constexpr int BATCH = 8, T = 4096, D = 1024, M = BATCH * T, DEPTH = 2, BW = 256;
constexpr int NMIX = 2560, NGATE = 4096, INW = NMIX + NGATE, FF = 4096;
constexpr float EPS = 1e-6f;
constexpr int NWAVES = 8, NTHREADS = 512;

constexpr size_t MiB = 1u << 20;
constexpr size_t WS_CTL = 0, CTL_ZERO_BYTES = 1 * MiB;
constexpr size_t WS_RS = 1 * MiB;
constexpr size_t WS_SD = 1 * MiB + 512 * 1024;
constexpr size_t WS_LA = 2 * MiB, WS_LH = 3 * MiB, WS_LC = 4 * MiB;
constexpr size_t WS_W = 8 * MiB;
constexpr size_t W_IN = 0, W_BR = 13 * MiB, W_OUT = 15 * MiB, W_UP = 17 * MiB, W_DOWN = 25 * MiB, W_LAYER = 33 * MiB;
constexpr size_t WS_HB = 76 * MiB;
constexpr size_t WS_PROJ = 140 * MiB;
constexpr size_t WS_G = WS_PROJ;
constexpr size_t WS_YS = 300 * MiB;
constexpr size_t WS_MERGED = 364 * MiB;
constexpr size_t WS_SU = WS_MERGED;
constexpr size_t WS_HID = WS_PROJ;
constexpr size_t WS_END = 428 * MiB;

constexpr int LDS_BYTES = 155648;
constexpr int MISC_OFF = 154624;

__device__ __forceinline__ float bf2f(unsigned b) { return __uint_as_float(b << 16); }
__device__ __forceinline__ unsigned f2bf(float f) { unsigned u = __float_as_uint(f); return (u + 0x7fffu + ((u >> 16) & 1u)) >> 16; }
__device__ __forceinline__ unsigned pk2(float lo, float hi) { return f2bf(lo) | (f2bf(hi) << 16); }
typedef __bf16 bf16x2_t __attribute__((ext_vector_type(2)));
__device__ __forceinline__ unsigned cvt_pk_bf16(float lo, float hi) { f32x2 v = {lo, hi}; bf16x2_t b = __builtin_convertvector(v, bf16x2_t); return __builtin_bit_cast(unsigned, b); }
__device__ __forceinline__ float fast_exp(float x) { return __builtin_amdgcn_exp2f(x * 1.4426950408889634f); }
__device__ __forceinline__ float sigmoid_f(float x) { return __builtin_amdgcn_rcpf(1.0f + fast_exp(-x)); }
__device__ __forceinline__ void ld8bf(const bf16_t* p, float (&o)[8]) {
    const u32x4 v = *(const u32x4*)p;
    o[0] = bf2f(v.x & 0xffffu); o[1] = bf2f(v.x >> 16); o[2] = bf2f(v.y & 0xffffu); o[3] = bf2f(v.y >> 16);
    o[4] = bf2f(v.z & 0xffffu); o[5] = bf2f(v.z >> 16); o[6] = bf2f(v.w & 0xffffu); o[7] = bf2f(v.w >> 16);
}
__device__ __forceinline__ float wave_sum(float v) {
#pragma unroll
    for (int o = 1; o < 64; o <<= 1) v += __shfl_xor(v, o);
    return v;
}

namespace pg8 {
constexpr int BM = 256, BK = 64, HALF = 128, HTB = HALF * BK * 2, STAGE_BYTES = 8 * HTB, NXCD = 8, WGM = 8;
__host__ __device__ __forceinline__ int lds_byte(int r, int c) { const int st = (r >> 4) * 2 + (c >> 5), rr = r & 15, cc = c & 31, ob = rr * 64 + cc * 2; return st * 1024 + (ob ^ (((ob >> 9) & 1) << 5)); }
__host__ __device__ __forceinline__ void stage_rc(int b, int& R, int& C) { const int st = b / 1024, sb = b % 1024, swz = sb ^ (((sb >> 9) & 1) << 5); R = (st >> 1) * 16 + swz / 64; C = (st & 1) * 32 + (swz % 64) / 2; }
__host__ __device__ __forceinline__ int perm32(int rho) { const int n = rho >> 4, i = rho & 15; return 8 * (i >> 2) + 4 * n + (i & 3); }

struct Unit { int pm, pn, kind; };

struct StaticOrder {
    const char* A; const char* Bt; size_t tstep;
    int nM, nN, nwg, G, c;
    __device__ void init(const void* A_, const void* Bt_, int M_, int N_, int K_, int G_, int c_) { A = (const char*)A_; Bt = (const char*)Bt_; tstep = (size_t)BM * K_ * 2; nt = K_ / BK; nM = M_ / BM; nN = N_ / BM; nwg = nM * nN; G = G_; c = c_; }
    __device__ bool next(int i, Unit& u) const {
        const long L = (long)i * G + c; if (L >= nwg) return false;
        int wgid = (int)L; { const int q = nwg / NXCD, r = nwg % NXCD, xcd = wgid % NXCD, off = wgid / NXCD; wgid = (xcd < r ? xcd * (q + 1) : r * (q + 1) + (xcd - r) * q) + off; }
        const int nig = WGM * nN, gid = wgid / nig, fm = gid * WGM, gsz = (nM - fm) < WGM ? (nM - fm) : WGM;
        u.pm = fm + ((wgid % nig) % gsz); u.pn = (wgid % nig) / gsz; u.kind = 0; return true;
    }
    __device__ __forceinline__ void tiles(const Unit& u, const char*& a, const char*& b) const { a = A + (size_t)u.pm * tstep; b = Bt + (size_t)u.pn * tstep; }
    int nt;
    __device__ __forceinline__ int ntiles(const Unit&) const { return nt; }
    __device__ __forceinline__ bool keep_acc(const Unit&) const { return false; }
};

struct GateOrder {
    const char* HB; const char* WGt; const char* YS; const char* WB; int G, vcu;
    __device__ bool next(int i, Unit& u) const {
        const int r = i / 16, ii = i % 16, su = vcu + r * G; if (su >= 256) return false;
        const int half = ii / 8, j = ii % 8;
        u.pm = half * 64 + (su >> 2); u.kind = j; u.pn = (j < 4) ? (j * 4 + (su & 3)) : (su & 3); return true;
    }
    __device__ __forceinline__ int ntiles(const Unit& u) const { return u.kind < 4 ? 16 : 4; }
    __device__ __forceinline__ bool keep_acc(const Unit& nx) const { return nx.kind > 4; }
    __device__ __forceinline__ void tiles(const Unit& u, const char*& a, const char*& b) const {
        const size_t ts = (size_t)BM * 1024 * 2;
        if (u.kind < 4) { a = HB + (size_t)u.pm * ts; b = WGt + (size_t)u.pn * ts; } else { a = YS + (size_t)u.pm * ts + (size_t)(u.kind - 4) * 512; b = WB + (size_t)u.pn * ts + (size_t)(u.kind - 4) * 512; }
    }
};

template <int MODE  > struct EpiRow {
    static constexpr bool PERM = true;
    bf16_t* O; int ldc; const float* rs;
    __device__ __forceinline__ void operator()(f32x4 (&acc)[2][2][4][2], const Unit& u, int wr, int wc, int fr, int fq) const {
        const int row0 = u.pm * BM + wr * 64 + fr, col0 = u.pn * BM + wc * 32 + 8 * fq;
#pragma unroll
        for (int ai = 0; ai < 2; ++ai)
#pragma unroll
            for (int m = 0; m < 4; ++m) {
                const int row = row0 + ai * HALF + m * 16; const float sc = (MODE != 0) ? rs[row] : 1.0f;
                bf16_t* rowp = O + (size_t)row * ldc + col0;
#pragma unroll
                for (int bj = 0; bj < 2; ++bj) {
                    f32x4 v0 = acc[ai][bj][m][0], v1 = acc[ai][bj][m][1];
                    if (MODE != 0) { v0 = v0 * sc; v1 = v1 * sc; }
                    if (MODE == 2) {
#pragma unroll
                        for (int j = 0; j < 4; ++j) { const float a = fmaxf(v0[j], 0.f), b = fmaxf(v1[j], 0.f); v0[j] = a * a; v1[j] = b * b; }
                    }
                    u32x4 w; w.x = cvt_pk_bf16(v0[0], v0[1]); w.y = cvt_pk_bf16(v0[2], v0[3]); w.z = cvt_pk_bf16(v1[0], v1[1]); w.w = cvt_pk_bf16(v1[2], v1[3]);
                    *(u32x4*)(rowp + bj * HALF) = w;
                }
            }
    }
};

struct EpiGate {
    static constexpr bool PERM = true;
    bf16_t* Gt;
    bf16_t* MERGED;
    const float* rs;
    __device__ __forceinline__ void rescale(f32x4 (&acc)[2][2][4][2], int j, int wr, int wc, int fr, int fq) const {
        int lane_off = (wr * 64 + fr) * 256 + wc * 32 + 8 * fq; asm volatile("" : "+v"(lane_off));
        const bf16_t* g0 = Gt + (size_t)j * 65536; const bf16_t* g1 = g0 + 65536;
#pragma unroll
        for (int ai = 0; ai < 2; ++ai)
#pragma unroll
            for (int mp = 0; mp < 2; ++mp) {
                u32x4 a[2][2], b[2][2];
#pragma unroll
                for (int mm = 0; mm < 2; ++mm)
#pragma unroll
                    for (int bj = 0; bj < 2; ++bj) { const int off = lane_off + (ai * HALF + (mp * 2 + mm) * 16) * 256 + bj * HALF; a[mm][bj] = *(const u32x4*)(g0 + off); b[mm][bj] = *(const u32x4*)(g1 + off); }
#pragma unroll
                for (int mm = 0; mm < 2; ++mm)
#pragma unroll
                    for (int bj = 0; bj < 2; ++bj) {
                        const int m = mp * 2 + mm;
                        const unsigned aw[4] = {a[mm][bj].x, a[mm][bj].y, a[mm][bj].z, a[mm][bj].w}, bw[4] = {b[mm][bj].x, b[mm][bj].y, b[mm][bj].z, b[mm][bj].w};
#pragma unroll
                        for (int q = 0; q < 4; ++q) {
                            const float r0 = bf2f(aw[q] & 0xffffu) * __builtin_amdgcn_rcpf(bf2f(bw[q] & 0xffffu)), r1 = bf2f(aw[q] >> 16) * __builtin_amdgcn_rcpf(bf2f(bw[q] >> 16));
                            acc[ai][bj][m][q >> 1][(q & 1) * 2] *= r0; acc[ai][bj][m][q >> 1][(q & 1) * 2 + 1] *= r1;
                        }
                    }
                asm volatile("" ::: "memory");
            }
    }
    __device__ __forceinline__ void operator()(f32x4 (&acc)[2][2][4][2], const Unit& u, int wr, int wc, int fr, int fq) const {
        if (u.kind >= 4 && u.kind < 7) { rescale(acc, u.kind - 4, wr, wc, fr, fq); return; }
        int rl0 = wr * 64 + fr, cl0 = wc * 32 + 8 * fq; asm volatile("" : "+v"(rl0), "+v"(cl0));
        if (u.kind < 4) {
            bf16_t* gt = Gt + (size_t)u.kind * 65536;
#pragma unroll
            for (int ai = 0; ai < 2; ++ai)
#pragma unroll
                for (int m = 0; m < 4; ++m) {
                    const int rl = rl0 + ai * HALF + m * 16; const float sc = rs[u.pm * BM + rl];
#pragma unroll
                    for (int bj = 0; bj < 2; ++bj) {
                        f32x4 v0 = acc[ai][bj][m][0] * sc, v1 = acc[ai][bj][m][1] * sc;
#pragma unroll
                        for (int j = 0; j < 4; ++j) { v0[j] = sigmoid_f(fmaxf(v0[j], -60.f)); v1[j] = sigmoid_f(fmaxf(v1[j], -60.f)); }
                        u32x4 w; w.x = cvt_pk_bf16(v0[0], v0[1]); w.y = cvt_pk_bf16(v0[2], v0[3]); w.z = cvt_pk_bf16(v1[0], v1[1]); w.w = cvt_pk_bf16(v1[2], v1[3]);
                        *(u32x4*)(gt + rl * 256 + cl0 + bj * HALF) = w;
                    }
                }
        } else {
            const bf16_t* g3 = Gt + (size_t)3 * 65536;
#pragma unroll
            for (int ai = 0; ai < 2; ++ai)
#pragma unroll
                for (int m = 0; m < 4; ++m) {
                    const int rl = rl0 + ai * HALF + m * 16;
                    bf16_t* rowp = MERGED + (size_t)(u.pm * BM + rl) * 1024 + u.pn * BM + cl0;
#pragma unroll
                    for (int bj = 0; bj < 2; ++bj) {
                        const u32x4 s = *(const u32x4*)(g3 + rl * 256 + cl0 + bj * HALF);
                        f32x4 v0 = acc[ai][bj][m][0], v1 = acc[ai][bj][m][1];
                        v0[0] *= bf2f(s.x & 0xffffu); v0[1] *= bf2f(s.x >> 16); v0[2] *= bf2f(s.y & 0xffffu); v0[3] *= bf2f(s.y >> 16);
                        v1[0] *= bf2f(s.z & 0xffffu); v1[1] *= bf2f(s.z >> 16); v1[2] *= bf2f(s.w & 0xffffu); v1[3] *= bf2f(s.w >> 16);
                        u32x4 w; w.x = cvt_pk_bf16(v0[0], v0[1]); w.y = cvt_pk_bf16(v0[2], v0[3]); w.z = cvt_pk_bf16(v1[0], v1[1]); w.w = cvt_pk_bf16(v1[2], v1[3]);
                        *(u32x4*)(rowp + bj * HALF) = w;
                    }
                }
        }
    }
};

template <class Epi, class Sched, bool ALIGN_EPI>
__device__ __forceinline__ void gemm_phase(LAS unsigned char* lds, const int K, const Sched& S, const Epi& E) {
    int tid = threadIdx.x; asm volatile("" : "+v"(tid));
    const int wid = __builtin_amdgcn_readfirstlane(tid >> 6), lane = tid & 63, wr = wid >> 2, wc = wid & 3, fr = lane & 15, fq = lane >> 4;
    unsigned voffA[2], voffB[2];
#pragma unroll
    for (int i = 0; i < 2; ++i) { int R, C; stage_rc(tid * 16 + i * 8192, R, C); const int Rb = Epi::PERM ? ((R & ~31) + perm32(R & 31)) : R;
        voffA[i] = (unsigned)(R * K + C) * 2u; voffB[i] = (unsigned)(Rb * K + C) * 2u; }
    const size_t kstep = (size_t)(BK * 2);
    const size_t hstep = (size_t)HALF * K * 2;
    const unsigned ldsw = (unsigned)wid * 1024u;
    const int aoff = lds_byte(wr * 64 + fr, fq * 8), boff = lds_byte(wc * 32 + fr, fq * 8);
#define PG8_SA(b, h) (((b) * 2 + (h)) * HTB)
#define PG8_SB(b, h) ((4 + (b) * 2 + (h)) * HTB)
#define PG8_STAGE(bufoff, gbase, voff) do { _Pragma("unroll") for (int _i = 0; _i < 2; ++_i) \
        __builtin_amdgcn_global_load_lds((const unsigned*)((const char*)(gbase) + (voff)[_i]), (LAS unsigned*)(lds + (bufoff) + ldsw + _i * 8192), 16, 0, 0); } while (0)
#define PG8_LDA(dst, b, h) do { _Pragma("unroll") for (int m = 0; m < 4; ++m) _Pragma("unroll") for (int k = 0; k < 2; ++k) dst[m][k] = *(const LAS bf16x8*)(lds + PG8_SA(b, h) + aoff + m * 2048 + k * 1024); } while (0)
#define PG8_LDB(dst, b, h) do { _Pragma("unroll") for (int n = 0; n < 2; ++n) _Pragma("unroll") for (int k = 0; k < 2; ++k) dst[n][k] = *(const LAS bf16x8*)(lds + PG8_SB(b, h) + boff + n * 2048 + k * 1024); } while (0)
#define PG8_MMA(ai, bj, At, Bt) do { __builtin_amdgcn_s_setprio(1); _Pragma("unroll") for (int m = 0; m < 4; ++m) _Pragma("unroll") for (int n = 0; n < 2; ++n) _Pragma("unroll") for (int k = 0; k < 2; ++k) \
        acc[ai][bj][m][n] = __builtin_amdgcn_mfma_f32_16x16x32_bf16(Bt[n][k], At[m][k], acc[ai][bj][m][n], 0, 0, 0); __builtin_amdgcn_s_setprio(0); } while (0)
#define PG8_WAIT_V(n) asm volatile("s_waitcnt vmcnt(" #n ")" ::: "memory")
#define PG8_WAIT_L(n) asm volatile("s_waitcnt lgkmcnt(" #n ")" ::: "memory")
#define PG8_BAR __builtin_amdgcn_s_barrier()
#define PG8_SCHED __builtin_amdgcn_sched_barrier(0)
    Unit cur, nxt; int ui = 0;
    if (!S.next(0, cur)) return;
    f32x4 acc[2][2][4][2];
#pragma unroll
    for (int a = 0; a < 2; ++a)
#pragma unroll
        for (int b = 0; b < 2; ++b)
#pragma unroll
            for (int m = 0; m < 4; ++m)
#pragma unroll
                for (int n = 0; n < 2; ++n) acc[a][b][m][n] = (f32x4){0.f, 0.f, 0.f, 0.f};
    bf16x8 At[4][2], B0[2][2], B1[2][2];
    const char* cA; const char* cB; S.tiles(cur, cA, cB);
    PG8_STAGE(PG8_SB(0, 0), cB, voffB); PG8_STAGE(PG8_SB(0, 1), cB + hstep, voffB); PG8_STAGE(PG8_SA(0, 0), cA, voffA); PG8_STAGE(PG8_SA(0, 1), cA + hstep, voffA);
    if (wr == 1) PG8_BAR;
    PG8_WAIT_V(2); PG8_BAR;
    PG8_STAGE(PG8_SB(1, 0), cB + kstep, voffB); PG8_STAGE(PG8_SA(1, 0), cA + kstep, voffA); PG8_STAGE(PG8_SB(1, 1), cB + hstep + kstep, voffB);
    PG8_WAIT_V(6); PG8_BAR;
    for (;;) {
        const bool has_next = S.next(ui + 1, nxt);
        const char* nA = cA; const char* nB = cB; if (has_next) S.tiles(nxt, nA, nB);
#define PG8_KT2(t, last) do { \
            const char* a1 = cA + (size_t)((t) + 1) * kstep; \
            const char* a2 = (last) ? nA : cA + (size_t)((t) + 2) * kstep; const char* b2 = (last) ? nB : cB + (size_t)((t) + 2) * kstep; \
            const char* a3 = a2 + kstep; const char* b3 = b2 + kstep; \
            PG8_LDB(B0, 0, 0); PG8_LDB(B1, 0, 1); PG8_SCHED; PG8_LDA(At, 0, 0); PG8_STAGE(PG8_SA(1, 1), a1 + hstep, voffA); \
            PG8_WAIT_V(8); PG8_WAIT_L(0); PG8_BAR; PG8_MMA(0, 0, At, B0); PG8_MMA(0, 1, At, B1); PG8_BAR; PG8_SCHED; \
            PG8_LDA(At, 0, 1); PG8_STAGE(PG8_SB(0, 0), b2, voffB); PG8_STAGE(PG8_SB(0, 1), b2 + hstep, voffB); PG8_STAGE(PG8_SA(0, 0), a2, voffA); \
            PG8_WAIT_V(8); PG8_WAIT_L(0); PG8_BAR; PG8_MMA(1, 0, At, B0); PG8_MMA(1, 1, At, B1); PG8_BAR; PG8_SCHED; \
            PG8_LDB(B0, 1, 0); PG8_LDB(B1, 1, 1); PG8_SCHED; PG8_LDA(At, 1, 0); PG8_STAGE(PG8_SA(0, 1), a2 + hstep, voffA); \
            PG8_WAIT_V(8); PG8_WAIT_L(0); PG8_BAR; PG8_MMA(0, 0, At, B0); PG8_MMA(0, 1, At, B1); PG8_BAR; PG8_SCHED; \
            PG8_LDA(At, 1, 1); PG8_STAGE(PG8_SB(1, 0), b3, voffB); PG8_STAGE(PG8_SB(1, 1), b3 + hstep, voffB); PG8_STAGE(PG8_SA(1, 0), a3, voffA); \
            PG8_WAIT_V(8); PG8_WAIT_L(0); PG8_BAR; PG8_MMA(1, 0, At, B0); PG8_MMA(1, 1, At, B1); PG8_BAR; PG8_SCHED; } while (0)
        {
            const int ntc = S.ntiles(cur);
#pragma unroll 1
            for (int t = 0; t < ntc; t += 2) { const bool last = (t == ntc - 2); PG8_KT2(t, last); }
        }
        if constexpr (ALIGN_EPI) { if (wr == 0) PG8_BAR; }
        E(acc, cur, wr, wc, fr, fq);
        if (!has_next) break;
        if (!S.keep_acc(nxt)) {
#pragma unroll
        for (int a = 0; a < 2; ++a)
#pragma unroll
            for (int b = 0; b < 2; ++b)
#pragma unroll
                for (int m = 0; m < 4; ++m)
#pragma unroll
                    for (int n = 0; n < 2; ++n) acc[a][b][m][n] = (f32x4){0.f, 0.f, 0.f, 0.f};
        }
        cur = nxt; cA = nA; cB = nB; ++ui;
        if constexpr (ALIGN_EPI) { if (wr == 1) PG8_BAR; }
    }
    PG8_WAIT_V(0);
    if constexpr (!ALIGN_EPI) { if (wr == 0) PG8_BAR; }
    PG8_BAR;
#undef PG8_KT2
#undef PG8_SA
#undef PG8_SB
#undef PG8_STAGE
#undef PG8_LDA
#undef PG8_LDB
#undef PG8_MMA
#undef PG8_WAIT_V
#undef PG8_WAIT_L
#undef PG8_BAR
#undef PG8_SCHED
}
}

struct Args {
    const float* in[22]; float* out; unsigned char* ws; int ph_lo, ph_hi;
};
enum { I_X = 0, I_NMIXPRE, I_NMIXPOST, I_NMLPPRE, I_NMLPPOST, I_WIN, I_LCW, I_LCB, I_LWA, I_LBA, I_LWX, I_LBX, I_LLAM, I_PW, I_PS, I_HLB, I_HN, I_SW, I_WBR, I_WOUT, I_WUP, I_WDOWN };

struct Ctx {
    LAS unsigned char* lds; int tid, lane, wave, vcu, G;
};

__device__ __forceinline__ void transpose_item(const float* W, int ldw, const float* gain, bf16_t* WT, int ldo, int col_off, int k0, int n0, LAS float* scr, int lane) {
#pragma unroll 8
    for (int i = 0; i < 32; ++i) { const int kk = 2 * i + (lane >> 5); const float g = gain ? gain[k0 + kk] : 1.0f; scr[kk * 33 + (lane & 31)] = g * W[(size_t)(k0 + kk) * ldw + n0 + (lane & 31)]; }
    asm volatile("s_waitcnt lgkmcnt(0)" ::: "memory");
    const int c = lane & 7;
#pragma unroll
    for (int j = 0; j < 4; ++j) { const int n = (lane >> 3) + 8 * j; const LAS float* s = scr + (8 * c) * 33 + n;
        u32x4 o; o.x = pk2(s[0 * 33], s[1 * 33]); o.y = pk2(s[2 * 33], s[3 * 33]); o.z = pk2(s[4 * 33], s[5 * 33]); o.w = pk2(s[6 * 33], s[7 * 33]);
        *(u32x4*)(WT + (size_t)(n0 + n) * ldo + col_off + k0 + 8 * c) = o; }
    asm volatile("s_waitcnt lgkmcnt(0)" ::: "memory");
}

__device__ __forceinline__ void p0_prologue(const Ctx& C, const Args& A) {
    LAS float* scr = (LAS float*)(C.lds + C.wave * 16384);
    const int gw = C.vcu * NWAVES + C.wave, NGW = C.G * NWAVES;
    constexpr int I_IN = (D / 64) * (INW / 32), I_BR1 = (BW / 64) * (D / 32), I_OUT = (D / 64) * (D / 32), I_UP = (D / 64) * (FF / 32), I_DN = (FF / 64) * (D / 32);
    constexpr int PER_LAYER = I_IN + 4 * I_BR1 + I_OUT + I_UP + I_DN;
    for (int it = gw; it < DEPTH * PER_LAYER; it += NGW) {
        const int l = it / PER_LAYER; int r = it % PER_LAYER;
        bf16_t* wl = (bf16_t*)(A.ws + WS_W + (size_t)l * W_LAYER);
        if (r < I_IN) { const int nb = INW / 32; transpose_item(A.in[I_WIN] + (size_t)l * D * INW, INW, A.in[I_NMIXPRE] + l * D, wl + W_IN / 2, D, 0, 64 * (r / nb), 32 * (r % nb), scr, C.lane); continue; } r -= I_IN;
        if (r < 4 * I_BR1) { const int k = r / I_BR1, rr = r % I_BR1, nb = D / 32; transpose_item(A.in[I_WBR] + ((size_t)l * 4 + k) * BW * D, D, nullptr, wl + W_BR / 2, D, k * BW, 64 * (rr / nb), 32 * (rr % nb), scr, C.lane); continue; } r -= 4 * I_BR1;
        if (r < I_OUT) { const int nb = D / 32; transpose_item(A.in[I_WOUT] + (size_t)l * D * D, D, nullptr, wl + W_OUT / 2, D, 0, 64 * (r / nb), 32 * (r % nb), scr, C.lane); continue; } r -= I_OUT;
        if (r < I_UP) { const int nb = FF / 32; transpose_item(A.in[I_WUP] + (size_t)l * D * FF, FF, A.in[I_NMLPPRE] + l * D, wl + W_UP / 2, D, 0, 64 * (r / nb), 32 * (r % nb), scr, C.lane); continue; } r -= I_UP;
        { const int nb = D / 32; transpose_item(A.in[I_WDOWN] + (size_t)l * FF * D, D, nullptr, wl + W_DOWN / 2, FF, 0, 64 * (r / nb), 32 * (r % nb), scr, C.lane); }
    }
    bf16_t* HB = (bf16_t*)(A.ws + WS_HB); float* RS = (float*)(A.ws + WS_RS);
    for (int m = gw; m < M; m += NGW) {
        const f32x4* xr = (const f32x4*)(A.in[I_X] + (size_t)m * D) + C.lane;
        f32x4 v[4]; float s = 0.f;
#pragma unroll
        for (int j = 0; j < 4; ++j) { v[j] = xr[64 * j]; s += (v[j].x * v[j].x + v[j].y * v[j].y) + (v[j].z * v[j].z + v[j].w * v[j].w); }
        s = wave_sum(s);
        u32x2* o8 = (u32x2*)(HB + (size_t)m * D) + C.lane;
#pragma unroll
        for (int j = 0; j < 4; ++j) { u32x2 w; w.x = pk2(v[j].x, v[j].y); w.y = pk2(v[j].z, v[j].w); o8[64 * j] = w; }
        if (C.lane == 0) RS[m] = 1.0f / sqrtf(s * (1.0f / D) + EPS);
    }
}

__device__ __forceinline__ void norm_phase(const Ctx& C, const Args& A, const float* hin, const float* gain) {
    bf16_t* HB = (bf16_t*)(A.ws + WS_HB); float* RS = (float*)(A.ws + WS_RS); float* OUT = A.out;
    int lane = C.lane; asm volatile("" : "+v"(lane));
    const int gw = C.vcu * NWAVES + C.wave, NGW = C.G * NWAVES;
    f32x4 g[4];
#pragma unroll
    for (int j = 0; j < 4; ++j) g[j] = ((const f32x4*)gain)[lane + 64 * j];
    for (int m = gw; m < M; m += NGW) {
        u32x2* vb = (u32x2*)(HB + (size_t)m * D) + lane;
        const f32x4* hr = (const f32x4*)(hin + (size_t)m * D) + lane;
        f32x4 v[4], h[4]; float s = 0.f;
#pragma unroll
        for (int j = 0; j < 4; ++j) { const u32x2 w = vb[64 * j]; h[j] = hr[64 * j]; v[j] = (f32x4){bf2f(w.x & 0xffffu), bf2f(w.x >> 16), bf2f(w.y & 0xffffu), bf2f(w.y >> 16)};
            s += (v[j].x * v[j].x + v[j].y * v[j].y) + (v[j].z * v[j].z + v[j].w * v[j].w); }
        const float r = 1.0f / sqrtf(wave_sum(s) * (1.0f / D) + EPS);
        float s2 = 0.f;
#pragma unroll
        for (int j = 0; j < 4; ++j) { h[j] = h[j] + g[j] * v[j] * r; s2 += (h[j].x * h[j].x + h[j].y * h[j].y) + (h[j].z * h[j].z + h[j].w * h[j].w); }
        s2 = wave_sum(s2);
        f32x4* orow = (f32x4*)(OUT + (size_t)m * D) + lane;
#pragma unroll
        for (int j = 0; j < 4; ++j) { orow[64 * j] = h[j]; u32x2 w; w.x = pk2(h[j].x, h[j].y); w.y = pk2(h[j].z, h[j].w); vb[64 * j] = w; }
        if (lane == 0) RS[m] = 1.0f / sqrtf(s2 * (1.0f / D) + EPS);
    }
}

__device__ __forceinline__ float gelu_tanh(float x) {
    const float u = 0.7978845608028654f * (x + 0.044715f * x * x * x);
    const float e = fast_exp(2.0f * u);
    const float th = 1.0f - 2.0f * __builtin_amdgcn_rcpf(e + 1.0f);
    return 0.5f * x * (1.0f + th);
}

template <bool FINAL>
__device__ __forceinline__ void lru_item(const Ctx& C, const Args& A, int l, int b, int c) {
    const bf16_t* PROJ = (const bf16_t*)(A.ws + WS_PROJ);
    LAS float* XS = (LAS float*)C.lds;
    LAS float* XC = (LAS float*)(C.lds + 69632);
    int tid = C.tid; asm volatile("" : "+v"(tid));
    const int ch = tid & 255, half = tid >> 8;
    const size_t m0 = (size_t)b * T + (size_t)c * 64;
    for (int idx = tid; idx < 67 * 32; idx += NTHREADS) {
        const int r = idx >> 5, c8 = idx & 31; const int tok = c * 64 - 3 + r;
        float v[8];
        if (tok >= 0) ld8bf(PROJ + ((size_t)b * T + tok) * NMIX + c8 * 8, v); else {
#pragma unroll
            for (int j = 0; j < 8; ++j) v[j] = 0.f; }
#pragma unroll
        for (int j = 0; j < 8; ++j) XS[r * 256 + c8 * 8 + j] = v[j];
    }
    __syncthreads();
    {
        const float* cw = A.in[I_LCW] + (size_t)l * 4 * BW; const float w0 = cw[ch], w1 = cw[BW + ch], w2 = cw[2 * BW + ch], w3 = cw[3 * BW + ch], cb = A.in[I_LCB][l * BW + ch];
#pragma unroll 1
        for (int t = half * 32; t < half * 32 + 32; ++t)
            XC[t * 256 + ch] = cb + w0 * XS[t * 256 + ch] + w1 * XS[(t + 1) * 256 + ch] + w2 * XS[(t + 2) * 256 + ch] + w3 * XS[(t + 3) * 256 + ch];
    }
    __syncthreads();
    const int blk = ch >> 5, o = ch & 31;
    float wa[32], wx[32];
    {
        const float* pa = A.in[I_LWA] + (((size_t)l * 8 + blk) * 32) * 32 + o; const float* px = A.in[I_LWX] + (((size_t)l * 8 + blk) * 32) * 32 + o;
#pragma unroll
        for (int j = 0; j < 32; ++j) { wa[j] = pa[j * 32]; wx[j] = px[j * 32]; }
    }
    const float ba = A.in[I_LBA][l * BW + ch], bx = A.in[I_LBX][l * BW + ch];
    const float lam = A.in[I_LLAM][l * BW + ch];
    const float sp = (-lam > 20.f) ? -lam : log1pf(expf(-lam));
    const int sc = c * 2 + half;
    const size_t aggi = ((size_t)b * 128 + sc) * 256 + ch;
    float hst = 0.f, P = 1.f;
    if (FINAL) hst = ((const float*)(A.ws + WS_LC))[aggi];
    bf16_t* YS = (bf16_t*)(A.ws + WS_YS);
#pragma unroll 1
    for (int t = half * 32; t < half * 32 + 32; ++t) {
        float rp = ba, ip = bx;
        const LAS f32x4* xr = (const LAS f32x4*)(XC + t * 256 + blk * 32);
#pragma unroll
        for (int j4 = 0; j4 < 8; ++j4) { const f32x4 x = xr[j4];
            rp += x.x * wa[4 * j4] + x.y * wa[4 * j4 + 1] + x.z * wa[4 * j4 + 2] + x.w * wa[4 * j4 + 3];
            ip += x.x * wx[4 * j4] + x.y * wx[4 * j4 + 1] + x.z * wx[4 * j4 + 2] + x.w * wx[4 * j4 + 3]; }
        const float r = sigmoid_f(rp), ig = sigmoid_f(ip);
        const float log_a = -8.0f * r * sp;
        const float a = expf(log_a);
        const float mult = sqrtf(-expm1f(2.0f * log_a));
        const float xc = XC[t * 256 + ch];
        const float u = mult * ig * xc;
        hst = a * hst + u; P *= a;
        if (FINAL) {
            const float gate = bf2f(PROJ[(m0 + t) * NMIX + 256 + ch]);
            YS[(m0 + t) * D + ch] = (bf16_t)f2bf((DBG_ZERO == 0 ? 0.f : 1.f) * hst * gelu_tanh(gate));
        }
    }
    if (!FINAL) { ((float*)(A.ws + WS_LA))[aggi] = P; ((float*)(A.ws + WS_LH))[aggi] = hst; }
    __syncthreads();
}

__device__ __forceinline__ void pool_sconv_item(const Ctx& C, const Args& A, int l, int b, int c) {
    const bf16_t* PROJ = (const bf16_t*)(A.ws + WS_PROJ);
    bf16_t* YS = (bf16_t*)(A.ws + WS_YS);
    LAS float* PX = (LAS float*)C.lds;
    LAS float* DD = (LAS float*)(C.lds + 81920);
    int tid = C.tid; asm volatile("" : "+v"(tid));
    const int ch = tid & 255, half = tid >> 8;
    const size_t m0 = (size_t)b * T + (size_t)c * 64;
    for (int idx = tid; idx < 79 * 32; idx += NTHREADS) {
        const int r = idx >> 5, c8 = idx & 31; const int tok = c * 64 - 15 + r;
        float v[8];
        if (tok >= 0) ld8bf(PROJ + ((size_t)b * T + tok) * NMIX + 512 + c8 * 8, v); else {
#pragma unroll
            for (int j = 0; j < 8; ++j) v[j] = 0.f; }
#pragma unroll
        for (int j = 0; j < 8; ++j) PX[r * 256 + c8 * 8 + j] = v[j];
    }
    __syncthreads();
    {
        const int g = ch >> 6, win = 2 << g;
        const int t0 = half * 32;
        float sum = 0.f;
#pragma unroll 1
        for (int j = 1; j < win; ++j) sum += PX[(t0 + 15 - j) * 256 + ch];
#pragma unroll 1
        for (int t = t0; t < t0 + 32; ++t) {
            const float x = PX[(t + 15) * 256 + ch];
            sum += x;
            const int pos = c * 64 + t + 1;
            const float cnt = (float)(pos < win ? pos : win);
            DD[t * 256 + ch] = sum / cnt - x;
            sum -= PX[(t + 15 - (win - 1)) * 256 + ch];
        }
    }
    __syncthreads();
    {
        const int g = ch >> 6, o = ch & 63;
        const float* pw = A.in[I_PW] + (((size_t)l * 4 + g) * 64) * 64 + o;
        float w[64];
#pragma unroll
        for (int j = 0; j < 64; ++j) w[j] = pw[j * 64];
        const float scl = A.in[I_PS][l * BW + ch];
#pragma unroll 1
        for (int t = half * 32; t < half * 32 + 32; ++t) {
            const LAS f32x4* dr = (const LAS f32x4*)(DD + t * 256 + g * 64);
            float y = 0.f;
#pragma unroll
            for (int j4 = 0; j4 < 16; ++j4) { const f32x4 d = dr[j4]; y += d.x * w[4 * j4] + d.y * w[4 * j4 + 1] + d.z * w[4 * j4 + 2] + d.w * w[4 * j4 + 3]; }
            YS[(m0 + t) * D + 256 + ch] = (bf16_t)f2bf((DBG_ZERO == 1 ? 0.f : 1.f) * y * scl);
        }
    }
    {
        const float* sw = A.in[I_SW] + (size_t)l * 3 * BW; const float w0 = sw[ch], w1 = sw[BW + ch], w2 = sw[2 * BW + ch];
        const int t0 = half * 32; float z0 = 0.f, z1 = 0.f;
        {
            const int tk = c * 64 + t0;
            if (tk >= 2) { const bf16_t* p = PROJ + (m0 + t0 - 2) * NMIX; z0 = bf2f(p[2048 + ch]) * bf2f(p[2304 + ch]); }
            if (tk >= 1) { const bf16_t* p = PROJ + (m0 + t0 - 1) * NMIX; z1 = bf2f(p[2048 + ch]) * bf2f(p[2304 + ch]); }
        }
#pragma unroll 1
        for (int t = t0; t < t0 + 32; ++t) {
            const bf16_t* p = PROJ + (m0 + t) * NMIX;
            const float z2 = bf2f(p[2048 + ch]) * bf2f(p[2304 + ch]);
            const float y = bf2f(p[1792 + ch]) * (w0 * z0 + w1 * z1 + w2 * z2);
            YS[(m0 + t) * D + 768 + ch] = (bf16_t)f2bf((DBG_ZERO == 3 ? 0.f : 1.f) * y);
            z0 = z1; z1 = z2;
        }
    }
    __syncthreads();
}

constexpr int HP = 65;
__device__ __forceinline__ float hgrn_lb(const Args& A, int l, int w) {
    if (l == 0) return 0.f;
    const float a0 = A.in[I_HLB][w], a1 = A.in[I_HLB][BW + w];
    return 1.0f / (1.0f + expf(a0 - a1));
}
__device__ __forceinline__ void hgrn_load(const bf16_t* src  , LAS float* dst, int tid) {
    const int t = tid >> 3, d0 = (tid & 7) * 8; float v[8]; ld8bf(src + (size_t)t * NMIX + d0, v);
#pragma unroll
    for (int j = 0; j < 8; ++j) dst[t * HP + d0 + j] = v[j];
}
__device__ __forceinline__ void hgrn_decay(int tid, const Args& A, int l, int h, LAS float* Bm, LAS float* KK) {
    const int t = tid >> 3, d0 = (tid & 7) * 8;
#pragma unroll
    for (int j = 0; j < 8; ++j) { const int d = d0 + j; const float lb = hgrn_lb(A, l, h * 64 + d);
        const float f = fmaxf(lb + (1.0f - lb) * sigmoid_f(Bm[t * HP + d]), 1e-30f); Bm[t * HP + d] = logf(f); KK[t * HP + d] = 1.0f - f; }
    __syncthreads();
    if (tid < 64) { float s = 0.f; for (int tt = 0; tt < 64; ++tt) { s += Bm[tt * HP + tid]; Bm[tt * HP + tid] = s; } }
    __syncthreads();
}

__device__ __forceinline__ void hgrn_m1_item(const Ctx& C, const Args& A, int l, int b, int c, int h) {
    const bf16_t* PROJ = (const bf16_t*)(A.ws + WS_PROJ);
    LAS float* Bm = (LAS float*)C.lds; LAS float* KK = Bm + 64 * HP; LAS float* V = KK + 64 * HP;
    int tid = C.tid; asm volatile("" : "+v"(tid)); const size_t m0 = (size_t)b * T + (size_t)c * 64;
    hgrn_load(PROJ + m0 * NMIX + 1024 + h * 64, Bm, tid);
    hgrn_load(PROJ + m0 * NMIX + 1280 + h * 64, V, tid);
    __syncthreads();
    hgrn_decay(tid, A, l, h, Bm, KK);
    {
        const int t = tid >> 3, d0 = (tid & 7) * 8;
#pragma unroll
        for (int j = 0; j < 8; ++j) { const int d = d0 + j; KK[t * HP + d] *= expf(Bm[63 * HP + d] - Bm[t * HP + d]); }
    }
    __syncthreads();
    const int bh = b * 4 + h; const size_t ci = (size_t)bh * 64 + c;
    if (tid < 64) ((float*)(A.ws + WS_SD))[ci * 64 + tid] = expf(Bm[63 * HP + tid]);
    {
        const int dk = tid >> 3, v0 = (tid & 7) * 8; float acc[8];
#pragma unroll
        for (int j = 0; j < 8; ++j) acc[j] = 0.f;
        for (int s = 0; s < 64; ++s) { const float kd = KK[s * HP + dk];
#pragma unroll
            for (int j = 0; j < 8; ++j) acc[j] += kd * V[s * HP + v0 + j]; }
        float* su = (float*)(A.ws + WS_SU) + ci * 4096 + dk * 64 + v0;
        *(f32x4*)su = (f32x4){acc[0], acc[1], acc[2], acc[3]}; *(f32x4*)(su + 4) = (f32x4){acc[4], acc[5], acc[6], acc[7]};
    }
    __syncthreads();
}

__device__ __forceinline__ void hgrn_m3_item(const Ctx& C, const Args& A, int l, int b, int c, int h) {
    const bf16_t* PROJ = (const bf16_t*)(A.ws + WS_PROJ);
    LAS float* Bm = (LAS float*)C.lds; LAS float* KK = Bm + 64 * HP; LAS float* V = KK + 64 * HP; LAS float* Q = V + 64 * HP; LAS float* SC = Q + 64 * HP; LAS float* S = SC + 64 * HP;
    int tid = C.tid; asm volatile("" : "+v"(tid)); const size_t m0 = (size_t)b * T + (size_t)c * 64;
    const int bh = b * 4 + h; const size_t ci = (size_t)bh * 64 + c;
    hgrn_load(PROJ + m0 * NMIX + 1024 + h * 64, Bm, tid);
    hgrn_load(PROJ + m0 * NMIX + 1280 + h * 64, V, tid);
    hgrn_load(PROJ + m0 * NMIX + 768 + h * 64, Q, tid);
    {
        const int dk = tid >> 3, v0 = (tid & 7) * 8; const float* su = (const float*)(A.ws + WS_SU) + ci * 4096 + dk * 64 + v0;
        const f32x4 s0 = *(const f32x4*)su, s1 = *(const f32x4*)(su + 4);
        S[dk * HP + v0] = s0.x; S[dk * HP + v0 + 1] = s0.y; S[dk * HP + v0 + 2] = s0.z; S[dk * HP + v0 + 3] = s0.w;
        S[dk * HP + v0 + 4] = s1.x; S[dk * HP + v0 + 5] = s1.y; S[dk * HP + v0 + 6] = s1.z; S[dk * HP + v0 + 7] = s1.w;
    }
    __syncthreads();
    hgrn_decay(tid, A, l, h, Bm, KK);
    {
        const int t = tid >> 3, sg = tid & 7;
#pragma unroll 1
        for (int j = 0; j < 8; ++j) { const int s = sg + 8 * j; float a = 0.f;
            if (s <= t) { for (int dk = 0; dk < 64; ++dk) a += Q[t * HP + dk] * KK[s * HP + dk] * fast_exp(Bm[t * HP + dk] - Bm[s * HP + dk]); }
            SC[t * HP + s] = a; }
    }
    __syncthreads();
    {
        const int t = tid >> 3, v0 = (tid & 7) * 8; float acc[8];
#pragma unroll
        for (int j = 0; j < 8; ++j) acc[j] = 0.f;
        for (int s = 0; s <= t; ++s) { const float p = SC[t * HP + s];
#pragma unroll
            for (int j = 0; j < 8; ++j) acc[j] += p * V[s * HP + v0 + j]; }
        for (int dk = 0; dk < 64; ++dk) { const float qb = Q[t * HP + dk] * fast_exp(Bm[t * HP + dk]);
#pragma unroll
            for (int j = 0; j < 8; ++j) acc[j] += qb * S[dk * HP + v0 + j]; }
        float ss = 0.f;
#pragma unroll
        for (int j = 0; j < 8; ++j) ss += acc[j] * acc[j];
        ss += __shfl_xor(ss, 1); ss += __shfl_xor(ss, 2); ss += __shfl_xor(ss, 4);
        const float rn = 1.0f / sqrtf(ss * (1.0f / 64.0f) + EPS);
        float g[8]; ld8bf(PROJ + (m0 + t) * NMIX + 1536 + h * 64 + v0, g);
        const float* gn = A.in[I_HN] + l * 64 + v0;
        float y[8];
#pragma unroll
        for (int j = 0; j < 8; ++j) { const float sil = g[j] * sigmoid_f(g[j]); y[j] = (DBG_ZERO == 2 ? 0.f : 1.f) * acc[j] * rn * gn[j] * sil; }
        u32x4 w; w.x = pk2(y[0], y[1]); w.y = pk2(y[2], y[3]); w.z = pk2(y[4], y[5]); w.w = pk2(y[6], y[7]);
        *(u32x4*)((bf16_t*)(A.ws + WS_YS) + (m0 + t) * D + 512 + h * 64 + v0) = w;
    }
    __syncthreads();
}

__device__ __forceinline__ void mix_phase2(const Ctx& C, const Args& A) {
    float* __restrict__ SU = (float*)(A.ws + WS_SU); const float* __restrict__ SD = (const float*)(A.ws + WS_SD);
    const int gt = C.vcu * NTHREADS + C.tid, NGT = C.G * NTHREADS;
    for (int e = gt; e < 32 * 4096; e += NGT) {
        const int bh = e >> 12, kv = e & 4095, dk = kv >> 6;
        float s = 0.f;
#pragma unroll 8
        for (int c = 0; c < 64; ++c) { const size_t ci = (size_t)bh * 64 + c; const float u = SU[ci * 4096 + kv]; const float d = SD[ci * 64 + dk]; SU[ci * 4096 + kv] = s; s = d * s + u; }
    }
    const float* __restrict__ LA = (const float*)(A.ws + WS_LA); const float* __restrict__ LH = (const float*)(A.ws + WS_LH); float* __restrict__ LC = (float*)(A.ws + WS_LC);
    for (int e = gt; e < BATCH * BW; e += NGT) {
        const int b = e >> 8, ch = e & 255; float cr = 0.f;
#pragma unroll 16
        for (int sc = 0; sc < 128; ++sc) { const size_t i = ((size_t)b * 128 + sc) * 256 + ch; const float a = LA[i], hh = LH[i]; LC[i] = cr; cr = a * cr + hh; }
    }
}

#define XB_TMO      128
#define XB_XCNT(j)  (256  + 64 * (j))
#define XB_XSUB(j)  (1280 + 64 * (j))
#define XB_XGEN(j)  (2304 + 64 * (j))
#define XB_TOP      3328
#define XB_TOPGEN   3392
#define XCD_BAR_WORDS 3456
#define XB_SPIN_CAP (1u << 20)
__device__ __forceinline__ unsigned xb_ld(unsigned* p)              { return __hip_atomic_load(p, __ATOMIC_RELAXED, __HIP_MEMORY_SCOPE_AGENT); }
__device__ __forceinline__ unsigned xb_add(unsigned* p, unsigned v) { return __hip_atomic_fetch_add(p, v, __ATOMIC_RELAXED, __HIP_MEMORY_SCOPE_AGENT); }
__device__ __forceinline__ unsigned xb_xcc_id() { return (unsigned)__builtin_amdgcn_s_getreg((3 << 11) | 20) & 0xFu; }
#define XB_SPIN(cond, bar) do { unsigned _sp = 0; while (cond) { __builtin_amdgcn_s_sleep(1); \
    if ((++_sp & 255u) == 0u) { if (xb_ld(&(bar)[XB_TMO])) break; if (_sp > XB_SPIN_CAP) { atomicAdd(&(bar)[XB_TMO], 1u); break; } } } } while (0)
struct XcdBarrier { unsigned* bar; unsigned x; volatile LAS unsigned* st; };
__device__ __forceinline__ XcdBarrier xcd_barrier_post(unsigned* bar, volatile LAS unsigned* st) {
    XcdBarrier b; b.bar = bar; b.x = xb_xcc_id(); b.st = st;
    if (threadIdx.x == 0) (void)xb_add(&bar[XB_XCNT(b.x)], 1u);
    return b;
}
__device__ __forceinline__ void xcd_barrier_complete(unsigned* bar, unsigned x, unsigned& nloc, unsigned& nx) {
    const unsigned G = gridDim.x * gridDim.y * gridDim.z;
    unsigned sum, cnt, mine, sp = 0u;
    for (;;) {
        sum = 0u; cnt = 0u; mine = 0u;
#pragma unroll
        for (unsigned j = 0; j < 16; ++j) { const unsigned c = xb_ld(&bar[XB_XCNT(j)]); sum += c; cnt += (c > 0u) ? 1u : 0u; mine = (j == x) ? c : mine; }
        if (sum == G) break;
        __builtin_amdgcn_s_sleep(1);
        if ((++sp & 255u) == 0u) { if (xb_ld(&bar[XB_TMO])) break; if (sp > XB_SPIN_CAP) { atomicAdd(&bar[XB_TMO], 1u); break; } }
    }
    nloc = mine > 0u ? mine : 1u; nx = cnt > 0u ? cnt : 1u;
}
__device__ __forceinline__ void xcd_barrier(const XcdBarrier& b) {
    asm volatile("s_waitcnt vmcnt(0)" ::: "memory");
    __syncthreads();
    if (threadIdx.x == 0) {
        unsigned* bar = b.bar;
        __builtin_amdgcn_s_waitcnt(0);
        unsigned nloc = b.st[0], nx = b.st[1];
        if (nloc == 0u) { xcd_barrier_complete(bar, b.x, nloc, nx); b.st[0] = nloc; b.st[1] = nx; }
        const unsigned old = xb_add(&bar[XB_XSUB(b.x)], 1u);
        const unsigned gen = old / nloc;
        if (old + 1u == (gen + 1u) * nloc) {
            __builtin_amdgcn_fence(__ATOMIC_RELEASE, "agent");
            asm volatile("s_waitcnt vmcnt(0)" ::: "memory");
            const unsigned og = xb_add(&bar[XB_TOP], 1u);
            const unsigned tg = og / nx;
            if (og + 1u == (tg + 1u) * nx) xb_add(&bar[XB_TOPGEN], 1u);
            else XB_SPIN(xb_ld(&bar[XB_TOPGEN]) == tg, bar);
            __builtin_amdgcn_fence(__ATOMIC_ACQUIRE, "agent");
            xb_add(&bar[XB_XGEN(b.x)], 1u);
            asm volatile("s_waitcnt vmcnt(0)" ::: "memory");
        } else {
            XB_SPIN(xb_ld(&bar[XB_XGEN(b.x)]) == gen, bar);
            __builtin_amdgcn_fence(__ATOMIC_ACQUIRE, "agent");
            asm volatile("s_waitcnt vmcnt(0)" ::: "memory");
        }
    }
    __syncthreads();
}

constexpr int PH_PER_LAYER = 10, N_PHASES = 1 + DEPTH * PH_PER_LAYER;
constexpr int CW_BAR = 4096;

__global__ void __launch_bounds__(NTHREADS, 2) trunk_fwd(Args args) {
    extern __shared__ __attribute__((aligned(16))) unsigned char lds_raw[];
    Ctx C;
    C.lds = (LAS unsigned char*)lds_raw; C.tid = threadIdx.x; C.lane = C.tid & 63; C.wave = __builtin_amdgcn_readfirstlane(C.tid >> 6);
    C.G = gridDim.x; { const int bx = blockIdx.x; C.vcu = (C.G % 8 == 0) ? (bx % 8) * (C.G / 8) + bx / 8 : bx; }
    unsigned char* ws = args.ws;
    volatile LAS unsigned* MISC = (volatile LAS unsigned*)(C.lds + MISC_OFF);
    if (C.tid < 64) MISC[C.tid] = 0u;
    __syncthreads();
#if MK_PER_PHASE
#define GRID_BAR() do { } while (0)
#else
    cg::grid_group grid = cg::this_grid();
    XcdBarrier bar = xcd_barrier_post((unsigned*)(ws + WS_CTL) + CW_BAR, MISC + 8);
    bool first_bar = true;
#define GRID_BAR() do { if (first_bar) { grid.sync(); first_bar = false; } else { xcd_barrier(bar); } } while (0)
#endif
    const int lo = args.ph_lo, hi = args.ph_hi;
    int ph = 0;
#define PHASE_BEGIN if (ph >= lo && ph < hi) {
#define PHASE_END   if (ph + 1 < hi && ph + 1 < N_PHASES) GRID_BAR(); } ++ph;

    PHASE_BEGIN p0_prologue(C, args); PHASE_END

    for (int li = 0; li < DEPTH; ++li) {
        int l = li; asm volatile("" : "+s"(l));
        const unsigned char* wl = ws + WS_W + (size_t)l * W_LAYER;
        const float* RS = (const float*)(ws + WS_RS);
        PHASE_BEGIN {
            pg8::StaticOrder S; S.init(ws + WS_HB, wl + W_IN, M, NMIX, D, C.G, (int)blockIdx.x);
            pg8::EpiRow<1> E{(bf16_t*)(ws + WS_PROJ), NMIX, RS};
            pg8::gemm_phase<pg8::EpiRow<1>, pg8::StaticOrder, true>(C.lds, D, S, E);
        } PHASE_END
        PHASE_BEGIN {
            for (int item = C.vcu; item < BATCH * 64; item += C.G) { const int b = item >> 6, c = item & 63;
                lru_item<false>(C, args, l, b, c); pool_sconv_item(C, args, l, b, c);
                for (int h = 0; h < 4; ++h) hgrn_m1_item(C, args, l, b, c, h); }
        } PHASE_END
        PHASE_BEGIN mix_phase2(C, args); PHASE_END
        PHASE_BEGIN {
            for (int item = C.vcu; item < BATCH * 64; item += C.G) { const int b = item >> 6, c = item & 63;
                lru_item<true>(C, args, l, b, c);
                for (int h = 0; h < 4; ++h) hgrn_m3_item(C, args, l, b, c, h); }
        } PHASE_END
        PHASE_BEGIN {
            pg8::GateOrder S{(const char*)(ws + WS_HB), (const char*)(wl + W_IN) + (size_t)NMIX * D * 2, (const char*)(ws + WS_YS), (const char*)(wl + W_BR), C.G, C.vcu};
            pg8::EpiGate E{(bf16_t*)(ws + WS_G) + (size_t)blockIdx.x * 4 * 65536, (bf16_t*)(ws + WS_MERGED), RS};
            pg8::gemm_phase<pg8::EpiGate, pg8::GateOrder, false>(C.lds, D, S, E);
        } PHASE_END
        PHASE_BEGIN {
            pg8::StaticOrder S; S.init(ws + WS_MERGED, wl + W_OUT, M, D, D, C.G, (int)blockIdx.x);
            pg8::EpiRow<0> E{(bf16_t*)(ws + WS_HB), D, nullptr};
            pg8::gemm_phase<pg8::EpiRow<0>, pg8::StaticOrder, true>(C.lds, D, S, E);
        } PHASE_END
        PHASE_BEGIN norm_phase(C, args, l == 0 ? args.in[I_X] : args.out, args.in[I_NMIXPOST] + l * D); PHASE_END
        PHASE_BEGIN {
            pg8::StaticOrder S; S.init(ws + WS_HB, wl + W_UP, M, FF, D, C.G, (int)blockIdx.x);
            pg8::EpiRow<2> E{(bf16_t*)(ws + WS_HID), FF, RS};
            pg8::gemm_phase<pg8::EpiRow<2>, pg8::StaticOrder, true>(C.lds, D, S, E);
        } PHASE_END
        PHASE_BEGIN {
            pg8::StaticOrder S; S.init(ws + WS_HID, wl + W_DOWN, M, D, FF, C.G, (int)blockIdx.x);
            pg8::EpiRow<0> E{(bf16_t*)(ws + WS_HB), D, nullptr};
            pg8::gemm_phase<pg8::EpiRow<0>, pg8::StaticOrder, true>(C.lds, FF, S, E);
        } PHASE_END
        PHASE_BEGIN norm_phase(C, args, args.out, args.in[I_NMLPPOST] + l * D); PHASE_END
    }
}

extern "C" void kernel_launch(void* const* d_in, const int* in_sizes, int n_in, void* d_out, int out_size, void* d_ws, size_t ws_size, hipStream_t stream) {
    static int grid = 0;
    if (grid == 0) {
        if (n_in != 22 || in_sizes[0] != M * D || out_size != M * D || ws_size < WS_END) { fprintf(stderr, "kernel_launch: unexpected shapes (n_in %d, in0 %d, out %d, ws %zu)\n", n_in, n_in > 0 ? in_sizes[0] : -1, out_size, ws_size); grid = -1; return; }
        int dev = 0, cus = 0, per_cu = 0;
        if (hipGetDevice(&dev) != hipSuccess || hipDeviceGetAttribute(&cus, hipDeviceAttributeMultiprocessorCount, dev) != hipSuccess) { grid = -1; return; }
        if (hipFuncSetAttribute((const void*)trunk_fwd, hipFuncAttributeMaxDynamicSharedMemorySize, LDS_BYTES) != hipSuccess) { fprintf(stderr, "kernel_launch: hipFuncSetAttribute failed\n"); grid = -1; return; }
        if (hipOccupancyMaxActiveBlocksPerMultiprocessor(&per_cu, (const void*)trunk_fwd, NTHREADS, LDS_BYTES) != hipSuccess || per_cu < 1) { fprintf(stderr, "kernel_launch: occupancy query says %d blocks per CU\n", per_cu); (void)hipGetLastError(); grid = -1; return; }
        grid = cus;
    }
    if (grid < 0) return;
    (void)hipMemsetAsync((char*)d_ws + WS_CTL, 0, CTL_ZERO_BYTES, stream);
    Args a{};
    for (int i = 0; i < 22; ++i) a.in[i] = (const float*)d_in[i];
    a.out = (float*)d_out; a.ws = (unsigned char*)d_ws;
#if MK_PER_PHASE
#ifndef DBG_MAXPH
#define DBG_MAXPH N_PHASES
#endif
    for (int p = 0; p < DBG_MAXPH; ++p) { a.ph_lo = p; a.ph_hi = p + 1; hipLaunchKernelGGL(trunk_fwd, dim3(grid), dim3(NTHREADS), LDS_BYTES, stream, a); }
#else
    a.ph_lo = 0; a.ph_hi = N_PHASES;
    void* kargs[] = {&a};
    hipError_t e = hipLaunchCooperativeKernel((const void*)trunk_fwd, dim3(grid), dim3(NTHREADS), kargs, LDS_BYTES, stream);
    if (e != hipSuccess) fprintf(stderr, "kernel_launch: cooperative launch failed: %s (grid %d)\n", hipGetErrorString(e), grid);
#endif
}
```

```cpp
#include <hip/hip_runtime.h>
#include <hip/hip_cooperative_groups.h>
#include <cstdio>
#include <cstdint>
namespace cg = cooperative_groups;

#ifndef DBG_ZERO
#define DBG_ZERO -1
#endif
#ifndef DBG_REPEAT
#define DBG_REPEAT 0
#endif
#ifndef MK_PER_PHASE
#define MK_PER_PHASE 0
#endif

#define LAS __attribute__((address_space(3)))
#define GAS __attribute__((address_space(1)))
typedef unsigned short bf16_t;
typedef short bf16x8 __attribute__((ext_vector_type(8)));
typedef float f32x4 __attribute__((ext_vector_type(4)));
typedef float f32x2 __attribute__((ext_vector_type(2)));
typedef unsigned u32x4 __attribute__((ext_vector_type(4)));
typedef unsigned u32x2 __attribute__((ext_vector_type(2)));

constexpr int BATCH = 8, T = 4096, D = 1024, M = BATCH * T, DEPTH = 2, BW = 256;
constexpr int NMIX = 2560, NGATE = 4096, INW = NMIX + NGATE, FF = 4096;
constexpr float EPS = 1e-6f;
constexpr int NWAVES = 8, NTHREADS = 512;

constexpr size_t MiB = 1u << 20;
constexpr size_t WS_CTL = 0, CTL_ZERO_BYTES = 1 * MiB;
constexpr size_t WS_RS = 1 * MiB;
constexpr size_t WS_SD = 1 * MiB + 512 * 1024;
constexpr size_t WS_LA = 2 * MiB, WS_LH = 3 * MiB, WS_LC = 4 * MiB;
constexpr size_t WS_W = 8 * MiB;
constexpr size_t W_IN = 0, W_BR = 13 * MiB, W_OUT = 15 * MiB, W_UP = 17 * MiB, W_DOWN = 25 * MiB, W_LAYER = 33 * MiB;
constexpr size_t WS_HB = 76 * MiB;
constexpr size_t WS_PROJ = 140 * MiB;
constexpr size_t WS_G = WS_PROJ;
constexpr size_t WS_YS = 300 * MiB;
constexpr size_t WS_MERGED = 364 * MiB;
constexpr size_t WS_SU = WS_MERGED;
constexpr size_t WS_MIX = WS_PROJ;
constexpr size_t WS_MOUT = 396 * MiB;
constexpr size_t WS_HID = WS_PROJ;
constexpr size_t WS_END = 460 * MiB;

constexpr int LDS_BYTES = 155648;
constexpr int MISC_OFF = 154624;

__device__ __forceinline__ float bf2f(unsigned b) { return __uint_as_float(b << 16); }
__device__ __forceinline__ unsigned f2bf(float f) { unsigned u = __float_as_uint(f); return (u + 0x7fffu + ((u >> 16) & 1u)) >> 16; }
__device__ __forceinline__ unsigned pk2(float lo, float hi) { return f2bf(lo) | (f2bf(hi) << 16); }
typedef __bf16 bf16x2_t __attribute__((ext_vector_type(2)));
__device__ __forceinline__ unsigned cvt_pk_bf16(float lo, float hi) { f32x2 v = {lo, hi}; bf16x2_t b = __builtin_convertvector(v, bf16x2_t); return __builtin_bit_cast(unsigned, b); }
__device__ __forceinline__ float fast_exp(float x) { return __builtin_amdgcn_exp2f(x * 1.4426950408889634f); }
__device__ __forceinline__ float sigmoid_f(float x) { return __builtin_amdgcn_rcpf(1.0f + fast_exp(-x)); }
__device__ __forceinline__ void ld8bf(const bf16_t* p, float (&o)[8]) {
    const u32x4 v = *(const u32x4*)p;
    o[0] = bf2f(v.x & 0xffffu); o[1] = bf2f(v.x >> 16); o[2] = bf2f(v.y & 0xffffu); o[3] = bf2f(v.y >> 16);
    o[4] = bf2f(v.z & 0xffffu); o[5] = bf2f(v.z >> 16); o[6] = bf2f(v.w & 0xffffu); o[7] = bf2f(v.w >> 16);
}
__device__ __forceinline__ float wave_sum(float v) {
#pragma unroll
    for (int o = 1; o < 64; o <<= 1) v += __shfl_xor(v, o);
    return v;
}

namespace pg8 {
constexpr int BM = 256, BK = 64, HALF = 128, HTB = HALF * BK * 2, STAGE_BYTES = 8 * HTB, NXCD = 8, WGM = 8;
__host__ __device__ __forceinline__ int lds_byte(int r, int c) { const int st = (r >> 4) * 2 + (c >> 5), rr = r & 15, cc = c & 31, ob = rr * 64 + cc * 2; return st * 1024 + (ob ^ (((ob >> 9) & 1) << 5)); }
__host__ __device__ __forceinline__ void stage_rc(int b, int& R, int& C) { const int st = b / 1024, sb = b % 1024, swz = sb ^ (((sb >> 9) & 1) << 5); R = (st >> 1) * 16 + swz / 64; C = (st & 1) * 32 + (swz % 64) / 2; }
__host__ __device__ __forceinline__ int perm32(int rho) { const int n = rho >> 4, i = rho & 15; return 8 * (i >> 2) + 4 * n + (i & 3); }

struct Unit { int pm, pn, kind; };

struct StaticOrder {
    const char* A; const char* Bt; size_t tstep;
    int nM, nN, nwg, G, c;
    __device__ void init(const void* A_, const void* Bt_, int M_, int N_, int K_, int G_, int c_) { A = (const char*)A_; Bt = (const char*)Bt_; tstep = (size_t)BM * K_ * 2; nt = K_ / BK; nM = M_ / BM; nN = N_ / BM; nwg = nM * nN; G = G_; c = c_; }
    __device__ bool next(int i, Unit& u) const {
        const long L = (long)i * G + c; if (L >= nwg) return false;
        int wgid = (int)L; { const int q = nwg / NXCD, r = nwg % NXCD, xcd = wgid % NXCD, off = wgid / NXCD; wgid = (xcd < r ? xcd * (q + 1) : r * (q + 1) + (xcd - r) * q) + off; }
        const int nig = WGM * nN, gid = wgid / nig, fm = gid * WGM, gsz = (nM - fm) < WGM ? (nM - fm) : WGM;
        u.pm = fm + ((wgid % nig) % gsz); u.pn = (wgid % nig) / gsz; u.kind = 0; return true;
    }
    __device__ __forceinline__ void tiles(const Unit& u, const char*& a, const char*& b) const { a = A + (size_t)u.pm * tstep; b = Bt + (size_t)u.pn * tstep; }
    int nt;
    __device__ __forceinline__ int ntiles(const Unit&) const { return nt; }
    __device__ __forceinline__ bool keep_acc(const Unit&) const { return false; }
};

struct GateOrder {
    const char* HB; const char* WGt; const char* YS; const char* WB; int G, vcu;
    __device__ bool next(int i, Unit& u) const {
        const int r = i / 16, ii = i % 16, su = vcu + r * G; if (su >= 256) return false;
        const int half = ii / 8, j = ii % 8;
        u.pm = half * 64 + (su >> 2); u.kind = j; u.pn = (j < 4) ? (j * 4 + (su & 3)) : (su & 3); return true;
    }
    __device__ __forceinline__ int ntiles(const Unit& u) const { return u.kind < 4 ? 16 : 4; }
    __device__ __forceinline__ bool keep_acc(const Unit& nx) const { return nx.kind > 4; }
    __device__ __forceinline__ void tiles(const Unit& u, const char*& a, const char*& b) const {
        const size_t ts = (size_t)BM * 1024 * 2;
        if (u.kind < 4) { a = HB + (size_t)u.pm * ts; b = WGt + (size_t)u.pn * ts; } else { a = YS + (size_t)u.pm * ts + (size_t)(u.kind - 4) * 512; b = WB + (size_t)u.pn * ts + (size_t)(u.kind - 4) * 512; }
    }
};

template <int MODE  > struct EpiRow {
    static constexpr bool PERM = true;
    bf16_t* O; int ldc; const float* rs;
    __device__ __forceinline__ void operator()(f32x4 (&acc)[2][2][4][2], const Unit& u, int wr, int wc, int fr, int fq) const {
        const int row0 = u.pm * BM + wr * 64 + fr, col0 = u.pn * BM + wc * 32 + 8 * fq;
#pragma unroll
        for (int ai = 0; ai < 2; ++ai)
#pragma unroll
            for (int m = 0; m < 4; ++m) {
                const int row = row0 + ai * HALF + m * 16; const float sc = (MODE != 0) ? rs[row] : 1.0f;
                bf16_t* rowp = O + (size_t)row * ldc + col0;
#pragma unroll
                for (int bj = 0; bj < 2; ++bj) {
                    f32x4 v0 = acc[ai][bj][m][0], v1 = acc[ai][bj][m][1];
                    if (MODE != 0) { v0 = v0 * sc; v1 = v1 * sc; }
                    if (MODE == 2) {
#pragma unroll
                        for (int j = 0; j < 4; ++j) { const float a = fmaxf(v0[j], 0.f), b = fmaxf(v1[j], 0.f); v0[j] = a * a; v1[j] = b * b; }
                    }
                    u32x4 w; w.x = cvt_pk_bf16(v0[0], v0[1]); w.y = cvt_pk_bf16(v0[2], v0[3]); w.z = cvt_pk_bf16(v1[0], v1[1]); w.w = cvt_pk_bf16(v1[2], v1[3]);
                    *(u32x4*)(rowp + bj * HALF) = w;
                }
            }
    }
};

struct EpiGate {
    static constexpr bool PERM = true;
    bf16_t* Gt;
    bf16_t* MERGED;
    const float* rs;
    __device__ __forceinline__ void rescale(f32x4 (&acc)[2][2][4][2], int j, int wr, int wc, int fr, int fq) const {
        int lane_off = (wr * 64 + fr) * 256 + wc * 32 + 8 * fq; asm volatile("" : "+v"(lane_off));
        const bf16_t* g0 = Gt + (size_t)j * 65536; const bf16_t* g1 = g0 + 65536;
#pragma unroll
        for (int ai = 0; ai < 2; ++ai)
#pragma unroll
            for (int mp = 0; mp < 2; ++mp) {
                u32x4 a[2][2], b[2][2];
#pragma unroll
                for (int mm = 0; mm < 2; ++mm)
#pragma unroll
                    for (int bj = 0; bj < 2; ++bj) { const int off = lane_off + (ai * HALF + (mp * 2 + mm) * 16) * 256 + bj * HALF; a[mm][bj] = *(const u32x4*)(g0 + off); b[mm][bj] = *(const u32x4*)(g1 + off); }
#pragma unroll
                for (int mm = 0; mm < 2; ++mm)
#pragma unroll
                    for (int bj = 0; bj < 2; ++bj) {
                        const int m = mp * 2 + mm;
                        const unsigned aw[4] = {a[mm][bj].x, a[mm][bj].y, a[mm][bj].z, a[mm][bj].w}, bw[4] = {b[mm][bj].x, b[mm][bj].y, b[mm][bj].z, b[mm][bj].w};
#pragma unroll
                        for (int q = 0; q < 4; ++q) {
                            const float r0 = bf2f(aw[q] & 0xffffu) * __builtin_amdgcn_rcpf(bf2f(bw[q] & 0xffffu)), r1 = bf2f(aw[q] >> 16) * __builtin_amdgcn_rcpf(bf2f(bw[q] >> 16));
                            acc[ai][bj][m][q >> 1][(q & 1) * 2] *= r0; acc[ai][bj][m][q >> 1][(q & 1) * 2 + 1] *= r1;
                        }
                    }
                asm volatile("" ::: "memory");
            }
    }
    __device__ __forceinline__ void operator()(f32x4 (&acc)[2][2][4][2], const Unit& u, int wr, int wc, int fr, int fq) const {
        if (u.kind >= 4 && u.kind < 7) { rescale(acc, u.kind - 4, wr, wc, fr, fq); return; }
        int rl0 = wr * 64 + fr, cl0 = wc * 32 + 8 * fq; asm volatile("" : "+v"(rl0), "+v"(cl0));
        if (u.kind < 4) {
            bf16_t* gt = Gt + (size_t)u.kind * 65536;
#pragma unroll
            for (int ai = 0; ai < 2; ++ai)
#pragma unroll
                for (int m = 0; m < 4; ++m) {
                    const int rl = rl0 + ai * HALF + m * 16; const float sc = rs[u.pm * BM + rl];
#pragma unroll
                    for (int bj = 0; bj < 2; ++bj) {
                        f32x4 v0 = acc[ai][bj][m][0] * sc, v1 = acc[ai][bj][m][1] * sc;
#pragma unroll
                        for (int j = 0; j < 4; ++j) { v0[j] = sigmoid_f(fmaxf(v0[j], -60.f)); v1[j] = sigmoid_f(fmaxf(v1[j], -60.f)); }
                        u32x4 w; w.x = cvt_pk_bf16(v0[0], v0[1]); w.y = cvt_pk_bf16(v0[2], v0[3]); w.z = cvt_pk_bf16(v1[0], v1[1]); w.w = cvt_pk_bf16(v1[2], v1[3]);
                        *(u32x4*)(gt + rl * 256 + cl0 + bj * HALF) = w;
                    }
                }
        } else {
            const bf16_t* g3 = Gt + (size_t)3 * 65536;
#pragma unroll
            for (int ai = 0; ai < 2; ++ai)
#pragma unroll
                for (int m = 0; m < 4; ++m) {
                    const int rl = rl0 + ai * HALF + m * 16;
                    bf16_t* rowp = MERGED + (size_t)(u.pm * BM + rl) * 1024 + u.pn * BM + cl0;
#pragma unroll
                    for (int bj = 0; bj < 2; ++bj) {
                        const u32x4 s = *(const u32x4*)(g3 + rl * 256 + cl0 + bj * HALF);
                        f32x4 v0 = acc[ai][bj][m][0], v1 = acc[ai][bj][m][1];
                        v0[0] *= bf2f(s.x & 0xffffu); v0[1] *= bf2f(s.x >> 16); v0[2] *= bf2f(s.y & 0xffffu); v0[3] *= bf2f(s.y >> 16);
                        v1[0] *= bf2f(s.z & 0xffffu); v1[1] *= bf2f(s.z >> 16); v1[2] *= bf2f(s.w & 0xffffu); v1[3] *= bf2f(s.w >> 16);
                        u32x4 w; w.x = cvt_pk_bf16(v0[0], v0[1]); w.y = cvt_pk_bf16(v0[2], v0[3]); w.z = cvt_pk_bf16(v1[0], v1[1]); w.w = cvt_pk_bf16(v1[2], v1[3]);
                        *(u32x4*)(rowp + bj * HALF) = w;
                    }
                }
        }
    }
};

template <class Epi, class Sched, bool ALIGN_EPI>
__device__ __forceinline__ void gemm_phase(LAS unsigned char* lds, const int K, const Sched& S, const Epi& E) {
    int tid = threadIdx.x; asm volatile("" : "+v"(tid));
    const int wid = __builtin_amdgcn_readfirstlane(tid >> 6), lane = tid & 63, wr = wid >> 2, wc = wid & 3, fr = lane & 15, fq = lane >> 4;
    unsigned voffA[2], voffB[2];
#pragma unroll
    for (int i = 0; i < 2; ++i) { int R, C; stage_rc(tid * 16 + i * 8192, R, C); const int Rb = Epi::PERM ? ((R & ~31) + perm32(R & 31)) : R;
        voffA[i] = (unsigned)(R * K + C) * 2u; voffB[i] = (unsigned)(Rb * K + C) * 2u; }
    const size_t kstep = (size_t)(BK * 2);
    const size_t hstep = (size_t)HALF * K * 2;
    const unsigned ldsw = (unsigned)wid * 1024u;
    const int aoff = lds_byte(wr * 64 + fr, fq * 8), boff = lds_byte(wc * 32 + fr, fq * 8);
#define PG8_SA(b, h) (((b) * 2 + (h)) * HTB)
#define PG8_SB(b, h) ((4 + (b) * 2 + (h)) * HTB)
#define PG8_STAGE(bufoff, gbase, voff) do { _Pragma("unroll") for (int _i = 0; _i < 2; ++_i) \
        __builtin_amdgcn_global_load_lds((const unsigned*)((const char*)(gbase) + (voff)[_i]), (LAS unsigned*)(lds + (bufoff) + ldsw + _i * 8192), 16, 0, 0); } while (0)
#define PG8_LDA(dst, b, h) do { _Pragma("unroll") for (int m = 0; m < 4; ++m) _Pragma("unroll") for (int k = 0; k < 2; ++k) dst[m][k] = *(const LAS bf16x8*)(lds + PG8_SA(b, h) + aoff + m * 2048 + k * 1024); } while (0)
#define PG8_LDB(dst, b, h) do { _Pragma("unroll") for (int n = 0; n < 2; ++n) _Pragma("unroll") for (int k = 0; k < 2; ++k) dst[n][k] = *(const LAS bf16x8*)(lds + PG8_SB(b, h) + boff + n * 2048 + k * 1024); } while (0)
#define PG8_MMA(ai, bj, At, Bt) do { __builtin_amdgcn_s_setprio(1); _Pragma("unroll") for (int m = 0; m < 4; ++m) _Pragma("unroll") for (int n = 0; n < 2; ++n) _Pragma("unroll") for (int k = 0; k < 2; ++k) \
        acc[ai][bj][m][n] = __builtin_amdgcn_mfma_f32_16x16x32_bf16(Bt[n][k], At[m][k], acc[ai][bj][m][n], 0, 0, 0); __builtin_amdgcn_s_setprio(0); } while (0)
#define PG8_WAIT_V(n) asm volatile("s_waitcnt vmcnt(" #n ")" ::: "memory")
#define PG8_WAIT_L(n) asm volatile("s_waitcnt lgkmcnt(" #n ")" ::: "memory")
#define PG8_BAR __builtin_amdgcn_s_barrier()
#define PG8_SCHED __builtin_amdgcn_sched_barrier(0)
    Unit cur, nxt; int ui = 0;
    if (!S.next(0, cur)) return;
    f32x4 acc[2][2][4][2];
#pragma unroll
    for (int a = 0; a < 2; ++a)
#pragma unroll
        for (int b = 0; b < 2; ++b)
#pragma unroll
            for (int m = 0; m < 4; ++m)
#pragma unroll
                for (int n = 0; n < 2; ++n) acc[a][b][m][n] = (f32x4){0.f, 0.f, 0.f, 0.f};
    bf16x8 At[4][2], B0[2][2], B1[2][2];
    const char* cA; const char* cB; S.tiles(cur, cA, cB);
    PG8_STAGE(PG8_SB(0, 0), cB, voffB); PG8_STAGE(PG8_SB(0, 1), cB + hstep, voffB); PG8_STAGE(PG8_SA(0, 0), cA, voffA); PG8_STAGE(PG8_SA(0, 1), cA + hstep, voffA);
    if (wr == 1) PG8_BAR;
    PG8_WAIT_V(2); PG8_BAR;
    PG8_STAGE(PG8_SB(1, 0), cB + kstep, voffB); PG8_STAGE(PG8_SA(1, 0), cA + kstep, voffA); PG8_STAGE(PG8_SB(1, 1), cB + hstep + kstep, voffB);
    PG8_WAIT_V(6); PG8_BAR;
    for (;;) {
        const bool has_next = S.next(ui + 1, nxt);
        const char* nA = cA; const char* nB = cB; if (has_next) S.tiles(nxt, nA, nB);
#define PG8_KT2(t, last) do { \
            const char* a1 = cA + (size_t)((t) + 1) * kstep; \
            const char* a2 = (last) ? nA : cA + (size_t)((t) + 2) * kstep; const char* b2 = (last) ? nB : cB + (size_t)((t) + 2) * kstep; \
            const char* a3 = a2 + kstep; const char* b3 = b2 + kstep; \
            PG8_LDB(B0, 0, 0); PG8_LDB(B1, 0, 1); PG8_SCHED; PG8_LDA(At, 0, 0); PG8_STAGE(PG8_SA(1, 1), a1 + hstep, voffA); \
            PG8_WAIT_V(8); PG8_WAIT_L(0); PG8_BAR; PG8_MMA(0, 0, At, B0); PG8_MMA(0, 1, At, B1); PG8_BAR; PG8_SCHED; \
            PG8_LDA(At, 0, 1); PG8_STAGE(PG8_SB(0, 0), b2, voffB); PG8_STAGE(PG8_SB(0, 1), b2 + hstep, voffB); PG8_STAGE(PG8_SA(0, 0), a2, voffA); \
            PG8_WAIT_V(8); PG8_WAIT_L(0); PG8_BAR; PG8_MMA(1, 0, At, B0); PG8_MMA(1, 1, At, B1); PG8_BAR; PG8_SCHED; \
            PG8_LDB(B0, 1, 0); PG8_LDB(B1, 1, 1); PG8_SCHED; PG8_LDA(At, 1, 0); PG8_STAGE(PG8_SA(0, 1), a2 + hstep, voffA); \
            PG8_WAIT_V(8); PG8_WAIT_L(0); PG8_BAR; PG8_MMA(0, 0, At, B0); PG8_MMA(0, 1, At, B1); PG8_BAR; PG8_SCHED; \
            PG8_LDA(At, 1, 1); PG8_STAGE(PG8_SB(1, 0), b3, voffB); PG8_STAGE(PG8_SB(1, 1), b3 + hstep, voffB); PG8_STAGE(PG8_SA(1, 0), a3, voffA); \
            PG8_WAIT_V(8); PG8_WAIT_L(0); PG8_BAR; PG8_MMA(1, 0, At, B0); PG8_MMA(1, 1, At, B1); PG8_BAR; PG8_SCHED; } while (0)
        {
            const int ntc = S.ntiles(cur);
#pragma unroll 1
            for (int t = 0; t < ntc; t += 2) { const bool last = (t == ntc - 2); PG8_KT2(t, last); }
        }
        if constexpr (ALIGN_EPI) { if (wr == 0) PG8_BAR; }
        E(acc, cur, wr, wc, fr, fq);
        if (!has_next) break;
        if (!S.keep_acc(nxt)) {
#pragma unroll
        for (int a = 0; a < 2; ++a)
#pragma unroll
            for (int b = 0; b < 2; ++b)
#pragma unroll
                for (int m = 0; m < 4; ++m)
#pragma unroll
                    for (int n = 0; n < 2; ++n) acc[a][b][m][n] = (f32x4){0.f, 0.f, 0.f, 0.f};
        }
        cur = nxt; cA = nA; cB = nB; ++ui;
        if constexpr (ALIGN_EPI) { if (wr == 1) PG8_BAR; }
    }
    PG8_WAIT_V(0);
    if constexpr (!ALIGN_EPI) { if (wr == 0) PG8_BAR; }
    PG8_BAR;
#undef PG8_KT2
#undef PG8_SA
#undef PG8_SB
#undef PG8_STAGE
#undef PG8_LDA
#undef PG8_LDB
#undef PG8_MMA
#undef PG8_WAIT_V
#undef PG8_WAIT_L
#undef PG8_BAR
#undef PG8_SCHED
}
}

struct Args {
    const float* in[22]; float* out; unsigned char* ws; int ph_lo, ph_hi;
};
enum { I_X = 0, I_NMIXPRE, I_NMIXPOST, I_NMLPPRE, I_NMLPPOST, I_WIN, I_LCW, I_LCB, I_LWA, I_LBA, I_LWX, I_LBX, I_LLAM, I_PW, I_PS, I_HLB, I_HN, I_SW, I_WBR, I_WOUT, I_WUP, I_WDOWN };

struct Ctx {
    LAS unsigned char* lds; int tid, lane, wave, vcu, G;
};

__device__ __forceinline__ void transpose_item(const float* W, int ldw, const float* gain, bf16_t* WT, int ldo, int col_off, int k0, int n0, LAS float* scr, int lane) {
#pragma unroll 8
    for (int i = 0; i < 32; ++i) { const int kk = 2 * i + (lane >> 5); const float g = gain ? gain[k0 + kk] : 1.0f; scr[kk * 33 + (lane & 31)] = g * W[(size_t)(k0 + kk) * ldw + n0 + (lane & 31)]; }
    asm volatile("s_waitcnt lgkmcnt(0)" ::: "memory");
    const int c = lane & 7;
#pragma unroll
    for (int j = 0; j < 4; ++j) { const int n = (lane >> 3) + 8 * j; const LAS float* s = scr + (8 * c) * 33 + n;
        u32x4 o; o.x = pk2(s[0 * 33], s[1 * 33]); o.y = pk2(s[2 * 33], s[3 * 33]); o.z = pk2(s[4 * 33], s[5 * 33]); o.w = pk2(s[6 * 33], s[7 * 33]);
        *(u32x4*)(WT + (size_t)(n0 + n) * ldo + col_off + k0 + 8 * c) = o; }
    asm volatile("s_waitcnt lgkmcnt(0)" ::: "memory");
}

__device__ __forceinline__ void p0_prologue(const Ctx& C, const Args& A) {
    LAS float* scr = (LAS float*)(C.lds + C.wave * 16384);
    const int gw = C.vcu * NWAVES + C.wave, NGW = C.G * NWAVES;
    constexpr int I_IN = (D / 64) * (INW / 32), I_BR1 = (BW / 64) * (D / 32), I_OUT = (D / 64) * (D / 32), I_UP = (D / 64) * (FF / 32), I_DN = (FF / 64) * (D / 32);
    constexpr int PER_LAYER = I_IN + 4 * I_BR1 + I_OUT + I_UP + I_DN;
    for (int it = gw; it < DEPTH * PER_LAYER; it += NGW) {
        const int l = it / PER_LAYER; int r = it % PER_LAYER;
        bf16_t* wl = (bf16_t*)(A.ws + WS_W + (size_t)l * W_LAYER);
        if (r < I_IN) { const int nb = INW / 32; transpose_item(A.in[I_WIN] + (size_t)l * D * INW, INW, A.in[I_NMIXPRE] + l * D, wl + W_IN / 2, D, 0, 64 * (r / nb), 32 * (r % nb), scr, C.lane); continue; } r -= I_IN;
        if (r < 4 * I_BR1) { const int k = r / I_BR1, rr = r % I_BR1, nb = D / 32; transpose_item(A.in[I_WBR] + ((size_t)l * 4 + k) * BW * D, D, nullptr, wl + W_BR / 2, D, k * BW, 64 * (rr / nb), 32 * (rr % nb), scr, C.lane); continue; } r -= 4 * I_BR1;
        if (r < I_OUT) { const int nb = D / 32; transpose_item(A.in[I_WOUT] + (size_t)l * D * D, D, nullptr, wl + W_OUT / 2, D, 0, 64 * (r / nb), 32 * (r % nb), scr, C.lane); continue; } r -= I_OUT;
        if (r < I_UP) { const int nb = FF / 32; transpose_item(A.in[I_WUP] + (size_t)l * D * FF, FF, A.in[I_NMLPPRE] + l * D, wl + W_UP / 2, D, 0, 64 * (r / nb), 32 * (r % nb), scr, C.lane); continue; } r -= I_UP;
        { const int nb = D / 32; transpose_item(A.in[I_WDOWN] + (size_t)l * FF * D, D, nullptr, wl + W_DOWN / 2, FF, 0, 64 * (r / nb), 32 * (r % nb), scr, C.lane); }
    }
    bf16_t* HB = (bf16_t*)(A.ws + WS_HB); float* RS = (float*)(A.ws + WS_RS);
    for (int m = gw; m < M; m += NGW) {
        const f32x4* xr = (const f32x4*)(A.in[I_X] + (size_t)m * D) + C.lane;
        f32x4 v[4]; float s = 0.f;
#pragma unroll
        for (int j = 0; j < 4; ++j) { v[j] = xr[64 * j]; s += (v[j].x * v[j].x + v[j].y * v[j].y) + (v[j].z * v[j].z + v[j].w * v[j].w); }
        s = wave_sum(s);
        u32x2* o8 = (u32x2*)(HB + (size_t)m * D) + C.lane;
#pragma unroll
        for (int j = 0; j < 4; ++j) { u32x2 w; w.x = pk2(v[j].x, v[j].y); w.y = pk2(v[j].z, v[j].w); o8[64 * j] = w; }
        if (C.lane == 0) RS[m] = 1.0f / sqrtf(s * (1.0f / D) + EPS);
    }
}

__device__ __forceinline__ void norm_phase(const Ctx& C, const Args& A, const bf16_t* VIN, const float* gain, bool write_out) {
    bf16_t* HB = (bf16_t*)(A.ws + WS_HB); float* RS = (float*)(A.ws + WS_RS); float* OUT = A.out;
    int lane = C.lane; asm volatile("" : "+v"(lane));
    const int gw = C.vcu * NWAVES + C.wave, NGW = C.G * NWAVES;
    f32x4 g[4];
#pragma unroll
    for (int j = 0; j < 4; ++j) g[j] = ((const f32x4*)gain)[lane + 64 * j];
    for (int m = gw; m < M; m += NGW) {
        u32x2* hb = (u32x2*)(HB + (size_t)m * D) + lane;
        const u32x2* vb = (const u32x2*)(VIN + (size_t)m * D) + lane;
        f32x4 v[4], h[4]; float s = 0.f;
#pragma unroll
        for (int j = 0; j < 4; ++j) { const u32x2 w = vb[64 * j], hw = hb[64 * j];
            v[j] = (f32x4){bf2f(w.x & 0xffffu), bf2f(w.x >> 16), bf2f(w.y & 0xffffu), bf2f(w.y >> 16)};
            h[j] = (f32x4){bf2f(hw.x & 0xffffu), bf2f(hw.x >> 16), bf2f(hw.y & 0xffffu), bf2f(hw.y >> 16)};
            s += (v[j].x * v[j].x + v[j].y * v[j].y) + (v[j].z * v[j].z + v[j].w * v[j].w); }
        const float r = 1.0f / sqrtf(wave_sum(s) * (1.0f / D) + EPS);
        float s2 = 0.f;
#pragma unroll
        for (int j = 0; j < 4; ++j) { h[j] = h[j] + g[j] * v[j] * r; s2 += (h[j].x * h[j].x + h[j].y * h[j].y) + (h[j].z * h[j].z + h[j].w * h[j].w); }
        s2 = wave_sum(s2);
        if (write_out) { f32x4* orow = (f32x4*)(OUT + (size_t)m * D) + lane;
#pragma unroll
            for (int j = 0; j < 4; ++j) orow[64 * j] = h[j]; }
        else {
#pragma unroll
            for (int j = 0; j < 4; ++j) { u32x2 w; w.x = pk2(h[j].x, h[j].y); w.y = pk2(h[j].z, h[j].w); hb[64 * j] = w; }
            if (lane == 0) RS[m] = 1.0f / sqrtf(s2 * (1.0f / D) + EPS); }
    }
}

__device__ __forceinline__ float gelu_tanh(float x) {
    const float u = 0.7978845608028654f * (x + 0.044715f * x * x * x);
    const float e = fast_exp(2.0f * u);
    const float th = 1.0f - 2.0f * __builtin_amdgcn_rcpf(e + 1.0f);
    return 0.5f * x * (1.0f + th);
}

constexpr size_t WS_LRA = 428 * MiB, WS_LRU = 444 * MiB;
constexpr int MX_PT = 528;
__device__ __forceinline__ bf16x8 gather_wfrag(const float* w, int stride) {
    union { bf16x8 v; unsigned u[4]; } r;
#pragma unroll
    for (int p = 0; p < 4; ++p) r.u[p] = pk2(w[(2 * p) * stride], w[(2 * p + 1) * stride]);
    return r.v;
}
__device__ __forceinline__ void mix1_item(const Ctx& C, const Args& A, int l, int b, int c) {
    const bf16_t* PROJ = (const bf16_t*)(A.ws + WS_PROJ);
    bf16_t* YS = (bf16_t*)(A.ws + WS_YS);
    int tid = C.tid; asm volatile("" : "+v"(tid));
    const int lane = tid & 63, wave = C.wave, fr = lane & 15, fg = lane >> 4;
    const size_t m0 = (size_t)b * T + (size_t)c * 64;
    LAS unsigned char* XC = C.lds;
    LAS unsigned char* LAi = C.lds + 34816;
    LAS unsigned char* LUi = C.lds + 34816 + 32768;
    {
        const float* cw = A.in[I_LCW] + (size_t)l * 4 * BW; const float* cbp = A.in[I_LCB] + l * BW;
#pragma unroll 1
        for (int k = 0; k < 4; ++k) { const int idx = tid + NTHREADS * k; const int t = idx >> 5, c8 = (idx & 31) * 8;
            float acc[8];
            { const f32x4 b0 = *(const f32x4*)(cbp + c8), b1 = *(const f32x4*)(cbp + c8 + 4); acc[0] = b0[0]; acc[1] = b0[1]; acc[2] = b0[2]; acc[3] = b0[3]; acc[4] = b1[0]; acc[5] = b1[1]; acc[6] = b1[2]; acc[7] = b1[3]; }
#pragma unroll
            for (int j = 0; j < 4; ++j) { const int tok = c * 64 + t - 3 + j;
                if (tok >= 0) { float x[8]; ld8bf(PROJ + ((size_t)b * T + tok) * NMIX + c8, x); const f32x4 w0 = *(const f32x4*)(cw + j * BW + c8), w1 = *(const f32x4*)(cw + j * BW + c8 + 4);
                    acc[0] += w0[0] * x[0]; acc[1] += w0[1] * x[1]; acc[2] += w0[2] * x[2]; acc[3] += w0[3] * x[3]; acc[4] += w1[0] * x[4]; acc[5] += w1[1] * x[5]; acc[6] += w1[2] * x[6]; acc[7] += w1[3] * x[7]; } }
            u32x4 w; w.x = cvt_pk_bf16(acc[0], acc[1]); w.y = cvt_pk_bf16(acc[2], acc[3]); w.z = cvt_pk_bf16(acc[4], acc[5]); w.w = cvt_pk_bf16(acc[6], acc[7]);
            *(LAS u32x4*)(XC + t * MX_PT + c8 * 2) = w; }
    }
    __syncthreads();
    {
        const int blk = wave;
        const float* wa = A.in[I_LWA] + (((size_t)l * 8 + blk) * 32) * 32; const float* wx = A.in[I_LWX] + (((size_t)l * 8 + blk) * 32) * 32;
        bf16x8 fa[2], fx[2];
#pragma unroll
        for (int nt = 0; nt < 2; ++nt) { fa[nt] = gather_wfrag(wa + (8 * fg) * 32 + 16 * nt + fr, 32); fx[nt] = gather_wfrag(wx + (8 * fg) * 32 + 16 * nt + fr, 32); }
        bf16_t* LRA = (bf16_t*)(A.ws + WS_LRA); bf16_t* LRU = (bf16_t*)(A.ws + WS_LRU);
#pragma unroll
        for (int nt = 0; nt < 2; ++nt) { const int ch = 32 * blk + 16 * nt + 4 * fg;
            const f32x4 ba = *(const f32x4*)(A.in[I_LBA] + l * BW + ch), bx = *(const f32x4*)(A.in[I_LBX] + l * BW + ch), lam = *(const f32x4*)(A.in[I_LLAM] + l * BW + ch);
            float sp8[4];
#pragma unroll
            for (int r = 0; r < 4; ++r) sp8[r] = -8.0f * ((-lam[r] > 20.f) ? -lam[r] : log1pf(expf(-lam[r])));
#pragma unroll
            for (int mt = 0; mt < 4; ++mt) { const int tok = 16 * mt + fr;
                const bf16x8 bxc = *(const LAS bf16x8*)(XC + tok * MX_PT + (32 * blk + 8 * fg) * 2);
                f32x4 ar = {0.f, 0.f, 0.f, 0.f}, ai = {0.f, 0.f, 0.f, 0.f};
                ar = __builtin_amdgcn_mfma_f32_16x16x32_bf16(fa[nt], bxc, ar, 0, 0, 0); ai = __builtin_amdgcn_mfma_f32_16x16x32_bf16(fx[nt], bxc, ai, 0, 0, 0);
                const u32x2 xw = *(const LAS u32x2*)(XC + tok * MX_PT + ch * 2);
                const float xc[4] = {bf2f(xw.x & 0xffffu), bf2f(xw.x >> 16), bf2f(xw.y & 0xffffu), bf2f(xw.y >> 16)};
                float la[4], uu[4];
#pragma unroll
                for (int r = 0; r < 4; ++r) { const float rg = sigmoid_f(ar[r] + ba[r]), ig = sigmoid_f(ai[r] + bx[r]);
                    la[r] = sp8[r] * rg; const float x2 = 2.0f * la[r];
                    const float om = (x2 > -0.02f) ? -x2 * (1.0f + 0.5f * x2 * (1.0f + x2 * (1.0f / 3.0f))) : 1.0f - fast_exp(x2);
                    uu[r] = sqrtf(om) * ig * xc[r]; }
                u32x2 wl, wu; wl.x = cvt_pk_bf16(la[0], la[1]); wl.y = cvt_pk_bf16(la[2], la[3]); wu.x = cvt_pk_bf16(uu[0], uu[1]); wu.y = cvt_pk_bf16(uu[2], uu[3]);
                *(LAS u32x2*)(LAi + tok * 512 + ch * 2) = wl; *(LAS u32x2*)(LUi + tok * 512 + ch * 2) = wu;
                *(u32x2*)(LRA + (m0 + tok) * BW + ch) = wl; *(u32x2*)(LRU + (m0 + tok) * BW + ch) = wu; }
        }
    }
    __syncthreads();
    {
        const int ch = tid & 255, half = tid >> 8; float P = 1.f, hst = 0.f;
#pragma unroll 8
        for (int i = 0; i < 32; ++i) { const int t = 32 * half + i; const float a = fast_exp(bf2f(*(const LAS bf16_t*)(LAi + t * 512 + ch * 2))); const float u = bf2f(*(const LAS bf16_t*)(LUi + t * 512 + ch * 2));
            hst = a * hst + u; P *= a; }
        const size_t aggi = ((size_t)b * 128 + c * 2 + half) * 256 + ch;
        ((float*)(A.ws + WS_LA))[aggi] = P; ((float*)(A.ws + WS_LH))[aggi] = hst;
    }
    __syncthreads();
    LAS unsigned char* PX = C.lds;
    LAS unsigned char* DD = C.lds + 43008;
    for (int idx = tid; idx < 79 * 32; idx += NTHREADS) { const int r = idx >> 5, c8 = (idx & 31) * 8; const int tok = c * 64 - 15 + r;
        u32x4 v = {0u, 0u, 0u, 0u}; if (tok >= 0) v = *(const u32x4*)(PROJ + ((size_t)b * T + tok) * NMIX + 512 + c8);
        *(LAS u32x4*)(PX + r * MX_PT + c8 * 2) = v; }
    __syncthreads();
#pragma unroll 1
    for (int k = 0; k < 4; ++k) { const int idx = tid + NTHREADS * k; const int t = idx >> 5, c8 = (idx & 31) * 8; const int g = c8 >> 6, win = 2 << g;
        float sum[8], x0[8];
#pragma unroll
        for (int e = 0; e < 8; ++e) sum[e] = 0.f;
        for (int j = 0; j < win; ++j) { const u32x4 v = *(const LAS u32x4*)(PX + (t + 15 - j) * MX_PT + c8 * 2);
            const float x[8] = {bf2f(v.x & 0xffffu), bf2f(v.x >> 16), bf2f(v.y & 0xffffu), bf2f(v.y >> 16), bf2f(v.z & 0xffffu), bf2f(v.z >> 16), bf2f(v.w & 0xffffu), bf2f(v.w >> 16)};
#pragma unroll
            for (int e = 0; e < 8; ++e) { sum[e] += x[e]; if (j == 0) x0[e] = x[e]; } }
        const int pos = c * 64 + t + 1; const float inv = 1.0f / (float)(pos < win ? pos : win);
        u32x4 w; w.x = cvt_pk_bf16(sum[0] * inv - x0[0], sum[1] * inv - x0[1]); w.y = cvt_pk_bf16(sum[2] * inv - x0[2], sum[3] * inv - x0[3]);
        w.z = cvt_pk_bf16(sum[4] * inv - x0[4], sum[5] * inv - x0[5]); w.w = cvt_pk_bf16(sum[6] * inv - x0[6], sum[7] * inv - x0[7]);
        *(LAS u32x4*)(DD + t * MX_PT + c8 * 2) = w; }
    __syncthreads();
    {
        const int g = wave >> 1, nb = (wave & 1) * 2;
        const float* pw = A.in[I_PW] + (((size_t)l * 4 + g) * 64) * 64;
        bf16x8 fw[2][2];
#pragma unroll
        for (int nn = 0; nn < 2; ++nn)
#pragma unroll
            for (int ks = 0; ks < 2; ++ks) fw[nn][ks] = gather_wfrag(pw + (32 * ks + 8 * fg) * 64 + 16 * (nb + nn) + fr, 64);
#pragma unroll
        for (int nn = 0; nn < 2; ++nn) { const int ch = 64 * g + 16 * (nb + nn) + 4 * fg; const f32x4 scl = *(const f32x4*)(A.in[I_PS] + l * BW + ch);
#pragma unroll
            for (int mt = 0; mt < 4; ++mt) { const int tok = 16 * mt + fr; f32x4 acc = {0.f, 0.f, 0.f, 0.f};
#pragma unroll
                for (int ks = 0; ks < 2; ++ks) { const bf16x8 bd = *(const LAS bf16x8*)(DD + tok * MX_PT + (64 * g + 32 * ks + 8 * fg) * 2); acc = __builtin_amdgcn_mfma_f32_16x16x32_bf16(fw[nn][ks], bd, acc, 0, 0, 0); }
                u32x2 w; w.x = cvt_pk_bf16(acc[0] * scl[0], acc[1] * scl[1]); w.y = cvt_pk_bf16(acc[2] * scl[2], acc[3] * scl[3]);
                *(u32x2*)(YS + (m0 + tok) * D + 256 + ch) = w; } }
    }
    {
        const float* sw = A.in[I_SW] + (size_t)l * 3 * BW;
#pragma unroll 1
        for (int k = 0; k < 4; ++k) { const int idx = tid + NTHREADS * k; const int t = idx >> 5, c8 = (idx & 31) * 8;
            float acc[8];
#pragma unroll
            for (int e = 0; e < 8; ++e) acc[e] = 0.f;
#pragma unroll
            for (int j = 0; j < 3; ++j) { const int tok = c * 64 + t - 2 + j;
                if (tok >= 0) { const bf16_t* p = PROJ + ((size_t)b * T + tok) * NMIX; float sc[8], sx[8]; ld8bf(p + 2048 + c8, sc); ld8bf(p + 2304 + c8, sx);
                    const f32x4 w0 = *(const f32x4*)(sw + j * BW + c8), w1 = *(const f32x4*)(sw + j * BW + c8 + 4);
                    acc[0] += w0[0] * sc[0] * sx[0]; acc[1] += w0[1] * sc[1] * sx[1]; acc[2] += w0[2] * sc[2] * sx[2]; acc[3] += w0[3] * sc[3] * sx[3];
                    acc[4] += w1[0] * sc[4] * sx[4]; acc[5] += w1[1] * sc[5] * sx[5]; acc[6] += w1[2] * sc[6] * sx[6]; acc[7] += w1[3] * sc[7] * sx[7]; } }
            float sb[8]; ld8bf(PROJ + (m0 + t) * NMIX + 1792 + c8, sb);
            u32x4 w; w.x = cvt_pk_bf16(sb[0] * acc[0], sb[1] * acc[1]); w.y = cvt_pk_bf16(sb[2] * acc[2], sb[3] * acc[3]); w.z = cvt_pk_bf16(sb[4] * acc[4], sb[5] * acc[5]); w.w = cvt_pk_bf16(sb[6] * acc[6], sb[7] * acc[7]);
            *(u32x4*)(YS + (m0 + t) * D + 768 + c8) = w; }
    }
    __syncthreads();
}
__device__ __forceinline__ void lru_final_item(const Ctx& C, const Args& A, int l, int b, int c) {
    const bf16_t* PROJ = (const bf16_t*)(A.ws + WS_PROJ);
    const bf16_t* LRA = (const bf16_t*)(A.ws + WS_LRA); const bf16_t* LRU = (const bf16_t*)(A.ws + WS_LRU);
    bf16_t* YS = (bf16_t*)(A.ws + WS_YS);
    int tid = C.tid; asm volatile("" : "+v"(tid));
    const int ch = tid & 255, half = tid >> 8;
    const size_t m0 = (size_t)b * T + (size_t)c * 64 + 32 * half;
    float hst = ((const float*)(A.ws + WS_LC))[((size_t)b * 128 + c * 2 + half) * 256 + ch];
#pragma unroll 8
    for (int i = 0; i < 32; ++i) { const float a = fast_exp(bf2f(LRA[(m0 + i) * BW + ch])), u = bf2f(LRU[(m0 + i) * BW + ch]);
        hst = a * hst + u;
        const float gate = bf2f(PROJ[(m0 + i) * NMIX + 256 + ch]);
        YS[(m0 + i) * D + ch] = (bf16_t)f2bf(hst * gelu_tanh(gate)); }
}

constexpr int HG_PT = 144;
constexpr int HG_IMG = 64 * HG_PT;
constexpr int HG_Q = 0, HG_K = HG_IMG, HG_P = 2 * HG_IMG, HG_BEND = 3 * HG_IMG, HG_REF = HG_BEND + 512, HG_HSZ = 29696;
constexpr size_t WS_ST16 = WS_MERGED + 32 * MiB;
__device__ __forceinline__ float hgrn_lb(const Args& A, int l, int w) {
    if (l == 0) return 0.f;
    const float a0 = A.in[I_HLB][w], a1 = A.in[I_HLB][BW + w];
    return 1.0f / (1.0f + expf(a0 - a1));
}
template <bool FINAL>
__device__ __forceinline__ void hgrn_item(const Ctx& C, const Args& A, int l, int b, int c) {
    const bf16_t* PROJ = (const bf16_t*)(A.ws + WS_PROJ);
    int lane = C.lane; asm volatile("" : "+v"(lane));
    const int wave = C.wave, h = wave >> 1, half = wave & 1, fr = lane & 15, fg = lane >> 4;
    LAS unsigned char* hb = C.lds + h * HG_HSZ;
    LAS float* BEND = (LAS float*)(hb + HG_BEND); LAS float* REF = (LAS float*)(hb + HG_REF);
    const size_t m0 = (size_t)b * T + (size_t)c * 64;
    const bf16_t* pr = PROJ + (m0 + 32 * half) * NMIX + h * 64 + lane;
    const int bh = b * 4 + h; const size_t ci = (size_t)bh * 64 + c;
    float bb[32], kk[32], vv[32];
    {
        const float lbv = hgrn_lb(A, l, h * 64 + lane);
        float acc = 0.f;
#pragma unroll
        for (int i = 0; i < 32; ++i) { const float x = bf2f(pr[(size_t)i * NMIX + 1024]); const float f = fmaxf(lbv + (1.0f - lbv) * sigmoid_f(x), 1e-30f);
            acc += __logf(f); bb[i] = acc; kk[i] = 1.0f - f; }
#pragma unroll
        for (int i = 0; i < 32; ++i) vv[i] = bf2f(pr[(size_t)i * NMIX + 1280]);
        BEND[half * 64 + lane] = acc;
    }
    __syncthreads();
    const float bend0 = BEND[lane], blast = bend0 + BEND[64 + lane];
    if (half) {
#pragma unroll
        for (int i = 0; i < 32; ++i) bb[i] += bend0;
    }
    if (!FINAL) {
        LAS unsigned char* kt = hb + HG_K + lane * HG_PT + 64 * half; LAS unsigned char* vt = hb + HG_Q + lane * HG_PT + 64 * half;
#pragma unroll
        for (int q4 = 0; q4 < 4; ++q4) { u32x4 wk, wv; unsigned kw[4], vw[4];
#pragma unroll
            for (int p = 0; p < 4; ++p) { const int i = q4 * 8 + 2 * p;
                kw[p] = cvt_pk_bf16(kk[i] * fast_exp(blast - bb[i]), kk[i + 1] * fast_exp(blast - bb[i + 1])); vw[p] = cvt_pk_bf16(vv[i], vv[i + 1]); }
            wk.x = kw[0]; wk.y = kw[1]; wk.z = kw[2]; wk.w = kw[3]; wv.x = vw[0]; wv.y = vw[1]; wv.z = vw[2]; wv.w = vw[3];
            *(LAS u32x4*)(kt + q4 * 16) = wk; *(LAS u32x4*)(vt + q4 * 16) = wv; }
        if (half == 0) ((float*)(A.ws + WS_SD))[ci * 64 + lane] = fast_exp(blast);
        __syncthreads();
        float* su = (float*)(A.ws + WS_SU) + ci * 4096;
#pragma unroll
        for (int aa = 0; aa < 2; ++aa) { const int a = 2 * half + aa;
            bf16x8 av[2];
#pragma unroll
            for (int ks = 0; ks < 2; ++ks) av[ks] = *(const LAS bf16x8*)(hb + HG_Q + (16 * a + fr) * HG_PT + 64 * ks + 16 * fg);
#pragma unroll
            for (int d = 0; d < 4; ++d) { f32x4 acc = {0.f, 0.f, 0.f, 0.f};
#pragma unroll
                for (int ks = 0; ks < 2; ++ks) { const bf16x8 bk = *(const LAS bf16x8*)(hb + HG_K + (16 * d + fr) * HG_PT + 64 * ks + 16 * fg);
                    acc = __builtin_amdgcn_mfma_f32_16x16x32_bf16(av[ks], bk, acc, 0, 0, 0); }
#pragma unroll
                for (int r = 0; r < 4; ++r) su[(16 * a + 4 * fg + r) * 64 + 16 * d + fr] = acc[r];
            } }
        __syncthreads();
    } else {
        float qq[32];
#pragma unroll
        for (int i = 0; i < 32; ++i) qq[i] = bf2f(pr[(size_t)i * NMIX + 768]);
        if (half == 0) { REF[64 + lane] = bb[15]; REF[128 + lane] = bb[31]; } else REF[192 + lane] = bb[15];
        { const u32x4 z = {0u, 0u, 0u, 0u};
#pragma unroll
            for (int k2 = 0; k2 < 5; ++k2) { const int idx = lane + 64 * k2; if (idx < 32 * 9) *(LAS u32x4*)(hb + HG_P + 32 * half * HG_PT + idx * 16) = z; } }
        __syncthreads();
        float rf[4]; rf[0] = 0.f; rf[1] = REF[64 + lane]; rf[2] = REF[128 + lane]; rf[3] = REF[192 + lane];
        {
            const float r_lo = half ? rf[2] : rf[0], r_hi = half ? rf[3] : rf[1];
#pragma unroll
            for (int i = 0; i < 32; ++i) { const float rr = (i < 16) ? r_lo : r_hi; const float val = qq[i] * fast_exp(bb[i] - rr);
                *(LAS bf16_t*)(hb + HG_Q + (32 * half + i) * HG_PT + 2 * lane) = (bf16_t)f2bf(val); }
        }
#pragma unroll
        for (int isub = 0; isub < 4; ++isub) {
            const int nrows = 16 * (isub + 1) - 32 * half;
#pragma unroll
            for (int i = 0; i < 32; ++i) { if (i < nrows) { const float e = fminf(rf[isub] - bb[i], 60.f); const float val = kk[i] * fast_exp(e);
                    *(LAS bf16_t*)(hb + HG_K + (32 * half + i) * HG_PT + 2 * lane) = (bf16_t)f2bf(val); } }
            __syncthreads();
            {
                bf16x8 bq[2];
#pragma unroll
                for (int ks = 0; ks < 2; ++ks) bq[ks] = *(const LAS bf16x8*)(hb + HG_Q + (16 * isub + fr) * HG_PT + 64 * ks + 16 * fg);
#pragma unroll
                for (int j = 0; j <= isub; ++j) { if ((j & 1) == half) {
                        f32x4 acc = {0.f, 0.f, 0.f, 0.f};
#pragma unroll
                        for (int ks = 0; ks < 2; ++ks) { const bf16x8 ak = *(const LAS bf16x8*)(hb + HG_K + (16 * j + fr) * HG_PT + 64 * ks + 16 * fg);
                            acc = __builtin_amdgcn_mfma_f32_16x16x32_bf16(ak, bq[ks], acc, 0, 0, 0); }
                        if (j == isub) {
#pragma unroll
                            for (int r = 0; r < 4; ++r) if (4 * fg + r > fr) acc[r] = 0.f; }
                        u32x2 w; w.x = cvt_pk_bf16(acc[0], acc[1]); w.y = cvt_pk_bf16(acc[2], acc[3]);
                        *(LAS u32x2*)(hb + HG_P + (16 * isub + fr) * HG_PT + 2 * (16 * j + 4 * fg)) = w;
                    } }
            }
            __syncthreads();
        }
        {
            LAS unsigned char* vt = hb + HG_Q + lane * HG_PT + 64 * half;
#pragma unroll
            for (int q4 = 0; q4 < 4; ++q4) { u32x4 wv; unsigned vw[4];
#pragma unroll
                for (int p = 0; p < 4; ++p) { const int i = q4 * 8 + 2 * p; vw[p] = cvt_pk_bf16(vv[i], vv[i + 1]); }
                wv.x = vw[0]; wv.y = vw[1]; wv.z = vw[2]; wv.w = vw[3]; *(LAS u32x4*)(vt + q4 * 16) = wv; }
#pragma unroll
            for (int i = 0; i < 32; ++i) *(LAS bf16_t*)(hb + HG_K + (32 * half + i) * HG_PT + 2 * lane) = (bf16_t)f2bf(qq[i] * fast_exp(bb[i]));
        }
        __syncthreads();
        {
            const bf16_t* st = (const bf16_t*)(A.ws + WS_ST16) + ci * 4096;
            bf16x8 a_st[4][2];
#pragma unroll
            for (int a = 0; a < 4; ++a)
#pragma unroll
                for (int ks = 0; ks < 2; ++ks) a_st[a][ks] = *(const bf16x8*)(st + (16 * a + fr) * 64 + 32 * ks + 8 * fg);
            bf16_t* YS = (bf16_t*)(A.ws + WS_YS);
            const float* gn = A.in[I_HN] + l * 64;
#pragma unroll
            for (int tt = 0; tt < 2; ++tt) { const int ti = 2 * half + tt;
                bf16x8 bp[2], bqb[2];
#pragma unroll
                for (int ks = 0; ks < 2; ++ks) { bp[ks] = *(const LAS bf16x8*)(hb + HG_P + (16 * ti + fr) * HG_PT + 64 * ks + 16 * fg); bqb[ks] = *(const LAS bf16x8*)(hb + HG_K + (16 * ti + fr) * HG_PT + 64 * ks + 16 * fg); }
                f32x4 o[4]; float ss = 0.f;
#pragma unroll
                for (int a = 0; a < 4; ++a) { f32x4 acc = {0.f, 0.f, 0.f, 0.f};
#pragma unroll
                    for (int ks = 0; ks < 2; ++ks) { const bf16x8 av = *(const LAS bf16x8*)(hb + HG_Q + (16 * a + fr) * HG_PT + 64 * ks + 16 * fg);
                        acc = __builtin_amdgcn_mfma_f32_16x16x32_bf16(av, bp[ks], acc, 0, 0, 0);
                        acc = __builtin_amdgcn_mfma_f32_16x16x32_bf16(a_st[a][ks], bqb[ks], acc, 0, 0, 0); }
                    o[a] = acc; ss += (acc[0] * acc[0] + acc[1] * acc[1]) + (acc[2] * acc[2] + acc[3] * acc[3]); }
                ss += __shfl_xor(ss, 16); ss += __shfl_xor(ss, 32);
                const float rn = 1.0f / sqrtf(ss * (1.0f / 64.0f) + EPS);
                const size_t row = m0 + 16 * ti + fr;
#pragma unroll
                for (int a = 0; a < 4; ++a) { const int dv = 16 * a + 4 * fg;
                    const u32x2 gw = *(const u32x2*)(PROJ + row * NMIX + 1536 + h * 64 + dv);
                    const float g0 = bf2f(gw.x & 0xffffu), g1 = bf2f(gw.x >> 16), g2 = bf2f(gw.y & 0xffffu), g3 = bf2f(gw.y >> 16);
                    const f32x4 gv = *(const f32x4*)(gn + dv);
                    const float y0 = o[a][0] * rn * gv[0] * (g0 * sigmoid_f(g0)), y1 = o[a][1] * rn * gv[1] * (g1 * sigmoid_f(g1));
                    const float y2 = o[a][2] * rn * gv[2] * (g2 * sigmoid_f(g2)), y3 = o[a][3] * rn * gv[3] * (g3 * sigmoid_f(g3));
                    u32x2 w; w.x = cvt_pk_bf16(y0, y1); w.y = cvt_pk_bf16(y2, y3);
                    *(u32x2*)(YS + row * D + 512 + h * 64 + dv) = w; }
            }
        }
        __syncthreads();
    }
}

__device__ __forceinline__ void mix_phase2(const Ctx& C, const Args& A) {
    float* __restrict__ SU = (float*)(A.ws + WS_SU); const float* __restrict__ SD = (const float*)(A.ws + WS_SD);
    int tid_ = C.tid; asm volatile("" : "+v"(tid_));
    const int gt = C.vcu * NTHREADS + tid_, NGT = C.G * NTHREADS;
    for (int e = gt; e < 32 * 4096; e += NGT) {
        const int bh = e >> 12, kv = e & 4095, dk = kv & 63;
        bf16_t* __restrict__ ST16 = (bf16_t*)(A.ws + WS_ST16);
        float s = 0.f;
#pragma unroll 8
        for (int c = 0; c < 64; ++c) { const size_t ci = (size_t)bh * 64 + c; const float u = SU[ci * 4096 + kv]; const float d = SD[ci * 64 + dk]; ST16[ci * 4096 + kv] = (bf16_t)f2bf(s); s = d * s + u; }
    }
    const float* __restrict__ LA = (const float*)(A.ws + WS_LA); const float* __restrict__ LH = (const float*)(A.ws + WS_LH); float* __restrict__ LC = (float*)(A.ws + WS_LC);
    for (int e = gt; e < BATCH * BW; e += NGT) {
        const int b = e >> 8, ch = e & 255; float cr = 0.f;
#pragma unroll 16
        for (int sc = 0; sc < 128; ++sc) { const size_t i = ((size_t)b * 128 + sc) * 256 + ch; const float a = LA[i], hh = LH[i]; LC[i] = cr; cr = a * cr + hh; }
    }
}

#define XB_TMO      128
#define XB_XCNT(j)  (256  + 64 * (j))
#define XB_XSUB(j)  (1280 + 64 * (j))
#define XB_XGEN(j)  (2304 + 64 * (j))
#define XB_TOP      3328
#define XB_TOPGEN   3392
#define XCD_BAR_WORDS 3456
#define XB_SPIN_CAP (1u << 20)
__device__ __forceinline__ unsigned xb_ld(unsigned* p)              { return __hip_atomic_load(p, __ATOMIC_RELAXED, __HIP_MEMORY_SCOPE_AGENT); }
__device__ __forceinline__ unsigned xb_add(unsigned* p, unsigned v) { return __hip_atomic_fetch_add(p, v, __ATOMIC_RELAXED, __HIP_MEMORY_SCOPE_AGENT); }
__device__ __forceinline__ unsigned xb_xcc_id() { return (unsigned)__builtin_amdgcn_s_getreg((3 << 11) | 20) & 0xFu; }
#define XB_SPIN(cond, bar) do { unsigned _sp = 0; while (cond) { __builtin_amdgcn_s_sleep(1); \
    if ((++_sp & 255u) == 0u) { if (xb_ld(&(bar)[XB_TMO])) break; if (_sp > XB_SPIN_CAP) { atomicAdd(&(bar)[XB_TMO], 1u); break; } } } } while (0)
struct XcdBarrier { unsigned* bar; unsigned x; volatile LAS unsigned* st; };
__device__ __forceinline__ XcdBarrier xcd_barrier_post(unsigned* bar, volatile LAS unsigned* st) {
    XcdBarrier b; b.bar = bar; b.x = xb_xcc_id(); b.st = st;
    if (threadIdx.x == 0) (void)xb_add(&bar[XB_XCNT(b.x)], 1u);
    return b;
}
__device__ __forceinline__ void xcd_barrier_complete(unsigned* bar, unsigned x, unsigned& nloc, unsigned& nx) {
    const unsigned G = gridDim.x * gridDim.y * gridDim.z;
    unsigned sum, cnt, mine, sp = 0u;
    for (;;) {
        sum = 0u; cnt = 0u; mine = 0u;
#pragma unroll
        for (unsigned j = 0; j < 16; ++j) { const unsigned c = xb_ld(&bar[XB_XCNT(j)]); sum += c; cnt += (c > 0u) ? 1u : 0u; mine = (j == x) ? c : mine; }
        if (sum == G) break;
        __builtin_amdgcn_s_sleep(1);
        if ((++sp & 255u) == 0u) { if (xb_ld(&bar[XB_TMO])) break; if (sp > XB_SPIN_CAP) { atomicAdd(&bar[XB_TMO], 1u); break; } }
    }
    nloc = mine > 0u ? mine : 1u; nx = cnt > 0u ? cnt : 1u;
}
__device__ __forceinline__ void xcd_barrier(const XcdBarrier& b) {
    asm volatile("s_waitcnt vmcnt(0)" ::: "memory");
    __syncthreads();
    if (threadIdx.x == 0) {
        unsigned* bar = b.bar;
        __builtin_amdgcn_s_waitcnt(0);
        unsigned nloc = b.st[0], nx = b.st[1];
        if (nloc == 0u) { xcd_barrier_complete(bar, b.x, nloc, nx); b.st[0] = nloc; b.st[1] = nx; }
        const unsigned old = xb_add(&bar[XB_XSUB(b.x)], 1u);
        const unsigned gen = old / nloc;
        if (old + 1u == (gen + 1u) * nloc) {
            __builtin_amdgcn_fence(__ATOMIC_RELEASE, "agent");
            asm volatile("s_waitcnt vmcnt(0)" ::: "memory");
            const unsigned og = xb_add(&bar[XB_TOP], 1u);
            const unsigned tg = og / nx;
            if (og + 1u == (tg + 1u) * nx) xb_add(&bar[XB_TOPGEN], 1u);
            else XB_SPIN(xb_ld(&bar[XB_TOPGEN]) == tg, bar);
            __builtin_amdgcn_fence(__ATOMIC_ACQUIRE, "agent");
            xb_add(&bar[XB_XGEN(b.x)], 1u);
            asm volatile("s_waitcnt vmcnt(0)" ::: "memory");
        } else {
            XB_SPIN(xb_ld(&bar[XB_XGEN(b.x)]) == gen, bar);
            __builtin_amdgcn_fence(__ATOMIC_ACQUIRE, "agent");
            asm volatile("s_waitcnt vmcnt(0)" ::: "memory");
        }
    }
    __syncthreads();
}

constexpr int PH_PER_LAYER = 10, N_PHASES = 1 + DEPTH * PH_PER_LAYER;
constexpr int CW_BAR = 4096;

__global__ void __launch_bounds__(NTHREADS, 2) trunk_fwd(Args args) {
    extern __shared__ __attribute__((aligned(16))) unsigned char lds_raw[];
    Ctx C;
    C.lds = (LAS unsigned char*)lds_raw; C.tid = threadIdx.x; C.lane = C.tid & 63; C.wave = __builtin_amdgcn_readfirstlane(C.tid >> 6);
    C.G = gridDim.x; { const int bx = blockIdx.x; C.vcu = (C.G % 8 == 0) ? (bx % 8) * (C.G / 8) + bx / 8 : bx; }
    unsigned char* ws = args.ws;
    volatile LAS unsigned* MISC = (volatile LAS unsigned*)(C.lds + MISC_OFF);
    if (C.tid < 64) MISC[C.tid] = 0u;
    __syncthreads();
#if MK_PER_PHASE
#define GRID_BAR() do { } while (0)
#else
    cg::grid_group grid = cg::this_grid();
    XcdBarrier bar = xcd_barrier_post((unsigned*)(ws + WS_CTL) + CW_BAR, MISC + 8);
    bool first_bar = true;
#define GRID_BAR() do { if (first_bar) { grid.sync(); first_bar = false; } else { xcd_barrier(bar); } } while (0)
#endif
    const int lo = args.ph_lo, hi = args.ph_hi;
    int ph = 0;
#define PHASE_BEGIN if (ph >= lo && ph < hi) { for (int rep_ = 0; rep_ < (((DBG_REPEAT >> ((ph - 1) % PH_PER_LAYER + 1)) & 1) && ph > 0 ? 2 : 1); ++rep_) {
#define PHASE_END   if (rep_ == 0 && (((DBG_REPEAT >> ((ph - 1) % PH_PER_LAYER + 1)) & 1) && ph > 0)) GRID_BAR(); } if (ph + 1 < hi && ph + 1 < N_PHASES) GRID_BAR(); } ++ph;

    PHASE_BEGIN p0_prologue(C, args); PHASE_END

    for (int li = 0; li < DEPTH; ++li) {
        int l = li; asm volatile("" : "+s"(l));
        const unsigned char* wl = ws + WS_W + (size_t)l * W_LAYER;
        const float* RS = (const float*)(ws + WS_RS);
        PHASE_BEGIN {
            pg8::StaticOrder S; S.init(ws + WS_HB, wl + W_IN, M, NMIX, D, C.G, (int)blockIdx.x);
            pg8::EpiRow<1> E{(bf16_t*)(ws + WS_PROJ), NMIX, RS};
            pg8::gemm_phase<pg8::EpiRow<1>, pg8::StaticOrder, true>(C.lds, D, S, E);
        } PHASE_END
        PHASE_BEGIN {
            for (int item = C.vcu; item < BATCH * 64; item += C.G) { const int b = item >> 6, c = item & 63;
                mix1_item(C, args, l, b, c);
                hgrn_item<false>(C, args, l, b, c); }
        } PHASE_END
        PHASE_BEGIN mix_phase2(C, args); PHASE_END
        PHASE_BEGIN {
            for (int item = C.vcu; item < BATCH * 64; item += C.G) { const int b = item >> 6, c = item & 63;
                lru_final_item(C, args, l, b, c);
                hgrn_item<true>(C, args, l, b, c); }
        } PHASE_END
        PHASE_BEGIN {
            pg8::GateOrder S{(const char*)(ws + WS_HB), (const char*)(wl + W_IN) + (size_t)NMIX * D * 2, (const char*)(ws + WS_YS), (const char*)(wl + W_BR), C.G, C.vcu};
            pg8::EpiGate E{(bf16_t*)(ws + WS_G) + (size_t)blockIdx.x * 4 * 65536, (bf16_t*)(ws + WS_MERGED), RS};
            pg8::gemm_phase<pg8::EpiGate, pg8::GateOrder, false>(C.lds, D, S, E);
        } PHASE_END
        PHASE_BEGIN {
            pg8::StaticOrder S; S.init(ws + WS_MERGED, wl + W_OUT, M, D, D, C.G, (int)blockIdx.x);
            pg8::EpiRow<0> E{(bf16_t*)(ws + WS_MIX), D, nullptr};
            pg8::gemm_phase<pg8::EpiRow<0>, pg8::StaticOrder, true>(C.lds, D, S, E);
        } PHASE_END
        PHASE_BEGIN norm_phase(C, args, (const bf16_t*)(ws + WS_MIX), args.in[I_NMIXPOST] + l * D, false); PHASE_END
        PHASE_BEGIN {
            pg8::StaticOrder S; S.init(ws + WS_HB, wl + W_UP, M, FF, D, C.G, (int)blockIdx.x);
            pg8::EpiRow<2> E{(bf16_t*)(ws + WS_HID), FF, RS};
            pg8::gemm_phase<pg8::EpiRow<2>, pg8::StaticOrder, true>(C.lds, D, S, E);
        } PHASE_END
        PHASE_BEGIN {
            pg8::StaticOrder S; S.init(ws + WS_HID, wl + W_DOWN, M, D, FF, C.G, (int)blockIdx.x);
            pg8::EpiRow<0> E{(bf16_t*)(ws + WS_MOUT), D, nullptr};
            pg8::gemm_phase<pg8::EpiRow<0>, pg8::StaticOrder, true>(C.lds, FF, S, E);
        } PHASE_END
        PHASE_BEGIN norm_phase(C, args, (const bf16_t*)(ws + WS_MOUT), args.in[I_NMLPPOST] + l * D, li == DEPTH - 1); PHASE_END
    }
}

extern "C" void kernel_launch(void* const* d_in, const int* in_sizes, int n_in, void* d_out, int out_size, void* d_ws, size_t ws_size, hipStream_t stream) {
    static int grid = 0;
    if (grid == 0) {
        if (n_in != 22 || in_sizes[0] != M * D || out_size != M * D || ws_size < WS_END) { fprintf(stderr, "kernel_launch: unexpected shapes (n_in %d, in0 %d, out %d, ws %zu)\n", n_in, n_in > 0 ? in_sizes[0] : -1, out_size, ws_size); grid = -1; return; }
        int dev = 0, cus = 0, per_cu = 0;
        if (hipGetDevice(&dev) != hipSuccess || hipDeviceGetAttribute(&cus, hipDeviceAttributeMultiprocessorCount, dev) != hipSuccess) { grid = -1; return; }
        if (hipFuncSetAttribute((const void*)trunk_fwd, hipFuncAttributeMaxDynamicSharedMemorySize, LDS_BYTES) != hipSuccess) { fprintf(stderr, "kernel_launch: hipFuncSetAttribute failed\n"); grid = -1; return; }
        if (hipOccupancyMaxActiveBlocksPerMultiprocessor(&per_cu, (const void*)trunk_fwd, NTHREADS, LDS_BYTES) != hipSuccess || per_cu < 1) { fprintf(stderr, "kernel_launch: occupancy query says %d blocks per CU\n", per_cu); (void)hipGetLastError(); grid = -1; return; }
        grid = cus;
    }
    if (grid < 0) return;
    (void)hipMemsetAsync((char*)d_ws + WS_CTL, 0, CTL_ZERO_BYTES, stream);
    Args a{};
    for (int i = 0; i < 22; ++i) a.in[i] = (const float*)d_in[i];
    a.out = (float*)d_out; a.ws = (unsigned char*)d_ws;
#if MK_PER_PHASE
#ifndef DBG_MAXPH
#define DBG_MAXPH N_PHASES
#endif
    for (int p = 0; p < DBG_MAXPH; ++p) { a.ph_lo = p; a.ph_hi = p + 1; hipLaunchKernelGGL(trunk_fwd, dim3(grid), dim3(NTHREADS), LDS_BYTES, stream, a); }
#else
    a.ph_lo = 0; a.ph_hi = N_PHASES;
    void* kargs[] = {&a};
    hipError_t e = hipLaunchCooperativeKernel((const void*)trunk_fwd, dim3(grid), dim3(NTHREADS), kargs, LDS_BYTES, stream);
    if (e != hipSuccess) fprintf(stderr, "kernel_launch: cooperative launch failed: %s (grid %d)\n", hipGetErrorString(e), grid);
#endif
}
```

```cpp
#include <hip/hip_runtime.h>
#include <hip/hip_cooperative_groups.h>
#include <cstdio>
#include <cstdint>
namespace cg = cooperative_groups;

#ifndef DBG_ZERO
#define DBG_ZERO -1
#endif
#ifndef DBG_REPEAT
#define DBG_REPEAT 0
#endif
#ifndef MK_PER_PHASE
#define MK_PER_PHASE 0
#endif

#define LAS __attribute__((address_space(3)))
#define GAS __attribute__((address_space(1)))
typedef unsigned short bf16_t;
typedef short bf16x8 __attribute__((ext_vector_type(8)));
typedef float f32x4 __attribute__((ext_vector_type(4)));
typedef float f32x2 __attribute__((ext_vector_type(2)));
typedef unsigned u32x4 __attribute__((ext_vector_type(4)));
typedef unsigned u32x2 __attribute__((ext_vector_type(2)));

constexpr int BATCH = 8, T = 4096, D = 1024, M = BATCH * T, DEPTH = 2, BW = 256;
constexpr int NMIX = 2560, NGATE = 4096, INW = NMIX + NGATE, FF = 4096;
constexpr float EPS = 1e-6f;
constexpr int NWAVES = 8, NTHREADS = 512;

constexpr size_t MiB = 1u << 20;
constexpr size_t WS_CTL = 0, CTL_ZERO_BYTES = 1 * MiB;
constexpr size_t WS_RS = 1 * MiB;
constexpr size_t WS_SD = 1 * MiB + 512 * 1024;
constexpr size_t WS_LA = 2 * MiB, WS_LH = 3 * MiB, WS_LC = 4 * MiB;
constexpr size_t WS_W = 8 * MiB;
constexpr size_t W_IN = 0, W_BR = 13 * MiB, W_OUT = 15 * MiB, W_UP = 17 * MiB, W_DOWN = 25 * MiB, W_LAYER = 33 * MiB;
constexpr size_t WS_HB = 76 * MiB;
constexpr size_t WS_PROJ = 140 * MiB;
constexpr size_t WS_G = WS_PROJ;
constexpr size_t WS_YS = 300 * MiB;
constexpr size_t WS_MERGED = 364 * MiB;
constexpr size_t WS_SU = WS_MERGED;
constexpr size_t WS_MIX = WS_PROJ;
constexpr size_t WS_MOUT = 396 * MiB;
constexpr size_t WS_HID = WS_PROJ;
constexpr size_t WS_END = 460 * MiB;

constexpr int LDS_BYTES = 155648;
constexpr int MISC_OFF = 154624;

__device__ __forceinline__ float bf2f(unsigned b) { return __uint_as_float(b << 16); }
__device__ __forceinline__ unsigned f2bf(float f) { unsigned u = __float_as_uint(f); return (u + 0x7fffu + ((u >> 16) & 1u)) >> 16; }
__device__ __forceinline__ unsigned pk2(float lo, float hi) { return f2bf(lo) | (f2bf(hi) << 16); }
typedef __bf16 bf16x2_t __attribute__((ext_vector_type(2)));
__device__ __forceinline__ unsigned cvt_pk_bf16(float lo, float hi) { f32x2 v = {lo, hi}; bf16x2_t b = __builtin_convertvector(v, bf16x2_t); return __builtin_bit_cast(unsigned, b); }
__device__ __forceinline__ float fast_exp(float x) { return __builtin_amdgcn_exp2f(x * 1.4426950408889634f); }
__device__ __forceinline__ float sigmoid_f(float x) { return __builtin_amdgcn_rcpf(1.0f + fast_exp(-x)); }
__device__ __forceinline__ void ld8bf(const bf16_t* p, float (&o)[8]) {
    const u32x4 v = *(const u32x4*)p;
    o[0] = bf2f(v.x & 0xffffu); o[1] = bf2f(v.x >> 16); o[2] = bf2f(v.y & 0xffffu); o[3] = bf2f(v.y >> 16);
    o[4] = bf2f(v.z & 0xffffu); o[5] = bf2f(v.z >> 16); o[6] = bf2f(v.w & 0xffffu); o[7] = bf2f(v.w >> 16);
}
__device__ __forceinline__ float wave_sum(float v) {
#pragma unroll
    for (int o = 1; o < 64; o <<= 1) v += __shfl_xor(v, o);
    return v;
}

namespace pg8 {
constexpr int BM = 256, BK = 64, HALF = 128, HTB = HALF * BK * 2, STAGE_BYTES = 8 * HTB, NXCD = 8, WGM = 4;
__host__ __device__ __forceinline__ int lds_byte(int r, int c) { const int st = (r >> 4) * 2 + (c >> 5), rr = r & 15, cc = c & 31, ob = rr * 64 + cc * 2; return st * 1024 + (ob ^ (((ob >> 9) & 1) << 5)); }
__host__ __device__ __forceinline__ void stage_rc(int b, int& R, int& C) { const int st = b / 1024, sb = b % 1024, swz = sb ^ (((sb >> 9) & 1) << 5); R = (st >> 1) * 16 + swz / 64; C = (st & 1) * 32 + (swz % 64) / 2; }
__host__ __device__ __forceinline__ int perm32(int rho) { const int n = rho >> 4, i = rho & 15; return 8 * (i >> 2) + 4 * n + (i & 3); }

struct Unit { int pm, pn, kind; };

struct StaticOrder {
    const char* A; const char* Bt; size_t tstep;
    int nM, nN, nwg, G, c;
    __device__ void init(const void* A_, const void* Bt_, int M_, int N_, int K_, int G_, int c_) { A = (const char*)A_; Bt = (const char*)Bt_; tstep = (size_t)BM * K_ * 2; nt = K_ / BK; nM = M_ / BM; nN = N_ / BM; nwg = nM * nN; G = G_; c = c_; }
    __device__ bool next(int i, Unit& u) const {
        const long L = (long)i * G + c; if (L >= nwg) return false;
        int wgid = (int)L; { const int q = nwg / NXCD, r = nwg % NXCD, xcd = wgid % NXCD, off = wgid / NXCD; wgid = (xcd < r ? xcd * (q + 1) : r * (q + 1) + (xcd - r) * q) + off; }
        const int nig = WGM * nN, gid = wgid / nig, fm = gid * WGM, gsz = (nM - fm) < WGM ? (nM - fm) : WGM;
        u.pm = fm + ((wgid % nig) % gsz); u.pn = (wgid % nig) / gsz; u.kind = 0; return true;
    }
    __device__ __forceinline__ void tiles(const Unit& u, const char*& a, const char*& b) const { a = A + (size_t)u.pm * tstep; b = Bt + (size_t)u.pn * tstep; }
    int nt;
    __device__ __forceinline__ int ntiles(const Unit&) const { return nt; }
    __device__ __forceinline__ bool keep_acc(const Unit&) const { return false; }
};

struct GateOrder {
    const char* HB; const char* WGt; const char* YS; const char* WB; int G, vcu;
    __device__ bool next(int i, Unit& u) const {
        const int r = i / 16, ii = i % 16, su = vcu + r * G; if (su >= 256) return false;
        const int half = ii / 8, j = ii % 8;
        u.pm = half * 64 + (su >> 2); u.kind = j; u.pn = (j < 4) ? (j * 4 + (su & 3)) : (su & 3); return true;
    }
    __device__ __forceinline__ int ntiles(const Unit& u) const { return u.kind < 4 ? 16 : 4; }
    __device__ __forceinline__ bool keep_acc(const Unit& nx) const { return nx.kind > 4; }
    __device__ __forceinline__ void tiles(const Unit& u, const char*& a, const char*& b) const {
        const size_t ts = (size_t)BM * 1024 * 2;
        if (u.kind < 4) { a = HB + (size_t)u.pm * ts; b = WGt + (size_t)u.pn * ts; } else { a = YS + (size_t)u.pm * ts + (size_t)(u.kind - 4) * 512; b = WB + (size_t)u.pn * ts + (size_t)(u.kind - 4) * 512; }
    }
};

template <int MODE  > struct EpiRow {
    static constexpr bool PERM = true;
    bf16_t* O; int ldc; const float* rs;
    __device__ __forceinline__ void operator()(f32x4 (&acc)[2][2][4][2], const Unit& u, int wr, int wc, int fr, int fq) const {
        const int row0 = u.pm * BM + wr * 64 + fr, col0 = u.pn * BM + wc * 32 + 8 * fq;
#pragma unroll
        for (int ai = 0; ai < 2; ++ai)
#pragma unroll
            for (int m = 0; m < 4; ++m) {
                const int row = row0 + ai * HALF + m * 16; const float sc = (MODE != 0) ? rs[row] : 1.0f;
                bf16_t* rowp = O + (size_t)row * ldc + col0;
#pragma unroll
                for (int bj = 0; bj < 2; ++bj) {
                    f32x4 v0 = acc[ai][bj][m][0], v1 = acc[ai][bj][m][1];
                    if (MODE != 0) { v0 = v0 * sc; v1 = v1 * sc; }
                    if (MODE == 2) {
#pragma unroll
                        for (int j = 0; j < 4; ++j) { const float a = fmaxf(v0[j], 0.f), b = fmaxf(v1[j], 0.f); v0[j] = a * a; v1[j] = b * b; }
                    }
                    u32x4 w; w.x = cvt_pk_bf16(v0[0], v0[1]); w.y = cvt_pk_bf16(v0[2], v0[3]); w.z = cvt_pk_bf16(v1[0], v1[1]); w.w = cvt_pk_bf16(v1[2], v1[3]);
                    *(u32x4*)(rowp + bj * HALF) = w;
                }
            }
    }
};

struct EpiGate {
    static constexpr bool PERM = true;
    bf16_t* Gt;
    bf16_t* MERGED;
    const float* rs;
    __device__ __forceinline__ void rescale(f32x4 (&acc)[2][2][4][2], int j, int wr, int wc, int fr, int fq) const {
        int lane_off = (wr * 64 + fr) * 256 + wc * 32 + 8 * fq; asm volatile("" : "+v"(lane_off));
        const bf16_t* g0 = Gt + (size_t)j * 65536; const bf16_t* g1 = g0 + 65536;
#pragma unroll
        for (int ai = 0; ai < 2; ++ai)
#pragma unroll
            for (int mp = 0; mp < 2; ++mp) {
                u32x4 a[2][2], b[2][2];
#pragma unroll
                for (int mm = 0; mm < 2; ++mm)
#pragma unroll
                    for (int bj = 0; bj < 2; ++bj) { const int off = lane_off + (ai * HALF + (mp * 2 + mm) * 16) * 256 + bj * HALF; a[mm][bj] = *(const u32x4*)(g0 + off); b[mm][bj] = *(const u32x4*)(g1 + off); }
#pragma unroll
                for (int mm = 0; mm < 2; ++mm)
#pragma unroll
                    for (int bj = 0; bj < 2; ++bj) {
                        const int m = mp * 2 + mm;
                        const unsigned aw[4] = {a[mm][bj].x, a[mm][bj].y, a[mm][bj].z, a[mm][bj].w}, bw[4] = {b[mm][bj].x, b[mm][bj].y, b[mm][bj].z, b[mm][bj].w};
#pragma unroll
                        for (int q = 0; q < 4; ++q) {
                            const float r0 = bf2f(aw[q] & 0xffffu) * __builtin_amdgcn_rcpf(bf2f(bw[q] & 0xffffu)), r1 = bf2f(aw[q] >> 16) * __builtin_amdgcn_rcpf(bf2f(bw[q] >> 16));
                            acc[ai][bj][m][q >> 1][(q & 1) * 2] *= r0; acc[ai][bj][m][q >> 1][(q & 1) * 2 + 1] *= r1;
                        }
                    }
                asm volatile("" ::: "memory");
            }
    }
    __device__ __forceinline__ void operator()(f32x4 (&acc)[2][2][4][2], const Unit& u, int wr, int wc, int fr, int fq) const {
        if (u.kind >= 4 && u.kind < 7) { rescale(acc, u.kind - 4, wr, wc, fr, fq); return; }
        int rl0 = wr * 64 + fr, cl0 = wc * 32 + 8 * fq; asm volatile("" : "+v"(rl0), "+v"(cl0));
        if (u.kind < 4) {
            bf16_t* gt = Gt + (size_t)u.kind * 65536;
#pragma unroll
            for (int ai = 0; ai < 2; ++ai)
#pragma unroll
                for (int m = 0; m < 4; ++m) {
                    const int rl = rl0 + ai * HALF + m * 16; const float sc = rs[u.pm * BM + rl];
#pragma unroll
                    for (int bj = 0; bj < 2; ++bj) {
                        f32x4 v0 = acc[ai][bj][m][0] * sc, v1 = acc[ai][bj][m][1] * sc;
#pragma unroll
                        for (int j = 0; j < 4; ++j) { v0[j] = sigmoid_f(fmaxf(v0[j], -60.f)); v1[j] = sigmoid_f(fmaxf(v1[j], -60.f)); }
                        u32x4 w; w.x = cvt_pk_bf16(v0[0], v0[1]); w.y = cvt_pk_bf16(v0[2], v0[3]); w.z = cvt_pk_bf16(v1[0], v1[1]); w.w = cvt_pk_bf16(v1[2], v1[3]);
                        *(u32x4*)(gt + rl * 256 + cl0 + bj * HALF) = w;
                    }
                }
        } else {
            const bf16_t* g3 = Gt + (size_t)3 * 65536;
#pragma unroll
            for (int ai = 0; ai < 2; ++ai)
#pragma unroll
                for (int m = 0; m < 4; ++m) {
                    const int rl = rl0 + ai * HALF + m * 16;
                    bf16_t* rowp = MERGED + (size_t)(u.pm * BM + rl) * 1024 + u.pn * BM + cl0;
#pragma unroll
                    for (int bj = 0; bj < 2; ++bj) {
                        const u32x4 s = *(const u32x4*)(g3 + rl * 256 + cl0 + bj * HALF);
                        f32x4 v0 = acc[ai][bj][m][0], v1 = acc[ai][bj][m][1];
                        v0[0] *= bf2f(s.x & 0xffffu); v0[1] *= bf2f(s.x >> 16); v0[2] *= bf2f(s.y & 0xffffu); v0[3] *= bf2f(s.y >> 16);
                        v1[0] *= bf2f(s.z & 0xffffu); v1[1] *= bf2f(s.z >> 16); v1[2] *= bf2f(s.w & 0xffffu); v1[3] *= bf2f(s.w >> 16);
                        u32x4 w; w.x = cvt_pk_bf16(v0[0], v0[1]); w.y = cvt_pk_bf16(v0[2], v0[3]); w.z = cvt_pk_bf16(v1[0], v1[1]); w.w = cvt_pk_bf16(v1[2], v1[3]);
                        *(u32x4*)(rowp + bj * HALF) = w;
                    }
                }
        }
    }
};

template <class Epi, class Sched, bool ALIGN_EPI>
__device__ __forceinline__ void gemm_phase(LAS unsigned char* lds, const int K, const Sched& S, const Epi& E) {
    int tid = threadIdx.x; asm volatile("" : "+v"(tid));
    const int wid = __builtin_amdgcn_readfirstlane(tid >> 6), lane = tid & 63, wr = wid >> 2, wc = wid & 3, fr = lane & 15, fq = lane >> 4;
    unsigned voffA[2], voffB[2];
#pragma unroll
    for (int i = 0; i < 2; ++i) { int R, C; stage_rc(tid * 16 + i * 8192, R, C); const int Rb = Epi::PERM ? ((R & ~31) + perm32(R & 31)) : R;
        voffA[i] = (unsigned)(R * K + C) * 2u; voffB[i] = (unsigned)(Rb * K + C) * 2u; }
    const size_t kstep = (size_t)(BK * 2);
    const size_t hstep = (size_t)HALF * K * 2;
    const unsigned ldsw = (unsigned)wid * 1024u;
    const int aoff = lds_byte(wr * 64 + fr, fq * 8), boff = lds_byte(wc * 32 + fr, fq * 8);
#define PG8_SA(b, h) (((b) * 2 + (h)) * HTB)
#define PG8_SB(b, h) ((4 + (b) * 2 + (h)) * HTB)
#define PG8_STAGE(bufoff, gbase, voff) do { _Pragma("unroll") for (int _i = 0; _i < 2; ++_i) \
        __builtin_amdgcn_global_load_lds((const unsigned*)((const char*)(gbase) + (voff)[_i]), (LAS unsigned*)(lds + (bufoff) + ldsw + _i * 8192), 16, 0, 0); } while (0)
#define PG8_LDA(dst, b, h) do { _Pragma("unroll") for (int m = 0; m < 4; ++m) _Pragma("unroll") for (int k = 0; k < 2; ++k) dst[m][k] = *(const LAS bf16x8*)(lds + PG8_SA(b, h) + aoff + m * 2048 + k * 1024); } while (0)
#define PG8_LDB(dst, b, h) do { _Pragma("unroll") for (int n = 0; n < 2; ++n) _Pragma("unroll") for (int k = 0; k < 2; ++k) dst[n][k] = *(const LAS bf16x8*)(lds + PG8_SB(b, h) + boff + n * 2048 + k * 1024); } while (0)
#define PG8_MMA(ai, bj, At, Bt) do { __builtin_amdgcn_s_setprio(1); _Pragma("unroll") for (int m = 0; m < 4; ++m) _Pragma("unroll") for (int n = 0; n < 2; ++n) _Pragma("unroll") for (int k = 0; k < 2; ++k) \
        acc[ai][bj][m][n] = __builtin_amdgcn_mfma_f32_16x16x32_bf16(Bt[n][k], At[m][k], acc[ai][bj][m][n], 0, 0, 0); __builtin_amdgcn_s_setprio(0); } while (0)
#define PG8_WAIT_V(n) asm volatile("s_waitcnt vmcnt(" #n ")" ::: "memory")
#define PG8_WAIT_L(n) asm volatile("s_waitcnt lgkmcnt(" #n ")" ::: "memory")
#define PG8_BAR __builtin_amdgcn_s_barrier()
#define PG8_SCHED __builtin_amdgcn_sched_barrier(0)
    Unit cur, nxt; int ui = 0;
    if (!S.next(0, cur)) return;
    f32x4 acc[2][2][4][2];
#pragma unroll
    for (int a = 0; a < 2; ++a)
#pragma unroll
        for (int b = 0; b < 2; ++b)
#pragma unroll
            for (int m = 0; m < 4; ++m)
#pragma unroll
                for (int n = 0; n < 2; ++n) acc[a][b][m][n] = (f32x4){0.f, 0.f, 0.f, 0.f};
    bf16x8 At[4][2], B0[2][2], B1[2][2];
    const char* cA; const char* cB; S.tiles(cur, cA, cB);
    PG8_STAGE(PG8_SB(0, 0), cB, voffB); PG8_STAGE(PG8_SB(0, 1), cB + hstep, voffB); PG8_STAGE(PG8_SA(0, 0), cA, voffA); PG8_STAGE(PG8_SA(0, 1), cA + hstep, voffA);
    if (wr == 1) PG8_BAR;
    PG8_WAIT_V(2); PG8_BAR;
    PG8_STAGE(PG8_SB(1, 0), cB + kstep, voffB); PG8_STAGE(PG8_SA(1, 0), cA + kstep, voffA); PG8_STAGE(PG8_SB(1, 1), cB + hstep + kstep, voffB);
    PG8_WAIT_V(6); PG8_BAR;
    for (;;) {
        const bool has_next = S.next(ui + 1, nxt);
        const char* nA = cA; const char* nB = cB; if (has_next) S.tiles(nxt, nA, nB);
#define PG8_KT2(t, last) do { \
            const char* a1 = cA + (size_t)((t) + 1) * kstep; \
            const char* a2 = (last) ? nA : cA + (size_t)((t) + 2) * kstep; const char* b2 = (last) ? nB : cB + (size_t)((t) + 2) * kstep; \
            const char* a3 = a2 + kstep; const char* b3 = b2 + kstep; \
            PG8_LDB(B0, 0, 0); PG8_LDB(B1, 0, 1); PG8_SCHED; PG8_LDA(At, 0, 0); PG8_STAGE(PG8_SA(1, 1), a1 + hstep, voffA); \
            PG8_WAIT_V(8); PG8_WAIT_L(0); PG8_BAR; PG8_MMA(0, 0, At, B0); PG8_MMA(0, 1, At, B1); PG8_BAR; PG8_SCHED; \
            PG8_LDA(At, 0, 1); PG8_STAGE(PG8_SB(0, 0), b2, voffB); PG8_STAGE(PG8_SB(0, 1), b2 + hstep, voffB); PG8_STAGE(PG8_SA(0, 0), a2, voffA); \
            PG8_WAIT_V(8); PG8_WAIT_L(0); PG8_BAR; PG8_MMA(1, 0, At, B0); PG8_MMA(1, 1, At, B1); PG8_BAR; PG8_SCHED; \
            PG8_LDB(B0, 1, 0); PG8_LDB(B1, 1, 1); PG8_SCHED; PG8_LDA(At, 1, 0); PG8_STAGE(PG8_SA(0, 1), a2 + hstep, voffA); \
            PG8_WAIT_V(8); PG8_WAIT_L(0); PG8_BAR; PG8_MMA(0, 0, At, B0); PG8_MMA(0, 1, At, B1); PG8_BAR; PG8_SCHED; \
            PG8_LDA(At, 1, 1); PG8_STAGE(PG8_SB(1, 0), b3, voffB); PG8_STAGE(PG8_SB(1, 1), b3 + hstep, voffB); PG8_STAGE(PG8_SA(1, 0), a3, voffA); \
            PG8_WAIT_V(8); PG8_WAIT_L(0); PG8_BAR; PG8_MMA(1, 0, At, B0); PG8_MMA(1, 1, At, B1); PG8_BAR; PG8_SCHED; } while (0)
        {
            const int ntc = S.ntiles(cur);
#pragma unroll 1
            for (int t = 0; t < ntc; t += 2) { const bool last = (t == ntc - 2); PG8_KT2(t, last); }
        }
        if constexpr (ALIGN_EPI) { if (wr == 0) PG8_BAR; }
        E(acc, cur, wr, wc, fr, fq);
        if (!has_next) break;
        if (!S.keep_acc(nxt)) {
#pragma unroll
        for (int a = 0; a < 2; ++a)
#pragma unroll
            for (int b = 0; b < 2; ++b)
#pragma unroll
                for (int m = 0; m < 4; ++m)
#pragma unroll
                    for (int n = 0; n < 2; ++n) acc[a][b][m][n] = (f32x4){0.f, 0.f, 0.f, 0.f};
        }
        cur = nxt; cA = nA; cB = nB; ++ui;
        if constexpr (ALIGN_EPI) { if (wr == 1) PG8_BAR; }
    }
    PG8_WAIT_V(0);
    if constexpr (!ALIGN_EPI) { if (wr == 0) PG8_BAR; }
    PG8_BAR;
#undef PG8_KT2
#undef PG8_SA
#undef PG8_SB
#undef PG8_STAGE
#undef PG8_LDA
#undef PG8_LDB
#undef PG8_MMA
#undef PG8_WAIT_V
#undef PG8_WAIT_L
#undef PG8_BAR
#undef PG8_SCHED
}
}

struct Args {
    const float* in[22]; float* out; unsigned char* ws; int ph_lo, ph_hi;
};
enum { I_X = 0, I_NMIXPRE, I_NMIXPOST, I_NMLPPRE, I_NMLPPOST, I_WIN, I_LCW, I_LCB, I_LWA, I_LBA, I_LWX, I_LBX, I_LLAM, I_PW, I_PS, I_HLB, I_HN, I_SW, I_WBR, I_WOUT, I_WUP, I_WDOWN };

struct Ctx {
    LAS unsigned char* lds; int tid, lane, wave, vcu, G;
};

__device__ __forceinline__ void transpose_item(const float* W, int ldw, const float* gain, bf16_t* WT, int ldo, int col_off, int k0, int n0, LAS float* scr, int lane) {
#pragma unroll 8
    for (int i = 0; i < 32; ++i) { const int kk = 2 * i + (lane >> 5); const float g = gain ? gain[k0 + kk] : 1.0f; scr[kk * 33 + (lane & 31)] = g * W[(size_t)(k0 + kk) * ldw + n0 + (lane & 31)]; }
    asm volatile("s_waitcnt lgkmcnt(0)" ::: "memory");
    const int c = lane & 7;
#pragma unroll
    for (int j = 0; j < 4; ++j) { const int n = (lane >> 3) + 8 * j; const LAS float* s = scr + (8 * c) * 33 + n;
        u32x4 o; o.x = pk2(s[0 * 33], s[1 * 33]); o.y = pk2(s[2 * 33], s[3 * 33]); o.z = pk2(s[4 * 33], s[5 * 33]); o.w = pk2(s[6 * 33], s[7 * 33]);
        *(u32x4*)(WT + (size_t)(n0 + n) * ldo + col_off + k0 + 8 * c) = o; }
    asm volatile("s_waitcnt lgkmcnt(0)" ::: "memory");
}

__device__ __forceinline__ void p0_prologue(const Ctx& C, const Args& A) {
    LAS float* scr = (LAS float*)(C.lds + C.wave * 16384);
    const int gw = C.vcu * NWAVES + C.wave, NGW = C.G * NWAVES;
    constexpr int I_IN = (D / 64) * (INW / 32), I_BR1 = (BW / 64) * (D / 32), I_OUT = (D / 64) * (D / 32), I_UP = (D / 64) * (FF / 32), I_DN = (FF / 64) * (D / 32);
    constexpr int PER_LAYER = I_IN + 4 * I_BR1 + I_OUT + I_UP + I_DN;
    for (int it = gw; it < DEPTH * PER_LAYER; it += NGW) {
        const int l = it / PER_LAYER; int r = it % PER_LAYER;
        bf16_t* wl = (bf16_t*)(A.ws + WS_W + (size_t)l * W_LAYER);
        if (r < I_IN) { const int nb = INW / 32; transpose_item(A.in[I_WIN] + (size_t)l * D * INW, INW, A.in[I_NMIXPRE] + l * D, wl + W_IN / 2, D, 0, 64 * (r / nb), 32 * (r % nb), scr, C.lane); continue; } r -= I_IN;
        if (r < 4 * I_BR1) { const int k = r / I_BR1, rr = r % I_BR1, nb = D / 32; transpose_item(A.in[I_WBR] + ((size_t)l * 4 + k) * BW * D, D, nullptr, wl + W_BR / 2, D, k * BW, 64 * (rr / nb), 32 * (rr % nb), scr, C.lane); continue; } r -= 4 * I_BR1;
        if (r < I_OUT) { const int nb = D / 32; transpose_item(A.in[I_WOUT] + (size_t)l * D * D, D, nullptr, wl + W_OUT / 2, D, 0, 64 * (r / nb), 32 * (r % nb), scr, C.lane); continue; } r -= I_OUT;
        if (r < I_UP) { const int nb = FF / 32; transpose_item(A.in[I_WUP] + (size_t)l * D * FF, FF, A.in[I_NMLPPRE] + l * D, wl + W_UP / 2, D, 0, 64 * (r / nb), 32 * (r % nb), scr, C.lane); continue; } r -= I_UP;
        { const int nb = D / 32; transpose_item(A.in[I_WDOWN] + (size_t)l * FF * D, D, nullptr, wl + W_DOWN / 2, FF, 0, 64 * (r / nb), 32 * (r % nb), scr, C.lane); }
    }
    bf16_t* HB = (bf16_t*)(A.ws + WS_HB); float* RS = (float*)(A.ws + WS_RS);
    for (int m = gw; m < M; m += NGW) {
        const f32x4* xr = (const f32x4*)(A.in[I_X] + (size_t)m * D) + C.lane;
        f32x4 v[4]; float s = 0.f;
#pragma unroll
        for (int j = 0; j < 4; ++j) { v[j] = xr[64 * j]; s += (v[j].x * v[j].x + v[j].y * v[j].y) + (v[j].z * v[j].z + v[j].w * v[j].w); }
        s = wave_sum(s);
        u32x2* o8 = (u32x2*)(HB + (size_t)m * D) + C.lane;
#pragma unroll
        for (int j = 0; j < 4; ++j) { u32x2 w; w.x = pk2(v[j].x, v[j].y); w.y = pk2(v[j].z, v[j].w); o8[64 * j] = w; }
        if (C.lane == 0) RS[m] = 1.0f / sqrtf(s * (1.0f / D) + EPS);
    }
}

__device__ __forceinline__ void norm_phase(const Ctx& C, const Args& A, const bf16_t* VIN, const float* gain, bool write_out) {
    bf16_t* HB = (bf16_t*)(A.ws + WS_HB); float* RS = (float*)(A.ws + WS_RS); float* OUT = A.out;
    int lane = C.lane; asm volatile("" : "+v"(lane));
    const int gw = C.vcu * NWAVES + C.wave, NGW = C.G * NWAVES;
    f32x4 g[4];
#pragma unroll
    for (int j = 0; j < 4; ++j) g[j] = ((const f32x4*)gain)[lane + 64 * j];
    for (int m = gw; m < M; m += NGW) {
        u32x2* hb = (u32x2*)(HB + (size_t)m * D) + lane;
        const u32x2* vb = (const u32x2*)(VIN + (size_t)m * D) + lane;
        f32x4 v[4], h[4]; float s = 0.f;
#pragma unroll
        for (int j = 0; j < 4; ++j) { const u32x2 w = vb[64 * j], hw = hb[64 * j];
            v[j] = (f32x4){bf2f(w.x & 0xffffu), bf2f(w.x >> 16), bf2f(w.y & 0xffffu), bf2f(w.y >> 16)};
            h[j] = (f32x4){bf2f(hw.x & 0xffffu), bf2f(hw.x >> 16), bf2f(hw.y & 0xffffu), bf2f(hw.y >> 16)};
            s += (v[j].x * v[j].x + v[j].y * v[j].y) + (v[j].z * v[j].z + v[j].w * v[j].w); }
        const float r = 1.0f / sqrtf(wave_sum(s) * (1.0f / D) + EPS);
        float s2 = 0.f;
#pragma unroll
        for (int j = 0; j < 4; ++j) { h[j] = h[j] + g[j] * v[j] * r; s2 += (h[j].x * h[j].x + h[j].y * h[j].y) + (h[j].z * h[j].z + h[j].w * h[j].w); }
        s2 = wave_sum(s2);
        if (write_out) { f32x4* orow = (f32x4*)(OUT + (size_t)m * D) + lane;
#pragma unroll
            for (int j = 0; j < 4; ++j) orow[64 * j] = h[j]; }
        else {
#pragma unroll
            for (int j = 0; j < 4; ++j) { u32x2 w; w.x = pk2(h[j].x, h[j].y); w.y = pk2(h[j].z, h[j].w); hb[64 * j] = w; }
            if (lane == 0) RS[m] = 1.0f / sqrtf(s2 * (1.0f / D) + EPS); }
    }
}

__device__ __forceinline__ float gelu_tanh(float x) {
    const float u = 0.7978845608028654f * (x + 0.044715f * x * x * x);
    const float e = fast_exp(2.0f * u);
    const float th = 1.0f - 2.0f * __builtin_amdgcn_rcpf(e + 1.0f);
    return 0.5f * x * (1.0f + th);
}

constexpr size_t WS_LRA = 428 * MiB, WS_LRU = 444 * MiB;
constexpr int MX_PT = 528;
__device__ __forceinline__ bf16x8 gather_wfrag(const float* w, int stride) {
    union { bf16x8 v; unsigned u[4]; } r;
#pragma unroll
    for (int p = 0; p < 4; ++p) r.u[p] = pk2(w[(2 * p) * stride], w[(2 * p + 1) * stride]);
    return r.v;
}
__device__ __forceinline__ void mix1_item(const Ctx& C, const Args& A, int l, int b, int c) {
    const bf16_t* PROJ = (const bf16_t*)(A.ws + WS_PROJ);
    bf16_t* YS = (bf16_t*)(A.ws + WS_YS);
    int tid = C.tid; asm volatile("" : "+v"(tid));
    const int lane = tid & 63, wave = C.wave, fr = lane & 15, fg = lane >> 4;
    const size_t m0 = (size_t)b * T + (size_t)c * 64;
    LAS unsigned char* XC = C.lds;
    LAS unsigned char* LAi = C.lds + 34816;
    LAS unsigned char* LUi = C.lds + 34816 + 32768;
    {
        const float* cw = A.in[I_LCW] + (size_t)l * 4 * BW; const float* cbp = A.in[I_LCB] + l * BW;
#pragma unroll
        for (int k = 0; k < 4; ++k) { const int idx = tid + NTHREADS * k; const int t = idx >> 5, c8 = (idx & 31) * 8;
            float acc[8];
            { const f32x4 b0 = *(const f32x4*)(cbp + c8), b1 = *(const f32x4*)(cbp + c8 + 4); acc[0] = b0[0]; acc[1] = b0[1]; acc[2] = b0[2]; acc[3] = b0[3]; acc[4] = b1[0]; acc[5] = b1[1]; acc[6] = b1[2]; acc[7] = b1[3]; }
#pragma unroll
            for (int j = 0; j < 4; ++j) { const int tok = c * 64 + t - 3 + j;
                if (tok >= 0) { float x[8]; ld8bf(PROJ + ((size_t)b * T + tok) * NMIX + c8, x); const f32x4 w0 = *(const f32x4*)(cw + j * BW + c8), w1 = *(const f32x4*)(cw + j * BW + c8 + 4);
                    acc[0] += w0[0] * x[0]; acc[1] += w0[1] * x[1]; acc[2] += w0[2] * x[2]; acc[3] += w0[3] * x[3]; acc[4] += w1[0] * x[4]; acc[5] += w1[1] * x[5]; acc[6] += w1[2] * x[6]; acc[7] += w1[3] * x[7]; } }
            u32x4 w; w.x = cvt_pk_bf16(acc[0], acc[1]); w.y = cvt_pk_bf16(acc[2], acc[3]); w.z = cvt_pk_bf16(acc[4], acc[5]); w.w = cvt_pk_bf16(acc[6], acc[7]);
            *(LAS u32x4*)(XC + t * MX_PT + c8 * 2) = w; }
    }
    __syncthreads();
    {
        const int blk = wave;
        const float* wa = A.in[I_LWA] + (((size_t)l * 8 + blk) * 32) * 32; const float* wx = A.in[I_LWX] + (((size_t)l * 8 + blk) * 32) * 32;
        bf16x8 fa[2], fx[2];
#pragma unroll
        for (int nt = 0; nt < 2; ++nt) { fa[nt] = gather_wfrag(wa + (8 * fg) * 32 + 16 * nt + fr, 32); fx[nt] = gather_wfrag(wx + (8 * fg) * 32 + 16 * nt + fr, 32); }
        bf16_t* LRA = (bf16_t*)(A.ws + WS_LRA); bf16_t* LRU = (bf16_t*)(A.ws + WS_LRU);
#pragma unroll
        for (int nt = 0; nt < 2; ++nt) { const int ch = 32 * blk + 16 * nt + 4 * fg;
            const f32x4 ba = *(const f32x4*)(A.in[I_LBA] + l * BW + ch), bx = *(const f32x4*)(A.in[I_LBX] + l * BW + ch), lam = *(const f32x4*)(A.in[I_LLAM] + l * BW + ch);
            float sp8[4];
#pragma unroll
            for (int r = 0; r < 4; ++r) sp8[r] = -8.0f * ((-lam[r] > 20.f) ? -lam[r] : log1pf(expf(-lam[r])));
#pragma unroll
            for (int mt = 0; mt < 4; ++mt) { const int tok = 16 * mt + fr;
                const bf16x8 bxc = *(const LAS bf16x8*)(XC + tok * MX_PT + (32 * blk + 8 * fg) * 2);
                f32x4 ar = {0.f, 0.f, 0.f, 0.f}, ai = {0.f, 0.f, 0.f, 0.f};
                ar = __builtin_amdgcn_mfma_f32_16x16x32_bf16(fa[nt], bxc, ar, 0, 0, 0); ai = __builtin_amdgcn_mfma_f32_16x16x32_bf16(fx[nt], bxc, ai, 0, 0, 0);
                const u32x2 xw = *(const LAS u32x2*)(XC + tok * MX_PT + ch * 2);
                const float xc[4] = {bf2f(xw.x & 0xffffu), bf2f(xw.x >> 16), bf2f(xw.y & 0xffffu), bf2f(xw.y >> 16)};
                float la[4], uu[4];
#pragma unroll
                for (int r = 0; r < 4; ++r) { const float rg = sigmoid_f(ar[r] + ba[r]), ig = sigmoid_f(ai[r] + bx[r]);
                    la[r] = sp8[r] * rg; const float x2 = 2.0f * la[r];
                    const float om = (x2 > -0.02f) ? -x2 * (1.0f + 0.5f * x2 * (1.0f + x2 * (1.0f / 3.0f))) : 1.0f - fast_exp(x2);
                    uu[r] = sqrtf(om) * ig * xc[r]; }
                u32x2 wl, wu; wl.x = cvt_pk_bf16(la[0], la[1]); wl.y = cvt_pk_bf16(la[2], la[3]); wu.x = cvt_pk_bf16(uu[0], uu[1]); wu.y = cvt_pk_bf16(uu[2], uu[3]);
                *(LAS u32x2*)(LAi + tok * 512 + ch * 2) = wl; *(LAS u32x2*)(LUi + tok * 512 + ch * 2) = wu;
                *(u32x2*)(LRA + (m0 + tok) * BW + ch) = wl; *(u32x2*)(LRU + (m0 + tok) * BW + ch) = wu; }
        }
    }
    __syncthreads();
    {
        const int ch = tid & 255, half = tid >> 8; float P = 1.f, hst = 0.f;
#pragma unroll
        for (int i = 0; i < 32; ++i) { const int t = 32 * half + i; const float a = fast_exp(bf2f(*(const LAS bf16_t*)(LAi + t * 512 + ch * 2))); const float u = bf2f(*(const LAS bf16_t*)(LUi + t * 512 + ch * 2));
            hst = a * hst + u; P *= a; }
        const size_t aggi = ((size_t)b * 128 + c * 2 + half) * 256 + ch;
        ((float*)(A.ws + WS_LA))[aggi] = P; ((float*)(A.ws + WS_LH))[aggi] = hst;
    }
    __syncthreads();
    LAS unsigned char* PX = C.lds;
    LAS unsigned char* DD = C.lds + 43008;
    { u32x4 pv[5];
#pragma unroll
        for (int k = 0; k < 5; ++k) { const int idx = tid + NTHREADS * k; const int r = idx >> 5, c8 = (idx & 31) * 8; const int tok = c * 64 - 15 + r;
            pv[k] = (u32x4){0u, 0u, 0u, 0u}; if (idx < 79 * 32 && tok >= 0) pv[k] = *(const u32x4*)(PROJ + ((size_t)b * T + tok) * NMIX + 512 + c8); }
#pragma unroll
        for (int k = 0; k < 5; ++k) { const int idx = tid + NTHREADS * k; const int r = idx >> 5, c8 = (idx & 31) * 8; if (idx < 79 * 32) *(LAS u32x4*)(PX + r * MX_PT + c8 * 2) = pv[k]; } }
    __syncthreads();
#pragma unroll 1
    for (int k = 0; k < 4; ++k) { const int idx = tid + NTHREADS * k; const int t = idx >> 5, c8 = (idx & 31) * 8; const int g = c8 >> 6, win = 2 << g;
        float sum[8], x0[8];
#pragma unroll
        for (int e = 0; e < 8; ++e) sum[e] = 0.f;
        for (int j = 0; j < win; ++j) { const u32x4 v = *(const LAS u32x4*)(PX + (t + 15 - j) * MX_PT + c8 * 2);
            const float x[8] = {bf2f(v.x & 0xffffu), bf2f(v.x >> 16), bf2f(v.y & 0xffffu), bf2f(v.y >> 16), bf2f(v.z & 0xffffu), bf2f(v.z >> 16), bf2f(v.w & 0xffffu), bf2f(v.w >> 16)};
#pragma unroll
            for (int e = 0; e < 8; ++e) { sum[e] += x[e]; if (j == 0) x0[e] = x[e]; } }
        const int pos = c * 64 + t + 1; const float inv = 1.0f / (float)(pos < win ? pos : win);
        u32x4 w; w.x = cvt_pk_bf16(sum[0] * inv - x0[0], sum[1] * inv - x0[1]); w.y = cvt_pk_bf16(sum[2] * inv - x0[2], sum[3] * inv - x0[3]);
        w.z = cvt_pk_bf16(sum[4] * inv - x0[4], sum[5] * inv - x0[5]); w.w = cvt_pk_bf16(sum[6] * inv - x0[6], sum[7] * inv - x0[7]);
        *(LAS u32x4*)(DD + t * MX_PT + c8 * 2) = w; }
    __syncthreads();
    {
        const int g = wave >> 1, nb = (wave & 1) * 2;
        const float* pw = A.in[I_PW] + (((size_t)l * 4 + g) * 64) * 64;
        bf16x8 fw[2][2];
#pragma unroll
        for (int nn = 0; nn < 2; ++nn)
#pragma unroll
            for (int ks = 0; ks < 2; ++ks) fw[nn][ks] = gather_wfrag(pw + (32 * ks + 8 * fg) * 64 + 16 * (nb + nn) + fr, 64);
#pragma unroll
        for (int nn = 0; nn < 2; ++nn) { const int ch = 64 * g + 16 * (nb + nn) + 4 * fg; const f32x4 scl = *(const f32x4*)(A.in[I_PS] + l * BW + ch);
#pragma unroll
            for (int mt = 0; mt < 4; ++mt) { const int tok = 16 * mt + fr; f32x4 acc = {0.f, 0.f, 0.f, 0.f};
#pragma unroll
                for (int ks = 0; ks < 2; ++ks) { const bf16x8 bd = *(const LAS bf16x8*)(DD + tok * MX_PT + (64 * g + 32 * ks + 8 * fg) * 2); acc = __builtin_amdgcn_mfma_f32_16x16x32_bf16(fw[nn][ks], bd, acc, 0, 0, 0); }
                u32x2 w; w.x = cvt_pk_bf16(acc[0] * scl[0], acc[1] * scl[1]); w.y = cvt_pk_bf16(acc[2] * scl[2], acc[3] * scl[3]);
                *(u32x2*)(YS + (m0 + tok) * D + 256 + ch) = w; } }
    }
    {
        const float* sw = A.in[I_SW] + (size_t)l * 3 * BW;
#pragma unroll 2
        for (int k = 0; k < 4; ++k) { const int idx = tid + NTHREADS * k; const int t = idx >> 5, c8 = (idx & 31) * 8;
            float acc[8];
#pragma unroll
            for (int e = 0; e < 8; ++e) acc[e] = 0.f;
#pragma unroll
            for (int j = 0; j < 3; ++j) { const int tok = c * 64 + t - 2 + j;
                if (tok >= 0) { const bf16_t* p = PROJ + ((size_t)b * T + tok) * NMIX; float sc[8], sx[8]; ld8bf(p + 2048 + c8, sc); ld8bf(p + 2304 + c8, sx);
                    const f32x4 w0 = *(const f32x4*)(sw + j * BW + c8), w1 = *(const f32x4*)(sw + j * BW + c8 + 4);
                    acc[0] += w0[0] * sc[0] * sx[0]; acc[1] += w0[1] * sc[1] * sx[1]; acc[2] += w0[2] * sc[2] * sx[2]; acc[3] += w0[3] * sc[3] * sx[3];
                    acc[4] += w1[0] * sc[4] * sx[4]; acc[5] += w1[1] * sc[5] * sx[5]; acc[6] += w1[2] * sc[6] * sx[6]; acc[7] += w1[3] * sc[7] * sx[7]; } }
            float sb[8]; ld8bf(PROJ + (m0 + t) * NMIX + 1792 + c8, sb);
            u32x4 w; w.x = cvt_pk_bf16(sb[0] * acc[0], sb[1] * acc[1]); w.y = cvt_pk_bf16(sb[2] * acc[2], sb[3] * acc[3]); w.z = cvt_pk_bf16(sb[4] * acc[4], sb[5] * acc[5]); w.w = cvt_pk_bf16(sb[6] * acc[6], sb[7] * acc[7]);
            *(u32x4*)(YS + (m0 + t) * D + 768 + c8) = w; }
    }
    __syncthreads();
}
__device__ __forceinline__ void lru_final_item(const Ctx& C, const Args& A, int l, int b, int c) {
    const bf16_t* PROJ = (const bf16_t*)(A.ws + WS_PROJ);
    const bf16_t* LRA = (const bf16_t*)(A.ws + WS_LRA); const bf16_t* LRU = (const bf16_t*)(A.ws + WS_LRU);
    bf16_t* YS = (bf16_t*)(A.ws + WS_YS);
    int tid = C.tid; asm volatile("" : "+v"(tid));
    const int ch = tid & 255, half = tid >> 8;
    const size_t m0 = (size_t)b * T + (size_t)c * 64 + 32 * half;
    float hst = ((const float*)(A.ws + WS_LC))[((size_t)b * 128 + c * 2 + half) * 256 + ch];
    unsigned short la[32], lu[32], lg[32];
#pragma unroll
    for (int i = 0; i < 32; ++i) { la[i] = LRA[(m0 + i) * BW + ch]; lu[i] = LRU[(m0 + i) * BW + ch]; lg[i] = PROJ[(m0 + i) * NMIX + 256 + ch]; }
#pragma unroll
    for (int i = 0; i < 32; ++i) { const float a = fast_exp(bf2f(la[i])), u = bf2f(lu[i]);
        hst = a * hst + u;
        YS[(m0 + i) * D + ch] = (bf16_t)f2bf(hst * gelu_tanh(bf2f(lg[i]))); }
}

constexpr int HG_PT = 144;
constexpr int HG_IMG = 64 * HG_PT;
constexpr int HG_Q = 0, HG_K = HG_IMG, HG_P = 2 * HG_IMG, HG_BEND = 3 * HG_IMG, HG_REF = HG_BEND + 512, HG_HSZ = 29696;
constexpr size_t WS_ST16 = WS_MERGED + 32 * MiB;
__device__ __forceinline__ float hgrn_lb(const Args& A, int l, int w) {
    if (l == 0) return 0.f;
    const float a0 = A.in[I_HLB][w], a1 = A.in[I_HLB][BW + w];
    return 1.0f / (1.0f + expf(a0 - a1));
}
template <bool FINAL>
__device__ __forceinline__ void hgrn_item(const Ctx& C, const Args& A, int l, int b, int c) {
    const bf16_t* PROJ = (const bf16_t*)(A.ws + WS_PROJ);
    int lane = C.lane; asm volatile("" : "+v"(lane));
    const int wave = C.wave, h = wave >> 1, half = wave & 1, fr = lane & 15, fg = lane >> 4;
    LAS unsigned char* hb = C.lds + h * HG_HSZ;
    LAS float* BEND = (LAS float*)(hb + HG_BEND); LAS float* REF = (LAS float*)(hb + HG_REF);
    const size_t m0 = (size_t)b * T + (size_t)c * 64;
    const bf16_t* pr = PROJ + (m0 + 32 * half) * NMIX + h * 64 + lane;
    const int bh = b * 4 + h; const size_t ci = (size_t)bh * 64 + c;
    float bb[32], kk[32], vv[32];
    {
        const float lbv = hgrn_lb(A, l, h * 64 + lane);
        float acc = 0.f;
#pragma unroll
        for (int i = 0; i < 32; ++i) { const float x = bf2f(pr[(size_t)i * NMIX + 1024]); const float f = fmaxf(lbv + (1.0f - lbv) * sigmoid_f(x), 1e-30f);
            acc += __logf(f); bb[i] = acc; kk[i] = 1.0f - f; }
#pragma unroll
        for (int i = 0; i < 32; ++i) vv[i] = bf2f(pr[(size_t)i * NMIX + 1280]);
        BEND[half * 64 + lane] = acc;
    }
    __syncthreads();
    const float bend0 = BEND[lane], blast = bend0 + BEND[64 + lane];
    if (half) {
#pragma unroll
        for (int i = 0; i < 32; ++i) bb[i] += bend0;
    }
    if (!FINAL) {
        LAS unsigned char* kt = hb + HG_K + lane * HG_PT + 64 * half; LAS unsigned char* vt = hb + HG_Q + lane * HG_PT + 64 * half;
#pragma unroll
        for (int q4 = 0; q4 < 4; ++q4) { u32x4 wk, wv; unsigned kw[4], vw[4];
#pragma unroll
            for (int p = 0; p < 4; ++p) { const int i = q4 * 8 + 2 * p;
                kw[p] = cvt_pk_bf16(kk[i] * fast_exp(blast - bb[i]), kk[i + 1] * fast_exp(blast - bb[i + 1])); vw[p] = cvt_pk_bf16(vv[i], vv[i + 1]); }
            wk.x = kw[0]; wk.y = kw[1]; wk.z = kw[2]; wk.w = kw[3]; wv.x = vw[0]; wv.y = vw[1]; wv.z = vw[2]; wv.w = vw[3];
            *(LAS u32x4*)(kt + q4 * 16) = wk; *(LAS u32x4*)(vt + q4 * 16) = wv; }
        if (half == 0) ((float*)(A.ws + WS_SD))[ci * 64 + lane] = fast_exp(blast);
        __syncthreads();
        float* su = (float*)(A.ws + WS_SU) + ci * 4096;
#pragma unroll
        for (int aa = 0; aa < 2; ++aa) { const int a = 2 * half + aa;
            bf16x8 av[2];
#pragma unroll
            for (int ks = 0; ks < 2; ++ks) av[ks] = *(const LAS bf16x8*)(hb + HG_Q + (16 * a + fr) * HG_PT + 64 * ks + 16 * fg);
#pragma unroll
            for (int d = 0; d < 4; ++d) { f32x4 acc = {0.f, 0.f, 0.f, 0.f};
#pragma unroll
                for (int ks = 0; ks < 2; ++ks) { const bf16x8 bk = *(const LAS bf16x8*)(hb + HG_K + (16 * d + fr) * HG_PT + 64 * ks + 16 * fg);
                    acc = __builtin_amdgcn_mfma_f32_16x16x32_bf16(av[ks], bk, acc, 0, 0, 0); }
#pragma unroll
                for (int r = 0; r < 4; ++r) su[(16 * a + 4 * fg + r) * 64 + 16 * d + fr] = acc[r];
            } }
        __syncthreads();
    } else {
        float qq[32];
#pragma unroll
        for (int i = 0; i < 32; ++i) qq[i] = bf2f(pr[(size_t)i * NMIX + 768]);
        if (half == 0) { REF[64 + lane] = bb[15]; REF[128 + lane] = bb[31]; } else REF[192 + lane] = bb[15];
        { const u32x4 z = {0u, 0u, 0u, 0u};
#pragma unroll
            for (int k2 = 0; k2 < 5; ++k2) { const int idx = lane + 64 * k2; if (idx < 32 * 9) *(LAS u32x4*)(hb + HG_P + 32 * half * HG_PT + idx * 16) = z; } }
        __syncthreads();
        float rf[4]; rf[0] = 0.f; rf[1] = REF[64 + lane]; rf[2] = REF[128 + lane]; rf[3] = REF[192 + lane];
        {
            const float r_lo = half ? rf[2] : rf[0], r_hi = half ? rf[3] : rf[1];
#pragma unroll
            for (int i = 0; i < 32; ++i) { const float rr = (i < 16) ? r_lo : r_hi; const float val = qq[i] * fast_exp(bb[i] - rr);
                *(LAS bf16_t*)(hb + HG_Q + (32 * half + i) * HG_PT + 2 * lane) = (bf16_t)f2bf(val); }
        }
#pragma unroll
        for (int isub = 0; isub < 4; ++isub) {
            const int nrows = 16 * (isub + 1) - 32 * half;
#pragma unroll
            for (int i = 0; i < 32; ++i) { if (i < nrows) { const float e = fminf(rf[isub] - bb[i], 60.f); const float val = kk[i] * fast_exp(e);
                    *(LAS bf16_t*)(hb + HG_K + (32 * half + i) * HG_PT + 2 * lane) = (bf16_t)f2bf(val); } }
            __syncthreads();
            {
                bf16x8 bq[2];
#pragma unroll
                for (int ks = 0; ks < 2; ++ks) bq[ks] = *(const LAS bf16x8*)(hb + HG_Q + (16 * isub + fr) * HG_PT + 64 * ks + 16 * fg);
#pragma unroll
                for (int j = 0; j <= isub; ++j) { if ((j & 1) == half) {
                        f32x4 acc = {0.f, 0.f, 0.f, 0.f};
#pragma unroll
                        for (int ks = 0; ks < 2; ++ks) { const bf16x8 ak = *(const LAS bf16x8*)(hb + HG_K + (16 * j + fr) * HG_PT + 64 * ks + 16 * fg);
                            acc = __builtin_amdgcn_mfma_f32_16x16x32_bf16(ak, bq[ks], acc, 0, 0, 0); }
                        if (j == isub) {
#pragma unroll
                            for (int r = 0; r < 4; ++r) if (4 * fg + r > fr) acc[r] = 0.f; }
                        u32x2 w; w.x = cvt_pk_bf16(acc[0], acc[1]); w.y = cvt_pk_bf16(acc[2], acc[3]);
                        *(LAS u32x2*)(hb + HG_P + (16 * isub + fr) * HG_PT + 2 * (16 * j + 4 * fg)) = w;
                    } }
            }
            __syncthreads();
        }
        {
            LAS unsigned char* vt = hb + HG_Q + lane * HG_PT + 64 * half;
#pragma unroll
            for (int q4 = 0; q4 < 4; ++q4) { u32x4 wv; unsigned vw[4];
#pragma unroll
                for (int p = 0; p < 4; ++p) { const int i = q4 * 8 + 2 * p; vw[p] = cvt_pk_bf16(vv[i], vv[i + 1]); }
                wv.x = vw[0]; wv.y = vw[1]; wv.z = vw[2]; wv.w = vw[3]; *(LAS u32x4*)(vt + q4 * 16) = wv; }
#pragma unroll
            for (int i = 0; i < 32; ++i) *(LAS bf16_t*)(hb + HG_K + (32 * half + i) * HG_PT + 2 * lane) = (bf16_t)f2bf(qq[i] * fast_exp(bb[i]));
        }
        __syncthreads();
        {
            const bf16_t* st = (const bf16_t*)(A.ws + WS_ST16) + ci * 4096;
            bf16x8 a_st[4][2];
#pragma unroll
            for (int a = 0; a < 4; ++a)
#pragma unroll
                for (int ks = 0; ks < 2; ++ks) a_st[a][ks] = *(const bf16x8*)(st + (16 * a + fr) * 64 + 32 * ks + 8 * fg);
            bf16_t* YS = (bf16_t*)(A.ws + WS_YS);
            const float* gn = A.in[I_HN] + l * 64;
#pragma unroll
            for (int tt = 0; tt < 2; ++tt) { const int ti = 2 * half + tt;
                bf16x8 bp[2], bqb[2];
#pragma unroll
                for (int ks = 0; ks < 2; ++ks) { bp[ks] = *(const LAS bf16x8*)(hb + HG_P + (16 * ti + fr) * HG_PT + 64 * ks + 16 * fg); bqb[ks] = *(const LAS bf16x8*)(hb + HG_K + (16 * ti + fr) * HG_PT + 64 * ks + 16 * fg); }
                f32x4 o[4]; float ss = 0.f;
#pragma unroll
                for (int a = 0; a < 4; ++a) { f32x4 acc = {0.f, 0.f, 0.f, 0.f};
#pragma unroll
                    for (int ks = 0; ks < 2; ++ks) { const bf16x8 av = *(const LAS bf16x8*)(hb + HG_Q + (16 * a + fr) * HG_PT + 64 * ks + 16 * fg);
                        acc = __builtin_amdgcn_mfma_f32_16x16x32_bf16(av, bp[ks], acc, 0, 0, 0);
                        acc = __builtin_amdgcn_mfma_f32_16x16x32_bf16(a_st[a][ks], bqb[ks], acc, 0, 0, 0); }
                    o[a] = acc; ss += (acc[0] * acc[0] + acc[1] * acc[1]) + (acc[2] * acc[2] + acc[3] * acc[3]); }
                ss += __shfl_xor(ss, 16); ss += __shfl_xor(ss, 32);
                const float rn = 1.0f / sqrtf(ss * (1.0f / 64.0f) + EPS);
                const size_t row = m0 + 16 * ti + fr;
#pragma unroll
                for (int a = 0; a < 4; ++a) { const int dv = 16 * a + 4 * fg;
                    const u32x2 gw = *(const u32x2*)(PROJ + row * NMIX + 1536 + h * 64 + dv);
                    const float g0 = bf2f(gw.x & 0xffffu), g1 = bf2f(gw.x >> 16), g2 = bf2f(gw.y & 0xffffu), g3 = bf2f(gw.y >> 16);
                    const f32x4 gv = *(const f32x4*)(gn + dv);
                    const float y0 = o[a][0] * rn * gv[0] * (g0 * sigmoid_f(g0)), y1 = o[a][1] * rn * gv[1] * (g1 * sigmoid_f(g1));
                    const float y2 = o[a][2] * rn * gv[2] * (g2 * sigmoid_f(g2)), y3 = o[a][3] * rn * gv[3] * (g3 * sigmoid_f(g3));
                    u32x2 w; w.x = cvt_pk_bf16(y0, y1); w.y = cvt_pk_bf16(y2, y3);
                    *(u32x2*)(YS + row * D + 512 + h * 64 + dv) = w; }
            }
        }
        __syncthreads();
    }
}

__device__ __forceinline__ void mix_phase2(const Ctx& C, const Args& A) {
    float* __restrict__ SU = (float*)(A.ws + WS_SU); const float* __restrict__ SD = (const float*)(A.ws + WS_SD);
    int tid_ = C.tid; asm volatile("" : "+v"(tid_));
    const int gt = C.vcu * NTHREADS + tid_, NGT = C.G * NTHREADS;
    for (int e = gt; e < 32 * 4096; e += NGT) {
        const int bh = e >> 12, kv = e & 4095, dk = kv & 63;
        bf16_t* __restrict__ ST16 = (bf16_t*)(A.ws + WS_ST16);
        float s = 0.f;
#pragma unroll 8
        for (int c = 0; c < 64; ++c) { const size_t ci = (size_t)bh * 64 + c; const float u = SU[ci * 4096 + kv]; const float d = SD[ci * 64 + dk]; ST16[ci * 4096 + kv] = (bf16_t)f2bf(s); s = d * s + u; }
    }
    const float* __restrict__ LA = (const float*)(A.ws + WS_LA); const float* __restrict__ LH = (const float*)(A.ws + WS_LH); float* __restrict__ LC = (float*)(A.ws + WS_LC);
    for (int e = gt; e < BATCH * BW; e += NGT) {
        const int b = e >> 8, ch = e & 255; float cr = 0.f;
#pragma unroll 16
        for (int sc = 0; sc < 128; ++sc) { const size_t i = ((size_t)b * 128 + sc) * 256 + ch; const float a = LA[i], hh = LH[i]; LC[i] = cr; cr = a * cr + hh; }
    }
}

#define XB_TMO      128
#define XB_XCNT(j)  (256  + 64 * (j))
#define XB_XSUB(j)  (1280 + 64 * (j))
#define XB_XGEN(j)  (2304 + 64 * (j))
#define XB_TOP      3328
#define XB_TOPGEN   3392
#define XCD_BAR_WORDS 3456
#define XB_SPIN_CAP (1u << 20)
__device__ __forceinline__ unsigned xb_ld(unsigned* p)              { return __hip_atomic_load(p, __ATOMIC_RELAXED, __HIP_MEMORY_SCOPE_AGENT); }
__device__ __forceinline__ unsigned xb_add(unsigned* p, unsigned v) { return __hip_atomic_fetch_add(p, v, __ATOMIC_RELAXED, __HIP_MEMORY_SCOPE_AGENT); }
__device__ __forceinline__ unsigned xb_xcc_id() { return (unsigned)__builtin_amdgcn_s_getreg((3 << 11) | 20) & 0xFu; }
#define XB_SPIN(cond, bar) do { unsigned _sp = 0; while (cond) { __builtin_amdgcn_s_sleep(1); \
    if ((++_sp & 255u) == 0u) { if (xb_ld(&(bar)[XB_TMO])) break; if (_sp > XB_SPIN_CAP) { atomicAdd(&(bar)[XB_TMO], 1u); break; } } } } while (0)
struct XcdBarrier { unsigned* bar; unsigned x; volatile LAS unsigned* st; };
__device__ __forceinline__ XcdBarrier xcd_barrier_post(unsigned* bar, volatile LAS unsigned* st) {
    XcdBarrier b; b.bar = bar; b.x = xb_xcc_id(); b.st = st;
    if (threadIdx.x == 0) (void)xb_add(&bar[XB_XCNT(b.x)], 1u);
    return b;
}
__device__ __forceinline__ void xcd_barrier_complete(unsigned* bar, unsigned x, unsigned& nloc, unsigned& nx) {
    const unsigned G = gridDim.x * gridDim.y * gridDim.z;
    unsigned sum, cnt, mine, sp = 0u;
    for (;;) {
        sum = 0u; cnt = 0u; mine = 0u;
#pragma unroll
        for (unsigned j = 0; j < 16; ++j) { const unsigned c = xb_ld(&bar[XB_XCNT(j)]); sum += c; cnt += (c > 0u) ? 1u : 0u; mine = (j == x) ? c : mine; }
        if (sum == G) break;
        __builtin_amdgcn_s_sleep(1);
        if ((++sp & 255u) == 0u) { if (xb_ld(&bar[XB_TMO])) break; if (sp > XB_SPIN_CAP) { atomicAdd(&bar[XB_TMO], 1u); break; } }
    }
    nloc = mine > 0u ? mine : 1u; nx = cnt > 0u ? cnt : 1u;
}
__device__ __forceinline__ void xcd_barrier(const XcdBarrier& b) {
    asm volatile("s_waitcnt vmcnt(0)" ::: "memory");
    __syncthreads();
    if (threadIdx.x == 0) {
        unsigned* bar = b.bar;
        __builtin_amdgcn_s_waitcnt(0);
        unsigned nloc = b.st[0], nx = b.st[1];
        if (nloc == 0u) { xcd_barrier_complete(bar, b.x, nloc, nx); b.st[0] = nloc; b.st[1] = nx; }
        const unsigned old = xb_add(&bar[XB_XSUB(b.x)], 1u);
        const unsigned gen = old / nloc;
        if (old + 1u == (gen + 1u) * nloc) {
            __builtin_amdgcn_fence(__ATOMIC_RELEASE, "agent");
            asm volatile("s_waitcnt vmcnt(0)" ::: "memory");
            const unsigned og = xb_add(&bar[XB_TOP], 1u);
            const unsigned tg = og / nx;
            if (og + 1u == (tg + 1u) * nx) xb_add(&bar[XB_TOPGEN], 1u);
            else XB_SPIN(xb_ld(&bar[XB_TOPGEN]) == tg, bar);
            __builtin_amdgcn_fence(__ATOMIC_ACQUIRE, "agent");
            xb_add(&bar[XB_XGEN(b.x)], 1u);
            asm volatile("s_waitcnt vmcnt(0)" ::: "memory");
        } else {
            XB_SPIN(xb_ld(&bar[XB_XGEN(b.x)]) == gen, bar);
            __builtin_amdgcn_fence(__ATOMIC_ACQUIRE, "agent");
            asm volatile("s_waitcnt vmcnt(0)" ::: "memory");
        }
    }
    __syncthreads();
}

constexpr int PH_PER_LAYER = 10, N_PHASES = 1 + DEPTH * PH_PER_LAYER;
constexpr int CW_BAR = 4096;

__global__ void __launch_bounds__(NTHREADS, 2) trunk_fwd(Args args) {
    extern __shared__ __attribute__((aligned(16))) unsigned char lds_raw[];
    Ctx C;
    C.lds = (LAS unsigned char*)lds_raw; C.tid = threadIdx.x; C.lane = C.tid & 63; C.wave = __builtin_amdgcn_readfirstlane(C.tid >> 6);
    C.G = gridDim.x; { const int bx = blockIdx.x; C.vcu = (C.G % 8 == 0) ? (bx % 8) * (C.G / 8) + bx / 8 : bx; }
    unsigned char* ws = args.ws;
    volatile LAS unsigned* MISC = (volatile LAS unsigned*)(C.lds + MISC_OFF);
    if (C.tid < 64) MISC[C.tid] = 0u;
    __syncthreads();
#if MK_PER_PHASE
#define GRID_BAR() do { } while (0)
#else
    cg::grid_group grid = cg::this_grid();
    XcdBarrier bar = xcd_barrier_post((unsigned*)(ws + WS_CTL) + CW_BAR, MISC + 8);
    bool first_bar = true;
#define GRID_BAR() do { if (first_bar) { grid.sync(); first_bar = false; } else { xcd_barrier(bar); } } while (0)
#endif
    const int lo = args.ph_lo, hi = args.ph_hi;
    int ph = 0;
#define PHASE_BEGIN if (ph >= lo && ph < hi) { for (int rep_ = 0; rep_ < (((DBG_REPEAT >> ((ph - 1) % PH_PER_LAYER + 1)) & 1) && ph > 0 ? 2 : 1); ++rep_) {
#define PHASE_END   if (rep_ == 0 && (((DBG_REPEAT >> ((ph - 1) % PH_PER_LAYER + 1)) & 1) && ph > 0)) GRID_BAR(); } if (ph + 1 < hi && ph + 1 < N_PHASES) GRID_BAR(); } ++ph;

    PHASE_BEGIN p0_prologue(C, args); PHASE_END

    for (int li = 0; li < DEPTH; ++li) {
        int l = li; asm volatile("" : "+s"(l));
        const unsigned char* wl = ws + WS_W + (size_t)l * W_LAYER;
        const float* RS = (const float*)(ws + WS_RS);
        PHASE_BEGIN {
            pg8::StaticOrder S; S.init(ws + WS_HB, wl + W_IN, M, NMIX, D, C.G, (int)blockIdx.x);
            pg8::EpiRow<1> E{(bf16_t*)(ws + WS_PROJ), NMIX, RS};
            pg8::gemm_phase<pg8::EpiRow<1>, pg8::StaticOrder, true>(C.lds, D, S, E);
        } PHASE_END
        PHASE_BEGIN {
            for (int item = C.vcu; item < BATCH * 64; item += C.G) { const int b = item >> 6, c = item & 63;
                mix1_item(C, args, l, b, c);
                hgrn_item<false>(C, args, l, b, c); }
        } PHASE_END
        PHASE_BEGIN mix_phase2(C, args); PHASE_END
        PHASE_BEGIN {
            for (int item = C.vcu; item < BATCH * 64; item += C.G) { const int b = item >> 6, c = item & 63;
                lru_final_item(C, args, l, b, c);
                hgrn_item<true>(C, args, l, b, c); }
        } PHASE_END
        PHASE_BEGIN {
            pg8::GateOrder S{(const char*)(ws + WS_HB), (const char*)(wl + W_IN) + (size_t)NMIX * D * 2, (const char*)(ws + WS_YS), (const char*)(wl + W_BR), C.G, C.vcu};
            pg8::EpiGate E{(bf16_t*)(ws + WS_G) + (size_t)blockIdx.x * 4 * 65536, (bf16_t*)(ws + WS_MERGED), RS};
            pg8::gemm_phase<pg8::EpiGate, pg8::GateOrder, true>(C.lds, D, S, E);
        } PHASE_END
        PHASE_BEGIN {
            pg8::StaticOrder S; S.init(ws + WS_MERGED, wl + W_OUT, M, D, D, C.G, (int)blockIdx.x);
            pg8::EpiRow<0> E{(bf16_t*)(ws + WS_MIX), D, nullptr};
            pg8::gemm_phase<pg8::EpiRow<0>, pg8::StaticOrder, true>(C.lds, D, S, E);
        } PHASE_END
        PHASE_BEGIN norm_phase(C, args, (const bf16_t*)(ws + WS_MIX), args.in[I_NMIXPOST] + l * D, false); PHASE_END
        PHASE_BEGIN {
            pg8::StaticOrder S; S.init(ws + WS_HB, wl + W_UP, M, FF, D, C.G, (int)blockIdx.x);
            pg8::EpiRow<2> E{(bf16_t*)(ws + WS_HID), FF, RS};
            pg8::gemm_phase<pg8::EpiRow<2>, pg8::StaticOrder, true>(C.lds, D, S, E);
        } PHASE_END
        PHASE_BEGIN {
            pg8::StaticOrder S; S.init(ws + WS_HID, wl + W_DOWN, M, D, FF, C.G, (int)blockIdx.x);
            pg8::EpiRow<0> E{(bf16_t*)(ws + WS_MOUT), D, nullptr};
            pg8::gemm_phase<pg8::EpiRow<0>, pg8::StaticOrder, true>(C.lds, FF, S, E);
        } PHASE_END
        PHASE_BEGIN norm_phase(C, args, (const bf16_t*)(ws + WS_MOUT), args.in[I_NMLPPOST] + l * D, li == DEPTH - 1); PHASE_END
    }
}

extern "C" void kernel_launch(void* const* d_in, const int* in_sizes, int n_in, void* d_out, int out_size, void* d_ws, size_t ws_size, hipStream_t stream) {
    static int grid = 0;
    if (grid == 0) {
        if (n_in != 22 || in_sizes[0] != M * D || out_size != M * D || ws_size < WS_END) { fprintf(stderr, "kernel_launch: unexpected shapes (n_in %d, in0 %d, out %d, ws %zu)\n", n_in, n_in > 0 ? in_sizes[0] : -1, out_size, ws_size); grid = -1; return; }
        int dev = 0, cus = 0, per_cu = 0;
        if (hipGetDevice(&dev) != hipSuccess || hipDeviceGetAttribute(&cus, hipDeviceAttributeMultiprocessorCount, dev) != hipSuccess) { grid = -1; return; }
        if (hipFuncSetAttribute((const void*)trunk_fwd, hipFuncAttributeMaxDynamicSharedMemorySize, LDS_BYTES) != hipSuccess) { fprintf(stderr, "kernel_launch: hipFuncSetAttribute failed\n"); grid = -1; return; }
        if (hipOccupancyMaxActiveBlocksPerMultiprocessor(&per_cu, (const void*)trunk_fwd, NTHREADS, LDS_BYTES) != hipSuccess || per_cu < 1) { fprintf(stderr, "kernel_launch: occupancy query says %d blocks per CU\n", per_cu); (void)hipGetLastError(); grid = -1; return; }
        grid = cus;
    }
    if (grid < 0) return;
    (void)hipMemsetAsync((char*)d_ws + WS_CTL, 0, CTL_ZERO_BYTES, stream);
    Args a{};
    for (int i = 0; i < 22; ++i) a.in[i] = (const float*)d_in[i];
    a.out = (float*)d_out; a.ws = (unsigned char*)d_ws;
#if MK_PER_PHASE
#ifndef DBG_MAXPH
#define DBG_MAXPH N_PHASES
#endif
    for (int p = 0; p < DBG_MAXPH; ++p) { a.ph_lo = p; a.ph_hi = p + 1; hipLaunchKernelGGL(trunk_fwd, dim3(grid), dim3(NTHREADS), LDS_BYTES, stream, a); }
#else
    a.ph_lo = 0; a.ph_hi = N_PHASES;
    void* kargs[] = {&a};
    hipError_t e = hipLaunchCooperativeKernel((const void*)trunk_fwd, dim3(grid), dim3(NTHREADS), kargs, LDS_BYTES, stream);
    if (e != hipSuccess) fprintf(stderr, "kernel_launch: cooperative launch failed: %s (grid %d)\n", hipGetErrorString(e), grid);
#endif
}
```

```cpp
#include <hip/hip_runtime.h>
#include <hip/hip_cooperative_groups.h>
#include <cstdio>
#include <cstdint>
namespace cg = cooperative_groups;

#ifndef DBG_ZERO
#define DBG_ZERO -1
#endif
#ifndef DBG_REPEAT
#define DBG_REPEAT 0
#endif
#ifndef MK_PER_PHASE
#define MK_PER_PHASE 0
#endif

#define LAS __attribute__((address_space(3)))
#define GAS __attribute__((address_space(1)))
typedef unsigned short bf16_t;
typedef short bf16x8 __attribute__((ext_vector_type(8)));
typedef float f32x4 __attribute__((ext_vector_type(4)));
typedef float f32x2 __attribute__((ext_vector_type(2)));
typedef unsigned u32x4 __attribute__((ext_vector_type(4)));
typedef unsigned u32x2 __attribute__((ext_vector_type(2)));

constexpr int BATCH = 8, T = 4096, D = 1024, M = BATCH * T, DEPTH = 2, BW = 256;
constexpr int NMIX = 2560, NGATE = 4096, INW = NMIX + NGATE, FF = 4096;
constexpr float EPS = 1e-6f;
constexpr int NWAVES = 8, NTHREADS = 512;

constexpr size_t MiB = 1u << 20;
constexpr size_t WS_CTL = 0, CTL_ZERO_BYTES = 1 * MiB;
constexpr size_t WS_RS = 1 * MiB;
constexpr size_t WS_SD = 1 * MiB + 512 * 1024;
constexpr size_t WS_LA = 2 * MiB, WS_LH = 3 * MiB, WS_LC = 4 * MiB;
constexpr size_t WS_X1 = 5 * MiB;
constexpr size_t WS_X2 = 6 * MiB;
constexpr size_t WS_W = 8 * MiB;
constexpr size_t W_IN = 0, W_BR = 13 * MiB, W_OUT = 15 * MiB, W_UP = 17 * MiB, W_DOWN = 25 * MiB, W_LAYER = 33 * MiB;
constexpr size_t WS_HB = 76 * MiB;
constexpr size_t WS_PROJ = 140 * MiB;
constexpr size_t WS_G = WS_PROJ;
constexpr size_t WS_YS = 300 * MiB;
constexpr size_t WS_MERGED = 364 * MiB;
constexpr size_t WS_SU = WS_MERGED;
constexpr size_t WS_MIX = WS_PROJ;
constexpr size_t WS_MOUT = 396 * MiB;
constexpr size_t WS_HID = WS_PROJ;
constexpr size_t WS_END = 460 * MiB;

constexpr int LDS_BYTES = 155648;
constexpr int MISC_OFF = 154624;

__device__ __forceinline__ float bf2f(unsigned b) { return __uint_as_float(b << 16); }
__device__ __forceinline__ unsigned f2bf(float f) { unsigned u = __float_as_uint(f); return (u + 0x7fffu + ((u >> 16) & 1u)) >> 16; }
__device__ __forceinline__ unsigned pk2(float lo, float hi) { return f2bf(lo) | (f2bf(hi) << 16); }
typedef __bf16 bf16x2_t __attribute__((ext_vector_type(2)));
__device__ __forceinline__ unsigned cvt_pk_bf16(float lo, float hi) { f32x2 v = {lo, hi}; bf16x2_t b = __builtin_convertvector(v, bf16x2_t); return __builtin_bit_cast(unsigned, b); }
__device__ __forceinline__ float fast_exp(float x) { return __builtin_amdgcn_exp2f(x * 1.4426950408889634f); }
__device__ __forceinline__ float sigmoid_f(float x) { return __builtin_amdgcn_rcpf(1.0f + fast_exp(-x)); }
__device__ __forceinline__ void ld8bf(const bf16_t* p, float (&o)[8]) {
    const u32x4 v = *(const u32x4*)p;
    o[0] = bf2f(v.x & 0xffffu); o[1] = bf2f(v.x >> 16); o[2] = bf2f(v.y & 0xffffu); o[3] = bf2f(v.y >> 16);
    o[4] = bf2f(v.z & 0xffffu); o[5] = bf2f(v.z >> 16); o[6] = bf2f(v.w & 0xffffu); o[7] = bf2f(v.w >> 16);
}
__device__ __forceinline__ float rs_of(const float* X2, int row) { const f32x4 x = *(const f32x4*)(X2 + (size_t)row * 4); return 1.0f / sqrtf(((x[0] + x[1]) + (x[2] + x[3])) * (1.0f / D) + EPS); }
__device__ __forceinline__ float wave_sum(float v) {
#pragma unroll
    for (int o = 1; o < 64; o <<= 1) v += __shfl_xor(v, o);
    return v;
}

namespace pg8 {
constexpr int BM = 256, BK = 64, HALF = 128, HTB = HALF * BK * 2, STAGE_BYTES = 8 * HTB, NXCD = 8, WGM = 4;
__host__ __device__ __forceinline__ int lds_byte(int r, int c) { const int st = (r >> 4) * 2 + (c >> 5), rr = r & 15, cc = c & 31, ob = rr * 64 + cc * 2; return st * 1024 + (ob ^ (((ob >> 9) & 1) << 5)); }
__host__ __device__ __forceinline__ void stage_rc(int b, int& R, int& C) { const int st = b / 1024, sb = b % 1024, swz = sb ^ (((sb >> 9) & 1) << 5); R = (st >> 1) * 16 + swz / 64; C = (st & 1) * 32 + (swz % 64) / 2; }
__host__ __device__ __forceinline__ int perm32(int rho) { const int n = rho >> 4, i = rho & 15; return 8 * (i >> 2) + 4 * n + (i & 3); }

struct Unit { int pm, pn, kind; };

struct StaticOrder {
    const char* A; const char* Bt; size_t tstep;
    int nM, nN, nwg, G, c;
    __device__ void init(const void* A_, const void* Bt_, int M_, int N_, int K_, int G_, int c_) { A = (const char*)A_; Bt = (const char*)Bt_; tstep = (size_t)BM * K_ * 2; nt = K_ / BK; nM = M_ / BM; nN = N_ / BM; nwg = nM * nN; G = G_; c = c_; }
    __device__ bool next(int i, Unit& u) const {
        const long L = (long)i * G + c; if (L >= nwg) return false;
        int wgid = (int)L; { const int q = nwg / NXCD, r = nwg % NXCD, xcd = wgid % NXCD, off = wgid / NXCD; wgid = (xcd < r ? xcd * (q + 1) : r * (q + 1) + (xcd - r) * q) + off; }
        const int nig = WGM * nN, gid = wgid / nig, fm = gid * WGM, gsz = (nM - fm) < WGM ? (nM - fm) : WGM;
        u.pm = fm + ((wgid % nig) % gsz); u.pn = (wgid % nig) / gsz; u.kind = 0; return true;
    }
    __device__ __forceinline__ void tiles(const Unit& u, const char*& a, const char*& b) const { a = A + (size_t)u.pm * tstep; b = Bt + (size_t)u.pn * tstep; }
    int nt;
    __device__ __forceinline__ int ntiles(const Unit&) const { return nt; }
    __device__ __forceinline__ bool keep_acc(const Unit&) const { return false; }
};

struct GateOrder {
    const char* HB; const char* WGt; const char* YS; const char* WB; int G, vcu;
    __device__ bool next(int i, Unit& u) const {
        const int r = i / 16, ii = i % 16, su = vcu + r * G; if (su >= 256) return false;
        const int half = ii / 8, j = ii % 8;
        u.pm = half * 64 + (su >> 2); u.kind = j; u.pn = (j < 4) ? (j * 4 + (su & 3)) : (su & 3); return true;
    }
    __device__ __forceinline__ int ntiles(const Unit& u) const { return u.kind < 4 ? 16 : 4; }
    __device__ __forceinline__ bool keep_acc(const Unit& nx) const { return nx.kind > 4; }
    __device__ __forceinline__ void tiles(const Unit& u, const char*& a, const char*& b) const {
        const size_t ts = (size_t)BM * 1024 * 2;
        if (u.kind < 4) { a = HB + (size_t)u.pm * ts; b = WGt + (size_t)u.pn * ts; } else { a = YS + (size_t)u.pm * ts + (size_t)(u.kind - 4) * 512; b = WB + (size_t)u.pn * ts + (size_t)(u.kind - 4) * 512; }
    }
};

template <int MODE  > struct EpiRow {
    static constexpr bool PERM = true;
    bf16_t* O; int ldc; const float* rs;
    __device__ __forceinline__ void operator()(f32x4 (&acc)[2][2][4][2], const Unit& u, int wr, int wc, int fr, int fq) const {
        const int row0 = u.pm * BM + wr * 64 + fr, col0 = u.pn * BM + wc * 32 + 8 * fq;
#pragma unroll
        for (int ai = 0; ai < 2; ++ai)
#pragma unroll
            for (int m = 0; m < 4; ++m) {
                const int row = row0 + ai * HALF + m * 16; const float sc = (MODE != 0) ? rs_of(rs, row) : 1.0f;
                bf16_t* rowp = O + (size_t)row * ldc + col0;
#pragma unroll
                for (int bj = 0; bj < 2; ++bj) {
                    f32x4 v0 = acc[ai][bj][m][0], v1 = acc[ai][bj][m][1];
                    if (MODE != 0) { v0 = v0 * sc; v1 = v1 * sc; }
                    if (MODE == 2) {
#pragma unroll
                        for (int j = 0; j < 4; ++j) { const float a = fmaxf(v0[j], 0.f), b = fmaxf(v1[j], 0.f); v0[j] = a * a; v1[j] = b * b; }
                    }
                    u32x4 w; w.x = cvt_pk_bf16(v0[0], v0[1]); w.y = cvt_pk_bf16(v0[2], v0[3]); w.z = cvt_pk_bf16(v1[0], v1[1]); w.w = cvt_pk_bf16(v1[2], v1[3]);
                    __builtin_nontemporal_store(w, (u32x4*)(rowp + bj * HALF));
                }
            }
    }
};

__device__ __forceinline__ unsigned pack_u8x4(float a, float b, float c, float d) { unsigned w = 0u;
    w = __builtin_amdgcn_cvt_pk_u8_f32(a * 256.0f - 0.5f, 0, w); w = __builtin_amdgcn_cvt_pk_u8_f32(b * 256.0f - 0.5f, 1, w); w = __builtin_amdgcn_cvt_pk_u8_f32(c * 256.0f - 0.5f, 2, w); w = __builtin_amdgcn_cvt_pk_u8_f32(d * 256.0f - 0.5f, 3, w); return w; }
__device__ __forceinline__ f32x4 unpack_u8x4(unsigned w) { return (f32x4){(float)(w & 0xffu) + 0.5f, (float)((w >> 8) & 0xffu) + 0.5f, (float)((w >> 16) & 0xffu) + 0.5f, (float)(w >> 24) + 0.5f}; }
struct EpiGate {
    static constexpr bool PERM = true;
    unsigned char* Gt;
    bf16_t* MERGED;
    const float* rs;
    __device__ __forceinline__ void rescale(f32x4 (&acc)[2][2][4][2], int j, int wr, int wc, int fr, int fq) const {
        int lane_off = (wr * 64 + fr) * 256 + wc * 32 + 8 * fq; asm volatile("" : "+v"(lane_off));
        const unsigned char* g0 = Gt + (size_t)j * 65536; const unsigned char* g1 = g0 + 65536;
#pragma unroll
        for (int ai = 0; ai < 2; ++ai) {
            u32x2 a[4][2], b[4][2];
#pragma unroll
            for (int m = 0; m < 4; ++m)
#pragma unroll
                for (int bj = 0; bj < 2; ++bj) { const int off = lane_off + (ai * HALF + m * 16) * 256 + bj * HALF; a[m][bj] = *(const u32x2*)(g0 + off); b[m][bj] = *(const u32x2*)(g1 + off); }
#pragma unroll
            for (int m = 0; m < 4; ++m)
#pragma unroll
                for (int bj = 0; bj < 2; ++bj) {
                    const f32x4 a0 = unpack_u8x4(a[m][bj].x), a1 = unpack_u8x4(a[m][bj].y), b0 = unpack_u8x4(b[m][bj].x), b1 = unpack_u8x4(b[m][bj].y);
#pragma unroll
                    for (int q = 0; q < 4; ++q) { acc[ai][bj][m][0][q] *= a0[q] * __builtin_amdgcn_rcpf(b0[q]); acc[ai][bj][m][1][q] *= a1[q] * __builtin_amdgcn_rcpf(b1[q]); }
                }
            asm volatile("" ::: "memory");
        }
    }
    __device__ __forceinline__ void operator()(f32x4 (&acc)[2][2][4][2], const Unit& u, int wr, int wc, int fr, int fq) const {
        if (u.kind >= 4 && u.kind < 7) { rescale(acc, u.kind - 4, wr, wc, fr, fq); return; }
        int rl0 = wr * 64 + fr, cl0 = wc * 32 + 8 * fq; asm volatile("" : "+v"(rl0), "+v"(cl0));
        if (u.kind < 4) {
            unsigned char* gt = Gt + (size_t)u.kind * 65536;
#pragma unroll
            for (int ai = 0; ai < 2; ++ai)
#pragma unroll
                for (int m = 0; m < 4; ++m) {
                    const int rl = rl0 + ai * HALF + m * 16; const float sc = rs_of(rs, u.pm * BM + rl);
#pragma unroll
                    for (int bj = 0; bj < 2; ++bj) {
                        f32x4 v0 = acc[ai][bj][m][0] * sc, v1 = acc[ai][bj][m][1] * sc;
#pragma unroll
                        for (int j = 0; j < 4; ++j) { v0[j] = sigmoid_f(fmaxf(v0[j], -60.f)); v1[j] = sigmoid_f(fmaxf(v1[j], -60.f)); }
                        u32x2 w; w.x = pack_u8x4(v0[0], v0[1], v0[2], v0[3]); w.y = pack_u8x4(v1[0], v1[1], v1[2], v1[3]);
                        *(u32x2*)(gt + rl * 256 + cl0 + bj * HALF) = w;
                    }
                }
        } else {
            const unsigned char* g3 = Gt + (size_t)3 * 65536;
#pragma unroll
            for (int ai = 0; ai < 2; ++ai)
#pragma unroll
                for (int m = 0; m < 4; ++m) {
                    const int rl = rl0 + ai * HALF + m * 16;
                    bf16_t* rowp = MERGED + (size_t)(u.pm * BM + rl) * 1024 + u.pn * BM + cl0;
#pragma unroll
                    for (int bj = 0; bj < 2; ++bj) {
                        const u32x2 sw = *(const u32x2*)(g3 + rl * 256 + cl0 + bj * HALF);
                        const f32x4 s0 = unpack_u8x4(sw.x) * (1.0f / 256.0f), s1 = unpack_u8x4(sw.y) * (1.0f / 256.0f);
                        const f32x4 v0 = acc[ai][bj][m][0] * s0, v1 = acc[ai][bj][m][1] * s1;
                        u32x4 w; w.x = cvt_pk_bf16(v0[0], v0[1]); w.y = cvt_pk_bf16(v0[2], v0[3]); w.z = cvt_pk_bf16(v1[0], v1[1]); w.w = cvt_pk_bf16(v1[2], v1[3]);
                        *(u32x4*)(rowp + bj * HALF) = w;
                    }
                }
        }
    }
};

struct PanelOrder {
    const char* A; const char* Bt; size_t tstep; int nt, half, vcu;
    __device__ bool next(int i, Unit& u) const { if (i > 1) return false; u.pm = i * 64 + (vcu >> 2); u.pn = vcu & 3; u.kind = 0; return true; }
    __device__ __forceinline__ void tiles(const Unit& u, const char*& a, const char*& b) const { a = A + (size_t)u.pm * tstep; b = Bt + (size_t)u.pn * tstep; }
    __device__ __forceinline__ int ntiles(const Unit&) const { return nt; }
    __device__ __forceinline__ bool keep_acc(const Unit&) const { return false; }
};
struct EpiNorm {
    static constexpr bool PERM = true;
    bf16_t* HB; float* OUTF; const float* gain; float* X1; float* X2; unsigned* cnt; unsigned* tmo; LAS unsigned char* sp;
    __device__ __forceinline__ void operator()(f32x4 (&acc)[2][2][4][2], const Unit& u, int wr, int wc, int fr, int fq) const {
        LAS float* P = (LAS float*)sp;
        LAS float* R = (LAS float*)(sp + 4096);
        const int tid = (wr * 4 + wc) * 64 + fq * 16 + fr;
#pragma unroll
        for (int ai = 0; ai < 2; ++ai)
#pragma unroll
            for (int m = 0; m < 4; ++m) { float s = 0.f;
#pragma unroll
                for (int bj = 0; bj < 2; ++bj)
#pragma unroll
                    for (int n = 0; n < 2; ++n) { const f32x4 x = acc[ai][bj][m][n]; s += (x[0] * x[0] + x[1] * x[1]) + (x[2] * x[2] + x[3] * x[3]); }
                s += __shfl_xor(s, 16); s += __shfl_xor(s, 32);
                if (fq == 0) P[(ai * HALF + wr * 64 + m * 16 + fr) * 4 + wc] = s; }
        asm volatile("s_waitcnt lgkmcnt(0)" ::: "memory"); __builtin_amdgcn_s_barrier(); asm volatile("" ::: "memory");
        if (tid < 256) {
            const f32x4 p = *(const LAS f32x4*)(P + tid * 4); const float tot = (p[0] + p[1]) + (p[2] + p[3]);
            __hip_atomic_store(X1 + ((size_t)u.pm * BM + tid) * 4 + u.pn, tot, __ATOMIC_RELAXED, __HIP_MEMORY_SCOPE_AGENT);
            asm volatile("s_waitcnt vmcnt(0)" ::: "memory");
            if ((tid & 63) == 0) __hip_atomic_fetch_add(cnt + 64 * u.pm, 1u, __ATOMIC_RELAXED, __HIP_MEMORY_SCOPE_AGENT);
        }
        if (tid < 64) {
            unsigned spins = 0;
            while ((unsigned)__builtin_amdgcn_readfirstlane(__hip_atomic_load(cnt + 64 * u.pm, __ATOMIC_RELAXED, __HIP_MEMORY_SCOPE_AGENT)) < 16u) {
                __builtin_amdgcn_s_sleep(2);
                if (++spins > (1u << 22)) { if (tid == 0) __hip_atomic_store(tmo, 1u, __ATOMIC_RELAXED, __HIP_MEMORY_SCOPE_AGENT); break; } }
            __builtin_amdgcn_fence(__ATOMIC_ACQUIRE, "agent");
        }
        asm volatile("s_waitcnt vmcnt(0) lgkmcnt(0)" ::: "memory"); __builtin_amdgcn_s_barrier(); asm volatile("" ::: "memory");
        if (tid < 256) { const float* sl = X1 + ((size_t)u.pm * BM + tid) * 4; float t4[4];
#pragma unroll
            for (int t = 0; t < 4; ++t) t4[t] = __hip_atomic_load(sl + t, __ATOMIC_RELAXED, __HIP_MEMORY_SCOPE_AGENT);
            R[tid] = 1.0f / sqrtf(((t4[0] + t4[1]) + (t4[2] + t4[3])) * (1.0f / 1024.0f) + 1e-6f); }
        asm volatile("s_waitcnt vmcnt(0) lgkmcnt(0)" ::: "memory"); __builtin_amdgcn_s_barrier(); asm volatile("" ::: "memory");
        int rl0 = wr * 64 + fr, cl0 = wc * 32 + 8 * fq; asm volatile("" : "+v"(rl0), "+v"(cl0));
        f32x4 gv[2][2];
#pragma unroll
        for (int bj = 0; bj < 2; ++bj) { gv[bj][0] = *(const f32x4*)(gain + u.pn * BM + cl0 + bj * HALF); gv[bj][1] = *(const f32x4*)(gain + u.pn * BM + cl0 + bj * HALF + 4); }
#pragma unroll
        for (int ai = 0; ai < 2; ++ai)
#pragma unroll
            for (int m = 0; m < 4; ++m) { const int rl = rl0 + ai * HALF + m * 16; const float r = R[rl]; const size_t go = ((size_t)u.pm * BM + rl) * 1024 + u.pn * BM + cl0;
                float s2 = 0.f;
#pragma unroll
                for (int bj = 0; bj < 2; ++bj) { const u32x4 hw = *(const u32x4*)(HB + go + bj * HALF);
                    f32x4 h0 = {bf2f(hw.x & 0xffffu), bf2f(hw.x >> 16), bf2f(hw.y & 0xffffu), bf2f(hw.y >> 16)}, h1 = {bf2f(hw.z & 0xffffu), bf2f(hw.z >> 16), bf2f(hw.w & 0xffffu), bf2f(hw.w >> 16)};
                    h0 = h0 + gv[bj][0] * acc[ai][bj][m][0] * r; h1 = h1 + gv[bj][1] * acc[ai][bj][m][1] * r;
                    s2 += (h0[0] * h0[0] + h0[1] * h0[1]) + (h0[2] * h0[2] + h0[3] * h0[3]) + (h1[0] * h1[0] + h1[1] * h1[1]) + (h1[2] * h1[2] + h1[3] * h1[3]);
                    if (OUTF) { *(f32x4*)(OUTF + go + bj * HALF) = h0; *(f32x4*)(OUTF + go + bj * HALF + 4) = h1; }
                    else { u32x4 w; w.x = cvt_pk_bf16(h0[0], h0[1]); w.y = cvt_pk_bf16(h0[2], h0[3]); w.z = cvt_pk_bf16(h1[0], h1[1]); w.w = cvt_pk_bf16(h1[2], h1[3]); __builtin_nontemporal_store(w, (u32x4*)(HB + go + bj * HALF)); } }
                s2 += __shfl_xor(s2, 16); s2 += __shfl_xor(s2, 32);
                if (fq == 0) P[rl * 4 + wc] = s2; }
        asm volatile("s_waitcnt lgkmcnt(0)" ::: "memory"); __builtin_amdgcn_s_barrier(); asm volatile("" ::: "memory");
        if (tid < 256) { const f32x4 p = *(const LAS f32x4*)(P + tid * 4); X2[((size_t)u.pm * BM + tid) * 4 + u.pn] = (p[0] + p[1]) + (p[2] + p[3]); }
    }
};

template <class Epi, class Sched, bool ALIGN_EPI>
__device__ __forceinline__ void gemm_phase(LAS unsigned char* lds, const int K, const Sched& S, const Epi& E) {
    int tid = threadIdx.x; asm volatile("" : "+v"(tid));
    const int wid = __builtin_amdgcn_readfirstlane(tid >> 6), lane = tid & 63, wr = wid >> 2, wc = wid & 3, fr = lane & 15, fq = lane >> 4;
    unsigned voffA[2], voffB[2];
#pragma unroll
    for (int i = 0; i < 2; ++i) { int R, C; stage_rc(tid * 16 + i * 8192, R, C); const int Rb = Epi::PERM ? ((R & ~31) + perm32(R & 31)) : R;
        voffA[i] = (unsigned)(R * K + C) * 2u; voffB[i] = (unsigned)(Rb * K + C) * 2u; }
    const size_t kstep = (size_t)(BK * 2);
    const size_t hstep = (size_t)HALF * K * 2;
    const unsigned ldsw = (unsigned)wid * 1024u;
    const int aoff = lds_byte(wr * 64 + fr, fq * 8), boff = lds_byte(wc * 32 + fr, fq * 8);
#define PG8_SA(b, h) (((b) * 2 + (h)) * HTB)
#define PG8_SB(b, h) ((4 + (b) * 2 + (h)) * HTB)
#define PG8_STAGE(bufoff, gbase, voff) do { _Pragma("unroll") for (int _i = 0; _i < 2; ++_i) \
        __builtin_amdgcn_global_load_lds((const unsigned*)((const char*)(gbase) + (voff)[_i]), (LAS unsigned*)(lds + (bufoff) + ldsw + _i * 8192), 16, 0, 0); } while (0)
#define PG8_LDA(dst, b, h) do { _Pragma("unroll") for (int m = 0; m < 4; ++m) _Pragma("unroll") for (int k = 0; k < 2; ++k) dst[m][k] = *(const LAS bf16x8*)(lds + PG8_SA(b, h) + aoff + m * 2048 + k * 1024); } while (0)
#define PG8_LDB(dst, b, h) do { _Pragma("unroll") for (int n = 0; n < 2; ++n) _Pragma("unroll") for (int k = 0; k < 2; ++k) dst[n][k] = *(const LAS bf16x8*)(lds + PG8_SB(b, h) + boff + n * 2048 + k * 1024); } while (0)
#define PG8_MMA(ai, bj, At, Bt) do { __builtin_amdgcn_s_setprio(1); _Pragma("unroll") for (int m = 0; m < 4; ++m) _Pragma("unroll") for (int n = 0; n < 2; ++n) _Pragma("unroll") for (int k = 0; k < 2; ++k) \
        acc[ai][bj][m][n] = __builtin_amdgcn_mfma_f32_16x16x32_bf16(Bt[n][k], At[m][k], acc[ai][bj][m][n], 0, 0, 0); __builtin_amdgcn_s_setprio(0); } while (0)
#define PG8_WAIT_V(n) asm volatile("s_waitcnt vmcnt(" #n ")" ::: "memory")
#define PG8_WAIT_L(n) asm volatile("s_waitcnt lgkmcnt(" #n ")" ::: "memory")
#define PG8_BAR __builtin_amdgcn_s_barrier()
#define PG8_SCHED __builtin_amdgcn_sched_barrier(0)
    Unit cur, nxt; int ui = 0;
    if (!S.next(0, cur)) return;
    f32x4 acc[2][2][4][2];
#pragma unroll
    for (int a = 0; a < 2; ++a)
#pragma unroll
        for (int b = 0; b < 2; ++b)
#pragma unroll
            for (int m = 0; m < 4; ++m)
#pragma unroll
                for (int n = 0; n < 2; ++n) acc[a][b][m][n] = (f32x4){0.f, 0.f, 0.f, 0.f};
    bf16x8 At[4][2], B0[2][2], B1[2][2];
    const char* cA; const char* cB; S.tiles(cur, cA, cB);
    PG8_STAGE(PG8_SB(0, 0), cB, voffB); PG8_STAGE(PG8_SB(0, 1), cB + hstep, voffB); PG8_STAGE(PG8_SA(0, 0), cA, voffA); PG8_STAGE(PG8_SA(0, 1), cA + hstep, voffA);
    if (wr == 1) PG8_BAR;
    PG8_WAIT_V(2); PG8_BAR;
    PG8_STAGE(PG8_SB(1, 0), cB + kstep, voffB); PG8_STAGE(PG8_SA(1, 0), cA + kstep, voffA); PG8_STAGE(PG8_SB(1, 1), cB + hstep + kstep, voffB);
    PG8_WAIT_V(6); PG8_BAR;
    for (;;) {
        const bool has_next = S.next(ui + 1, nxt);
        const char* nA = cA; const char* nB = cB; if (has_next) S.tiles(nxt, nA, nB);
#define PG8_KT2(t, last) do { \
            const char* a1 = cA + (size_t)((t) + 1) * kstep; \
            const char* a2 = (last) ? nA : cA + (size_t)((t) + 2) * kstep; const char* b2 = (last) ? nB : cB + (size_t)((t) + 2) * kstep; \
            const char* a3 = a2 + kstep; const char* b3 = b2 + kstep; \
            PG8_LDB(B0, 0, 0); PG8_LDB(B1, 0, 1); PG8_SCHED; PG8_LDA(At, 0, 0); PG8_STAGE(PG8_SA(1, 1), a1 + hstep, voffA); \
            PG8_WAIT_V(8); PG8_WAIT_L(0); PG8_BAR; PG8_MMA(0, 0, At, B0); PG8_MMA(0, 1, At, B1); PG8_BAR; PG8_SCHED; \
            PG8_LDA(At, 0, 1); PG8_STAGE(PG8_SB(0, 0), b2, voffB); PG8_STAGE(PG8_SB(0, 1), b2 + hstep, voffB); PG8_STAGE(PG8_SA(0, 0), a2, voffA); \
            PG8_WAIT_V(8); PG8_WAIT_L(0); PG8_BAR; PG8_MMA(1, 0, At, B0); PG8_MMA(1, 1, At, B1); PG8_BAR; PG8_SCHED; \
            PG8_LDB(B0, 1, 0); PG8_LDB(B1, 1, 1); PG8_SCHED; PG8_LDA(At, 1, 0); PG8_STAGE(PG8_SA(0, 1), a2 + hstep, voffA); \
            PG8_WAIT_V(8); PG8_WAIT_L(0); PG8_BAR; PG8_MMA(0, 0, At, B0); PG8_MMA(0, 1, At, B1); PG8_BAR; PG8_SCHED; \
            PG8_LDA(At, 1, 1); PG8_STAGE(PG8_SB(1, 0), b3, voffB); PG8_STAGE(PG8_SB(1, 1), b3 + hstep, voffB); PG8_STAGE(PG8_SA(1, 0), a3, voffA); \
            PG8_WAIT_V(8); PG8_WAIT_L(0); PG8_BAR; PG8_MMA(1, 0, At, B0); PG8_MMA(1, 1, At, B1); PG8_BAR; PG8_SCHED; } while (0)
        {
            const int ntc = S.ntiles(cur);
#pragma unroll 1
            for (int t = 0; t < ntc; t += 2) { const bool last = (t == ntc - 2); PG8_KT2(t, last); }
        }
        if constexpr (ALIGN_EPI) { if (wr == 0) PG8_BAR; }
        E(acc, cur, wr, wc, fr, fq);
        if (!has_next) break;
        if (!S.keep_acc(nxt)) {
#pragma unroll
        for (int a = 0; a < 2; ++a)
#pragma unroll
            for (int b = 0; b < 2; ++b)
#pragma unroll
                for (int m = 0; m < 4; ++m)
#pragma unroll
                    for (int n = 0; n < 2; ++n) acc[a][b][m][n] = (f32x4){0.f, 0.f, 0.f, 0.f};
        }
        cur = nxt; cA = nA; cB = nB; ++ui;
        if constexpr (ALIGN_EPI) { if (wr == 1) PG8_BAR; }
    }
    PG8_WAIT_V(0);
    if constexpr (!ALIGN_EPI) { if (wr == 0) PG8_BAR; }
    PG8_BAR;
#undef PG8_KT2
#undef PG8_SA
#undef PG8_SB
#undef PG8_STAGE
#undef PG8_LDA
#undef PG8_LDB
#undef PG8_MMA
#undef PG8_WAIT_V
#undef PG8_WAIT_L
#undef PG8_BAR
#undef PG8_SCHED
}
}

struct Args {
    const float* in[22]; float* out; unsigned char* ws; int ph_lo, ph_hi;
};
enum { I_X = 0, I_NMIXPRE, I_NMIXPOST, I_NMLPPRE, I_NMLPPOST, I_WIN, I_LCW, I_LCB, I_LWA, I_LBA, I_LWX, I_LBX, I_LLAM, I_PW, I_PS, I_HLB, I_HN, I_SW, I_WBR, I_WOUT, I_WUP, I_WDOWN };

struct Ctx {
    LAS unsigned char* lds; int tid, lane, wave, vcu, G;
};

__device__ __forceinline__ void transpose_item(const float* W, int ldw, const float* gain, bf16_t* WT, int ldo, int col_off, int k0, int n0, LAS float* scr, int lane) {
    float wv[32];
#pragma unroll
    for (int i = 0; i < 32; ++i) { const int kk = 2 * i + (lane >> 5); wv[i] = W[(size_t)(k0 + kk) * ldw + n0 + (lane & 31)]; }
#pragma unroll
    for (int i = 0; i < 32; ++i) { const int kk = 2 * i + (lane >> 5); const float g = gain ? gain[k0 + kk] : 1.0f; scr[kk * 33 + (lane & 31)] = g * wv[i]; }
    asm volatile("s_waitcnt lgkmcnt(0)" ::: "memory");
    const int c = lane & 7;
#pragma unroll
    for (int j = 0; j < 4; ++j) { const int n = (lane >> 3) + 8 * j; const LAS float* s = scr + (8 * c) * 33 + n;
        u32x4 o; o.x = pk2(s[0 * 33], s[1 * 33]); o.y = pk2(s[2 * 33], s[3 * 33]); o.z = pk2(s[4 * 33], s[5 * 33]); o.w = pk2(s[6 * 33], s[7 * 33]);
        *(u32x4*)(WT + (size_t)(n0 + n) * ldo + col_off + k0 + 8 * c) = o; }
    asm volatile("s_waitcnt lgkmcnt(0)" ::: "memory");
}

__device__ __forceinline__ void p0_prologue(const Ctx& C, const Args& A) {
    LAS float* scr = (LAS float*)(C.lds + C.wave * 16384);
    const int gw = C.vcu * NWAVES + C.wave, NGW = C.G * NWAVES;
    constexpr int I_IN = (D / 64) * (INW / 32), I_BR1 = (BW / 64) * (D / 32), I_OUT = (D / 64) * (D / 32), I_UP = (D / 64) * (FF / 32), I_DN = (FF / 64) * (D / 32);
    constexpr int PER_LAYER = I_IN + 4 * I_BR1 + I_OUT + I_UP + I_DN;
    for (int it = gw; it < DEPTH * PER_LAYER; it += NGW) {
        const int l = it / PER_LAYER; int r = it % PER_LAYER;
        bf16_t* wl = (bf16_t*)(A.ws + WS_W + (size_t)l * W_LAYER);
        if (r < I_IN) { const int nb = INW / 32; transpose_item(A.in[I_WIN] + (size_t)l * D * INW, INW, A.in[I_NMIXPRE] + l * D, wl + W_IN / 2, D, 0, 64 * (r / nb), 32 * (r % nb), scr, C.lane); continue; } r -= I_IN;
        if (r < 4 * I_BR1) { const int k = r / I_BR1, rr = r % I_BR1, nb = D / 32; transpose_item(A.in[I_WBR] + ((size_t)l * 4 + k) * BW * D, D, nullptr, wl + W_BR / 2, D, k * BW, 64 * (rr / nb), 32 * (rr % nb), scr, C.lane); continue; } r -= 4 * I_BR1;
        if (r < I_OUT) { const int nb = D / 32; transpose_item(A.in[I_WOUT] + (size_t)l * D * D, D, nullptr, wl + W_OUT / 2, D, 0, 64 * (r / nb), 32 * (r % nb), scr, C.lane); continue; } r -= I_OUT;
        if (r < I_UP) { const int nb = FF / 32; transpose_item(A.in[I_WUP] + (size_t)l * D * FF, FF, A.in[I_NMLPPRE] + l * D, wl + W_UP / 2, D, 0, 64 * (r / nb), 32 * (r % nb), scr, C.lane); continue; } r -= I_UP;
        { const int nb = D / 32; transpose_item(A.in[I_WDOWN] + (size_t)l * FF * D, D, nullptr, wl + W_DOWN / 2, FF, 0, 64 * (r / nb), 32 * (r % nb), scr, C.lane); }
    }
    bf16_t* HB = (bf16_t*)(A.ws + WS_HB); float* RS = (float*)(A.ws + WS_X2);
    for (int m0 = gw; m0 < M; m0 += 4 * NGW) {
        f32x4 v[4][4];
#pragma unroll
        for (int q = 0; q < 4; ++q) { const int m = m0 + q * NGW; const f32x4* xr = (const f32x4*)(A.in[I_X] + (size_t)(m < M ? m : 0) * D) + C.lane;
#pragma unroll
            for (int j = 0; j < 4; ++j) v[q][j] = xr[64 * j]; }
#pragma unroll
        for (int q = 0; q < 4; ++q) { const int m = m0 + q * NGW; if (m < M) { float s = 0.f;
#pragma unroll
            for (int j = 0; j < 4; ++j) s += (v[q][j].x * v[q][j].x + v[q][j].y * v[q][j].y) + (v[q][j].z * v[q][j].z + v[q][j].w * v[q][j].w);
            s = wave_sum(s);
            u32x2* o8 = (u32x2*)(HB + (size_t)m * D) + C.lane;
#pragma unroll
            for (int j = 0; j < 4; ++j) { u32x2 w; w.x = pk2(v[q][j].x, v[q][j].y); w.y = pk2(v[q][j].z, v[q][j].w); o8[64 * j] = w; }
            if (C.lane == 0) *(f32x4*)(RS + (size_t)m * 4) = (f32x4){s, 0.f, 0.f, 0.f}; } }
    }
}

__device__ __forceinline__ void norm_phase(const Ctx& C, const Args& A, const bf16_t* VIN, const float* gain, bool write_out) {
    bf16_t* HB = (bf16_t*)(A.ws + WS_HB); float* RS = (float*)(A.ws + WS_X2); float* OUT = A.out;
    int lane = C.lane; asm volatile("" : "+v"(lane));
    const int gw = C.vcu * NWAVES + C.wave, NGW = C.G * NWAVES;
    f32x4 g[4];
#pragma unroll
    for (int j = 0; j < 4; ++j) g[j] = ((const f32x4*)gain)[lane + 64 * j];
    for (int m = gw; m < M; m += NGW) {
        u32x2* hb = (u32x2*)(HB + (size_t)m * D) + lane;
        const u32x2* vb = (const u32x2*)(VIN + (size_t)m * D) + lane;
        f32x4 v[4], h[4]; float s = 0.f;
#pragma unroll
        for (int j = 0; j < 4; ++j) { const u32x2 w = vb[64 * j], hw = hb[64 * j];
            v[j] = (f32x4){bf2f(w.x & 0xffffu), bf2f(w.x >> 16), bf2f(w.y & 0xffffu), bf2f(w.y >> 16)};
            h[j] = (f32x4){bf2f(hw.x & 0xffffu), bf2f(hw.x >> 16), bf2f(hw.y & 0xffffu), bf2f(hw.y >> 16)};
            s += (v[j].x * v[j].x + v[j].y * v[j].y) + (v[j].z * v[j].z + v[j].w * v[j].w); }
        const float r = 1.0f / sqrtf(wave_sum(s) * (1.0f / D) + EPS);
        float s2 = 0.f;
#pragma unroll
        for (int j = 0; j < 4; ++j) { h[j] = h[j] + g[j] * v[j] * r; s2 += (h[j].x * h[j].x + h[j].y * h[j].y) + (h[j].z * h[j].z + h[j].w * h[j].w); }
        s2 = wave_sum(s2);
        if (write_out) { f32x4* orow = (f32x4*)(OUT + (size_t)m * D) + lane;
#pragma unroll
            for (int j = 0; j < 4; ++j) orow[64 * j] = h[j]; }
        else {
#pragma unroll
            for (int j = 0; j < 4; ++j) { u32x2 w; w.x = pk2(h[j].x, h[j].y); w.y = pk2(h[j].z, h[j].w); hb[64 * j] = w; }
            if (lane == 0) *(f32x4*)(RS + (size_t)m * 4) = (f32x4){s2, 0.f, 0.f, 0.f}; }
    }
}

__device__ __forceinline__ float gelu_tanh(float x) {
    const float u = 0.7978845608028654f * (x + 0.044715f * x * x * x);
    const float e = fast_exp(2.0f * u);
    const float th = 1.0f - 2.0f * __builtin_amdgcn_rcpf(e + 1.0f);
    return 0.5f * x * (1.0f + th);
}

constexpr size_t WS_LRA = 428 * MiB, WS_LRU = 444 * MiB;
constexpr int MX_PT = 528;
__device__ __forceinline__ bf16x8 gather_wfrag(const float* w, int stride) {
    union { bf16x8 v; unsigned u[4]; } r;
#pragma unroll
    for (int p = 0; p < 4; ++p) r.u[p] = pk2(w[(2 * p) * stride], w[(2 * p + 1) * stride]);
    return r.v;
}
__device__ __forceinline__ void mix1_item(const Ctx& C, const Args& A, int l, int b, int c) {
    const bf16_t* PROJ = (const bf16_t*)(A.ws + WS_PROJ);
    bf16_t* YS = (bf16_t*)(A.ws + WS_YS);
    int tid = C.tid; asm volatile("" : "+v"(tid));
    const int lane = tid & 63, wave = C.wave, fr = lane & 15, fg = lane >> 4;
    const size_t m0 = (size_t)b * T + (size_t)c * 64;
    LAS unsigned char* XC = C.lds;
    LAS unsigned char* LAi = C.lds + 34816;
    LAS unsigned char* LUi = C.lds + 34816 + 32768;
    {
        const float* cw = A.in[I_LCW] + (size_t)l * 4 * BW; const float* cbp = A.in[I_LCB] + l * BW;
#pragma unroll
        for (int k = 0; k < 4; ++k) { const int idx = tid + NTHREADS * k; const int t = idx >> 5, c8 = (idx & 31) * 8;
            float acc[8];
            { const f32x4 b0 = *(const f32x4*)(cbp + c8), b1 = *(const f32x4*)(cbp + c8 + 4); acc[0] = b0[0]; acc[1] = b0[1]; acc[2] = b0[2]; acc[3] = b0[3]; acc[4] = b1[0]; acc[5] = b1[1]; acc[6] = b1[2]; acc[7] = b1[3]; }
#pragma unroll
            for (int j = 0; j < 4; ++j) { const int tok = c * 64 + t - 3 + j;
                if (tok >= 0) { float x[8]; ld8bf(PROJ + ((size_t)b * T + tok) * NMIX + c8, x); const f32x4 w0 = *(const f32x4*)(cw + j * BW + c8), w1 = *(const f32x4*)(cw + j * BW + c8 + 4);
                    acc[0] += w0[0] * x[0]; acc[1] += w0[1] * x[1]; acc[2] += w0[2] * x[2]; acc[3] += w0[3] * x[3]; acc[4] += w1[0] * x[4]; acc[5] += w1[1] * x[5]; acc[6] += w1[2] * x[6]; acc[7] += w1[3] * x[7]; } }
            u32x4 w; w.x = cvt_pk_bf16(acc[0], acc[1]); w.y = cvt_pk_bf16(acc[2], acc[3]); w.z = cvt_pk_bf16(acc[4], acc[5]); w.w = cvt_pk_bf16(acc[6], acc[7]);
            *(LAS u32x4*)(XC + t * MX_PT + c8 * 2) = w; }
    }
    __syncthreads();
    {
        const int blk = wave;
        const float* wa = A.in[I_LWA] + (((size_t)l * 8 + blk) * 32) * 32; const float* wx = A.in[I_LWX] + (((size_t)l * 8 + blk) * 32) * 32;
        bf16x8 fa[2], fx[2];
#pragma unroll
        for (int nt = 0; nt < 2; ++nt) { fa[nt] = gather_wfrag(wa + (8 * fg) * 32 + 16 * nt + fr, 32); fx[nt] = gather_wfrag(wx + (8 * fg) * 32 + 16 * nt + fr, 32); }
        bf16_t* LRA = (bf16_t*)(A.ws + WS_LRA); bf16_t* LRU = (bf16_t*)(A.ws + WS_LRU);
#pragma unroll
        for (int nt = 0; nt < 2; ++nt) { const int ch = 32 * blk + 16 * nt + 4 * fg;
            const f32x4 ba = *(const f32x4*)(A.in[I_LBA] + l * BW + ch), bx = *(const f32x4*)(A.in[I_LBX] + l * BW + ch), lam = *(const f32x4*)(A.in[I_LLAM] + l * BW + ch);
            float sp8[4];
#pragma unroll
            for (int r = 0; r < 4; ++r) sp8[r] = -8.0f * ((-lam[r] > 20.f) ? -lam[r] : log1pf(expf(-lam[r])));
#pragma unroll
            for (int mt = 0; mt < 4; ++mt) { const int tok = 16 * mt + fr;
                const bf16x8 bxc = *(const LAS bf16x8*)(XC + tok * MX_PT + (32 * blk + 8 * fg) * 2);
                f32x4 ar = {0.f, 0.f, 0.f, 0.f}, ai = {0.f, 0.f, 0.f, 0.f};
                ar = __builtin_amdgcn_mfma_f32_16x16x32_bf16(fa[nt], bxc, ar, 0, 0, 0); ai = __builtin_amdgcn_mfma_f32_16x16x32_bf16(fx[nt], bxc, ai, 0, 0, 0);
                const u32x2 xw = *(const LAS u32x2*)(XC + tok * MX_PT + ch * 2);
                const float xc[4] = {bf2f(xw.x & 0xffffu), bf2f(xw.x >> 16), bf2f(xw.y & 0xffffu), bf2f(xw.y >> 16)};
                float la[4], uu[4];
#pragma unroll
                for (int r = 0; r < 4; ++r) { const float rg = sigmoid_f(ar[r] + ba[r]), ig = sigmoid_f(ai[r] + bx[r]);
                    la[r] = sp8[r] * rg; const float x2 = 2.0f * la[r];
                    const float om = (x2 > -0.02f) ? -x2 * (1.0f + 0.5f * x2 * (1.0f + x2 * (1.0f / 3.0f))) : 1.0f - fast_exp(x2);
                    uu[r] = sqrtf(om) * ig * xc[r]; }
                u32x2 wl, wu; wl.x = cvt_pk_bf16(la[0], la[1]); wl.y = cvt_pk_bf16(la[2], la[3]); wu.x = cvt_pk_bf16(uu[0], uu[1]); wu.y = cvt_pk_bf16(uu[2], uu[3]);
                *(LAS u32x2*)(LAi + tok * 512 + ch * 2) = wl; *(LAS u32x2*)(LUi + tok * 512 + ch * 2) = wu;
                *(u32x2*)(LRA + (m0 + tok) * BW + ch) = wl; *(u32x2*)(LRU + (m0 + tok) * BW + ch) = wu; }
        }
    }
    __syncthreads();
    {
        const int ch = tid & 255, half = tid >> 8; float P = 1.f, hst = 0.f;
#pragma unroll
        for (int i = 0; i < 32; ++i) { const int t = 32 * half + i; const float a = fast_exp(bf2f(*(const LAS bf16_t*)(LAi + t * 512 + ch * 2))); const float u = bf2f(*(const LAS bf16_t*)(LUi + t * 512 + ch * 2));
            hst = a * hst + u; P *= a; }
        const size_t aggi = ((size_t)b * 128 + c * 2 + half) * 256 + ch;
        ((float*)(A.ws + WS_LA))[aggi] = P; ((float*)(A.ws + WS_LH))[aggi] = hst;
    }
    __syncthreads();
    LAS unsigned char* PX = C.lds;
    LAS unsigned char* DD = C.lds + 43008;
    { u32x4 pv[5];
#pragma unroll
        for (int k = 0; k < 5; ++k) { const int idx = tid + NTHREADS * k; const int r = idx >> 5, c8 = (idx & 31) * 8; const int tok = c * 64 - 15 + r;
            pv[k] = (u32x4){0u, 0u, 0u, 0u}; if (idx < 79 * 32 && tok >= 0) pv[k] = *(const u32x4*)(PROJ + ((size_t)b * T + tok) * NMIX + 512 + c8); }
#pragma unroll
        for (int k = 0; k < 5; ++k) { const int idx = tid + NTHREADS * k; const int r = idx >> 5, c8 = (idx & 31) * 8; if (idx < 79 * 32) *(LAS u32x4*)(PX + r * MX_PT + c8 * 2) = pv[k]; } }
    __syncthreads();
#pragma unroll 1
    for (int k = 0; k < 4; ++k) { const int idx = tid + NTHREADS * k; const int t = idx >> 5, c8 = (idx & 31) * 8; const int g = c8 >> 6, win = 2 << g;
        float sum[8], x0[8];
#pragma unroll
        for (int e = 0; e < 8; ++e) sum[e] = 0.f;
        for (int j = 0; j < win; ++j) { const u32x4 v = *(const LAS u32x4*)(PX + (t + 15 - j) * MX_PT + c8 * 2);
            const float x[8] = {bf2f(v.x & 0xffffu), bf2f(v.x >> 16), bf2f(v.y & 0xffffu), bf2f(v.y >> 16), bf2f(v.z & 0xffffu), bf2f(v.z >> 16), bf2f(v.w & 0xffffu), bf2f(v.w >> 16)};
#pragma unroll
            for (int e = 0; e < 8; ++e) { sum[e] += x[e]; if (j == 0) x0[e] = x[e]; } }
        const int pos = c * 64 + t + 1; const float inv = 1.0f / (float)(pos < win ? pos : win);
        u32x4 w; w.x = cvt_pk_bf16(sum[0] * inv - x0[0], sum[1] * inv - x0[1]); w.y = cvt_pk_bf16(sum[2] * inv - x0[2], sum[3] * inv - x0[3]);
        w.z = cvt_pk_bf16(sum[4] * inv - x0[4], sum[5] * inv - x0[5]); w.w = cvt_pk_bf16(sum[6] * inv - x0[6], sum[7] * inv - x0[7]);
        *(LAS u32x4*)(DD + t * MX_PT + c8 * 2) = w; }
    __syncthreads();
    {
        const int g = wave >> 1, nb = (wave & 1) * 2;
        const float* pw = A.in[I_PW] + (((size_t)l * 4 + g) * 64) * 64;
        bf16x8 fw[2][2];
#pragma unroll
        for (int nn = 0; nn < 2; ++nn)
#pragma unroll
            for (int ks = 0; ks < 2; ++ks) fw[nn][ks] = gather_wfrag(pw + (32 * ks + 8 * fg) * 64 + 16 * (nb + nn) + fr, 64);
#pragma unroll
        for (int nn = 0; nn < 2; ++nn) { const int ch = 64 * g + 16 * (nb + nn) + 4 * fg; const f32x4 scl = *(const f32x4*)(A.in[I_PS] + l * BW + ch);
#pragma unroll
            for (int mt = 0; mt < 4; ++mt) { const int tok = 16 * mt + fr; f32x4 acc = {0.f, 0.f, 0.f, 0.f};
#pragma unroll
                for (int ks = 0; ks < 2; ++ks) { const bf16x8 bd = *(const LAS bf16x8*)(DD + tok * MX_PT + (64 * g + 32 * ks + 8 * fg) * 2); acc = __builtin_amdgcn_mfma_f32_16x16x32_bf16(fw[nn][ks], bd, acc, 0, 0, 0); }
                u32x2 w; w.x = cvt_pk_bf16(acc[0] * scl[0], acc[1] * scl[1]); w.y = cvt_pk_bf16(acc[2] * scl[2], acc[3] * scl[3]);
                *(u32x2*)(YS + (m0 + tok) * D + 256 + ch) = w; } }
    }
    {
        const float* sw = A.in[I_SW] + (size_t)l * 3 * BW;
#pragma unroll 2
        for (int k = 0; k < 4; ++k) { const int idx = tid + NTHREADS * k; const int t = idx >> 5, c8 = (idx & 31) * 8;
            float acc[8];
#pragma unroll
            for (int e = 0; e < 8; ++e) acc[e] = 0.f;
#pragma unroll
            for (int j = 0; j < 3; ++j) { const int tok = c * 64 + t - 2 + j;
                if (tok >= 0) { const bf16_t* p = PROJ + ((size_t)b * T + tok) * NMIX; float sc[8], sx[8]; ld8bf(p + 2048 + c8, sc); ld8bf(p + 2304 + c8, sx);
                    const f32x4 w0 = *(const f32x4*)(sw + j * BW + c8), w1 = *(const f32x4*)(sw + j * BW + c8 + 4);
                    acc[0] += w0[0] * sc[0] * sx[0]; acc[1] += w0[1] * sc[1] * sx[1]; acc[2] += w0[2] * sc[2] * sx[2]; acc[3] += w0[3] * sc[3] * sx[3];
                    acc[4] += w1[0] * sc[4] * sx[4]; acc[5] += w1[1] * sc[5] * sx[5]; acc[6] += w1[2] * sc[6] * sx[6]; acc[7] += w1[3] * sc[7] * sx[7]; } }
            float sb[8]; ld8bf(PROJ + (m0 + t) * NMIX + 1792 + c8, sb);
            u32x4 w; w.x = cvt_pk_bf16(sb[0] * acc[0], sb[1] * acc[1]); w.y = cvt_pk_bf16(sb[2] * acc[2], sb[3] * acc[3]); w.z = cvt_pk_bf16(sb[4] * acc[4], sb[5] * acc[5]); w.w = cvt_pk_bf16(sb[6] * acc[6], sb[7] * acc[7]);
            *(u32x4*)(YS + (m0 + t) * D + 768 + c8) = w; }
    }
    __syncthreads();
}
__device__ __forceinline__ void lru_final_item(const Ctx& C, const Args& A, int l, int b, int c) {
    const bf16_t* PROJ = (const bf16_t*)(A.ws + WS_PROJ);
    const bf16_t* LRA = (const bf16_t*)(A.ws + WS_LRA); const bf16_t* LRU = (const bf16_t*)(A.ws + WS_LRU);
    bf16_t* YS = (bf16_t*)(A.ws + WS_YS);
    int tid = C.tid; asm volatile("" : "+v"(tid));
    const int ch = tid & 255, half = tid >> 8;
    const size_t m0 = (size_t)b * T + (size_t)c * 64 + 32 * half;
    float hst = ((const float*)(A.ws + WS_LC))[((size_t)b * 128 + c * 2 + half) * 256 + ch];
    unsigned short la[32], lu[32], lg[32];
#pragma unroll
    for (int i = 0; i < 32; ++i) { la[i] = LRA[(m0 + i) * BW + ch]; lu[i] = LRU[(m0 + i) * BW + ch]; lg[i] = PROJ[(m0 + i) * NMIX + 256 + ch]; }
#pragma unroll
    for (int i = 0; i < 32; ++i) { const float a = fast_exp(bf2f(la[i])), u = bf2f(lu[i]);
        hst = a * hst + u;
        YS[(m0 + i) * D + ch] = (bf16_t)f2bf(hst * gelu_tanh(bf2f(lg[i]))); }
}

constexpr int HG_PT = 144;
constexpr int HG_IMG = 64 * HG_PT;
constexpr int HG_Q = 0, HG_K = HG_IMG, HG_P = 2 * HG_IMG, HG_BEND = 3 * HG_IMG, HG_REF = HG_BEND + 512, HG_HSZ = 29696;
constexpr size_t WS_ST16 = WS_MERGED + 32 * MiB;
__device__ __forceinline__ float hgrn_lb(const Args& A, int l, int w) {
    if (l == 0) return 0.f;
    const float a0 = A.in[I_HLB][w], a1 = A.in[I_HLB][BW + w];
    return 1.0f / (1.0f + expf(a0 - a1));
}
template <bool FINAL>
__device__ __forceinline__ void hgrn_item(const Ctx& C, const Args& A, int l, int b, int c) {
    const bf16_t* PROJ = (const bf16_t*)(A.ws + WS_PROJ);
    int lane = C.lane; asm volatile("" : "+v"(lane));
    const int wave = C.wave, h = wave >> 1, half = wave & 1, fr = lane & 15, fg = lane >> 4;
    LAS unsigned char* hb = C.lds + h * HG_HSZ;
    LAS float* BEND = (LAS float*)(hb + HG_BEND); LAS float* REF = (LAS float*)(hb + HG_REF);
    const size_t m0 = (size_t)b * T + (size_t)c * 64;
    const bf16_t* pr = PROJ + (m0 + 32 * half) * NMIX + h * 64 + lane;
    const int bh = b * 4 + h; const size_t ci = (size_t)bh * 64 + c;
    float bb[32], kk[32], vv[32];
    {
        const float lbv = hgrn_lb(A, l, h * 64 + lane);
        float acc = 0.f;
#pragma unroll
        for (int i = 0; i < 32; ++i) { const float x = bf2f(pr[(size_t)i * NMIX + 1024]); const float f = fmaxf(lbv + (1.0f - lbv) * sigmoid_f(x), 1e-30f);
            acc += __logf(f); bb[i] = acc; kk[i] = 1.0f - f; }
#pragma unroll
        for (int i = 0; i < 32; ++i) vv[i] = bf2f(pr[(size_t)i * NMIX + 1280]);
        BEND[half * 64 + lane] = acc;
    }
    __syncthreads();
    const float bend0 = BEND[lane], blast = bend0 + BEND[64 + lane];
    if (half) {
#pragma unroll
        for (int i = 0; i < 32; ++i) bb[i] += bend0;
    }
    if (!FINAL) {
        LAS unsigned char* kt = hb + HG_K + lane * HG_PT + 64 * half; LAS unsigned char* vt = hb + HG_Q + lane * HG_PT + 64 * half;
#pragma unroll
        for (int q4 = 0; q4 < 4; ++q4) { u32x4 wk, wv; unsigned kw[4], vw[4];
#pragma unroll
            for (int p = 0; p < 4; ++p) { const int i = q4 * 8 + 2 * p;
                kw[p] = cvt_pk_bf16(kk[i] * fast_exp(blast - bb[i]), kk[i + 1] * fast_exp(blast - bb[i + 1])); vw[p] = cvt_pk_bf16(vv[i], vv[i + 1]); }
            wk.x = kw[0]; wk.y = kw[1]; wk.z = kw[2]; wk.w = kw[3]; wv.x = vw[0]; wv.y = vw[1]; wv.z = vw[2]; wv.w = vw[3];
            *(LAS u32x4*)(kt + q4 * 16) = wk; *(LAS u32x4*)(vt + q4 * 16) = wv; }
        if (half == 0) ((float*)(A.ws + WS_SD))[ci * 64 + lane] = fast_exp(blast);
        __syncthreads();
        float* su = (float*)(A.ws + WS_SU) + ci * 4096;
#pragma unroll
        for (int aa = 0; aa < 2; ++aa) { const int a = 2 * half + aa;
            bf16x8 av[2];
#pragma unroll
            for (int ks = 0; ks < 2; ++ks) av[ks] = *(const LAS bf16x8*)(hb + HG_Q + (16 * a + fr) * HG_PT + 64 * ks + 16 * fg);
#pragma unroll
            for (int d = 0; d < 4; ++d) { f32x4 acc = {0.f, 0.f, 0.f, 0.f};
#pragma unroll
                for (int ks = 0; ks < 2; ++ks) { const bf16x8 bk = *(const LAS bf16x8*)(hb + HG_K + (16 * d + fr) * HG_PT + 64 * ks + 16 * fg);
                    acc = __builtin_amdgcn_mfma_f32_16x16x32_bf16(av[ks], bk, acc, 0, 0, 0); }
#pragma unroll
                for (int r = 0; r < 4; ++r) su[(16 * a + 4 * fg + r) * 64 + 16 * d + fr] = acc[r];
            } }
        __syncthreads();
    } else {
        float qq[32];
#pragma unroll
        for (int i = 0; i < 32; ++i) qq[i] = bf2f(pr[(size_t)i * NMIX + 768]);
        if (half == 0) { REF[64 + lane] = bb[15]; REF[128 + lane] = bb[31]; } else REF[192 + lane] = bb[15];
        { const u32x4 z = {0u, 0u, 0u, 0u};
#pragma unroll
            for (int k2 = 0; k2 < 5; ++k2) { const int idx = lane + 64 * k2; if (idx < 32 * 9) *(LAS u32x4*)(hb + HG_P + 32 * half * HG_PT + idx * 16) = z; } }
        __syncthreads();
        float rf[4]; rf[0] = 0.f; rf[1] = REF[64 + lane]; rf[2] = REF[128 + lane]; rf[3] = REF[192 + lane];
        {
            const float r_lo = half ? rf[2] : rf[0], r_hi = half ? rf[3] : rf[1];
#pragma unroll
            for (int i = 0; i < 32; ++i) { const float rr = (i < 16) ? r_lo : r_hi; const float val = qq[i] * fast_exp(bb[i] - rr);
                *(LAS bf16_t*)(hb + HG_Q + (32 * half + i) * HG_PT + 2 * lane) = (bf16_t)f2bf(val); }
        }
#pragma unroll
        for (int isub = 0; isub < 4; ++isub) {
            const int nrows = 16 * (isub + 1) - 32 * half;
#pragma unroll
            for (int i = 0; i < 32; ++i) { if (i < nrows) { const float e = fminf(rf[isub] - bb[i], 60.f); const float val = kk[i] * fast_exp(e);
                    *(LAS bf16_t*)(hb + HG_K + (32 * half + i) * HG_PT + 2 * lane) = (bf16_t)f2bf(val); } }
            __syncthreads();
            {
                bf16x8 bq[2];
#pragma unroll
                for (int ks = 0; ks < 2; ++ks) bq[ks] = *(const LAS bf16x8*)(hb + HG_Q + (16 * isub + fr) * HG_PT + 64 * ks + 16 * fg);
#pragma unroll
                for (int j = 0; j <= isub; ++j) { if ((j & 1) == half) {
                        f32x4 acc = {0.f, 0.f, 0.f, 0.f};
#pragma unroll
                        for (int ks = 0; ks < 2; ++ks) { const bf16x8 ak = *(const LAS bf16x8*)(hb + HG_K + (16 * j + fr) * HG_PT + 64 * ks + 16 * fg);
                            acc = __builtin_amdgcn_mfma_f32_16x16x32_bf16(ak, bq[ks], acc, 0, 0, 0); }
                        if (j == isub) {
#pragma unroll
                            for (int r = 0; r < 4; ++r) if (4 * fg + r > fr) acc[r] = 0.f; }
                        u32x2 w; w.x = cvt_pk_bf16(acc[0], acc[1]); w.y = cvt_pk_bf16(acc[2], acc[3]);
                        *(LAS u32x2*)(hb + HG_P + (16 * isub + fr) * HG_PT + 2 * (16 * j + 4 * fg)) = w;
                    } }
            }
            __syncthreads();
        }
        {
            LAS unsigned char* vt = hb + HG_Q + lane * HG_PT + 64 * half;
#pragma unroll
            for (int q4 = 0; q4 < 4; ++q4) { u32x4 wv; unsigned vw[4];
#pragma unroll
                for (int p = 0; p < 4; ++p) { const int i = q4 * 8 + 2 * p; vw[p] = cvt_pk_bf16(vv[i], vv[i + 1]); }
                wv.x = vw[0]; wv.y = vw[1]; wv.z = vw[2]; wv.w = vw[3]; *(LAS u32x4*)(vt + q4 * 16) = wv; }
#pragma unroll
            for (int i = 0; i < 32; ++i) *(LAS bf16_t*)(hb + HG_K + (32 * half + i) * HG_PT + 2 * lane) = (bf16_t)f2bf(qq[i] * fast_exp(bb[i]));
        }
        __syncthreads();
        {
            const bf16_t* st = (const bf16_t*)(A.ws + WS_ST16) + ci * 4096;
            bf16x8 a_st[4][2];
#pragma unroll
            for (int a = 0; a < 4; ++a)
#pragma unroll
                for (int ks = 0; ks < 2; ++ks) a_st[a][ks] = *(const bf16x8*)(st + (16 * a + fr) * 64 + 32 * ks + 8 * fg);
            bf16_t* YS = (bf16_t*)(A.ws + WS_YS);
            const float* gn = A.in[I_HN] + l * 64;
#pragma unroll
            for (int tt = 0; tt < 2; ++tt) { const int ti = 2 * half + tt;
                bf16x8 bp[2], bqb[2];
#pragma unroll
                for (int ks = 0; ks < 2; ++ks) { bp[ks] = *(const LAS bf16x8*)(hb + HG_P + (16 * ti + fr) * HG_PT + 64 * ks + 16 * fg); bqb[ks] = *(const LAS bf16x8*)(hb + HG_K + (16 * ti + fr) * HG_PT + 64 * ks + 16 * fg); }
                f32x4 o[4]; float ss = 0.f;
#pragma unroll
                for (int a = 0; a < 4; ++a) { f32x4 acc = {0.f, 0.f, 0.f, 0.f};
#pragma unroll
                    for (int ks = 0; ks < 2; ++ks) { const bf16x8 av = *(const LAS bf16x8*)(hb + HG_Q + (16 * a + fr) * HG_PT + 64 * ks + 16 * fg);
                        acc = __builtin_amdgcn_mfma_f32_16x16x32_bf16(av, bp[ks], acc, 0, 0, 0);
                        acc = __builtin_amdgcn_mfma_f32_16x16x32_bf16(a_st[a][ks], bqb[ks], acc, 0, 0, 0); }
                    o[a] = acc; ss += (acc[0] * acc[0] + acc[1] * acc[1]) + (acc[2] * acc[2] + acc[3] * acc[3]); }
                ss += __shfl_xor(ss, 16); ss += __shfl_xor(ss, 32);
                const float rn = 1.0f / sqrtf(ss * (1.0f / 64.0f) + EPS);
                const size_t row = m0 + 16 * ti + fr;
#pragma unroll
                for (int a = 0; a < 4; ++a) { const int dv = 16 * a + 4 * fg;
                    const u32x2 gw = *(const u32x2*)(PROJ + row * NMIX + 1536 + h * 64 + dv);
                    const float g0 = bf2f(gw.x & 0xffffu), g1 = bf2f(gw.x >> 16), g2 = bf2f(gw.y & 0xffffu), g3 = bf2f(gw.y >> 16);
                    const f32x4 gv = *(const f32x4*)(gn + dv);
                    const float y0 = o[a][0] * rn * gv[0] * (g0 * sigmoid_f(g0)), y1 = o[a][1] * rn * gv[1] * (g1 * sigmoid_f(g1));
                    const float y2 = o[a][2] * rn * gv[2] * (g2 * sigmoid_f(g2)), y3 = o[a][3] * rn * gv[3] * (g3 * sigmoid_f(g3));
                    u32x2 w; w.x = cvt_pk_bf16(y0, y1); w.y = cvt_pk_bf16(y2, y3);
                    *(u32x2*)(YS + row * D + 512 + h * 64 + dv) = w; }
            }
        }
        __syncthreads();
    }
}

__device__ __forceinline__ void mix_phase2(const Ctx& C, const Args& A) {
    float* __restrict__ SU = (float*)(A.ws + WS_SU); const float* __restrict__ SD = (const float*)(A.ws + WS_SD);
    int tid_ = C.tid; asm volatile("" : "+v"(tid_));
    const int gt = C.vcu * NTHREADS + tid_, NGT = C.G * NTHREADS;
    for (int e = gt; e < 32 * 4096; e += NGT) {
        const int bh = e >> 12, kv = e & 4095, dk = kv & 63;
        bf16_t* __restrict__ ST16 = (bf16_t*)(A.ws + WS_ST16);
        float s = 0.f;
#pragma unroll 32
        for (int c = 0; c < 64; ++c) { const size_t ci = (size_t)bh * 64 + c; const float u = SU[ci * 4096 + kv]; const float d = SD[ci * 64 + dk]; ST16[ci * 4096 + kv] = (bf16_t)f2bf(s); s = d * s + u; }
    }
    const float* __restrict__ LA = (const float*)(A.ws + WS_LA); const float* __restrict__ LH = (const float*)(A.ws + WS_LH); float* __restrict__ LC = (float*)(A.ws + WS_LC);
    for (int e = gt; e < BATCH * BW; e += NGT) {
        const int b = e >> 8, ch = e & 255; float cr = 0.f;
#pragma unroll 32
        for (int sc = 0; sc < 128; ++sc) { const size_t i = ((size_t)b * 128 + sc) * 256 + ch; const float a = LA[i], hh = LH[i]; LC[i] = cr; cr = a * cr + hh; }
    }
}

#define XB_TMO      128
#define XB_XCNT(j)  (256  + 64 * (j))
#define XB_XSUB(j)  (1280 + 64 * (j))
#define XB_XGEN(j)  (2304 + 64 * (j))
#define XB_TOP      3328
#define XB_TOPGEN   3392
#define XCD_BAR_WORDS 3456
#define XB_SPIN_CAP (1u << 20)
__device__ __forceinline__ unsigned xb_ld(unsigned* p)              { return __hip_atomic_load(p, __ATOMIC_RELAXED, __HIP_MEMORY_SCOPE_AGENT); }
__device__ __forceinline__ unsigned xb_add(unsigned* p, unsigned v) { return __hip_atomic_fetch_add(p, v, __ATOMIC_RELAXED, __HIP_MEMORY_SCOPE_AGENT); }
__device__ __forceinline__ unsigned xb_xcc_id() { return (unsigned)__builtin_amdgcn_s_getreg((3 << 11) | 20) & 0xFu; }
#define XB_SPIN(cond, bar) do { unsigned _sp = 0; while (cond) { __builtin_amdgcn_s_sleep(1); \
    if ((++_sp & 255u) == 0u) { if (xb_ld(&(bar)[XB_TMO])) break; if (_sp > XB_SPIN_CAP) { atomicAdd(&(bar)[XB_TMO], 1u); break; } } } } while (0)
struct XcdBarrier { unsigned* bar; unsigned x; volatile LAS unsigned* st; };
__device__ __forceinline__ XcdBarrier xcd_barrier_post(unsigned* bar, volatile LAS unsigned* st) {
    XcdBarrier b; b.bar = bar; b.x = xb_xcc_id(); b.st = st;
    if (threadIdx.x == 0) (void)xb_add(&bar[XB_XCNT(b.x)], 1u);
    return b;
}
__device__ __forceinline__ void xcd_barrier_complete(unsigned* bar, unsigned x, unsigned& nloc, unsigned& nx) {
    const unsigned G = gridDim.x * gridDim.y * gridDim.z;
    unsigned sum, cnt, mine, sp = 0u;
    for (;;) {
        sum = 0u; cnt = 0u; mine = 0u;
#pragma unroll
        for (unsigned j = 0; j < 16; ++j) { const unsigned c = xb_ld(&bar[XB_XCNT(j)]); sum += c; cnt += (c > 0u) ? 1u : 0u; mine = (j == x) ? c : mine; }
        if (sum == G) break;
        __builtin_amdgcn_s_sleep(1);
        if ((++sp & 255u) == 0u) { if (xb_ld(&bar[XB_TMO])) break; if (sp > XB_SPIN_CAP) { atomicAdd(&bar[XB_TMO], 1u); break; } }
    }
    nloc = mine > 0u ? mine : 1u; nx = cnt > 0u ? cnt : 1u;
}
__device__ __forceinline__ void xcd_barrier(const XcdBarrier& b) {
    asm volatile("s_waitcnt vmcnt(0)" ::: "memory");
    __syncthreads();
    if (threadIdx.x == 0) {
        unsigned* bar = b.bar;
        __builtin_amdgcn_s_waitcnt(0);
        unsigned nloc = b.st[0], nx = b.st[1];
        if (nloc == 0u) { xcd_barrier_complete(bar, b.x, nloc, nx); b.st[0] = nloc; b.st[1] = nx; }
        const unsigned old = xb_add(&bar[XB_XSUB(b.x)], 1u);
        const unsigned gen = old / nloc;
        if (old + 1u == (gen + 1u) * nloc) {
            __builtin_amdgcn_fence(__ATOMIC_RELEASE, "agent");
            asm volatile("s_waitcnt vmcnt(0)" ::: "memory");
            const unsigned og = xb_add(&bar[XB_TOP], 1u);
            const unsigned tg = og / nx;
            if (og + 1u == (tg + 1u) * nx) xb_add(&bar[XB_TOPGEN], 1u);
            else XB_SPIN(xb_ld(&bar[XB_TOPGEN]) == tg, bar);
            __builtin_amdgcn_fence(__ATOMIC_ACQUIRE, "agent");
            xb_add(&bar[XB_XGEN(b.x)], 1u);
            asm volatile("s_waitcnt vmcnt(0)" ::: "memory");
        } else {
            XB_SPIN(xb_ld(&bar[XB_XGEN(b.x)]) == gen, bar);
            __builtin_amdgcn_fence(__ATOMIC_ACQUIRE, "agent");
            asm volatile("s_waitcnt vmcnt(0)" ::: "memory");
        }
    }
    __syncthreads();
}

constexpr int PH_PER_LAYER = 10, N_PHASES = 1 + DEPTH * PH_PER_LAYER;
constexpr int CW_BAR = 4096;
constexpr int CW_SEAM = 16384;

__global__ void __launch_bounds__(NTHREADS, 2) trunk_fwd(Args args) {
    extern __shared__ __attribute__((aligned(16))) unsigned char lds_raw[];
    Ctx C;
    C.lds = (LAS unsigned char*)lds_raw; C.tid = threadIdx.x; C.lane = C.tid & 63; C.wave = __builtin_amdgcn_readfirstlane(C.tid >> 6);
    C.G = gridDim.x; { const int bx = blockIdx.x; C.vcu = (C.G % 8 == 0) ? (bx % 8) * (C.G / 8) + bx / 8 : bx; }
    unsigned char* ws = args.ws;
    volatile LAS unsigned* MISC = (volatile LAS unsigned*)(C.lds + MISC_OFF);
    if (C.tid < 64) MISC[C.tid] = 0u;
    __syncthreads();
#if MK_PER_PHASE
#define GRID_BAR() do { } while (0)
#else
    cg::grid_group grid = cg::this_grid();
    XcdBarrier bar = xcd_barrier_post((unsigned*)(ws + WS_CTL) + CW_BAR, MISC + 8);
    bool first_bar = true;
#define GRID_BAR() do { if (first_bar) { grid.sync(); first_bar = false; } else { xcd_barrier(bar); } } while (0)
#endif
    const int lo = args.ph_lo, hi = args.ph_hi;
    int ph = 0;
#define PHASE_BEGIN if (ph >= lo && ph < hi) { for (int rep_ = 0; rep_ < (((DBG_REPEAT >> ((ph - 1) % PH_PER_LAYER + 1)) & 1) && ph > 0 ? 2 : 1); ++rep_) {
#define PHASE_END   if (rep_ == 0 && (((DBG_REPEAT >> ((ph - 1) % PH_PER_LAYER + 1)) & 1) && ph > 0)) GRID_BAR(); } if (ph + 1 < hi && ph + 1 < N_PHASES) GRID_BAR(); } ++ph;

    PHASE_BEGIN p0_prologue(C, args); PHASE_END

    for (int li = 0; li < DEPTH; ++li) {
        int l = li; asm volatile("" : "+s"(l));
        const unsigned char* wl = ws + WS_W + (size_t)l * W_LAYER;
        const float* RS = (const float*)(ws + WS_X2);
        PHASE_BEGIN {
            pg8::StaticOrder S; S.init(ws + WS_HB, wl + W_IN, M, NMIX, D, C.G, (int)blockIdx.x);
            pg8::EpiRow<1> E{(bf16_t*)(ws + WS_PROJ), NMIX, RS};
            pg8::gemm_phase<pg8::EpiRow<1>, pg8::StaticOrder, true>(C.lds, D, S, E);
        } PHASE_END
        PHASE_BEGIN {
            for (int item = C.vcu; item < BATCH * 64; item += C.G) { const int b = item >> 6, c = item & 63;
                mix1_item(C, args, l, b, c);
                hgrn_item<false>(C, args, l, b, c); }
        } PHASE_END
        PHASE_BEGIN mix_phase2(C, args); PHASE_END
        PHASE_BEGIN {
            for (int item = C.vcu; item < BATCH * 64; item += C.G) { const int b = item >> 6, c = item & 63;
                lru_final_item(C, args, l, b, c);
                hgrn_item<true>(C, args, l, b, c); }
        } PHASE_END
        PHASE_BEGIN {
            pg8::GateOrder S{(const char*)(ws + WS_HB), (const char*)(wl + W_IN) + (size_t)NMIX * D * 2, (const char*)(ws + WS_YS), (const char*)(wl + W_BR), C.G, C.vcu};
            pg8::EpiGate E{(unsigned char*)(ws + WS_G) + (size_t)blockIdx.x * 4 * 65536, (bf16_t*)(ws + WS_MERGED), RS};
            pg8::gemm_phase<pg8::EpiGate, pg8::GateOrder, true>(C.lds, D, S, E);
        } PHASE_END
        const bool fused_norm = (C.G == 256) && !MK_PER_PHASE;
        if (fused_norm) {
            PHASE_BEGIN {
                { const int half = 0;
                    pg8::PanelOrder S{(const char*)(ws + WS_MERGED), (const char*)(wl + W_OUT), (size_t)pg8::BM * D * 2, D / pg8::BK, half, C.vcu};
                    pg8::EpiNorm E{(bf16_t*)(ws + WS_HB), nullptr, args.in[I_NMIXPOST] + l * D, (float*)(ws + WS_X1), (float*)(ws + WS_X2), (unsigned*)(ws + WS_CTL) + CW_SEAM + (size_t)(l * 2 + 0) * 128 * 64, (unsigned*)(ws + WS_CTL) + 8, C.lds + 131072};
                    pg8::gemm_phase<pg8::EpiNorm, pg8::PanelOrder, true>(C.lds, D, S, E);
                }
            } PHASE_END
            ++ph;
        } else {
        PHASE_BEGIN {
            pg8::StaticOrder S; S.init(ws + WS_MERGED, wl + W_OUT, M, D, D, C.G, (int)blockIdx.x);
            pg8::EpiRow<0> E{(bf16_t*)(ws + WS_MIX), D, nullptr};
            pg8::gemm_phase<pg8::EpiRow<0>, pg8::StaticOrder, true>(C.lds, D, S, E);
        } PHASE_END
        PHASE_BEGIN norm_phase(C, args, (const bf16_t*)(ws + WS_MIX), args.in[I_NMIXPOST] + l * D, false); PHASE_END
        }
        PHASE_BEGIN {
            pg8::StaticOrder S; S.init(ws + WS_HB, wl + W_UP, M, FF, D, C.G, (int)blockIdx.x);
            pg8::EpiRow<2> E{(bf16_t*)(ws + WS_HID), FF, RS};
            pg8::gemm_phase<pg8::EpiRow<2>, pg8::StaticOrder, true>(C.lds, D, S, E);
        } PHASE_END
        if (fused_norm) {
            PHASE_BEGIN {
                { const int half = 0;
                    pg8::PanelOrder S{(const char*)(ws + WS_HID), (const char*)(wl + W_DOWN), (size_t)pg8::BM * FF * 2, FF / pg8::BK, half, C.vcu};
                    pg8::EpiNorm E{(bf16_t*)(ws + WS_HB), (li == DEPTH - 1) ? args.out : nullptr, args.in[I_NMLPPOST] + l * D, (float*)(ws + WS_X1), (float*)(ws + WS_X2), (unsigned*)(ws + WS_CTL) + CW_SEAM + (size_t)(l * 2 + 1) * 128 * 64, (unsigned*)(ws + WS_CTL) + 8, C.lds + 131072};
                    pg8::gemm_phase<pg8::EpiNorm, pg8::PanelOrder, true>(C.lds, FF, S, E);
                }
            } PHASE_END
            ++ph;
        } else {
        PHASE_BEGIN {
            pg8::StaticOrder S; S.init(ws + WS_HID, wl + W_DOWN, M, D, FF, C.G, (int)blockIdx.x);
            pg8::EpiRow<0> E{(bf16_t*)(ws + WS_MOUT), D, nullptr};
            pg8::gemm_phase<pg8::EpiRow<0>, pg8::StaticOrder, true>(C.lds, FF, S, E);
        } PHASE_END
        PHASE_BEGIN norm_phase(C, args, (const bf16_t*)(ws + WS_MOUT), args.in[I_NMLPPOST] + l * D, li == DEPTH - 1); PHASE_END
        }
    }
}

extern "C" void kernel_launch(void* const* d_in, const int* in_sizes, int n_in, void* d_out, int out_size, void* d_ws, size_t ws_size, hipStream_t stream) {
    static int grid = 0;
    if (grid == 0) {
        if (n_in != 22 || in_sizes[0] != M * D || out_size != M * D || ws_size < WS_END) { fprintf(stderr, "kernel_launch: unexpected shapes (n_in %d, in0 %d, out %d, ws %zu)\n", n_in, n_in > 0 ? in_sizes[0] : -1, out_size, ws_size); grid = -1; return; }
        int dev = 0, cus = 0, per_cu = 0;
        if (hipGetDevice(&dev) != hipSuccess || hipDeviceGetAttribute(&cus, hipDeviceAttributeMultiprocessorCount, dev) != hipSuccess) { grid = -1; return; }
        if (hipFuncSetAttribute((const void*)trunk_fwd, hipFuncAttributeMaxDynamicSharedMemorySize, LDS_BYTES) != hipSuccess) { fprintf(stderr, "kernel_launch: hipFuncSetAttribute failed\n"); grid = -1; return; }
        if (hipOccupancyMaxActiveBlocksPerMultiprocessor(&per_cu, (const void*)trunk_fwd, NTHREADS, LDS_BYTES) != hipSuccess || per_cu < 1) { fprintf(stderr, "kernel_launch: occupancy query says %d blocks per CU\n", per_cu); (void)hipGetLastError(); grid = -1; return; }
        grid = cus;
    }
    if (grid < 0) return;
    (void)hipMemsetAsync((char*)d_ws + WS_CTL, 0, CTL_ZERO_BYTES, stream);
    Args a{};
    for (int i = 0; i < 22; ++i) a.in[i] = (const float*)d_in[i];
    a.out = (float*)d_out; a.ws = (unsigned char*)d_ws;
#if MK_PER_PHASE
#ifndef DBG_MAXPH
#define DBG_MAXPH N_PHASES
#endif
    for (int p = 0; p < DBG_MAXPH; ++p) { a.ph_lo = p; a.ph_hi = p + 1; hipLaunchKernelGGL(trunk_fwd, dim3(grid), dim3(NTHREADS), LDS_BYTES, stream, a); }
#else
    a.ph_lo = 0; a.ph_hi = N_PHASES;
    void* kargs[] = {&a};
    hipError_t e = hipLaunchCooperativeKernel((const void*)trunk_fwd, dim3(grid), dim3(NTHREADS), kargs, LDS_BYTES, stream);
    if (e != hipSuccess) fprintf(stderr, "kernel_launch: cooperative launch failed: %s (grid %d)\n", hipGetErrorString(e), grid);
#endif
}
```

```cpp
#include <hip/hip_runtime.h>
#include <hip/hip_cooperative_groups.h>
#include <cstdio>
#include <cstdint>
namespace cg = cooperative_groups;

#ifndef DBG_ZERO
#define DBG_ZERO -1
#endif
#ifndef DBG_REPEAT
#define DBG_REPEAT 0
#endif
#ifndef MK_PER_PHASE
#define MK_PER_PHASE 0
#endif

#define LAS __attribute__((address_space(3)))
#define GAS __attribute__((address_space(1)))
typedef unsigned short bf16_t;
typedef short bf16x8 __attribute__((ext_vector_type(8)));
typedef float f32x4 __attribute__((ext_vector_type(4)));
typedef float f32x2 __attribute__((ext_vector_type(2)));
typedef unsigned u32x4 __attribute__((ext_vector_type(4)));
typedef unsigned u32x2 __attribute__((ext_vector_type(2)));

constexpr int BATCH = 8, T = 4096, D = 1024, M = BATCH * T, DEPTH = 2, BW = 256;
constexpr int NMIX = 2560, NGATE = 4096, INW = NMIX + NGATE, FF = 4096;
constexpr float EPS = 1e-6f;
constexpr int NWAVES = 8, NTHREADS = 512;

constexpr size_t MiB = 1u << 20;
constexpr size_t WS_CTL = 0, CTL_ZERO_BYTES = 1 * MiB;
constexpr size_t WS_RS = 1 * MiB;
constexpr size_t WS_SD = 1 * MiB + 512 * 1024;
constexpr size_t WS_LA = 2 * MiB, WS_LH = 3 * MiB, WS_LC = 4 * MiB;
constexpr size_t WS_SP8 = 7 * MiB;
constexpr size_t WS_X1 = 5 * MiB;
constexpr size_t WS_X2 = 6 * MiB;
constexpr size_t WS_W = 8 * MiB;
constexpr size_t W_IN = 0, W_BR = 13 * MiB, W_OUT = 15 * MiB, W_UP = 17 * MiB, W_DOWN = 25 * MiB, W_LAYER = 33 * MiB;
constexpr size_t WS_HB = 76 * MiB;
constexpr size_t WS_PROJ = 140 * MiB;
constexpr size_t WS_G = WS_PROJ;
constexpr size_t WS_YS = 300 * MiB;
constexpr size_t WS_MERGED = 364 * MiB;
constexpr size_t WS_SU = WS_MERGED;
constexpr size_t WS_MIX = WS_PROJ;
constexpr size_t WS_MOUT = 396 * MiB;
constexpr size_t WS_HID = WS_PROJ;
constexpr size_t WS_END = 460 * MiB;

constexpr int LDS_BYTES = 155648;
constexpr int MISC_OFF = 154624;

__device__ __forceinline__ float bf2f(unsigned b) { return __uint_as_float(b << 16); }
__device__ __forceinline__ unsigned f2bf(float f) { unsigned u = __float_as_uint(f); return (u + 0x7fffu + ((u >> 16) & 1u)) >> 16; }
__device__ __forceinline__ unsigned pk2(float lo, float hi) { return f2bf(lo) | (f2bf(hi) << 16); }
typedef __bf16 bf16x2_t __attribute__((ext_vector_type(2)));
__device__ __forceinline__ unsigned cvt_pk_bf16(float lo, float hi) { f32x2 v = {lo, hi}; bf16x2_t b = __builtin_convertvector(v, bf16x2_t); return __builtin_bit_cast(unsigned, b); }
__device__ __forceinline__ float fast_exp(float x) { return __builtin_amdgcn_exp2f(x * 1.4426950408889634f); }
__device__ __forceinline__ float sigmoid_f(float x) { return __builtin_amdgcn_rcpf(1.0f + fast_exp(-x)); }
__device__ __forceinline__ void ld8bf(const bf16_t* p, float (&o)[8]) {
    const u32x4 v = *(const u32x4*)p;
    o[0] = bf2f(v.x & 0xffffu); o[1] = bf2f(v.x >> 16); o[2] = bf2f(v.y & 0xffffu); o[3] = bf2f(v.y >> 16);
    o[4] = bf2f(v.z & 0xffffu); o[5] = bf2f(v.z >> 16); o[6] = bf2f(v.w & 0xffffu); o[7] = bf2f(v.w >> 16);
}
__device__ __forceinline__ float rs_of(const float* X2, int row) { const f32x4 x = *(const f32x4*)(X2 + (size_t)row * 4); return 1.0f / sqrtf(((x[0] + x[1]) + (x[2] + x[3])) * (1.0f / D) + EPS); }
__device__ __forceinline__ float wave_sum(float v) {
#pragma unroll
    for (int o = 1; o < 64; o <<= 1) v += __shfl_xor(v, o);
    return v;
}

namespace pg8 {
constexpr int BM = 256, BK = 64, HALF = 128, HTB = HALF * BK * 2, STAGE_BYTES = 8 * HTB, NXCD = 8, WGM = 4;
__host__ __device__ __forceinline__ int lds_byte(int r, int c) { const int st = (r >> 4) * 2 + (c >> 5), rr = r & 15, cc = c & 31, ob = rr * 64 + cc * 2; return st * 1024 + (ob ^ (((ob >> 9) & 1) << 5)); }
__host__ __device__ __forceinline__ void stage_rc(int b, int& R, int& C) { const int st = b / 1024, sb = b % 1024, swz = sb ^ (((sb >> 9) & 1) << 5); R = (st >> 1) * 16 + swz / 64; C = (st & 1) * 32 + (swz % 64) / 2; }
__host__ __device__ __forceinline__ int perm32(int rho) { const int n = rho >> 4, i = rho & 15; return 8 * (i >> 2) + 4 * n + (i & 3); }

struct Unit { int pm, pn, kind; };

struct StaticOrder {
    const char* A; const char* Bt; size_t tstep;
    int nM, nN, nwg, G, c;
    __device__ void init(const void* A_, const void* Bt_, int M_, int N_, int K_, int G_, int c_) { A = (const char*)A_; Bt = (const char*)Bt_; tstep = (size_t)BM * K_ * 2; nt = K_ / BK; nM = M_ / BM; nN = N_ / BM; nwg = nM * nN; G = G_; c = c_; }
    __device__ bool next(int i, Unit& u) const {
        const long L = (long)i * G + c; if (L >= nwg) return false;
        int wgid = (int)L; { const int q = nwg / NXCD, r = nwg % NXCD, xcd = wgid % NXCD, off = wgid / NXCD; wgid = (xcd < r ? xcd * (q + 1) : r * (q + 1) + (xcd - r) * q) + off; }
        const int nig = WGM * nN, gid = wgid / nig, fm = gid * WGM, gsz = (nM - fm) < WGM ? (nM - fm) : WGM;
        u.pm = fm + ((wgid % nig) % gsz); u.pn = (wgid % nig) / gsz; u.kind = 0; return true;
    }
    __device__ __forceinline__ void tiles(const Unit& u, const char*& a, const char*& b) const { a = A + (size_t)u.pm * tstep; b = Bt + (size_t)u.pn * tstep; }
    int nt;
    __device__ __forceinline__ int ntiles(const Unit&) const { return nt; }
    __device__ __forceinline__ bool keep_acc(const Unit&) const { return false; }
};

struct GateOrder {
    const char* HB; const char* WGt; const char* YS; const char* WB; int G, vcu;
    __device__ bool next(int i, Unit& u) const {
        const int r = i / 16, ii = i % 16, su = vcu + r * G; if (su >= 256) return false;
        const int half = ii / 8, j = ii % 8;
        u.pm = half * 64 + (su >> 2); u.kind = j; u.pn = (j < 4) ? (j * 4 + (su & 3)) : (su & 3); return true;
    }
    __device__ __forceinline__ int ntiles(const Unit& u) const { return u.kind < 4 ? 16 : 4; }
    __device__ __forceinline__ bool keep_acc(const Unit& nx) const { return nx.kind > 4; }
    __device__ __forceinline__ void tiles(const Unit& u, const char*& a, const char*& b) const {
        const size_t ts = (size_t)BM * 1024 * 2;
        if (u.kind < 4) { a = HB + (size_t)u.pm * ts; b = WGt + (size_t)u.pn * ts; } else { a = YS + (size_t)u.pm * ts + (size_t)(u.kind - 4) * 512; b = WB + (size_t)u.pn * ts + (size_t)(u.kind - 4) * 512; }
    }
};

template <int MODE  > struct EpiRow {
    static constexpr bool PERM = true;
    bf16_t* O; int ldc; const float* rs;
    __device__ __forceinline__ void operator()(f32x4 (&acc)[2][2][4][2], const Unit& u, int wr, int wc, int fr, int fq) const {
        const int row0 = u.pm * BM + wr * 64 + fr, col0 = u.pn * BM + wc * 32 + 8 * fq;
#pragma unroll
        for (int ai = 0; ai < 2; ++ai)
#pragma unroll
            for (int m = 0; m < 4; ++m) {
                const int row = row0 + ai * HALF + m * 16; const float sc = (MODE != 0) ? rs_of(rs, row) : 1.0f;
                bf16_t* rowp = O + (size_t)row * ldc + col0;
#pragma unroll
                for (int bj = 0; bj < 2; ++bj) {
                    f32x4 v0 = acc[ai][bj][m][0], v1 = acc[ai][bj][m][1];
                    if (MODE != 0) { v0 = v0 * sc; v1 = v1 * sc; }
                    if (MODE == 2) {
#pragma unroll
                        for (int j = 0; j < 4; ++j) { const float a = fmaxf(v0[j], 0.f), b = fmaxf(v1[j], 0.f); v0[j] = a * a; v1[j] = b * b; }
                    }
                    u32x4 w; w.x = cvt_pk_bf16(v0[0], v0[1]); w.y = cvt_pk_bf16(v0[2], v0[3]); w.z = cvt_pk_bf16(v1[0], v1[1]); w.w = cvt_pk_bf16(v1[2], v1[3]);
                    __builtin_nontemporal_store(w, (u32x4*)(rowp + bj * HALF));
                }
            }
    }
};

__device__ __forceinline__ unsigned pack_u8x4(float a, float b, float c, float d) { unsigned w = 0u;
    w = __builtin_amdgcn_cvt_pk_u8_f32(a * 256.0f - 0.5f, 0, w); w = __builtin_amdgcn_cvt_pk_u8_f32(b * 256.0f - 0.5f, 1, w); w = __builtin_amdgcn_cvt_pk_u8_f32(c * 256.0f - 0.5f, 2, w); w = __builtin_amdgcn_cvt_pk_u8_f32(d * 256.0f - 0.5f, 3, w); return w; }
__device__ __forceinline__ f32x4 unpack_u8x4(unsigned w) { return (f32x4){(float)(w & 0xffu) + 0.5f, (float)((w >> 8) & 0xffu) + 0.5f, (float)((w >> 16) & 0xffu) + 0.5f, (float)(w >> 24) + 0.5f}; }
struct EpiGate {
    static constexpr bool PERM = true;
    unsigned char* Gt;
    bf16_t* MERGED;
    const float* rs;
    __device__ __forceinline__ void rescale(f32x4 (&acc)[2][2][4][2], int j, int wr, int wc, int fr, int fq) const {
        int lane_off = (wr * 64 + fr) * 256 + wc * 32 + 8 * fq; asm volatile("" : "+v"(lane_off));
        const unsigned char* g0 = Gt + (size_t)j * 65536; const unsigned char* g1 = g0 + 65536;
#pragma unroll
        for (int ai = 0; ai < 2; ++ai) {
            u32x2 a[4][2], b[4][2];
#pragma unroll
            for (int m = 0; m < 4; ++m)
#pragma unroll
                for (int bj = 0; bj < 2; ++bj) { const int off = lane_off + (ai * HALF + m * 16) * 256 + bj * HALF; a[m][bj] = *(const u32x2*)(g0 + off); b[m][bj] = *(const u32x2*)(g1 + off); }
#pragma unroll
            for (int m = 0; m < 4; ++m)
#pragma unroll
                for (int bj = 0; bj < 2; ++bj) {
                    const f32x4 a0 = unpack_u8x4(a[m][bj].x), a1 = unpack_u8x4(a[m][bj].y), b0 = unpack_u8x4(b[m][bj].x), b1 = unpack_u8x4(b[m][bj].y);
#pragma unroll
                    for (int q = 0; q < 4; ++q) { acc[ai][bj][m][0][q] *= a0[q] * __builtin_amdgcn_rcpf(b0[q]); acc[ai][bj][m][1][q] *= a1[q] * __builtin_amdgcn_rcpf(b1[q]); }
                }
            asm volatile("" ::: "memory");
        }
    }
    __device__ __forceinline__ void operator()(f32x4 (&acc)[2][2][4][2], const Unit& u, int wr, int wc, int fr, int fq) const {
        if (u.kind >= 4 && u.kind < 7) { rescale(acc, u.kind - 4, wr, wc, fr, fq); return; }
        int rl0 = wr * 64 + fr, cl0 = wc * 32 + 8 * fq; asm volatile("" : "+v"(rl0), "+v"(cl0));
        if (u.kind < 4) {
            unsigned char* gt = Gt + (size_t)u.kind * 65536;
#pragma unroll
            for (int ai = 0; ai < 2; ++ai)
#pragma unroll
                for (int m = 0; m < 4; ++m) {
                    const int rl = rl0 + ai * HALF + m * 16; const float sc = rs_of(rs, u.pm * BM + rl);
#pragma unroll
                    for (int bj = 0; bj < 2; ++bj) {
                        f32x4 v0 = acc[ai][bj][m][0] * sc, v1 = acc[ai][bj][m][1] * sc;
#pragma unroll
                        for (int j = 0; j < 4; ++j) { v0[j] = sigmoid_f(fmaxf(v0[j], -60.f)); v1[j] = sigmoid_f(fmaxf(v1[j], -60.f)); }
                        u32x2 w; w.x = pack_u8x4(v0[0], v0[1], v0[2], v0[3]); w.y = pack_u8x4(v1[0], v1[1], v1[2], v1[3]);
                        *(u32x2*)(gt + rl * 256 + cl0 + bj * HALF) = w;
                    }
                }
        } else {
            const unsigned char* g3 = Gt + (size_t)3 * 65536;
#pragma unroll
            for (int ai = 0; ai < 2; ++ai)
#pragma unroll
                for (int m = 0; m < 4; ++m) {
                    const int rl = rl0 + ai * HALF + m * 16;
                    bf16_t* rowp = MERGED + (size_t)(u.pm * BM + rl) * 1024 + u.pn * BM + cl0;
#pragma unroll
                    for (int bj = 0; bj < 2; ++bj) {
                        const u32x2 sw = *(const u32x2*)(g3 + rl * 256 + cl0 + bj * HALF);
                        const f32x4 s0 = unpack_u8x4(sw.x) * (1.0f / 256.0f), s1 = unpack_u8x4(sw.y) * (1.0f / 256.0f);
                        const f32x4 v0 = acc[ai][bj][m][0] * s0, v1 = acc[ai][bj][m][1] * s1;
                        u32x4 w; w.x = cvt_pk_bf16(v0[0], v0[1]); w.y = cvt_pk_bf16(v0[2], v0[3]); w.z = cvt_pk_bf16(v1[0], v1[1]); w.w = cvt_pk_bf16(v1[2], v1[3]);
                        *(u32x4*)(rowp + bj * HALF) = w;
                    }
                }
        }
    }
};

struct PanelOrder {
    const char* A; const char* Bt; size_t tstep; int nt, half, vcu;
    __device__ bool next(int i, Unit& u) const { if (i > 1) return false; u.pm = i * 64 + (vcu >> 2); u.pn = vcu & 3; u.kind = 0; return true; }
    __device__ __forceinline__ void tiles(const Unit& u, const char*& a, const char*& b) const { a = A + (size_t)u.pm * tstep; b = Bt + (size_t)u.pn * tstep; }
    __device__ __forceinline__ int ntiles(const Unit&) const { return nt; }
    __device__ __forceinline__ bool keep_acc(const Unit&) const { return false; }
};
struct EpiNorm {
    static constexpr bool PERM = true;
    bf16_t* HB; float* OUTF; const float* gain; float* X1; float* X2; unsigned* cnt; unsigned* tmo; LAS unsigned char* sp;
    __device__ __forceinline__ void operator()(f32x4 (&acc)[2][2][4][2], const Unit& u, int wr, int wc, int fr, int fq) const {
        LAS float* P = (LAS float*)sp;
        LAS float* R = (LAS float*)(sp + 4096);
        const int tid = (wr * 4 + wc) * 64 + fq * 16 + fr;
#pragma unroll
        for (int ai = 0; ai < 2; ++ai)
#pragma unroll
            for (int m = 0; m < 4; ++m) { float s = 0.f;
#pragma unroll
                for (int bj = 0; bj < 2; ++bj)
#pragma unroll
                    for (int n = 0; n < 2; ++n) { const f32x4 x = acc[ai][bj][m][n]; s += (x[0] * x[0] + x[1] * x[1]) + (x[2] * x[2] + x[3] * x[3]); }
                s += __shfl_xor(s, 16); s += __shfl_xor(s, 32);
                if (fq == 0) P[(ai * HALF + wr * 64 + m * 16 + fr) * 4 + wc] = s; }
        asm volatile("s_waitcnt lgkmcnt(0)" ::: "memory"); __builtin_amdgcn_s_barrier(); asm volatile("" ::: "memory");
        if (tid < 256) {
            const f32x4 p = *(const LAS f32x4*)(P + tid * 4); const float tot = (p[0] + p[1]) + (p[2] + p[3]);
            __hip_atomic_store(X1 + ((size_t)u.pm * BM + tid) * 4 + u.pn, tot, __ATOMIC_RELAXED, __HIP_MEMORY_SCOPE_AGENT);
            asm volatile("s_waitcnt vmcnt(0)" ::: "memory");
            if ((tid & 63) == 0) __hip_atomic_fetch_add(cnt + 64 * u.pm, 1u, __ATOMIC_RELAXED, __HIP_MEMORY_SCOPE_AGENT);
        }
        if (tid < 64) {
            unsigned spins = 0;
            while ((unsigned)__builtin_amdgcn_readfirstlane(__hip_atomic_load(cnt + 64 * u.pm, __ATOMIC_RELAXED, __HIP_MEMORY_SCOPE_AGENT)) < 16u) {
                __builtin_amdgcn_s_sleep(2);
                if (++spins > (1u << 22)) { if (tid == 0) __hip_atomic_store(tmo, 1u, __ATOMIC_RELAXED, __HIP_MEMORY_SCOPE_AGENT); break; } }
            __builtin_amdgcn_fence(__ATOMIC_ACQUIRE, "agent");
        }
        asm volatile("s_waitcnt vmcnt(0) lgkmcnt(0)" ::: "memory"); __builtin_amdgcn_s_barrier(); asm volatile("" ::: "memory");
        if (tid < 256) { const float* sl = X1 + ((size_t)u.pm * BM + tid) * 4; float t4[4];
#pragma unroll
            for (int t = 0; t < 4; ++t) t4[t] = __hip_atomic_load(sl + t, __ATOMIC_RELAXED, __HIP_MEMORY_SCOPE_AGENT);
            R[tid] = 1.0f / sqrtf(((t4[0] + t4[1]) + (t4[2] + t4[3])) * (1.0f / 1024.0f) + 1e-6f); }
        asm volatile("s_waitcnt vmcnt(0) lgkmcnt(0)" ::: "memory"); __builtin_amdgcn_s_barrier(); asm volatile("" ::: "memory");
        int rl0 = wr * 64 + fr, cl0 = wc * 32 + 8 * fq; asm volatile("" : "+v"(rl0), "+v"(cl0));
        f32x4 gv[2][2];
#pragma unroll
        for (int bj = 0; bj < 2; ++bj) { gv[bj][0] = *(const f32x4*)(gain + u.pn * BM + cl0 + bj * HALF); gv[bj][1] = *(const f32x4*)(gain + u.pn * BM + cl0 + bj * HALF + 4); }
#pragma unroll
        for (int ai = 0; ai < 2; ++ai)
#pragma unroll
            for (int m = 0; m < 4; ++m) { const int rl = rl0 + ai * HALF + m * 16; const float r = R[rl]; const size_t go = ((size_t)u.pm * BM + rl) * 1024 + u.pn * BM + cl0;
                float s2 = 0.f;
#pragma unroll
                for (int bj = 0; bj < 2; ++bj) { const u32x4 hw = *(const u32x4*)(HB + go + bj * HALF);
                    f32x4 h0 = {bf2f(hw.x & 0xffffu), bf2f(hw.x >> 16), bf2f(hw.y & 0xffffu), bf2f(hw.y >> 16)}, h1 = {bf2f(hw.z & 0xffffu), bf2f(hw.z >> 16), bf2f(hw.w & 0xffffu), bf2f(hw.w >> 16)};
                    h0 = h0 + gv[bj][0] * acc[ai][bj][m][0] * r; h1 = h1 + gv[bj][1] * acc[ai][bj][m][1] * r;
                    s2 += (h0[0] * h0[0] + h0[1] * h0[1]) + (h0[2] * h0[2] + h0[3] * h0[3]) + (h1[0] * h1[0] + h1[1] * h1[1]) + (h1[2] * h1[2] + h1[3] * h1[3]);
                    if (OUTF) { *(f32x4*)(OUTF + go + bj * HALF) = h0; *(f32x4*)(OUTF + go + bj * HALF + 4) = h1; }
                    else { u32x4 w; w.x = cvt_pk_bf16(h0[0], h0[1]); w.y = cvt_pk_bf16(h0[2], h0[3]); w.z = cvt_pk_bf16(h1[0], h1[1]); w.w = cvt_pk_bf16(h1[2], h1[3]); __builtin_nontemporal_store(w, (u32x4*)(HB + go + bj * HALF)); } }
                s2 += __shfl_xor(s2, 16); s2 += __shfl_xor(s2, 32);
                if (fq == 0) P[rl * 4 + wc] = s2; }
        asm volatile("s_waitcnt lgkmcnt(0)" ::: "memory"); __builtin_amdgcn_s_barrier(); asm volatile("" ::: "memory");
        if (tid < 256) { const f32x4 p = *(const LAS f32x4*)(P + tid * 4); X2[((size_t)u.pm * BM + tid) * 4 + u.pn] = (p[0] + p[1]) + (p[2] + p[3]); }
    }
};

template <class Epi, class Sched, bool ALIGN_EPI>
__device__ __forceinline__ void gemm_phase(LAS unsigned char* lds, const int K, const Sched& S, const Epi& E) {
    int tid = threadIdx.x; asm volatile("" : "+v"(tid));
    const int wid = __builtin_amdgcn_readfirstlane(tid >> 6), lane = tid & 63, wr = wid >> 2, wc = wid & 3, fr = lane & 15, fq = lane >> 4;
    unsigned voffA[2], voffB[2];
#pragma unroll
    for (int i = 0; i < 2; ++i) { int R, C; stage_rc(tid * 16 + i * 8192, R, C); const int Rb = Epi::PERM ? ((R & ~31) + perm32(R & 31)) : R;
        voffA[i] = (unsigned)(R * K + C) * 2u; voffB[i] = (unsigned)(Rb * K + C) * 2u; }
    const size_t kstep = (size_t)(BK * 2);
    const size_t hstep = (size_t)HALF * K * 2;
    const unsigned ldsw = (unsigned)wid * 1024u;
    const int aoff = lds_byte(wr * 64 + fr, fq * 8), boff = lds_byte(wc * 32 + fr, fq * 8);
#define PG8_SA(b, h) (((b) * 2 + (h)) * HTB)
#define PG8_SB(b, h) ((4 + (b) * 2 + (h)) * HTB)
#define PG8_STAGE(bufoff, gbase, voff) do { _Pragma("unroll") for (int _i = 0; _i < 2; ++_i) \
        __builtin_amdgcn_global_load_lds((const unsigned*)((const char*)(gbase) + (voff)[_i]), (LAS unsigned*)(lds + (bufoff) + ldsw + _i * 8192), 16, 0, 0); } while (0)
#define PG8_LDA(dst, b, h) do { _Pragma("unroll") for (int m = 0; m < 4; ++m) _Pragma("unroll") for (int k = 0; k < 2; ++k) dst[m][k] = *(const LAS bf16x8*)(lds + PG8_SA(b, h) + aoff + m * 2048 + k * 1024); } while (0)
#define PG8_LDB(dst, b, h) do { _Pragma("unroll") for (int n = 0; n < 2; ++n) _Pragma("unroll") for (int k = 0; k < 2; ++k) dst[n][k] = *(const LAS bf16x8*)(lds + PG8_SB(b, h) + boff + n * 2048 + k * 1024); } while (0)
#define PG8_MMA(ai, bj, At, Bt) do { __builtin_amdgcn_s_setprio(1); _Pragma("unroll") for (int m = 0; m < 4; ++m) _Pragma("unroll") for (int n = 0; n < 2; ++n) _Pragma("unroll") for (int k = 0; k < 2; ++k) \
        acc[ai][bj][m][n] = __builtin_amdgcn_mfma_f32_16x16x32_bf16(Bt[n][k], At[m][k], acc[ai][bj][m][n], 0, 0, 0); __builtin_amdgcn_s_setprio(0); } while (0)
#define PG8_WAIT_V(n) asm volatile("s_waitcnt vmcnt(" #n ")" ::: "memory")
#define PG8_WAIT_L(n) asm volatile("s_waitcnt lgkmcnt(" #n ")" ::: "memory")
#define PG8_BAR __builtin_amdgcn_s_barrier()
#define PG8_SCHED __builtin_amdgcn_sched_barrier(0)
    Unit cur, nxt; int ui = 0;
    if (!S.next(0, cur)) return;
    f32x4 acc[2][2][4][2];
#pragma unroll
    for (int a = 0; a < 2; ++a)
#pragma unroll
        for (int b = 0; b < 2; ++b)
#pragma unroll
            for (int m = 0; m < 4; ++m)
#pragma unroll
                for (int n = 0; n < 2; ++n) acc[a][b][m][n] = (f32x4){0.f, 0.f, 0.f, 0.f};
    bf16x8 At[4][2], B0[2][2], B1[2][2];
    const char* cA; const char* cB; S.tiles(cur, cA, cB);
    PG8_STAGE(PG8_SB(0, 0), cB, voffB); PG8_STAGE(PG8_SB(0, 1), cB + hstep, voffB); PG8_STAGE(PG8_SA(0, 0), cA, voffA); PG8_STAGE(PG8_SA(0, 1), cA + hstep, voffA);
    if (wr == 1) PG8_BAR;
    PG8_WAIT_V(2); PG8_BAR;
    PG8_STAGE(PG8_SB(1, 0), cB + kstep, voffB); PG8_STAGE(PG8_SA(1, 0), cA + kstep, voffA); PG8_STAGE(PG8_SB(1, 1), cB + hstep + kstep, voffB);
    PG8_WAIT_V(6); PG8_BAR;
    for (;;) {
        const bool has_next = S.next(ui + 1, nxt);
        const char* nA = cA; const char* nB = cB; if (has_next) S.tiles(nxt, nA, nB);
#define PG8_KT2(t, last) do { \
            const char* a1 = cA + (size_t)((t) + 1) * kstep; \
            const char* a2 = (last) ? nA : cA + (size_t)((t) + 2) * kstep; const char* b2 = (last) ? nB : cB + (size_t)((t) + 2) * kstep; \
            const char* a3 = a2 + kstep; const char* b3 = b2 + kstep; \
            PG8_LDB(B0, 0, 0); PG8_LDB(B1, 0, 1); PG8_SCHED; PG8_LDA(At, 0, 0); PG8_STAGE(PG8_SA(1, 1), a1 + hstep, voffA); \
            PG8_WAIT_V(8); PG8_WAIT_L(0); PG8_BAR; PG8_MMA(0, 0, At, B0); PG8_MMA(0, 1, At, B1); PG8_BAR; PG8_SCHED; \
            PG8_LDA(At, 0, 1); PG8_STAGE(PG8_SB(0, 0), b2, voffB); PG8_STAGE(PG8_SB(0, 1), b2 + hstep, voffB); PG8_STAGE(PG8_SA(0, 0), a2, voffA); \
            PG8_WAIT_V(8); PG8_WAIT_L(0); PG8_BAR; PG8_MMA(1, 0, At, B0); PG8_MMA(1, 1, At, B1); PG8_BAR; PG8_SCHED; \
            PG8_LDB(B0, 1, 0); PG8_LDB(B1, 1, 1); PG8_SCHED; PG8_LDA(At, 1, 0); PG8_STAGE(PG8_SA(0, 1), a2 + hstep, voffA); \
            PG8_WAIT_V(8); PG8_WAIT_L(0); PG8_BAR; PG8_MMA(0, 0, At, B0); PG8_MMA(0, 1, At, B1); PG8_BAR; PG8_SCHED; \
            PG8_LDA(At, 1, 1); PG8_STAGE(PG8_SB(1, 0), b3, voffB); PG8_STAGE(PG8_SB(1, 1), b3 + hstep, voffB); PG8_STAGE(PG8_SA(1, 0), a3, voffA); \
            PG8_WAIT_V(8); PG8_WAIT_L(0); PG8_BAR; PG8_MMA(1, 0, At, B0); PG8_MMA(1, 1, At, B1); PG8_BAR; PG8_SCHED; } while (0)
        {
            const int ntc = S.ntiles(cur);
#pragma unroll 1
            for (int t = 0; t < ntc; t += 2) { const bool last = (t == ntc - 2); PG8_KT2(t, last); }
        }
        if constexpr (ALIGN_EPI) { if (wr == 0) PG8_BAR; }
        E(acc, cur, wr, wc, fr, fq);
        if (!has_next) break;
        if (!S.keep_acc(nxt)) {
#pragma unroll
        for (int a = 0; a < 2; ++a)
#pragma unroll
            for (int b = 0; b < 2; ++b)
#pragma unroll
                for (int m = 0; m < 4; ++m)
#pragma unroll
                    for (int n = 0; n < 2; ++n) acc[a][b][m][n] = (f32x4){0.f, 0.f, 0.f, 0.f};
        }
        cur = nxt; cA = nA; cB = nB; ++ui;
        if constexpr (ALIGN_EPI) { if (wr == 1) PG8_BAR; }
    }
    PG8_WAIT_V(0);
    if constexpr (!ALIGN_EPI) { if (wr == 0) PG8_BAR; }
    PG8_BAR;
#undef PG8_KT2
#undef PG8_SA
#undef PG8_SB
#undef PG8_STAGE
#undef PG8_LDA
#undef PG8_LDB
#undef PG8_MMA
#undef PG8_WAIT_V
#undef PG8_WAIT_L
#undef PG8_BAR
#undef PG8_SCHED
}
}

struct Args {
    const float* in[22]; float* out; unsigned char* ws; int ph_lo, ph_hi;
};
enum { I_X = 0, I_NMIXPRE, I_NMIXPOST, I_NMLPPRE, I_NMLPPOST, I_WIN, I_LCW, I_LCB, I_LWA, I_LBA, I_LWX, I_LBX, I_LLAM, I_PW, I_PS, I_HLB, I_HN, I_SW, I_WBR, I_WOUT, I_WUP, I_WDOWN };

struct Ctx {
    LAS unsigned char* lds; int tid, lane, wave, vcu, G;
};

__device__ __forceinline__ void transpose_item(const float* W, int ldw, const float* gain, bf16_t* WT, int ldo, int col_off, int k0, int n0, LAS float* scr, int lane) {
    float wv[32];
#pragma unroll
    for (int i = 0; i < 32; ++i) { const int kk = 2 * i + (lane >> 5); wv[i] = W[(size_t)(k0 + kk) * ldw + n0 + (lane & 31)]; }
#pragma unroll
    for (int i = 0; i < 32; ++i) { const int kk = 2 * i + (lane >> 5); const float g = gain ? gain[k0 + kk] : 1.0f; scr[kk * 33 + (lane & 31)] = g * wv[i]; }
    asm volatile("s_waitcnt lgkmcnt(0)" ::: "memory");
    const int c = lane & 7;
#pragma unroll
    for (int j = 0; j < 4; ++j) { const int n = (lane >> 3) + 8 * j; const LAS float* s = scr + (8 * c) * 33 + n;
        u32x4 o; o.x = pk2(s[0 * 33], s[1 * 33]); o.y = pk2(s[2 * 33], s[3 * 33]); o.z = pk2(s[4 * 33], s[5 * 33]); o.w = pk2(s[6 * 33], s[7 * 33]);
        *(u32x4*)(WT + (size_t)(n0 + n) * ldo + col_off + k0 + 8 * c) = o; }
    asm volatile("s_waitcnt lgkmcnt(0)" ::: "memory");
}

__device__ __forceinline__ void p0_prologue(const Ctx& C, const Args& A) {
    LAS float* scr = (LAS float*)(C.lds + C.wave * 16384);
    const int gw = C.vcu * NWAVES + C.wave, NGW = C.G * NWAVES;
    constexpr int I_IN = (D / 64) * (INW / 32), I_BR1 = (BW / 64) * (D / 32), I_OUT = (D / 64) * (D / 32), I_UP = (D / 64) * (FF / 32), I_DN = (FF / 64) * (D / 32);
    constexpr int PER_LAYER = I_IN + 4 * I_BR1 + I_OUT + I_UP + I_DN;
    for (int it = gw; it < DEPTH * PER_LAYER; it += NGW) {
        const int l = it / PER_LAYER; int r = it % PER_LAYER;
        bf16_t* wl = (bf16_t*)(A.ws + WS_W + (size_t)l * W_LAYER);
        if (r < I_IN) { const int nb = INW / 32; transpose_item(A.in[I_WIN] + (size_t)l * D * INW, INW, A.in[I_NMIXPRE] + l * D, wl + W_IN / 2, D, 0, 64 * (r / nb), 32 * (r % nb), scr, C.lane); continue; } r -= I_IN;
        if (r < 4 * I_BR1) { const int k = r / I_BR1, rr = r % I_BR1, nb = D / 32; transpose_item(A.in[I_WBR] + ((size_t)l * 4 + k) * BW * D, D, nullptr, wl + W_BR / 2, D, k * BW, 64 * (rr / nb), 32 * (rr % nb), scr, C.lane); continue; } r -= 4 * I_BR1;
        if (r < I_OUT) { const int nb = D / 32; transpose_item(A.in[I_WOUT] + (size_t)l * D * D, D, nullptr, wl + W_OUT / 2, D, 0, 64 * (r / nb), 32 * (r % nb), scr, C.lane); continue; } r -= I_OUT;
        if (r < I_UP) { const int nb = FF / 32; transpose_item(A.in[I_WUP] + (size_t)l * D * FF, FF, A.in[I_NMLPPRE] + l * D, wl + W_UP / 2, D, 0, 64 * (r / nb), 32 * (r % nb), scr, C.lane); continue; } r -= I_UP;
        { const int nb = D / 32; transpose_item(A.in[I_WDOWN] + (size_t)l * FF * D, D, nullptr, wl + W_DOWN / 2, FF, 0, 64 * (r / nb), 32 * (r % nb), scr, C.lane); }
    }
    { const int gt = gw * 64 + C.lane; if (gt < DEPTH * BW) { const float lam = A.in[I_LLAM][gt]; ((float*)(A.ws + WS_SP8))[gt] = -8.0f * ((-lam > 20.f) ? -lam : log1pf(expf(-lam))); } }
    bf16_t* HB = (bf16_t*)(A.ws + WS_HB); float* RS = (float*)(A.ws + WS_X2);
    for (int m0 = gw; m0 < M; m0 += 4 * NGW) {
        f32x4 v[4][4];
#pragma unroll
        for (int q = 0; q < 4; ++q) { const int m = m0 + q * NGW; const f32x4* xr = (const f32x4*)(A.in[I_X] + (size_t)(m < M ? m : 0) * D) + C.lane;
#pragma unroll
            for (int j = 0; j < 4; ++j) v[q][j] = xr[64 * j]; }
#pragma unroll
        for (int q = 0; q < 4; ++q) { const int m = m0 + q * NGW; if (m < M) { float s = 0.f;
#pragma unroll
            for (int j = 0; j < 4; ++j) s += (v[q][j].x * v[q][j].x + v[q][j].y * v[q][j].y) + (v[q][j].z * v[q][j].z + v[q][j].w * v[q][j].w);
            s = wave_sum(s);
            u32x2* o8 = (u32x2*)(HB + (size_t)m * D) + C.lane;
#pragma unroll
            for (int j = 0; j < 4; ++j) { u32x2 w; w.x = pk2(v[q][j].x, v[q][j].y); w.y = pk2(v[q][j].z, v[q][j].w); o8[64 * j] = w; }
            if (C.lane == 0) *(f32x4*)(RS + (size_t)m * 4) = (f32x4){s, 0.f, 0.f, 0.f}; } }
    }
}

__device__ __forceinline__ void norm_phase(const Ctx& C, const Args& A, const bf16_t* VIN, const float* gain, bool write_out) {
    bf16_t* HB = (bf16_t*)(A.ws + WS_HB); float* RS = (float*)(A.ws + WS_X2); float* OUT = A.out;
    int lane = C.lane; asm volatile("" : "+v"(lane));
    const int gw = C.vcu * NWAVES + C.wave, NGW = C.G * NWAVES;
    f32x4 g[4];
#pragma unroll
    for (int j = 0; j < 4; ++j) g[j] = ((const f32x4*)gain)[lane + 64 * j];
    for (int m = gw; m < M; m += NGW) {
        u32x2* hb = (u32x2*)(HB + (size_t)m * D) + lane;
        const u32x2* vb = (const u32x2*)(VIN + (size_t)m * D) + lane;
        f32x4 v[4], h[4]; float s = 0.f;
#pragma unroll
        for (int j = 0; j < 4; ++j) { const u32x2 w = vb[64 * j], hw = hb[64 * j];
            v[j] = (f32x4){bf2f(w.x & 0xffffu), bf2f(w.x >> 16), bf2f(w.y & 0xffffu), bf2f(w.y >> 16)};
            h[j] = (f32x4){bf2f(hw.x & 0xffffu), bf2f(hw.x >> 16), bf2f(hw.y & 0xffffu), bf2f(hw.y >> 16)};
            s += (v[j].x * v[j].x + v[j].y * v[j].y) + (v[j].z * v[j].z + v[j].w * v[j].w); }
        const float r = 1.0f / sqrtf(wave_sum(s) * (1.0f / D) + EPS);
        float s2 = 0.f;
#pragma unroll
        for (int j = 0; j < 4; ++j) { h[j] = h[j] + g[j] * v[j] * r; s2 += (h[j].x * h[j].x + h[j].y * h[j].y) + (h[j].z * h[j].z + h[j].w * h[j].w); }
        s2 = wave_sum(s2);
        if (write_out) { f32x4* orow = (f32x4*)(OUT + (size_t)m * D) + lane;
#pragma unroll
            for (int j = 0; j < 4; ++j) orow[64 * j] = h[j]; }
        else {
#pragma unroll
            for (int j = 0; j < 4; ++j) { u32x2 w; w.x = pk2(h[j].x, h[j].y); w.y = pk2(h[j].z, h[j].w); hb[64 * j] = w; }
            if (lane == 0) *(f32x4*)(RS + (size_t)m * 4) = (f32x4){s2, 0.f, 0.f, 0.f}; }
    }
}

__device__ __forceinline__ float gelu_tanh(float x) {
    const float u = 0.7978845608028654f * (x + 0.044715f * x * x * x);
    const float e = fast_exp(2.0f * u);
    const float th = 1.0f - 2.0f * __builtin_amdgcn_rcpf(e + 1.0f);
    return 0.5f * x * (1.0f + th);
}

constexpr size_t WS_LRA = 428 * MiB, WS_LRU = 444 * MiB;
constexpr int MX_PT = 528;
__device__ __forceinline__ bf16x8 gather_wfrag(const float* w, int stride) {
    union { bf16x8 v; unsigned u[4]; } r;
#pragma unroll
    for (int p = 0; p < 4; ++p) r.u[p] = pk2(w[(2 * p) * stride], w[(2 * p + 1) * stride]);
    return r.v;
}
__device__ __forceinline__ void mix1_item(const Ctx& C, const Args& A, int l, int b, int c) {
    const bf16_t* PROJ = (const bf16_t*)(A.ws + WS_PROJ);
    bf16_t* YS = (bf16_t*)(A.ws + WS_YS);
    int tid = C.tid; asm volatile("" : "+v"(tid));
    const int lane = tid & 63, wave = C.wave, fr = lane & 15, fg = lane >> 4;
    const size_t m0 = (size_t)b * T + (size_t)c * 64;
    LAS unsigned char* XC = C.lds;
    LAS unsigned char* LAi = C.lds + 34816;
    LAS unsigned char* LUi = C.lds + 34816 + 32768;
    {
        const float* cw = A.in[I_LCW] + (size_t)l * 4 * BW; const float* cbp = A.in[I_LCB] + l * BW;
#pragma unroll
        for (int k = 0; k < 4; ++k) { const int idx = tid + NTHREADS * k; const int t = idx >> 5, c8 = (idx & 31) * 8;
            float acc[8];
            { const f32x4 b0 = *(const f32x4*)(cbp + c8), b1 = *(const f32x4*)(cbp + c8 + 4); acc[0] = b0[0]; acc[1] = b0[1]; acc[2] = b0[2]; acc[3] = b0[3]; acc[4] = b1[0]; acc[5] = b1[1]; acc[6] = b1[2]; acc[7] = b1[3]; }
#pragma unroll
            for (int j = 0; j < 4; ++j) { const int tok = c * 64 + t - 3 + j;
                if (tok >= 0) { float x[8]; ld8bf(PROJ + ((size_t)b * T + tok) * NMIX + c8, x); const f32x4 w0 = *(const f32x4*)(cw + j * BW + c8), w1 = *(const f32x4*)(cw + j * BW + c8 + 4);
                    acc[0] += w0[0] * x[0]; acc[1] += w0[1] * x[1]; acc[2] += w0[2] * x[2]; acc[3] += w0[3] * x[3]; acc[4] += w1[0] * x[4]; acc[5] += w1[1] * x[5]; acc[6] += w1[2] * x[6]; acc[7] += w1[3] * x[7]; } }
            u32x4 w; w.x = cvt_pk_bf16(acc[0], acc[1]); w.y = cvt_pk_bf16(acc[2], acc[3]); w.z = cvt_pk_bf16(acc[4], acc[5]); w.w = cvt_pk_bf16(acc[6], acc[7]);
            *(LAS u32x4*)(XC + t * MX_PT + c8 * 2) = w; }
    }
    __syncthreads();
    {
        const int blk = wave;
        const float* wa = A.in[I_LWA] + (((size_t)l * 8 + blk) * 32) * 32; const float* wx = A.in[I_LWX] + (((size_t)l * 8 + blk) * 32) * 32;
        bf16x8 fa[2], fx[2];
#pragma unroll
        for (int nt = 0; nt < 2; ++nt) { fa[nt] = gather_wfrag(wa + (8 * fg) * 32 + 16 * nt + fr, 32); fx[nt] = gather_wfrag(wx + (8 * fg) * 32 + 16 * nt + fr, 32); }
        bf16_t* LRA = (bf16_t*)(A.ws + WS_LRA); bf16_t* LRU = (bf16_t*)(A.ws + WS_LRU);
#pragma unroll
        for (int nt = 0; nt < 2; ++nt) { const int ch = 32 * blk + 16 * nt + 4 * fg;
            const f32x4 ba = *(const f32x4*)(A.in[I_LBA] + l * BW + ch), bx = *(const f32x4*)(A.in[I_LBX] + l * BW + ch), sp8 = *(const f32x4*)((const float*)(A.ws + WS_SP8) + l * BW + ch);
#pragma unroll
            for (int mt = 0; mt < 4; ++mt) { const int tok = 16 * mt + fr;
                const bf16x8 bxc = *(const LAS bf16x8*)(XC + tok * MX_PT + (32 * blk + 8 * fg) * 2);
                f32x4 ar = {0.f, 0.f, 0.f, 0.f}, ai = {0.f, 0.f, 0.f, 0.f};
                ar = __builtin_amdgcn_mfma_f32_16x16x32_bf16(fa[nt], bxc, ar, 0, 0, 0); ai = __builtin_amdgcn_mfma_f32_16x16x32_bf16(fx[nt], bxc, ai, 0, 0, 0);
                const u32x2 xw = *(const LAS u32x2*)(XC + tok * MX_PT + ch * 2);
                const float xc[4] = {bf2f(xw.x & 0xffffu), bf2f(xw.x >> 16), bf2f(xw.y & 0xffffu), bf2f(xw.y >> 16)};
                float la[4], uu[4];
#pragma unroll
                for (int r = 0; r < 4; ++r) { const float rg = sigmoid_f(ar[r] + ba[r]), ig = sigmoid_f(ai[r] + bx[r]);
                    la[r] = sp8[r] * rg; const float x2 = 2.0f * la[r];
                    const float om = (x2 > -0.02f) ? -x2 * (1.0f + 0.5f * x2 * (1.0f + x2 * (1.0f / 3.0f))) : 1.0f - fast_exp(x2);
                    uu[r] = sqrtf(om) * ig * xc[r]; }
                u32x2 wl, wu; wl.x = cvt_pk_bf16(la[0], la[1]); wl.y = cvt_pk_bf16(la[2], la[3]); wu.x = cvt_pk_bf16(uu[0], uu[1]); wu.y = cvt_pk_bf16(uu[2], uu[3]);
                *(LAS u32x2*)(LAi + tok * 512 + ch * 2) = wl; *(LAS u32x2*)(LUi + tok * 512 + ch * 2) = wu;
                *(u32x2*)(LRA + (m0 + tok) * BW + ch) = wl; *(u32x2*)(LRU + (m0 + tok) * BW + ch) = wu; }
        }
    }
    __syncthreads();
    {
        const int ch = tid & 255, half = tid >> 8; float P = 1.f, hst = 0.f;
#pragma unroll
        for (int i = 0; i < 32; ++i) { const int t = 32 * half + i; const float a = fast_exp(bf2f(*(const LAS bf16_t*)(LAi + t * 512 + ch * 2))); const float u = bf2f(*(const LAS bf16_t*)(LUi + t * 512 + ch * 2));
            hst = a * hst + u; P *= a; }
        const size_t aggi = ((size_t)b * 128 + c * 2 + half) * 256 + ch;
        ((float*)(A.ws + WS_LA))[aggi] = P; ((float*)(A.ws + WS_LH))[aggi] = hst;
    }
    __syncthreads();
    LAS unsigned char* PX = C.lds;
    LAS unsigned char* DD = C.lds + 43008;
    { u32x4 pv[5];
#pragma unroll
        for (int k = 0; k < 5; ++k) { const int idx = tid + NTHREADS * k; const int r = idx >> 5, c8 = (idx & 31) * 8; const int tok = c * 64 - 15 + r;
            pv[k] = (u32x4){0u, 0u, 0u, 0u}; if (idx < 79 * 32 && tok >= 0) pv[k] = *(const u32x4*)(PROJ + ((size_t)b * T + tok) * NMIX + 512 + c8); }
#pragma unroll
        for (int k = 0; k < 5; ++k) { const int idx = tid + NTHREADS * k; const int r = idx >> 5, c8 = (idx & 31) * 8; if (idx < 79 * 32) *(LAS u32x4*)(PX + r * MX_PT + c8 * 2) = pv[k]; } }
    __syncthreads();
#pragma unroll 1
    for (int k = 0; k < 4; ++k) { const int idx = tid + NTHREADS * k; const int t = idx >> 5, c8 = (idx & 31) * 8; const int g = c8 >> 6, win = 2 << g;
        float sum[8], x0[8];
#pragma unroll
        for (int e = 0; e < 8; ++e) sum[e] = 0.f;
        for (int j = 0; j < win; ++j) { const u32x4 v = *(const LAS u32x4*)(PX + (t + 15 - j) * MX_PT + c8 * 2);
            const float x[8] = {bf2f(v.x & 0xffffu), bf2f(v.x >> 16), bf2f(v.y & 0xffffu), bf2f(v.y >> 16), bf2f(v.z & 0xffffu), bf2f(v.z >> 16), bf2f(v.w & 0xffffu), bf2f(v.w >> 16)};
#pragma unroll
            for (int e = 0; e < 8; ++e) { sum[e] += x[e]; if (j == 0) x0[e] = x[e]; } }
        const int pos = c * 64 + t + 1; const float inv = 1.0f / (float)(pos < win ? pos : win);
        u32x4 w; w.x = cvt_pk_bf16(sum[0] * inv - x0[0], sum[1] * inv - x0[1]); w.y = cvt_pk_bf16(sum[2] * inv - x0[2], sum[3] * inv - x0[3]);
        w.z = cvt_pk_bf16(sum[4] * inv - x0[4], sum[5] * inv - x0[5]); w.w = cvt_pk_bf16(sum[6] * inv - x0[6], sum[7] * inv - x0[7]);
        *(LAS u32x4*)(DD + t * MX_PT + c8 * 2) = w; }
    __syncthreads();
    {
        const int g = wave >> 1, nb = (wave & 1) * 2;
        const float* pw = A.in[I_PW] + (((size_t)l * 4 + g) * 64) * 64;
        bf16x8 fw[2][2];
#pragma unroll
        for (int nn = 0; nn < 2; ++nn)
#pragma unroll
            for (int ks = 0; ks < 2; ++ks) fw[nn][ks] = gather_wfrag(pw + (32 * ks + 8 * fg) * 64 + 16 * (nb + nn) + fr, 64);
#pragma unroll
        for (int nn = 0; nn < 2; ++nn) { const int ch = 64 * g + 16 * (nb + nn) + 4 * fg; const f32x4 scl = *(const f32x4*)(A.in[I_PS] + l * BW + ch);
#pragma unroll
            for (int mt = 0; mt < 4; ++mt) { const int tok = 16 * mt + fr; f32x4 acc = {0.f, 0.f, 0.f, 0.f};
#pragma unroll
                for (int ks = 0; ks < 2; ++ks) { const bf16x8 bd = *(const LAS bf16x8*)(DD + tok * MX_PT + (64 * g + 32 * ks + 8 * fg) * 2); acc = __builtin_amdgcn_mfma_f32_16x16x32_bf16(fw[nn][ks], bd, acc, 0, 0, 0); }
                u32x2 w; w.x = cvt_pk_bf16(acc[0] * scl[0], acc[1] * scl[1]); w.y = cvt_pk_bf16(acc[2] * scl[2], acc[3] * scl[3]);
                *(u32x2*)(YS + (m0 + tok) * D + 256 + ch) = w; } }
    }
    {
        const float* sw = A.in[I_SW] + (size_t)l * 3 * BW;
#pragma unroll 2
        for (int k = 0; k < 4; ++k) { const int idx = tid + NTHREADS * k; const int t = idx >> 5, c8 = (idx & 31) * 8;
            float acc[8];
#pragma unroll
            for (int e = 0; e < 8; ++e) acc[e] = 0.f;
#pragma unroll
            for (int j = 0; j < 3; ++j) { const int tok = c * 64 + t - 2 + j;
                if (tok >= 0) { const bf16_t* p = PROJ + ((size_t)b * T + tok) * NMIX; float sc[8], sx[8]; ld8bf(p + 2048 + c8, sc); ld8bf(p + 2304 + c8, sx);
                    const f32x4 w0 = *(const f32x4*)(sw + j * BW + c8), w1 = *(const f32x4*)(sw + j * BW + c8 + 4);
                    acc[0] += w0[0] * sc[0] * sx[0]; acc[1] += w0[1] * sc[1] * sx[1]; acc[2] += w0[2] * sc[2] * sx[2]; acc[3] += w0[3] * sc[3] * sx[3];
                    acc[4] += w1[0] * sc[4] * sx[4]; acc[5] += w1[1] * sc[5] * sx[5]; acc[6] += w1[2] * sc[6] * sx[6]; acc[7] += w1[3] * sc[7] * sx[7]; } }
            float sb[8]; ld8bf(PROJ + (m0 + t) * NMIX + 1792 + c8, sb);
            u32x4 w; w.x = cvt_pk_bf16(sb[0] * acc[0], sb[1] * acc[1]); w.y = cvt_pk_bf16(sb[2] * acc[2], sb[3] * acc[3]); w.z = cvt_pk_bf16(sb[4] * acc[4], sb[5] * acc[5]); w.w = cvt_pk_bf16(sb[6] * acc[6], sb[7] * acc[7]);
            *(u32x4*)(YS + (m0 + t) * D + 768 + c8) = w; }
    }
    __syncthreads();
}
__device__ __forceinline__ void lru_final_item(const Ctx& C, const Args& A, int l, int b, int c) {
    const bf16_t* PROJ = (const bf16_t*)(A.ws + WS_PROJ);
    const bf16_t* LRA = (const bf16_t*)(A.ws + WS_LRA); const bf16_t* LRU = (const bf16_t*)(A.ws + WS_LRU);
    bf16_t* YS = (bf16_t*)(A.ws + WS_YS);
    int tid = C.tid; asm volatile("" : "+v"(tid));
    const int ch = tid & 255, half = tid >> 8;
    const size_t m0 = (size_t)b * T + (size_t)c * 64 + 32 * half;
    float hst = ((const float*)(A.ws + WS_LC))[((size_t)b * 128 + c * 2 + half) * 256 + ch];
    unsigned short la[32], lu[32], lg[32];
#pragma unroll
    for (int i = 0; i < 32; ++i) { la[i] = LRA[(m0 + i) * BW + ch]; lu[i] = LRU[(m0 + i) * BW + ch]; lg[i] = PROJ[(m0 + i) * NMIX + 256 + ch]; }
#pragma unroll
    for (int i = 0; i < 32; ++i) { const float a = fast_exp(bf2f(la[i])), u = bf2f(lu[i]);
        hst = a * hst + u;
        YS[(m0 + i) * D + ch] = (bf16_t)f2bf(hst * gelu_tanh(bf2f(lg[i]))); }
}

constexpr int HG_PT = 144;
constexpr int HG_IMG = 64 * HG_PT;
constexpr int HG_Q = 0, HG_K = HG_IMG, HG_P = 2 * HG_IMG, HG_BEND = 3 * HG_IMG, HG_REF = HG_BEND + 512, HG_HSZ = 29696;
constexpr size_t WS_ST16 = WS_MERGED + 32 * MiB;
__device__ __forceinline__ float hgrn_lb(const Args& A, int l, int w) {
    if (l == 0) return 0.f;
    const float a0 = A.in[I_HLB][w], a1 = A.in[I_HLB][BW + w];
    return 1.0f / (1.0f + expf(a0 - a1));
}
template <bool FINAL>
__device__ __forceinline__ void hgrn_item(const Ctx& C, const Args& A, int l, int b, int c) {
    const bf16_t* PROJ = (const bf16_t*)(A.ws + WS_PROJ);
    int lane = C.lane; asm volatile("" : "+v"(lane));
    const int wave = C.wave, h = wave >> 1, half = wave & 1, fr = lane & 15, fg = lane >> 4;
    LAS unsigned char* hb = C.lds + h * HG_HSZ;
    LAS float* BEND = (LAS float*)(hb + HG_BEND); LAS float* REF = (LAS float*)(hb + HG_REF);
    const size_t m0 = (size_t)b * T + (size_t)c * 64;
    const bf16_t* pr = PROJ + (m0 + 32 * half) * NMIX + h * 64 + lane;
    const int bh = b * 4 + h; const size_t ci = (size_t)bh * 64 + c;
    float bb[32], kk[32], vv[32];
    {
        const float lbv = hgrn_lb(A, l, h * 64 + lane);
        float acc = 0.f;
#pragma unroll
        for (int i = 0; i < 32; ++i) { const float x = bf2f(pr[(size_t)i * NMIX + 1024]); const float f = fmaxf(lbv + (1.0f - lbv) * sigmoid_f(x), 1e-30f);
            acc += __logf(f); bb[i] = acc; kk[i] = 1.0f - f; }
#pragma unroll
        for (int i = 0; i < 32; ++i) vv[i] = bf2f(pr[(size_t)i * NMIX + 1280]);
        BEND[half * 64 + lane] = acc;
    }
    __syncthreads();
    const float bend0 = BEND[lane], blast = bend0 + BEND[64 + lane];
    if (half) {
#pragma unroll
        for (int i = 0; i < 32; ++i) bb[i] += bend0;
    }
    if (!FINAL) {
        LAS unsigned char* kt = hb + HG_K + lane * HG_PT + 64 * half; LAS unsigned char* vt = hb + HG_Q + lane * HG_PT + 64 * half;
#pragma unroll
        for (int q4 = 0; q4 < 4; ++q4) { u32x4 wk, wv; unsigned kw[4], vw[4];
#pragma unroll
            for (int p = 0; p < 4; ++p) { const int i = q4 * 8 + 2 * p;
                kw[p] = cvt_pk_bf16(kk[i] * fast_exp(blast - bb[i]), kk[i + 1] * fast_exp(blast - bb[i + 1])); vw[p] = cvt_pk_bf16(vv[i], vv[i + 1]); }
            wk.x = kw[0]; wk.y = kw[1]; wk.z = kw[2]; wk.w = kw[3]; wv.x = vw[0]; wv.y = vw[1]; wv.z = vw[2]; wv.w = vw[3];
            *(LAS u32x4*)(kt + q4 * 16) = wk; *(LAS u32x4*)(vt + q4 * 16) = wv; }
        if (half == 0) ((float*)(A.ws + WS_SD))[ci * 64 + lane] = fast_exp(blast);
        __syncthreads();
        float* su = (float*)(A.ws + WS_SU) + ci * 4096;
#pragma unroll
        for (int aa = 0; aa < 2; ++aa) { const int a = 2 * half + aa;
            bf16x8 av[2];
#pragma unroll
            for (int ks = 0; ks < 2; ++ks) av[ks] = *(const LAS bf16x8*)(hb + HG_Q + (16 * a + fr) * HG_PT + 64 * ks + 16 * fg);
#pragma unroll
            for (int d = 0; d < 4; ++d) { f32x4 acc = {0.f, 0.f, 0.f, 0.f};
#pragma unroll
                for (int ks = 0; ks < 2; ++ks) { const bf16x8 bk = *(const LAS bf16x8*)(hb + HG_K + (16 * d + fr) * HG_PT + 64 * ks + 16 * fg);
                    acc = __builtin_amdgcn_mfma_f32_16x16x32_bf16(av[ks], bk, acc, 0, 0, 0); }
#pragma unroll
                for (int r = 0; r < 4; ++r) su[(16 * a + 4 * fg + r) * 64 + 16 * d + fr] = acc[r];
            } }
        __syncthreads();
    } else {
        float qq[32];
#pragma unroll
        for (int i = 0; i < 32; ++i) qq[i] = bf2f(pr[(size_t)i * NMIX + 768]);
        if (half == 0) { REF[64 + lane] = bb[15]; REF[128 + lane] = bb[31]; } else REF[192 + lane] = bb[15];
        { const u32x4 z = {0u, 0u, 0u, 0u};
#pragma unroll
            for (int k2 = 0; k2 < 5; ++k2) { const int idx = lane + 64 * k2; if (idx < 32 * 9) *(LAS u32x4*)(hb + HG_P + 32 * half * HG_PT + idx * 16) = z; } }
        __syncthreads();
        float rf[4]; rf[0] = 0.f; rf[1] = REF[64 + lane]; rf[2] = REF[128 + lane]; rf[3] = REF[192 + lane];
        {
            const float r_lo = half ? rf[2] : rf[0], r_hi = half ? rf[3] : rf[1];
#pragma unroll
            for (int i = 0; i < 32; ++i) { const float rr = (i < 16) ? r_lo : r_hi; const float val = qq[i] * fast_exp(bb[i] - rr);
                *(LAS bf16_t*)(hb + HG_Q + (32 * half + i) * HG_PT + 2 * lane) = (bf16_t)f2bf(val); }
        }
#pragma unroll
        for (int isub = 0; isub < 4; ++isub) {
            const int nrows = 16 * (isub + 1) - 32 * half;
#pragma unroll
            for (int i = 0; i < 32; ++i) { if (i < nrows) { const float e = fminf(rf[isub] - bb[i], 60.f); const float val = kk[i] * fast_exp(e);
                    *(LAS bf16_t*)(hb + HG_K + (32 * half + i) * HG_PT + 2 * lane) = (bf16_t)f2bf(val); } }
            __syncthreads();
            {
                bf16x8 bq[2];
#pragma unroll
                for (int ks = 0; ks < 2; ++ks) bq[ks] = *(const LAS bf16x8*)(hb + HG_Q + (16 * isub + fr) * HG_PT + 64 * ks + 16 * fg);
#pragma unroll
                for (int j = 0; j <= isub; ++j) { if ((j & 1) == half) {
                        f32x4 acc = {0.f, 0.f, 0.f, 0.f};
#pragma unroll
                        for (int ks = 0; ks < 2; ++ks) { const bf16x8 ak = *(const LAS bf16x8*)(hb + HG_K + (16 * j + fr) * HG_PT + 64 * ks + 16 * fg);
                            acc = __builtin_amdgcn_mfma_f32_16x16x32_bf16(ak, bq[ks], acc, 0, 0, 0); }
                        if (j == isub) {
#pragma unroll
                            for (int r = 0; r < 4; ++r) if (4 * fg + r > fr) acc[r] = 0.f; }
                        u32x2 w; w.x = cvt_pk_bf16(acc[0], acc[1]); w.y = cvt_pk_bf16(acc[2], acc[3]);
                        *(LAS u32x2*)(hb + HG_P + (16 * isub + fr) * HG_PT + 2 * (16 * j + 4 * fg)) = w;
                    } }
            }
            __syncthreads();
        }
        {
            LAS unsigned char* vt = hb + HG_Q + lane * HG_PT + 64 * half;
#pragma unroll
            for (int q4 = 0; q4 < 4; ++q4) { u32x4 wv; unsigned vw[4];
#pragma unroll
                for (int p = 0; p < 4; ++p) { const int i = q4 * 8 + 2 * p; vw[p] = cvt_pk_bf16(vv[i], vv[i + 1]); }
                wv.x = vw[0]; wv.y = vw[1]; wv.z = vw[2]; wv.w = vw[3]; *(LAS u32x4*)(vt + q4 * 16) = wv; }
#pragma unroll
            for (int i = 0; i < 32; ++i) *(LAS bf16_t*)(hb + HG_K + (32 * half + i) * HG_PT + 2 * lane) = (bf16_t)f2bf(qq[i] * fast_exp(bb[i]));
        }
        __syncthreads();
        {
            const bf16_t* st = (const bf16_t*)(A.ws + WS_ST16) + ci * 4096;
            bf16x8 a_st[4][2];
#pragma unroll
            for (int a = 0; a < 4; ++a)
#pragma unroll
                for (int ks = 0; ks < 2; ++ks) a_st[a][ks] = *(const bf16x8*)(st + (16 * a + fr) * 64 + 32 * ks + 8 * fg);
            bf16_t* YS = (bf16_t*)(A.ws + WS_YS);
            const float* gn = A.in[I_HN] + l * 64;
#pragma unroll
            for (int tt = 0; tt < 2; ++tt) { const int ti = 2 * half + tt;
                bf16x8 bp[2], bqb[2];
#pragma unroll
                for (int ks = 0; ks < 2; ++ks) { bp[ks] = *(const LAS bf16x8*)(hb + HG_P + (16 * ti + fr) * HG_PT + 64 * ks + 16 * fg); bqb[ks] = *(const LAS bf16x8*)(hb + HG_K + (16 * ti + fr) * HG_PT + 64 * ks + 16 * fg); }
                f32x4 o[4]; float ss = 0.f;
#pragma unroll
                for (int a = 0; a < 4; ++a) { f32x4 acc = {0.f, 0.f, 0.f, 0.f};
#pragma unroll
                    for (int ks = 0; ks < 2; ++ks) { const bf16x8 av = *(const LAS bf16x8*)(hb + HG_Q + (16 * a + fr) * HG_PT + 64 * ks + 16 * fg);
                        acc = __builtin_amdgcn_mfma_f32_16x16x32_bf16(av, bp[ks], acc, 0, 0, 0);
                        acc = __builtin_amdgcn_mfma_f32_16x16x32_bf16(a_st[a][ks], bqb[ks], acc, 0, 0, 0); }
                    o[a] = acc; ss += (acc[0] * acc[0] + acc[1] * acc[1]) + (acc[2] * acc[2] + acc[3] * acc[3]); }
                ss += __shfl_xor(ss, 16); ss += __shfl_xor(ss, 32);
                const float rn = 1.0f / sqrtf(ss * (1.0f / 64.0f) + EPS);
                const size_t row = m0 + 16 * ti + fr;
#pragma unroll
                for (int a = 0; a < 4; ++a) { const int dv = 16 * a + 4 * fg;
                    const u32x2 gw = *(const u32x2*)(PROJ + row * NMIX + 1536 + h * 64 + dv);
                    const float g0 = bf2f(gw.x & 0xffffu), g1 = bf2f(gw.x >> 16), g2 = bf2f(gw.y & 0xffffu), g3 = bf2f(gw.y >> 16);
                    const f32x4 gv = *(const f32x4*)(gn + dv);
                    const float y0 = o[a][0] * rn * gv[0] * (g0 * sigmoid_f(g0)), y1 = o[a][1] * rn * gv[1] * (g1 * sigmoid_f(g1));
                    const float y2 = o[a][2] * rn * gv[2] * (g2 * sigmoid_f(g2)), y3 = o[a][3] * rn * gv[3] * (g3 * sigmoid_f(g3));
                    u32x2 w; w.x = cvt_pk_bf16(y0, y1); w.y = cvt_pk_bf16(y2, y3);
                    *(u32x2*)(YS + row * D + 512 + h * 64 + dv) = w; }
            }
        }
        __syncthreads();
    }
}

__device__ __forceinline__ void mix_phase2(const Ctx& C, const Args& A) {
    float* __restrict__ SU = (float*)(A.ws + WS_SU); const float* __restrict__ SD = (const float*)(A.ws + WS_SD);
    int tid_ = C.tid; asm volatile("" : "+v"(tid_));
    const int gt = C.vcu * NTHREADS + tid_, NGT = C.G * NTHREADS;
    for (int e = gt; e < 32 * 4096; e += NGT) {
        const int bh = e >> 12, kv = e & 4095, dk = kv & 63;
        bf16_t* __restrict__ ST16 = (bf16_t*)(A.ws + WS_ST16);
        float s = 0.f;
#pragma unroll 32
        for (int c = 0; c < 64; ++c) { const size_t ci = (size_t)bh * 64 + c; const float u = SU[ci * 4096 + kv]; const float d = SD[ci * 64 + dk]; ST16[ci * 4096 + kv] = (bf16_t)f2bf(s); s = d * s + u; }
    }
    const float* __restrict__ LA = (const float*)(A.ws + WS_LA); const float* __restrict__ LH = (const float*)(A.ws + WS_LH); float* __restrict__ LC = (float*)(A.ws + WS_LC);
    for (int e = gt; e < BATCH * BW; e += NGT) {
        const int b = e >> 8, ch = e & 255; float cr = 0.f;
#pragma unroll 32
        for (int sc = 0; sc < 128; ++sc) { const size_t i = ((size_t)b * 128 + sc) * 256 + ch; const float a = LA[i], hh = LH[i]; LC[i] = cr; cr = a * cr + hh; }
    }
}

#define XB_TMO      128
#define XB_XCNT(j)  (256  + 64 * (j))
#define XB_XSUB(j)  (1280 + 64 * (j))
#define XB_XGEN(j)  (2304 + 64 * (j))
#define XB_TOP      3328
#define XB_TOPGEN   3392
#define XCD_BAR_WORDS 3456
#define XB_SPIN_CAP (1u << 20)
__device__ __forceinline__ unsigned xb_ld(unsigned* p)              { return __hip_atomic_load(p, __ATOMIC_RELAXED, __HIP_MEMORY_SCOPE_AGENT); }
__device__ __forceinline__ unsigned xb_add(unsigned* p, unsigned v) { return __hip_atomic_fetch_add(p, v, __ATOMIC_RELAXED, __HIP_MEMORY_SCOPE_AGENT); }
__device__ __forceinline__ unsigned xb_xcc_id() { return (unsigned)__builtin_amdgcn_s_getreg((3 << 11) | 20) & 0xFu; }
#define XB_SPIN(cond, bar) do { unsigned _sp = 0; while (cond) { __builtin_amdgcn_s_sleep(1); \
    if ((++_sp & 255u) == 0u) { if (xb_ld(&(bar)[XB_TMO])) break; if (_sp > XB_SPIN_CAP) { atomicAdd(&(bar)[XB_TMO], 1u); break; } } } } while (0)
struct XcdBarrier { unsigned* bar; unsigned x; volatile LAS unsigned* st; };
__device__ __forceinline__ XcdBarrier xcd_barrier_post(unsigned* bar, volatile LAS unsigned* st) {
    XcdBarrier b; b.bar = bar; b.x = xb_xcc_id(); b.st = st;
    if (threadIdx.x == 0) (void)xb_add(&bar[XB_XCNT(b.x)], 1u);
    return b;
}
__device__ __forceinline__ void xcd_barrier_complete(unsigned* bar, unsigned x, unsigned& nloc, unsigned& nx) {
    const unsigned G = gridDim.x * gridDim.y * gridDim.z;
    unsigned sum, cnt, mine, sp = 0u;
    for (;;) {
        sum = 0u; cnt = 0u; mine = 0u;
#pragma unroll
        for (unsigned j = 0; j < 16; ++j) { const unsigned c = xb_ld(&bar[XB_XCNT(j)]); sum += c; cnt += (c > 0u) ? 1u : 0u; mine = (j == x) ? c : mine; }
        if (sum == G) break;
        __builtin_amdgcn_s_sleep(1);
        if ((++sp & 255u) == 0u) { if (xb_ld(&bar[XB_TMO])) break; if (sp > XB_SPIN_CAP) { atomicAdd(&bar[XB_TMO], 1u); break; } }
    }
    nloc = mine > 0u ? mine : 1u; nx = cnt > 0u ? cnt : 1u;
}
__device__ __forceinline__ void xcd_barrier(const XcdBarrier& b) {
    asm volatile("s_waitcnt vmcnt(0)" ::: "memory");
    __syncthreads();
    if (threadIdx.x == 0) {
        unsigned* bar = b.bar;
        __builtin_amdgcn_s_waitcnt(0);
        unsigned nloc = b.st[0], nx = b.st[1];
        if (nloc == 0u) { xcd_barrier_complete(bar, b.x, nloc, nx); b.st[0] = nloc; b.st[1] = nx; }
        const unsigned old = xb_add(&bar[XB_XSUB(b.x)], 1u);
        const unsigned gen = old / nloc;
        if (old + 1u == (gen + 1u) * nloc) {
            __builtin_amdgcn_fence(__ATOMIC_RELEASE, "agent");
            asm volatile("s_waitcnt vmcnt(0)" ::: "memory");
            const unsigned og = xb_add(&bar[XB_TOP], 1u);
            const unsigned tg = og / nx;
            if (og + 1u == (tg + 1u) * nx) xb_add(&bar[XB_TOPGEN], 1u);
            else XB_SPIN(xb_ld(&bar[XB_TOPGEN]) == tg, bar);
            __builtin_amdgcn_fence(__ATOMIC_ACQUIRE, "agent");
            xb_add(&bar[XB_XGEN(b.x)], 1u);
            asm volatile("s_waitcnt vmcnt(0)" ::: "memory");
        } else {
            XB_SPIN(xb_ld(&bar[XB_XGEN(b.x)]) == gen, bar);
            __builtin_amdgcn_fence(__ATOMIC_ACQUIRE, "agent");
            asm volatile("s_waitcnt vmcnt(0)" ::: "memory");
        }
    }
    __syncthreads();
}

constexpr int PH_PER_LAYER = 10, N_PHASES = 1 + DEPTH * PH_PER_LAYER;
constexpr int CW_BAR = 4096;
constexpr int CW_SEAM = 16384;

__global__ void __launch_bounds__(NTHREADS, 2) trunk_fwd(Args args) {
    extern __shared__ __attribute__((aligned(16))) unsigned char lds_raw[];
    Ctx C;
    C.lds = (LAS unsigned char*)lds_raw; C.tid = threadIdx.x; C.lane = C.tid & 63; C.wave = __builtin_amdgcn_readfirstlane(C.tid >> 6);
    C.G = gridDim.x; { const int bx = blockIdx.x; C.vcu = (C.G % 8 == 0) ? (bx % 8) * (C.G / 8) + bx / 8 : bx; }
    unsigned char* ws = args.ws;
    volatile LAS unsigned* MISC = (volatile LAS unsigned*)(C.lds + MISC_OFF);
    if (C.tid < 64) MISC[C.tid] = 0u;
    __syncthreads();
#if MK_PER_PHASE
#define GRID_BAR() do { } while (0)
#else
    cg::grid_group grid = cg::this_grid();
    XcdBarrier bar = xcd_barrier_post((unsigned*)(ws + WS_CTL) + CW_BAR, MISC + 8);
    bool first_bar = true;
#define GRID_BAR() do { if (first_bar) { grid.sync(); first_bar = false; } else { xcd_barrier(bar); } } while (0)
#endif
    const int lo = args.ph_lo, hi = args.ph_hi;
    int ph = 0;
#define PHASE_BEGIN if (ph >= lo && ph < hi) { for (int rep_ = 0; rep_ < (((DBG_REPEAT >> ((ph - 1) % PH_PER_LAYER + 1)) & 1) && ph > 0 ? 2 : 1); ++rep_) {
#define PHASE_END   if (rep_ == 0 && (((DBG_REPEAT >> ((ph - 1) % PH_PER_LAYER + 1)) & 1) && ph > 0)) GRID_BAR(); } if (ph + 1 < hi && ph + 1 < N_PHASES) GRID_BAR(); } ++ph;

    PHASE_BEGIN p0_prologue(C, args); PHASE_END

    for (int li = 0; li < DEPTH; ++li) {
        int l = li; asm volatile("" : "+s"(l));
        const unsigned char* wl = ws + WS_W + (size_t)l * W_LAYER;
        const float* RS = (const float*)(ws + WS_X2);
        PHASE_BEGIN {
            pg8::StaticOrder S; S.init(ws + WS_HB, wl + W_IN, M, NMIX, D, C.G, (int)blockIdx.x);
            pg8::EpiRow<1> E{(bf16_t*)(ws + WS_PROJ), NMIX, RS};
            pg8::gemm_phase<pg8::EpiRow<1>, pg8::StaticOrder, true>(C.lds, D, S, E);
        } PHASE_END
        PHASE_BEGIN {
            for (int item = C.vcu; item < BATCH * 64; item += C.G) { const int b = item >> 6, c = item & 63;
                mix1_item(C, args, l, b, c);
                hgrn_item<false>(C, args, l, b, c); }
        } PHASE_END
        PHASE_BEGIN mix_phase2(C, args); PHASE_END
        PHASE_BEGIN {
            for (int item = C.vcu; item < BATCH * 64; item += C.G) { const int b = item >> 6, c = item & 63;
                lru_final_item(C, args, l, b, c);
                hgrn_item<true>(C, args, l, b, c); }
        } PHASE_END
        PHASE_BEGIN {
            pg8::GateOrder S{(const char*)(ws + WS_HB), (const char*)(wl + W_IN) + (size_t)NMIX * D * 2, (const char*)(ws + WS_YS), (const char*)(wl + W_BR), C.G, C.vcu};
            pg8::EpiGate E{(unsigned char*)(ws + WS_G) + (size_t)blockIdx.x * 4 * 65536, (bf16_t*)(ws + WS_MERGED), RS};
            pg8::gemm_phase<pg8::EpiGate, pg8::GateOrder, true>(C.lds, D, S, E);
        } PHASE_END
        const bool fused_norm = (C.G == 256) && !MK_PER_PHASE;
        if (fused_norm) {
            PHASE_BEGIN {
                { const int half = 0;
                    pg8::PanelOrder S{(const char*)(ws + WS_MERGED), (const char*)(wl + W_OUT), (size_t)pg8::BM * D * 2, D / pg8::BK, half, C.vcu};
                    pg8::EpiNorm E{(bf16_t*)(ws + WS_HB), nullptr, args.in[I_NMIXPOST] + l * D, (float*)(ws + WS_X1), (float*)(ws + WS_X2), (unsigned*)(ws + WS_CTL) + CW_SEAM + (size_t)(l * 2 + 0) * 128 * 64, (unsigned*)(ws + WS_CTL) + 8, C.lds + 131072};
                    pg8::gemm_phase<pg8::EpiNorm, pg8::PanelOrder, true>(C.lds, D, S, E);
                }
            } PHASE_END
            ++ph;
        } else {
        PHASE_BEGIN {
            pg8::StaticOrder S; S.init(ws + WS_MERGED, wl + W_OUT, M, D, D, C.G, (int)blockIdx.x);
            pg8::EpiRow<0> E{(bf16_t*)(ws + WS_MIX), D, nullptr};
            pg8::gemm_phase<pg8::EpiRow<0>, pg8::StaticOrder, true>(C.lds, D, S, E);
        } PHASE_END
        PHASE_BEGIN norm_phase(C, args, (const bf16_t*)(ws + WS_MIX), args.in[I_NMIXPOST] + l * D, false); PHASE_END
        }
        PHASE_BEGIN {
            pg8::StaticOrder S; S.init(ws + WS_HB, wl + W_UP, M, FF, D, C.G, (int)blockIdx.x);
            pg8::EpiRow<2> E{(bf16_t*)(ws + WS_HID), FF, RS};
            pg8::gemm_phase<pg8::EpiRow<2>, pg8::StaticOrder, true>(C.lds, D, S, E);
        } PHASE_END
        if (fused_norm) {
            PHASE_BEGIN {
                { const int half = 0;
                    pg8::PanelOrder S{(const char*)(ws + WS_HID), (const char*)(wl + W_DOWN), (size_t)pg8::BM * FF * 2, FF / pg8::BK, half, C.vcu};
                    pg8::EpiNorm E{(bf16_t*)(ws + WS_HB), (li == DEPTH - 1) ? args.out : nullptr, args.in[I_NMLPPOST] + l * D, (float*)(ws + WS_X1), (float*)(ws + WS_X2), (unsigned*)(ws + WS_CTL) + CW_SEAM + (size_t)(l * 2 + 1) * 128 * 64, (unsigned*)(ws + WS_CTL) + 8, C.lds + 131072};
                    pg8::gemm_phase<pg8::EpiNorm, pg8::PanelOrder, true>(C.lds, FF, S, E);
                }
            } PHASE_END
            ++ph;
        } else {
        PHASE_BEGIN {
            pg8::StaticOrder S; S.init(ws + WS_HID, wl + W_DOWN, M, D, FF, C.G, (int)blockIdx.x);
            pg8::EpiRow<0> E{(bf16_t*)(ws + WS_MOUT), D, nullptr};
            pg8::gemm_phase<pg8::EpiRow<0>, pg8::StaticOrder, true>(C.lds, FF, S, E);
        } PHASE_END
        PHASE_BEGIN norm_phase(C, args, (const bf16_t*)(ws + WS_MOUT), args.in[I_NMLPPOST] + l * D, li == DEPTH - 1); PHASE_END
        }
    }
}

extern "C" void kernel_launch(void* const* d_in, const int* in_sizes, int n_in, void* d_out, int out_size, void* d_ws, size_t ws_size, hipStream_t stream) {
    static int grid = 0;
    if (grid == 0) {
        if (n_in != 22 || in_sizes[0] != M * D || out_size != M * D || ws_size < WS_END) { fprintf(stderr, "kernel_launch: unexpected shapes (n_in %d, in0 %d, out %d, ws %zu)\n", n_in, n_in > 0 ? in_sizes[0] : -1, out_size, ws_size); grid = -1; return; }
        int dev = 0, cus = 0, per_cu = 0;
        if (hipGetDevice(&dev) != hipSuccess || hipDeviceGetAttribute(&cus, hipDeviceAttributeMultiprocessorCount, dev) != hipSuccess) { grid = -1; return; }
        if (hipFuncSetAttribute((const void*)trunk_fwd, hipFuncAttributeMaxDynamicSharedMemorySize, LDS_BYTES) != hipSuccess) { fprintf(stderr, "kernel_launch: hipFuncSetAttribute failed\n"); grid = -1; return; }
        if (hipOccupancyMaxActiveBlocksPerMultiprocessor(&per_cu, (const void*)trunk_fwd, NTHREADS, LDS_BYTES) != hipSuccess || per_cu < 1) { fprintf(stderr, "kernel_launch: occupancy query says %d blocks per CU\n", per_cu); (void)hipGetLastError(); grid = -1; return; }
        grid = cus;
    }
    if (grid < 0) return;
    (void)hipMemsetAsync((char*)d_ws + WS_CTL, 0, CTL_ZERO_BYTES, stream);
    Args a{};
    for (int i = 0; i < 22; ++i) a.in[i] = (const float*)d_in[i];
    a.out = (float*)d_out; a.ws = (unsigned char*)d_ws;
#if MK_PER_PHASE
#ifndef DBG_MAXPH
#define DBG_MAXPH N_PHASES
#endif
    for (int p = 0; p < DBG_MAXPH; ++p) { a.ph_lo = p; a.ph_hi = p + 1; hipLaunchKernelGGL(trunk_fwd, dim3(grid), dim3(NTHREADS), LDS_BYTES, stream, a); }
#else
    a.ph_lo = 0; a.ph_hi = N_PHASES;
    void* kargs[] = {&a};
    hipError_t e = hipLaunchCooperativeKernel((const void*)trunk_fwd, dim3(grid), dim3(NTHREADS), kargs, LDS_BYTES, stream);
    if (e != hipSuccess) fprintf(stderr, "kernel_launch: cooperative launch failed: %s (grid %d)\n", hipGetErrorString(e), grid);
#endif
}
```

```cpp
#include <hip/hip_runtime.h>
#include <hip/hip_cooperative_groups.h>
#include <cstdio>
#include <cstdint>
namespace cg = cooperative_groups;

#ifndef DBG_ZERO
#define DBG_ZERO -1
#endif
#ifndef DBG_REPEAT
#define DBG_REPEAT 0
#endif
#ifndef MK_PER_PHASE
#define MK_PER_PHASE 0
#endif

#define LAS __attribute__((address_space(3)))
#define GAS __attribute__((address_space(1)))
typedef unsigned short bf16_t;
typedef short bf16x8 __attribute__((ext_vector_type(8)));
typedef float f32x4 __attribute__((ext_vector_type(4)));
typedef float f32x2 __attribute__((ext_vector_type(2)));
typedef unsigned u32x4 __attribute__((ext_vector_type(4)));
typedef unsigned u32x2 __attribute__((ext_vector_type(2)));

constexpr int BATCH = 8, T = 4096, D = 1024, M = BATCH * T, DEPTH = 2, BW = 256;
constexpr int NMIX = 2560, NGATE = 4096, INW = NMIX + NGATE, FF = 4096;
constexpr float EPS = 1e-6f;
constexpr int NWAVES = 8, NTHREADS = 512;

constexpr size_t MiB = 1u << 20;
constexpr size_t WS_CTL = 0, CTL_ZERO_BYTES = 1 * MiB;
constexpr size_t WS_RS = 1 * MiB;
constexpr size_t WS_SD = 1 * MiB + 512 * 1024;
constexpr size_t WS_LA = 2 * MiB, WS_LH = 3 * MiB, WS_LC = 4 * MiB;
constexpr size_t WS_SP8 = 7 * MiB;
constexpr size_t WS_X1 = 5 * MiB;
constexpr size_t WS_X2 = 6 * MiB;
constexpr size_t WS_W = 8 * MiB;
constexpr size_t W_IN = 0, W_BR = 13 * MiB, W_OUT = 15 * MiB, W_UP = 17 * MiB, W_DOWN = 25 * MiB, W_LAYER = 33 * MiB;
constexpr size_t WS_HB = 76 * MiB;
constexpr size_t WS_PROJ = 140 * MiB;
constexpr size_t WS_G = WS_PROJ;
constexpr size_t WS_YS = 300 * MiB;
constexpr size_t WS_MERGED = 364 * MiB;
constexpr size_t WS_SU = WS_MERGED;
constexpr size_t WS_MIX = WS_PROJ;
constexpr size_t WS_MOUT = 396 * MiB;
constexpr size_t WS_HID = WS_PROJ;
constexpr size_t WS_HB8 = 460 * MiB;
constexpr size_t WS_WG8 = 492 * MiB;
constexpr size_t WS_SA = 7 * MiB + 64 * 1024;
constexpr size_t WS_SBG = 7 * MiB + 256 * 1024;
constexpr size_t WS_END = 500 * MiB;

constexpr int LDS_BYTES = 155648;
constexpr int MISC_OFF = 154624;

__device__ __forceinline__ float bf2f(unsigned b) { return __uint_as_float(b << 16); }
__device__ __forceinline__ unsigned f2bf(float f) { unsigned u = __float_as_uint(f); return (u + 0x7fffu + ((u >> 16) & 1u)) >> 16; }
__device__ __forceinline__ unsigned pk2(float lo, float hi) { return f2bf(lo) | (f2bf(hi) << 16); }
typedef __bf16 bf16x2_t __attribute__((ext_vector_type(2)));
__device__ __forceinline__ unsigned cvt_pk_bf16(float lo, float hi) { f32x2 v = {lo, hi}; bf16x2_t b = __builtin_convertvector(v, bf16x2_t); return __builtin_bit_cast(unsigned, b); }
__device__ __forceinline__ float fast_exp(float x) { return __builtin_amdgcn_exp2f(x * 1.4426950408889634f); }
__device__ __forceinline__ float sigmoid_f(float x) { return __builtin_amdgcn_rcpf(1.0f + fast_exp(-x)); }
__device__ __forceinline__ void ld8bf(const bf16_t* p, float (&o)[8]) {
    const u32x4 v = *(const u32x4*)p;
    o[0] = bf2f(v.x & 0xffffu); o[1] = bf2f(v.x >> 16); o[2] = bf2f(v.y & 0xffffu); o[3] = bf2f(v.y >> 16);
    o[4] = bf2f(v.z & 0xffffu); o[5] = bf2f(v.z >> 16); o[6] = bf2f(v.w & 0xffffu); o[7] = bf2f(v.w >> 16);
}
__device__ __forceinline__ float rs_of(const float* X2, int row) { const f32x4 x = *(const f32x4*)(X2 + (size_t)row * 4); return 1.0f / sqrtf(((x[0] + x[1]) + (x[2] + x[3])) * (1.0f / D) + EPS); }
typedef int i32x4 __attribute__((ext_vector_type(4)));
__device__ __forceinline__ void quant_row_i8(const bf16_t* src, signed char* dst, float* scale_out, int lane) {
    float x[16]; ld8bf(src + 16 * lane, *(float(*)[8])&x[0]); ld8bf(src + 16 * lane + 8, *(float(*)[8])&x[8]);
    float mx = 0.f;
#pragma unroll
    for (int j = 0; j < 16; ++j) mx = fmaxf(mx, fabsf(x[j]));
#pragma unroll
    for (int o = 1; o < 64; o <<= 1) mx = fmaxf(mx, __shfl_xor(mx, o));
    const float sc = (mx > 0.f) ? mx * (1.0f / 127.0f) : 1.0f, inv = 1.0f / sc;
    unsigned w[4];
#pragma unroll
    for (int p = 0; p < 4; ++p) { unsigned v = 0u;
#pragma unroll
        for (int e = 0; e < 4; ++e) { const int q = (int)__builtin_rintf(x[4 * p + e] * inv); v |= ((unsigned)q & 0xffu) << (8 * e); }
        w[p] = v; }
    *(u32x4*)(dst + 16 * lane) = (u32x4){w[0], w[1], w[2], w[3]};
    if (lane == 0) *scale_out = sc;
}
__device__ __forceinline__ float wave_sum(float v) {
#pragma unroll
    for (int o = 1; o < 64; o <<= 1) v += __shfl_xor(v, o);
    return v;
}

namespace pg8 {
constexpr int BM = 256, BK = 64, HALF = 128, HTB = HALF * BK * 2, STAGE_BYTES = 8 * HTB, NXCD = 8, WGM = 4;
__host__ __device__ __forceinline__ int lds_byte(int r, int c) { const int st = (r >> 4) * 2 + (c >> 5), rr = r & 15, cc = c & 31, ob = rr * 64 + cc * 2; return st * 1024 + (ob ^ (((ob >> 9) & 1) << 5)); }
__host__ __device__ __forceinline__ void stage_rc(int b, int& R, int& C) { const int st = b / 1024, sb = b % 1024, swz = sb ^ (((sb >> 9) & 1) << 5); R = (st >> 1) * 16 + swz / 64; C = (st & 1) * 32 + (swz % 64) / 2; }
__host__ __device__ __forceinline__ int perm32(int rho) { const int n = rho >> 4, i = rho & 15; return 8 * (i >> 2) + 4 * n + (i & 3); }

struct Unit { int pm, pn, kind; };

struct StaticOrder {
    const char* A; const char* Bt; size_t tstep;
    int nM, nN, nwg, G, c;
    __device__ void init(const void* A_, const void* Bt_, int M_, int N_, int K_, int G_, int c_) { A = (const char*)A_; Bt = (const char*)Bt_; tstep = (size_t)BM * K_ * 2; nt = K_ / BK; nM = M_ / BM; nN = N_ / BM; nwg = nM * nN; G = G_; c = c_; }
    __device__ bool next(int i, Unit& u) const {
        const long L = (long)i * G + c; if (L >= nwg) return false;
        int wgid = (int)L; { const int q = nwg / NXCD, r = nwg % NXCD, xcd = wgid % NXCD, off = wgid / NXCD; wgid = (xcd < r ? xcd * (q + 1) : r * (q + 1) + (xcd - r) * q) + off; }
        const int nig = WGM * nN, gid = wgid / nig, fm = gid * WGM, gsz = (nM - fm) < WGM ? (nM - fm) : WGM;
        u.pm = fm + ((wgid % nig) % gsz); u.pn = (wgid % nig) / gsz; u.kind = 0; return true;
    }
    __device__ __forceinline__ void tiles(const Unit& u, const char*& a, const char*& b) const { a = A + (size_t)u.pm * tstep; b = Bt + (size_t)u.pn * tstep; }
    int nt;
    __device__ __forceinline__ int ntiles(const Unit&) const { return nt; }
    __device__ __forceinline__ bool keep_acc(const Unit&) const { return false; }
};

struct GateOrder {
    const char* HB; const char* WGt; const char* YS; const char* WB; int G, vcu;
    __device__ bool next(int i, Unit& u) const {
        const int r = i / 16, ii = i % 16, su = vcu + r * G; if (su >= 256) return false;
        const int half = ii / 8, j = ii % 8;
        u.pm = half * 64 + (su >> 2); u.kind = j; u.pn = (j < 4) ? (j * 4 + (su & 3)) : (su & 3); return true;
    }
    __device__ __forceinline__ int ntiles(const Unit& u) const { return u.kind < 4 ? 16 : 4; }
    __device__ __forceinline__ bool keep_acc(const Unit& nx) const { return nx.kind > 4; }
    __device__ __forceinline__ void tiles(const Unit& u, const char*& a, const char*& b) const {
        const size_t ts = (size_t)BM * 1024 * 2;
        if (u.kind < 4) { a = HB + (size_t)u.pm * ts; b = WGt + (size_t)u.pn * ts; } else { a = YS + (size_t)u.pm * ts + (size_t)(u.kind - 4) * 512; b = WB + (size_t)u.pn * ts + (size_t)(u.kind - 4) * 512; }
    }
};

struct GateOrder8 {
    const char* HB8; const char* WG8; int G, vcu;
    __device__ bool next(int i, Unit& u) const {
        const int r = i / 8, ii = i % 8, su = vcu + r * G; if (su >= 256) return false;
        u.pm = (ii >> 2) * 64 + (su >> 2); u.kind = ii; u.pn = (ii & 3) * 4 + (su & 3); return true;
    }
    __device__ __forceinline__ int ntiles(const Unit&) const { return 8; }
    __device__ __forceinline__ bool keep_acc(const Unit&) const { return false; }
    __device__ __forceinline__ void tiles(const Unit& u, const char*& a, const char*& b) const { a = HB8 + (size_t)u.pm * 262144; b = WG8 + (size_t)u.pn * 262144; }
};
struct MergeOrder {
    const char* YS; const char* WB; int G, vcu;
    __device__ bool next(int i, Unit& u) const {
        const int r = i / 8, ii = i % 8, su = vcu + r * G; if (su >= 256) return false;
        u.pm = (ii >> 2) * 64 + (su >> 2); u.kind = 4 + (ii & 3); u.pn = su & 3; return true;
    }
    __device__ __forceinline__ int ntiles(const Unit&) const { return 4; }
    __device__ __forceinline__ bool keep_acc(const Unit& nx) const { return nx.kind > 4; }
    __device__ __forceinline__ void tiles(const Unit& u, const char*& a, const char*& b) const {
        const size_t ts = (size_t)BM * 1024 * 2; a = YS + (size_t)u.pm * ts + (size_t)(u.kind - 4) * 512; b = WB + (size_t)u.pn * ts + (size_t)(u.kind - 4) * 512; }
};

template <int MODE  > struct EpiRow {
    static constexpr bool PERM = true;
    bf16_t* O; int ldc; const float* rs;
    __device__ __forceinline__ void operator()(f32x4 (&acc)[2][2][4][2], const Unit& u, int wr, int wc, int fr, int fq) const {
        const int row0 = u.pm * BM + wr * 64 + fr, col0 = u.pn * BM + wc * 32 + 8 * fq;
#pragma unroll
        for (int ai = 0; ai < 2; ++ai)
#pragma unroll
            for (int m = 0; m < 4; ++m) {
                const int row = row0 + ai * HALF + m * 16; const float sc = (MODE != 0) ? rs_of(rs, row) : 1.0f;
                bf16_t* rowp = O + (size_t)row * ldc + col0;
#pragma unroll
                for (int bj = 0; bj < 2; ++bj) {
                    f32x4 v0 = acc[ai][bj][m][0], v1 = acc[ai][bj][m][1];
                    if (MODE != 0) { v0 = v0 * sc; v1 = v1 * sc; }
                    if (MODE == 2) {
#pragma unroll
                        for (int j = 0; j < 4; ++j) { const float a = fmaxf(v0[j], 0.f), b = fmaxf(v1[j], 0.f); v0[j] = a * a; v1[j] = b * b; }
                    }
                    u32x4 w; w.x = cvt_pk_bf16(v0[0], v0[1]); w.y = cvt_pk_bf16(v0[2], v0[3]); w.z = cvt_pk_bf16(v1[0], v1[1]); w.w = cvt_pk_bf16(v1[2], v1[3]);
                    __builtin_nontemporal_store(w, (u32x4*)(rowp + bj * HALF));
                }
            }
    }
};

__device__ __forceinline__ unsigned pack_u8x4(float a, float b, float c, float d) { unsigned w = 0u;
    w = __builtin_amdgcn_cvt_pk_u8_f32(a * 256.0f - 0.5f, 0, w); w = __builtin_amdgcn_cvt_pk_u8_f32(b * 256.0f - 0.5f, 1, w); w = __builtin_amdgcn_cvt_pk_u8_f32(c * 256.0f - 0.5f, 2, w); w = __builtin_amdgcn_cvt_pk_u8_f32(d * 256.0f - 0.5f, 3, w); return w; }
__device__ __forceinline__ f32x4 unpack_u8x4(unsigned w) { return (f32x4){(float)(w & 0xffu) + 0.5f, (float)((w >> 8) & 0xffu) + 0.5f, (float)((w >> 16) & 0xffu) + 0.5f, (float)(w >> 24) + 0.5f}; }
struct EpiGate {
    static constexpr bool PERM = true;
    unsigned char* Gt;
    bf16_t* MERGED;
    const float* rs;
    __device__ __forceinline__ void rescale(f32x4 (&acc)[2][2][4][2], int hsel, int j, int wr, int wc, int fr, int fq) const {
        int lane_off = (wr * 64 + fr) * 256 + wc * 32 + 8 * fq; asm volatile("" : "+v"(lane_off));
        const unsigned char* g0 = Gt + (size_t)(hsel * 4 + j) * 65536; const unsigned char* g1 = g0 + 65536;
#pragma unroll
        for (int ai = 0; ai < 2; ++ai) {
            u32x2 a[4][2], b[4][2];
#pragma unroll
            for (int m = 0; m < 4; ++m)
#pragma unroll
                for (int bj = 0; bj < 2; ++bj) { const int off = lane_off + (ai * HALF + m * 16) * 256 + bj * HALF; a[m][bj] = *(const u32x2*)(g0 + off); b[m][bj] = *(const u32x2*)(g1 + off); }
#pragma unroll
            for (int m = 0; m < 4; ++m)
#pragma unroll
                for (int bj = 0; bj < 2; ++bj) {
                    const f32x4 a0 = unpack_u8x4(a[m][bj].x), a1 = unpack_u8x4(a[m][bj].y), b0 = unpack_u8x4(b[m][bj].x), b1 = unpack_u8x4(b[m][bj].y);
#pragma unroll
                    for (int q = 0; q < 4; ++q) { acc[ai][bj][m][0][q] *= a0[q] * __builtin_amdgcn_rcpf(b0[q]); acc[ai][bj][m][1][q] *= a1[q] * __builtin_amdgcn_rcpf(b1[q]); }
                }
            asm volatile("" ::: "memory");
        }
    }
    __device__ __forceinline__ void operator()(f32x4 (&acc)[2][2][4][2], const Unit& u, int wr, int wc, int fr, int fq) const {
        if (u.kind >= 4 && u.kind < 7) { rescale(acc, u.pm >> 6, u.kind - 4, wr, wc, fr, fq); return; }
        int rl0 = wr * 64 + fr, cl0 = wc * 32 + 8 * fq; asm volatile("" : "+v"(rl0), "+v"(cl0));
        if (u.kind < 4) {
            unsigned char* gt = Gt + (size_t)u.kind * 65536;
#pragma unroll
            for (int ai = 0; ai < 2; ++ai)
#pragma unroll
                for (int m = 0; m < 4; ++m) {
                    const int rl = rl0 + ai * HALF + m * 16; const float sc = rs_of(rs, u.pm * BM + rl);
#pragma unroll
                    for (int bj = 0; bj < 2; ++bj) {
                        f32x4 v0 = acc[ai][bj][m][0] * sc, v1 = acc[ai][bj][m][1] * sc;
#pragma unroll
                        for (int j = 0; j < 4; ++j) { v0[j] = sigmoid_f(fmaxf(v0[j], -60.f)); v1[j] = sigmoid_f(fmaxf(v1[j], -60.f)); }
                        u32x2 w; w.x = pack_u8x4(v0[0], v0[1], v0[2], v0[3]); w.y = pack_u8x4(v1[0], v1[1], v1[2], v1[3]);
                        *(u32x2*)(gt + rl * 256 + cl0 + bj * HALF) = w;
                    }
                }
        } else {
            const unsigned char* g3 = Gt + (size_t)((u.pm >> 6) * 4 + 3) * 65536;
#pragma unroll
            for (int ai = 0; ai < 2; ++ai)
#pragma unroll
                for (int m = 0; m < 4; ++m) {
                    const int rl = rl0 + ai * HALF + m * 16;
                    bf16_t* rowp = MERGED + (size_t)(u.pm * BM + rl) * 1024 + u.pn * BM + cl0;
#pragma unroll
                    for (int bj = 0; bj < 2; ++bj) {
                        const u32x2 sw = *(const u32x2*)(g3 + rl * 256 + cl0 + bj * HALF);
                        const f32x4 s0 = unpack_u8x4(sw.x) * (1.0f / 256.0f), s1 = unpack_u8x4(sw.y) * (1.0f / 256.0f);
                        const f32x4 v0 = acc[ai][bj][m][0] * s0, v1 = acc[ai][bj][m][1] * s1;
                        u32x4 w; w.x = cvt_pk_bf16(v0[0], v0[1]); w.y = cvt_pk_bf16(v0[2], v0[3]); w.z = cvt_pk_bf16(v1[0], v1[1]); w.w = cvt_pk_bf16(v1[2], v1[3]);
                        *(u32x4*)(rowp + bj * HALF) = w;
                    }
                }
        }
    }
};

struct EpiGate8 {
    static constexpr bool PERM = true;
    unsigned char* Gt;
    const float* rs; const float* sa; const float* sb;
    __device__ __forceinline__ void operator()(f32x4 (&acc)[2][2][4][2], const Unit& u, int wr, int wc, int fr, int fq) const {
        int rl0 = wr * 64 + fr, cl0 = wc * 32 + 8 * fq; asm volatile("" : "+v"(rl0), "+v"(cl0));
        unsigned char* gt = Gt + (size_t)u.kind * 65536;
        f32x4 cs[2][2];
#pragma unroll
        for (int bj = 0; bj < 2; ++bj) { cs[bj][0] = *(const f32x4*)(sb + u.pn * BM + cl0 + bj * HALF); cs[bj][1] = *(const f32x4*)(sb + u.pn * BM + cl0 + bj * HALF + 4); }
#pragma unroll
        for (int ai = 0; ai < 2; ++ai)
#pragma unroll
            for (int m = 0; m < 4; ++m) {
                const int rl = rl0 + ai * HALF + m * 16; const float sc = rs_of(rs, u.pm * BM + rl) * sa[u.pm * BM + rl];
#pragma unroll
                for (int bj = 0; bj < 2; ++bj) {
                    const i32x4 i0 = __builtin_bit_cast(i32x4, acc[ai][bj][m][0]), i1 = __builtin_bit_cast(i32x4, acc[ai][bj][m][1]);
                    f32x4 v0, v1;
#pragma unroll
                    for (int j = 0; j < 4; ++j) { v0[j] = sigmoid_f(fmaxf((float)i0[j] * (sc * cs[bj][0][j]), -60.f)); v1[j] = sigmoid_f(fmaxf((float)i1[j] * (sc * cs[bj][1][j]), -60.f)); }
                    u32x2 w; w.x = pack_u8x4(v0[0], v0[1], v0[2], v0[3]); w.y = pack_u8x4(v1[0], v1[1], v1[2], v1[3]);
                    *(u32x2*)(gt + rl * 256 + cl0 + bj * HALF) = w;
                }
            }
    }
};

struct PanelOrder {
    const char* A; const char* Bt; size_t tstep; int nt, half, vcu;
    __device__ bool next(int i, Unit& u) const { if (i > 1) return false; u.pm = i * 64 + (vcu >> 2); u.pn = vcu & 3; u.kind = 0; return true; }
    __device__ __forceinline__ void tiles(const Unit& u, const char*& a, const char*& b) const { a = A + (size_t)u.pm * tstep; b = Bt + (size_t)u.pn * tstep; }
    __device__ __forceinline__ int ntiles(const Unit&) const { return nt; }
    __device__ __forceinline__ bool keep_acc(const Unit&) const { return false; }
};
struct EpiNorm {
    static constexpr bool PERM = true;
    bf16_t* HB; float* OUTF; const float* gain; float* X1; float* X2; unsigned* cnt; unsigned* tmo; LAS unsigned char* sp;
    __device__ __forceinline__ void operator()(f32x4 (&acc)[2][2][4][2], const Unit& u, int wr, int wc, int fr, int fq) const {
        LAS float* P = (LAS float*)sp;
        LAS float* R = (LAS float*)(sp + 4096);
        const int tid = (wr * 4 + wc) * 64 + fq * 16 + fr;
#pragma unroll
        for (int ai = 0; ai < 2; ++ai)
#pragma unroll
            for (int m = 0; m < 4; ++m) { float s = 0.f;
#pragma unroll
                for (int bj = 0; bj < 2; ++bj)
#pragma unroll
                    for (int n = 0; n < 2; ++n) { const f32x4 x = acc[ai][bj][m][n]; s += (x[0] * x[0] + x[1] * x[1]) + (x[2] * x[2] + x[3] * x[3]); }
                s += __shfl_xor(s, 16); s += __shfl_xor(s, 32);
                if (fq == 0) P[(ai * HALF + wr * 64 + m * 16 + fr) * 4 + wc] = s; }
        asm volatile("s_waitcnt lgkmcnt(0)" ::: "memory"); __builtin_amdgcn_s_barrier(); asm volatile("" ::: "memory");
        if (tid < 256) {
            const f32x4 p = *(const LAS f32x4*)(P + tid * 4); const float tot = (p[0] + p[1]) + (p[2] + p[3]);
            __hip_atomic_store(X1 + ((size_t)u.pm * BM + tid) * 4 + u.pn, tot, __ATOMIC_RELAXED, __HIP_MEMORY_SCOPE_AGENT);
            asm volatile("s_waitcnt vmcnt(0)" ::: "memory");
            if ((tid & 63) == 0) __hip_atomic_fetch_add(cnt + 64 * u.pm, 1u, __ATOMIC_RELAXED, __HIP_MEMORY_SCOPE_AGENT);
        }
        if (tid < 64) {
            unsigned spins = 0;
            while ((unsigned)__builtin_amdgcn_readfirstlane(__hip_atomic_load(cnt + 64 * u.pm, __ATOMIC_RELAXED, __HIP_MEMORY_SCOPE_AGENT)) < 16u) {
                __builtin_amdgcn_s_sleep(2);
                if (++spins > (1u << 22)) { if (tid == 0) __hip_atomic_store(tmo, 1u, __ATOMIC_RELAXED, __HIP_MEMORY_SCOPE_AGENT); break; } }
            __builtin_amdgcn_fence(__ATOMIC_ACQUIRE, "agent");
        }
        asm volatile("s_waitcnt vmcnt(0) lgkmcnt(0)" ::: "memory"); __builtin_amdgcn_s_barrier(); asm volatile("" ::: "memory");
        if (tid < 256) { const float* sl = X1 + ((size_t)u.pm * BM + tid) * 4; float t4[4];
#pragma unroll
            for (int t = 0; t < 4; ++t) t4[t] = __hip_atomic_load(sl + t, __ATOMIC_RELAXED, __HIP_MEMORY_SCOPE_AGENT);
            R[tid] = 1.0f / sqrtf(((t4[0] + t4[1]) + (t4[2] + t4[3])) * (1.0f / 1024.0f) + 1e-6f); }
        asm volatile("s_waitcnt vmcnt(0) lgkmcnt(0)" ::: "memory"); __builtin_amdgcn_s_barrier(); asm volatile("" ::: "memory");
        int rl0 = wr * 64 + fr, cl0 = wc * 32 + 8 * fq; asm volatile("" : "+v"(rl0), "+v"(cl0));
        f32x4 gv[2][2];
#pragma unroll
        for (int bj = 0; bj < 2; ++bj) { gv[bj][0] = *(const f32x4*)(gain + u.pn * BM + cl0 + bj * HALF); gv[bj][1] = *(const f32x4*)(gain + u.pn * BM + cl0 + bj * HALF + 4); }
#pragma unroll
        for (int ai = 0; ai < 2; ++ai)
#pragma unroll
            for (int m = 0; m < 4; ++m) { const int rl = rl0 + ai * HALF + m * 16; const float r = R[rl]; const size_t go = ((size_t)u.pm * BM + rl) * 1024 + u.pn * BM + cl0;
                float s2 = 0.f;
#pragma unroll
                for (int bj = 0; bj < 2; ++bj) { const u32x4 hw = *(const u32x4*)(HB + go + bj * HALF);
                    f32x4 h0 = {bf2f(hw.x & 0xffffu), bf2f(hw.x >> 16), bf2f(hw.y & 0xffffu), bf2f(hw.y >> 16)}, h1 = {bf2f(hw.z & 0xffffu), bf2f(hw.z >> 16), bf2f(hw.w & 0xffffu), bf2f(hw.w >> 16)};
                    h0 = h0 + gv[bj][0] * acc[ai][bj][m][0] * r; h1 = h1 + gv[bj][1] * acc[ai][bj][m][1] * r;
                    s2 += (h0[0] * h0[0] + h0[1] * h0[1]) + (h0[2] * h0[2] + h0[3] * h0[3]) + (h1[0] * h1[0] + h1[1] * h1[1]) + (h1[2] * h1[2] + h1[3] * h1[3]);
                    if (OUTF) { *(f32x4*)(OUTF + go + bj * HALF) = h0; *(f32x4*)(OUTF + go + bj * HALF + 4) = h1; }
                    else { u32x4 w; w.x = cvt_pk_bf16(h0[0], h0[1]); w.y = cvt_pk_bf16(h0[2], h0[3]); w.z = cvt_pk_bf16(h1[0], h1[1]); w.w = cvt_pk_bf16(h1[2], h1[3]); __builtin_nontemporal_store(w, (u32x4*)(HB + go + bj * HALF)); } }
                s2 += __shfl_xor(s2, 16); s2 += __shfl_xor(s2, 32);
                if (fq == 0) P[rl * 4 + wc] = s2; }
        asm volatile("s_waitcnt lgkmcnt(0)" ::: "memory"); __builtin_amdgcn_s_barrier(); asm volatile("" ::: "memory");
        if (tid < 256) { const f32x4 p = *(const LAS f32x4*)(P + tid * 4); X2[((size_t)u.pm * BM + tid) * 4 + u.pn] = (p[0] + p[1]) + (p[2] + p[3]); }
    }
};

template <class Epi, class Sched, bool ALIGN_EPI, bool I8 = false>
__device__ __forceinline__ void gemm_phase(LAS unsigned char* lds, const int K, const Sched& S, const Epi& E) {
    int tid = threadIdx.x; asm volatile("" : "+v"(tid));
    const int wid = __builtin_amdgcn_readfirstlane(tid >> 6), lane = tid & 63, wr = wid >> 2, wc = wid & 3, fr = lane & 15, fq = lane >> 4;
    unsigned voffA[2], voffB[2];
#pragma unroll
    for (int i = 0; i < 2; ++i) { int R, C; stage_rc(tid * 16 + i * 8192, R, C); const int Rb = Epi::PERM ? ((R & ~31) + perm32(R & 31)) : R;
        voffA[i] = (unsigned)(R * K + C) * 2u; voffB[i] = (unsigned)(Rb * K + C) * 2u; }
    const size_t kstep = (size_t)(BK * 2);
    const size_t hstep = (size_t)HALF * K * 2;
    const unsigned ldsw = (unsigned)wid * 1024u;
    const int aoff = lds_byte(wr * 64 + fr, fq * 8), boff = lds_byte(wc * 32 + fr, fq * 8);
#define PG8_SA(b, h) (((b) * 2 + (h)) * HTB)
#define PG8_SB(b, h) ((4 + (b) * 2 + (h)) * HTB)
#define PG8_STAGE(bufoff, gbase, voff) do { _Pragma("unroll") for (int _i = 0; _i < 2; ++_i) \
        __builtin_amdgcn_global_load_lds((const unsigned*)((const char*)(gbase) + (voff)[_i]), (LAS unsigned*)(lds + (bufoff) + ldsw + _i * 8192), 16, 0, 0); } while (0)
#define PG8_LDA(dst, b, h) do { _Pragma("unroll") for (int m = 0; m < 4; ++m) _Pragma("unroll") for (int k = 0; k < 2; ++k) dst[m][k] = *(const LAS bf16x8*)(lds + PG8_SA(b, h) + aoff + m * 2048 + k * 1024); } while (0)
#define PG8_LDB(dst, b, h) do { _Pragma("unroll") for (int n = 0; n < 2; ++n) _Pragma("unroll") for (int k = 0; k < 2; ++k) dst[n][k] = *(const LAS bf16x8*)(lds + PG8_SB(b, h) + boff + n * 2048 + k * 1024); } while (0)
#define PG8_MMA(ai, bj, At, Bt) do { __builtin_amdgcn_s_setprio(1); _Pragma("unroll") for (int m = 0; m < 4; ++m) _Pragma("unroll") for (int n = 0; n < 2; ++n) _Pragma("unroll") for (int k = 0; k < 2; ++k) \
        { if constexpr (I8) acc[ai][bj][m][n] = __builtin_bit_cast(f32x4, __builtin_amdgcn_mfma_i32_16x16x64_i8(__builtin_bit_cast(i32x4, Bt[n][k]), __builtin_bit_cast(i32x4, At[m][k]), __builtin_bit_cast(i32x4, acc[ai][bj][m][n]), 0, 0, 0)); \
          else acc[ai][bj][m][n] = __builtin_amdgcn_mfma_f32_16x16x32_bf16(Bt[n][k], At[m][k], acc[ai][bj][m][n], 0, 0, 0); } __builtin_amdgcn_s_setprio(0); } while (0)
#define PG8_WAIT_V(n) asm volatile("s_waitcnt vmcnt(" #n ")" ::: "memory")
#define PG8_WAIT_L(n) asm volatile("s_waitcnt lgkmcnt(" #n ")" ::: "memory")
#define PG8_BAR __builtin_amdgcn_s_barrier()
#define PG8_SCHED __builtin_amdgcn_sched_barrier(0)
    Unit cur, nxt; int ui = 0;
    if (!S.next(0, cur)) return;
    f32x4 acc[2][2][4][2];
#pragma unroll
    for (int a = 0; a < 2; ++a)
#pragma unroll
        for (int b = 0; b < 2; ++b)
#pragma unroll
            for (int m = 0; m < 4; ++m)
#pragma unroll
                for (int n = 0; n < 2; ++n) acc[a][b][m][n] = (f32x4){0.f, 0.f, 0.f, 0.f};
    bf16x8 At[4][2], B0[2][2], B1[2][2];
    const char* cA; const char* cB; S.tiles(cur, cA, cB);
    PG8_STAGE(PG8_SB(0, 0), cB, voffB); PG8_STAGE(PG8_SB(0, 1), cB + hstep, voffB); PG8_STAGE(PG8_SA(0, 0), cA, voffA); PG8_STAGE(PG8_SA(0, 1), cA + hstep, voffA);
    if (wr == 1) PG8_BAR;
    PG8_WAIT_V(2); PG8_BAR;
    PG8_STAGE(PG8_SB(1, 0), cB + kstep, voffB); PG8_STAGE(PG8_SA(1, 0), cA + kstep, voffA); PG8_STAGE(PG8_SB(1, 1), cB + hstep + kstep, voffB);
    PG8_WAIT_V(6); PG8_BAR;
    for (;;) {
        const bool has_next = S.next(ui + 1, nxt);
        const char* nA = cA; const char* nB = cB; if (has_next) S.tiles(nxt, nA, nB);
#define PG8_KT2(t, last) do { \
            const char* a1 = cA + (size_t)((t) + 1) * kstep; \
            const char* a2 = (last) ? nA : cA + (size_t)((t) + 2) * kstep; const char* b2 = (last) ? nB : cB + (size_t)((t) + 2) * kstep; \
            const char* a3 = a2 + kstep; const char* b3 = b2 + kstep; \
            PG8_LDB(B0, 0, 0); PG8_LDB(B1, 0, 1); PG8_SCHED; PG8_LDA(At, 0, 0); PG8_STAGE(PG8_SA(1, 1), a1 + hstep, voffA); \
            PG8_WAIT_V(8); PG8_WAIT_L(0); PG8_BAR; PG8_MMA(0, 0, At, B0); PG8_MMA(0, 1, At, B1); PG8_BAR; PG8_SCHED; \
            PG8_LDA(At, 0, 1); PG8_STAGE(PG8_SB(0, 0), b2, voffB); PG8_STAGE(PG8_SB(0, 1), b2 + hstep, voffB); PG8_STAGE(PG8_SA(0, 0), a2, voffA); \
            PG8_WAIT_V(8); PG8_WAIT_L(0); PG8_BAR; PG8_MMA(1, 0, At, B0); PG8_MMA(1, 1, At, B1); PG8_BAR; PG8_SCHED; \
            PG8_LDB(B0, 1, 0); PG8_LDB(B1, 1, 1); PG8_SCHED; PG8_LDA(At, 1, 0); PG8_STAGE(PG8_SA(0, 1), a2 + hstep, voffA); \
            PG8_WAIT_V(8); PG8_WAIT_L(0); PG8_BAR; PG8_MMA(0, 0, At, B0); PG8_MMA(0, 1, At, B1); PG8_BAR; PG8_SCHED; \
            PG8_LDA(At, 1, 1); PG8_STAGE(PG8_SB(1, 0), b3, voffB); PG8_STAGE(PG8_SB(1, 1), b3 + hstep, voffB); PG8_STAGE(PG8_SA(1, 0), a3, voffA); \
            PG8_WAIT_V(8); PG8_WAIT_L(0); PG8_BAR; PG8_MMA(1, 0, At, B0); PG8_MMA(1, 1, At, B1); PG8_BAR; PG8_SCHED; } while (0)
        {
            const int ntc = S.ntiles(cur);
#pragma unroll 1
            for (int t = 0; t < ntc; t += 2) { const bool last = (t == ntc - 2); PG8_KT2(t, last); }
        }
        if constexpr (ALIGN_EPI) { if (wr == 0) PG8_BAR; }
        E(acc, cur, wr, wc, fr, fq);
        if (!has_next) break;
        if (!S.keep_acc(nxt)) {
#pragma unroll
        for (int a = 0; a < 2; ++a)
#pragma unroll
            for (int b = 0; b < 2; ++b)
#pragma unroll
                for (int m = 0; m < 4; ++m)
#pragma unroll
                    for (int n = 0; n < 2; ++n) acc[a][b][m][n] = (f32x4){0.f, 0.f, 0.f, 0.f};
        }
        cur = nxt; cA = nA; cB = nB; ++ui;
        if constexpr (ALIGN_EPI) { if (wr == 1) PG8_BAR; }
    }
    PG8_WAIT_V(0);
    if constexpr (!ALIGN_EPI) { if (wr == 0) PG8_BAR; }
    PG8_BAR;
#undef PG8_KT2
#undef PG8_SA
#undef PG8_SB
#undef PG8_STAGE
#undef PG8_LDA
#undef PG8_LDB
#undef PG8_MMA
#undef PG8_WAIT_V
#undef PG8_WAIT_L
#undef PG8_BAR
#undef PG8_SCHED
}
}

struct Args {
    const float* in[22]; float* out; unsigned char* ws; int ph_lo, ph_hi;
};
enum { I_X = 0, I_NMIXPRE, I_NMIXPOST, I_NMLPPRE, I_NMLPPOST, I_WIN, I_LCW, I_LCB, I_LWA, I_LBA, I_LWX, I_LBX, I_LLAM, I_PW, I_PS, I_HLB, I_HN, I_SW, I_WBR, I_WOUT, I_WUP, I_WDOWN };

struct Ctx {
    LAS unsigned char* lds; int tid, lane, wave, vcu, G;
};

__device__ __forceinline__ void transpose_item(const float* W, int ldw, const float* gain, bf16_t* WT, int ldo, int col_off, int k0, int n0, LAS float* scr, int lane) {
    float wv[32];
#pragma unroll
    for (int i = 0; i < 32; ++i) { const int kk = 2 * i + (lane >> 5); wv[i] = W[(size_t)(k0 + kk) * ldw + n0 + (lane & 31)]; }
#pragma unroll
    for (int i = 0; i < 32; ++i) { const int kk = 2 * i + (lane >> 5); const float g = gain ? gain[k0 + kk] : 1.0f; scr[kk * 33 + (lane & 31)] = g * wv[i]; }
    asm volatile("s_waitcnt lgkmcnt(0)" ::: "memory");
    const int c = lane & 7;
#pragma unroll
    for (int j = 0; j < 4; ++j) { const int n = (lane >> 3) + 8 * j; const LAS float* s = scr + (8 * c) * 33 + n;
        u32x4 o; o.x = pk2(s[0 * 33], s[1 * 33]); o.y = pk2(s[2 * 33], s[3 * 33]); o.z = pk2(s[4 * 33], s[5 * 33]); o.w = pk2(s[6 * 33], s[7 * 33]);
        *(u32x4*)(WT + (size_t)(n0 + n) * ldo + col_off + k0 + 8 * c) = o; }
    asm volatile("s_waitcnt lgkmcnt(0)" ::: "memory");
}

__device__ __forceinline__ void p0_prologue(const Ctx& C, const Args& A) {
    LAS float* scr = (LAS float*)(C.lds + C.wave * 16384);
    const int gw = C.vcu * NWAVES + C.wave, NGW = C.G * NWAVES;
    constexpr int I_IN = (D / 64) * (INW / 32), I_BR1 = (BW / 64) * (D / 32), I_OUT = (D / 64) * (D / 32), I_UP = (D / 64) * (FF / 32), I_DN = (FF / 64) * (D / 32);
    constexpr int PER_LAYER = I_IN + 4 * I_BR1 + I_OUT + I_UP + I_DN;
    for (int it = gw; it < DEPTH * PER_LAYER; it += NGW) {
        const int l = it / PER_LAYER; int r = it % PER_LAYER;
        bf16_t* wl = (bf16_t*)(A.ws + WS_W + (size_t)l * W_LAYER);
        if (r < I_IN) { const int nb = INW / 32; transpose_item(A.in[I_WIN] + (size_t)l * D * INW, INW, A.in[I_NMIXPRE] + l * D, wl + W_IN / 2, D, 0, 64 * (r / nb), 32 * (r % nb), scr, C.lane); continue; } r -= I_IN;
        if (r < 4 * I_BR1) { const int k = r / I_BR1, rr = r % I_BR1, nb = D / 32; transpose_item(A.in[I_WBR] + ((size_t)l * 4 + k) * BW * D, D, nullptr, wl + W_BR / 2, D, k * BW, 64 * (rr / nb), 32 * (rr % nb), scr, C.lane); continue; } r -= 4 * I_BR1;
        if (r < I_OUT) { const int nb = D / 32; transpose_item(A.in[I_WOUT] + (size_t)l * D * D, D, nullptr, wl + W_OUT / 2, D, 0, 64 * (r / nb), 32 * (r % nb), scr, C.lane); continue; } r -= I_OUT;
        if (r < I_UP) { const int nb = FF / 32; transpose_item(A.in[I_WUP] + (size_t)l * D * FF, FF, A.in[I_NMLPPRE] + l * D, wl + W_UP / 2, D, 0, 64 * (r / nb), 32 * (r % nb), scr, C.lane); continue; } r -= I_UP;
        { const int nb = D / 32; transpose_item(A.in[I_WDOWN] + (size_t)l * FF * D, D, nullptr, wl + W_DOWN / 2, FF, 0, 64 * (r / nb), 32 * (r % nb), scr, C.lane); }
    }
    { const int gt = gw * 64 + C.lane; if (gt < DEPTH * BW) { const float lam = A.in[I_LLAM][gt]; ((float*)(A.ws + WS_SP8))[gt] = -8.0f * ((-lam > 20.f) ? -lam : log1pf(expf(-lam))); } }
    bf16_t* HB = (bf16_t*)(A.ws + WS_HB); float* RS = (float*)(A.ws + WS_X2);
    for (int m0 = gw; m0 < M; m0 += 4 * NGW) {
        f32x4 v[4][4];
#pragma unroll
        for (int q = 0; q < 4; ++q) { const int m = m0 + q * NGW; const f32x4* xr = (const f32x4*)(A.in[I_X] + (size_t)(m < M ? m : 0) * D) + C.lane;
#pragma unroll
            for (int j = 0; j < 4; ++j) v[q][j] = xr[64 * j]; }
#pragma unroll
        for (int q = 0; q < 4; ++q) { const int m = m0 + q * NGW; if (m < M) { float s = 0.f;
#pragma unroll
            for (int j = 0; j < 4; ++j) s += (v[q][j].x * v[q][j].x + v[q][j].y * v[q][j].y) + (v[q][j].z * v[q][j].z + v[q][j].w * v[q][j].w);
            s = wave_sum(s);
            u32x2* o8 = (u32x2*)(HB + (size_t)m * D) + C.lane;
#pragma unroll
            for (int j = 0; j < 4; ++j) { u32x2 w; w.x = pk2(v[q][j].x, v[q][j].y); w.y = pk2(v[q][j].z, v[q][j].w); o8[64 * j] = w; }
            if (C.lane == 0) *(f32x4*)(RS + (size_t)m * 4) = (f32x4){s, 0.f, 0.f, 0.f}; } }
    }
}

__device__ __forceinline__ void norm_phase(const Ctx& C, const Args& A, const bf16_t* VIN, const float* gain, bool write_out) {
    bf16_t* HB = (bf16_t*)(A.ws + WS_HB); float* RS = (float*)(A.ws + WS_X2); float* OUT = A.out;
    int lane = C.lane; asm volatile("" : "+v"(lane));
    const int gw = C.vcu * NWAVES + C.wave, NGW = C.G * NWAVES;
    f32x4 g[4];
#pragma unroll
    for (int j = 0; j < 4; ++j) g[j] = ((const f32x4*)gain)[lane + 64 * j];
    for (int m = gw; m < M; m += NGW) {
        u32x2* hb = (u32x2*)(HB + (size_t)m * D) + lane;
        const u32x2* vb = (const u32x2*)(VIN + (size_t)m * D) + lane;
        f32x4 v[4], h[4]; float s = 0.f;
#pragma unroll
        for (int j = 0; j < 4; ++j) { const u32x2 w = vb[64 * j], hw = hb[64 * j];
            v[j] = (f32x4){bf2f(w.x & 0xffffu), bf2f(w.x >> 16), bf2f(w.y & 0xffffu), bf2f(w.y >> 16)};
            h[j] = (f32x4){bf2f(hw.x & 0xffffu), bf2f(hw.x >> 16), bf2f(hw.y & 0xffffu), bf2f(hw.y >> 16)};
            s += (v[j].x * v[j].x + v[j].y * v[j].y) + (v[j].z * v[j].z + v[j].w * v[j].w); }
        const float r = 1.0f / sqrtf(wave_sum(s) * (1.0f / D) + EPS);
        float s2 = 0.f;
#pragma unroll
        for (int j = 0; j < 4; ++j) { h[j] = h[j] + g[j] * v[j] * r; s2 += (h[j].x * h[j].x + h[j].y * h[j].y) + (h[j].z * h[j].z + h[j].w * h[j].w); }
        s2 = wave_sum(s2);
        if (write_out) { f32x4* orow = (f32x4*)(OUT + (size_t)m * D) + lane;
#pragma unroll
            for (int j = 0; j < 4; ++j) orow[64 * j] = h[j]; }
        else {
#pragma unroll
            for (int j = 0; j < 4; ++j) { u32x2 w; w.x = pk2(h[j].x, h[j].y); w.y = pk2(h[j].z, h[j].w); hb[64 * j] = w; }
            if (lane == 0) *(f32x4*)(RS + (size_t)m * 4) = (f32x4){s2, 0.f, 0.f, 0.f}; }
    }
}

__device__ __forceinline__ float gelu_tanh(float x) {
    const float u = 0.7978845608028654f * (x + 0.044715f * x * x * x);
    const float e = fast_exp(2.0f * u);
    const float th = 1.0f - 2.0f * __builtin_amdgcn_rcpf(e + 1.0f);
    return 0.5f * x * (1.0f + th);
}

constexpr size_t WS_LRA = 428 * MiB, WS_LRU = 444 * MiB;
constexpr int MX_PT = 528;
__device__ __forceinline__ bf16x8 gather_wfrag(const float* w, int stride) {
    union { bf16x8 v; unsigned u[4]; } r;
#pragma unroll
    for (int p = 0; p < 4; ++p) r.u[p] = pk2(w[(2 * p) * stride], w[(2 * p + 1) * stride]);
    return r.v;
}
__device__ __forceinline__ void mix1_item(const Ctx& C, const Args& A, int l, int b, int c) {
    const bf16_t* PROJ = (const bf16_t*)(A.ws + WS_PROJ);
    bf16_t* YS = (bf16_t*)(A.ws + WS_YS);
    int tid = C.tid; asm volatile("" : "+v"(tid));
    const int lane = tid & 63, wave = C.wave, fr = lane & 15, fg = lane >> 4;
    const size_t m0 = (size_t)b * T + (size_t)c * 64;
    LAS unsigned char* XC = C.lds;
    LAS unsigned char* LAi = C.lds + 34816;
    LAS unsigned char* LUi = C.lds + 34816 + 32768;
    {
        const float* cw = A.in[I_LCW] + (size_t)l * 4 * BW; const float* cbp = A.in[I_LCB] + l * BW;
#pragma unroll
        for (int k = 0; k < 4; ++k) { const int idx = tid + NTHREADS * k; const int t = idx >> 5, c8 = (idx & 31) * 8;
            float acc[8];
            { const f32x4 b0 = *(const f32x4*)(cbp + c8), b1 = *(const f32x4*)(cbp + c8 + 4); acc[0] = b0[0]; acc[1] = b0[1]; acc[2] = b0[2]; acc[3] = b0[3]; acc[4] = b1[0]; acc[5] = b1[1]; acc[6] = b1[2]; acc[7] = b1[3]; }
#pragma unroll
            for (int j = 0; j < 4; ++j) { const int tok = c * 64 + t - 3 + j;
                if (tok >= 0) { float x[8]; ld8bf(PROJ + ((size_t)b * T + tok) * NMIX + c8, x); const f32x4 w0 = *(const f32x4*)(cw + j * BW + c8), w1 = *(const f32x4*)(cw + j * BW + c8 + 4);
                    acc[0] += w0[0] * x[0]; acc[1] += w0[1] * x[1]; acc[2] += w0[2] * x[2]; acc[3] += w0[3] * x[3]; acc[4] += w1[0] * x[4]; acc[5] += w1[1] * x[5]; acc[6] += w1[2] * x[6]; acc[7] += w1[3] * x[7]; } }
            u32x4 w; w.x = cvt_pk_bf16(acc[0], acc[1]); w.y = cvt_pk_bf16(acc[2], acc[3]); w.z = cvt_pk_bf16(acc[4], acc[5]); w.w = cvt_pk_bf16(acc[6], acc[7]);
            *(LAS u32x4*)(XC + t * MX_PT + c8 * 2) = w; }
    }
    __syncthreads();
    {
        const int blk = wave;
        const float* wa = A.in[I_LWA] + (((size_t)l * 8 + blk) * 32) * 32; const float* wx = A.in[I_LWX] + (((size_t)l * 8 + blk) * 32) * 32;
        bf16x8 fa[2], fx[2];
#pragma unroll
        for (int nt = 0; nt < 2; ++nt) { fa[nt] = gather_wfrag(wa + (8 * fg) * 32 + 16 * nt + fr, 32); fx[nt] = gather_wfrag(wx + (8 * fg) * 32 + 16 * nt + fr, 32); }
        bf16_t* LRA = (bf16_t*)(A.ws + WS_LRA); bf16_t* LRU = (bf16_t*)(A.ws + WS_LRU);
#pragma unroll
        for (int nt = 0; nt < 2; ++nt) { const int ch = 32 * blk + 16 * nt + 4 * fg;
            const f32x4 ba = *(const f32x4*)(A.in[I_LBA] + l * BW + ch), bx = *(const f32x4*)(A.in[I_LBX] + l * BW + ch), sp8 = *(const f32x4*)((const float*)(A.ws + WS_SP8) + l * BW + ch);
#pragma unroll
            for (int mt = 0; mt < 4; ++mt) { const int tok = 16 * mt + fr;
                const bf16x8 bxc = *(const LAS bf16x8*)(XC + tok * MX_PT + (32 * blk + 8 * fg) * 2);
                f32x4 ar = {0.f, 0.f, 0.f, 0.f}, ai = {0.f, 0.f, 0.f, 0.f};
                ar = __builtin_amdgcn_mfma_f32_16x16x32_bf16(fa[nt], bxc, ar, 0, 0, 0); ai = __builtin_amdgcn_mfma_f32_16x16x32_bf16(fx[nt], bxc, ai, 0, 0, 0);
                const u32x2 xw = *(const LAS u32x2*)(XC + tok * MX_PT + ch * 2);
                const float xc[4] = {bf2f(xw.x & 0xffffu), bf2f(xw.x >> 16), bf2f(xw.y & 0xffffu), bf2f(xw.y >> 16)};
                float la[4], uu[4];
#pragma unroll
                for (int r = 0; r < 4; ++r) { const float rg = sigmoid_f(ar[r] + ba[r]), ig = sigmoid_f(ai[r] + bx[r]);
                    la[r] = sp8[r] * rg; const float x2 = 2.0f * la[r];
                    const float om = (x2 > -0.02f) ? -x2 * (1.0f + 0.5f * x2 * (1.0f + x2 * (1.0f / 3.0f))) : 1.0f - fast_exp(x2);
                    uu[r] = sqrtf(om) * ig * xc[r]; }
                u32x2 wl, wu; wl.x = cvt_pk_bf16(la[0], la[1]); wl.y = cvt_pk_bf16(la[2], la[3]); wu.x = cvt_pk_bf16(uu[0], uu[1]); wu.y = cvt_pk_bf16(uu[2], uu[3]);
                *(LAS u32x2*)(LAi + tok * 512 + ch * 2) = wl; *(LAS u32x2*)(LUi + tok * 512 + ch * 2) = wu;
                *(u32x2*)(LRA + (m0 + tok) * BW + ch) = wl; *(u32x2*)(LRU + (m0 + tok) * BW + ch) = wu; }
        }
    }
    __syncthreads();
    {
        const int ch = tid & 255, half = tid >> 8; float P = 1.f, hst = 0.f;
#pragma unroll
        for (int i = 0; i < 32; ++i) { const int t = 32 * half + i; const float a = fast_exp(bf2f(*(const LAS bf16_t*)(LAi + t * 512 + ch * 2))); const float u = bf2f(*(const LAS bf16_t*)(LUi + t * 512 + ch * 2));
            hst = a * hst + u; P *= a; }
        const size_t aggi = ((size_t)b * 128 + c * 2 + half) * 256 + ch;
        ((float*)(A.ws + WS_LA))[aggi] = P; ((float*)(A.ws + WS_LH))[aggi] = hst;
    }
    __syncthreads();
    LAS unsigned char* PX = C.lds;
    LAS unsigned char* DD = C.lds + 43008;
    { u32x4 pv[5];
#pragma unroll
        for (int k = 0; k < 5; ++k) { const int idx = tid + NTHREADS * k; const int r = idx >> 5, c8 = (idx & 31) * 8; const int tok = c * 64 - 15 + r;
            pv[k] = (u32x4){0u, 0u, 0u, 0u}; if (idx < 79 * 32 && tok >= 0) pv[k] = *(const u32x4*)(PROJ + ((size_t)b * T + tok) * NMIX + 512 + c8); }
#pragma unroll
        for (int k = 0; k < 5; ++k) { const int idx = tid + NTHREADS * k; const int r = idx >> 5, c8 = (idx & 31) * 8; if (idx < 79 * 32) *(LAS u32x4*)(PX + r * MX_PT + c8 * 2) = pv[k]; } }
    __syncthreads();
#pragma unroll 1
    for (int k = 0; k < 4; ++k) { const int idx = tid + NTHREADS * k; const int t = idx >> 5, c8 = (idx & 31) * 8; const int g = c8 >> 6, win = 2 << g;
        float sum[8], x0[8];
#pragma unroll
        for (int e = 0; e < 8; ++e) sum[e] = 0.f;
        for (int j = 0; j < win; ++j) { const u32x4 v = *(const LAS u32x4*)(PX + (t + 15 - j) * MX_PT + c8 * 2);
            const float x[8] = {bf2f(v.x & 0xffffu), bf2f(v.x >> 16), bf2f(v.y & 0xffffu), bf2f(v.y >> 16), bf2f(v.z & 0xffffu), bf2f(v.z >> 16), bf2f(v.w & 0xffffu), bf2f(v.w >> 16)};
#pragma unroll
            for (int e = 0; e < 8; ++e) { sum[e] += x[e]; if (j == 0) x0[e] = x[e]; } }
        const int pos = c * 64 + t + 1; const float inv = 1.0f / (float)(pos < win ? pos : win);
        u32x4 w; w.x = cvt_pk_bf16(sum[0] * inv - x0[0], sum[1] * inv - x0[1]); w.y = cvt_pk_bf16(sum[2] * inv - x0[2], sum[3] * inv - x0[3]);
        w.z = cvt_pk_bf16(sum[4] * inv - x0[4], sum[5] * inv - x0[5]); w.w = cvt_pk_bf16(sum[6] * inv - x0[6], sum[7] * inv - x0[7]);
        *(LAS u32x4*)(DD + t * MX_PT + c8 * 2) = w; }
    __syncthreads();
    {
        const int g = wave >> 1, nb = (wave & 1) * 2;
        const float* pw = A.in[I_PW] + (((size_t)l * 4 + g) * 64) * 64;
        bf16x8 fw[2][2];
#pragma unroll
        for (int nn = 0; nn < 2; ++nn)
#pragma unroll
            for (int ks = 0; ks < 2; ++ks) fw[nn][ks] = gather_wfrag(pw + (32 * ks + 8 * fg) * 64 + 16 * (nb + nn) + fr, 64);
#pragma unroll
        for (int nn = 0; nn < 2; ++nn) { const int ch = 64 * g + 16 * (nb + nn) + 4 * fg; const f32x4 scl = *(const f32x4*)(A.in[I_PS] + l * BW + ch);
#pragma unroll
            for (int mt = 0; mt < 4; ++mt) { const int tok = 16 * mt + fr; f32x4 acc = {0.f, 0.f, 0.f, 0.f};
#pragma unroll
                for (int ks = 0; ks < 2; ++ks) { const bf16x8 bd = *(const LAS bf16x8*)(DD + tok * MX_PT + (64 * g + 32 * ks + 8 * fg) * 2); acc = __builtin_amdgcn_mfma_f32_16x16x32_bf16(fw[nn][ks], bd, acc, 0, 0, 0); }
                u32x2 w; w.x = cvt_pk_bf16(acc[0] * scl[0], acc[1] * scl[1]); w.y = cvt_pk_bf16(acc[2] * scl[2], acc[3] * scl[3]);
                *(u32x2*)(YS + (m0 + tok) * D + 256 + ch) = w; } }
    }
    {
        const float* sw = A.in[I_SW] + (size_t)l * 3 * BW;
#pragma unroll 2
        for (int k = 0; k < 4; ++k) { const int idx = tid + NTHREADS * k; const int t = idx >> 5, c8 = (idx & 31) * 8;
            float acc[8];
#pragma unroll
            for (int e = 0; e < 8; ++e) acc[e] = 0.f;
#pragma unroll
            for (int j = 0; j < 3; ++j) { const int tok = c * 64 + t - 2 + j;
                if (tok >= 0) { const bf16_t* p = PROJ + ((size_t)b * T + tok) * NMIX; float sc[8], sx[8]; ld8bf(p + 2048 + c8, sc); ld8bf(p + 2304 + c8, sx);
                    const f32x4 w0 = *(const f32x4*)(sw + j * BW + c8), w1 = *(const f32x4*)(sw + j * BW + c8 + 4);
                    acc[0] += w0[0] * sc[0] * sx[0]; acc[1] += w0[1] * sc[1] * sx[1]; acc[2] += w0[2] * sc[2] * sx[2]; acc[3] += w0[3] * sc[3] * sx[3];
                    acc[4] += w1[0] * sc[4] * sx[4]; acc[5] += w1[1] * sc[5] * sx[5]; acc[6] += w1[2] * sc[6] * sx[6]; acc[7] += w1[3] * sc[7] * sx[7]; } }
            float sb[8]; ld8bf(PROJ + (m0 + t) * NMIX + 1792 + c8, sb);
            u32x4 w; w.x = cvt_pk_bf16(sb[0] * acc[0], sb[1] * acc[1]); w.y = cvt_pk_bf16(sb[2] * acc[2], sb[3] * acc[3]); w.z = cvt_pk_bf16(sb[4] * acc[4], sb[5] * acc[5]); w.w = cvt_pk_bf16(sb[6] * acc[6], sb[7] * acc[7]);
            *(u32x4*)(YS + (m0 + t) * D + 768 + c8) = w; }
    }
    __syncthreads();
}
__device__ __forceinline__ void lru_final_item(const Ctx& C, const Args& A, int l, int b, int c) {
    const bf16_t* PROJ = (const bf16_t*)(A.ws + WS_PROJ);
    const bf16_t* LRA = (const bf16_t*)(A.ws + WS_LRA); const bf16_t* LRU = (const bf16_t*)(A.ws + WS_LRU);
    bf16_t* YS = (bf16_t*)(A.ws + WS_YS);
    int tid = C.tid; asm volatile("" : "+v"(tid));
    const int ch = tid & 255, half = tid >> 8;
    const size_t m0 = (size_t)b * T + (size_t)c * 64 + 32 * half;
    float hst = ((const float*)(A.ws + WS_LC))[((size_t)b * 128 + c * 2 + half) * 256 + ch];
    unsigned short la[32], lu[32], lg[32];
#pragma unroll
    for (int i = 0; i < 32; ++i) { la[i] = LRA[(m0 + i) * BW + ch]; lu[i] = LRU[(m0 + i) * BW + ch]; lg[i] = PROJ[(m0 + i) * NMIX + 256 + ch]; }
#pragma unroll
    for (int i = 0; i < 32; ++i) { const float a = fast_exp(bf2f(la[i])), u = bf2f(lu[i]);
        hst = a * hst + u;
        YS[(m0 + i) * D + ch] = (bf16_t)f2bf(hst * gelu_tanh(bf2f(lg[i]))); }
}

constexpr int HG_PT = 144;
constexpr int HG_IMG = 64 * HG_PT;
constexpr int HG_Q = 0, HG_K = HG_IMG, HG_P = 2 * HG_IMG, HG_BEND = 3 * HG_IMG, HG_REF = HG_BEND + 512, HG_HSZ = 29696;
constexpr size_t WS_ST16 = WS_MERGED + 32 * MiB;
__device__ __forceinline__ float hgrn_lb(const Args& A, int l, int w) {
    if (l == 0) return 0.f;
    const float a0 = A.in[I_HLB][w], a1 = A.in[I_HLB][BW + w];
    return 1.0f / (1.0f + expf(a0 - a1));
}
template <bool FINAL>
__device__ __forceinline__ void hgrn_item(const Ctx& C, const Args& A, int l, int b, int c) {
    const bf16_t* PROJ = (const bf16_t*)(A.ws + WS_PROJ);
    int lane = C.lane; asm volatile("" : "+v"(lane));
    const int wave = C.wave, h = wave >> 1, half = wave & 1, fr = lane & 15, fg = lane >> 4;
    LAS unsigned char* hb = C.lds + h * HG_HSZ;
    LAS float* BEND = (LAS float*)(hb + HG_BEND); LAS float* REF = (LAS float*)(hb + HG_REF);
    const size_t m0 = (size_t)b * T + (size_t)c * 64;
    const bf16_t* pr = PROJ + (m0 + 32 * half) * NMIX + h * 64 + lane;
    const int bh = b * 4 + h; const size_t ci = (size_t)bh * 64 + c;
    float bb[32], kk[32], vv[32];
    {
        const float lbv = hgrn_lb(A, l, h * 64 + lane);
        float acc = 0.f;
#pragma unroll
        for (int i = 0; i < 32; ++i) { const float x = bf2f(pr[(size_t)i * NMIX + 1024]); const float f = fmaxf(lbv + (1.0f - lbv) * sigmoid_f(x), 1e-30f);
            acc += __logf(f); bb[i] = acc; kk[i] = 1.0f - f; }
#pragma unroll
        for (int i = 0; i < 32; ++i) vv[i] = bf2f(pr[(size_t)i * NMIX + 1280]);
        BEND[half * 64 + lane] = acc;
    }
    __syncthreads();
    const float bend0 = BEND[lane], blast = bend0 + BEND[64 + lane];
    if (half) {
#pragma unroll
        for (int i = 0; i < 32; ++i) bb[i] += bend0;
    }
    if (!FINAL) {
        LAS unsigned char* kt = hb + HG_K + lane * HG_PT + 64 * half; LAS unsigned char* vt = hb + HG_Q + lane * HG_PT + 64 * half;
#pragma unroll
        for (int q4 = 0; q4 < 4; ++q4) { u32x4 wk, wv; unsigned kw[4], vw[4];
#pragma unroll
            for (int p = 0; p < 4; ++p) { const int i = q4 * 8 + 2 * p;
                kw[p] = cvt_pk_bf16(kk[i] * fast_exp(blast - bb[i]), kk[i + 1] * fast_exp(blast - bb[i + 1])); vw[p] = cvt_pk_bf16(vv[i], vv[i + 1]); }
            wk.x = kw[0]; wk.y = kw[1]; wk.z = kw[2]; wk.w = kw[3]; wv.x = vw[0]; wv.y = vw[1]; wv.z = vw[2]; wv.w = vw[3];
            *(LAS u32x4*)(kt + q4 * 16) = wk; *(LAS u32x4*)(vt + q4 * 16) = wv; }
        if (half == 0) ((float*)(A.ws + WS_SD))[ci * 64 + lane] = fast_exp(blast);
        __syncthreads();
        float* su = (float*)(A.ws + WS_SU) + ci * 4096;
#pragma unroll
        for (int aa = 0; aa < 2; ++aa) { const int a = 2 * half + aa;
            bf16x8 av[2];
#pragma unroll
            for (int ks = 0; ks < 2; ++ks) av[ks] = *(const LAS bf16x8*)(hb + HG_Q + (16 * a + fr) * HG_PT + 64 * ks + 16 * fg);
#pragma unroll
            for (int d = 0; d < 4; ++d) { f32x4 acc = {0.f, 0.f, 0.f, 0.f};
#pragma unroll
                for (int ks = 0; ks < 2; ++ks) { const bf16x8 bk = *(const LAS bf16x8*)(hb + HG_K + (16 * d + fr) * HG_PT + 64 * ks + 16 * fg);
                    acc = __builtin_amdgcn_mfma_f32_16x16x32_bf16(av[ks], bk, acc, 0, 0, 0); }
#pragma unroll
                for (int r = 0; r < 4; ++r) su[(16 * a + 4 * fg + r) * 64 + 16 * d + fr] = acc[r];
            } }
        __syncthreads();
    } else {
        float qq[32];
#pragma unroll
        for (int i = 0; i < 32; ++i) qq[i] = bf2f(pr[(size_t)i * NMIX + 768]);
        if (half == 0) { REF[64 + lane] = bb[15]; REF[128 + lane] = bb[31]; } else REF[192 + lane] = bb[15];
        { const u32x4 z = {0u, 0u, 0u, 0u};
#pragma unroll
            for (int k2 = 0; k2 < 5; ++k2) { const int idx = lane + 64 * k2; if (idx < 32 * 9) *(LAS u32x4*)(hb + HG_P + 32 * half * HG_PT + idx * 16) = z; } }
        __syncthreads();
        float rf[4]; rf[0] = 0.f; rf[1] = REF[64 + lane]; rf[2] = REF[128 + lane]; rf[3] = REF[192 + lane];
        {
            const float r_lo = half ? rf[2] : rf[0], r_hi = half ? rf[3] : rf[1];
#pragma unroll
            for (int i = 0; i < 32; ++i) { const float rr = (i < 16) ? r_lo : r_hi; const float val = qq[i] * fast_exp(bb[i] - rr);
                *(LAS bf16_t*)(hb + HG_Q + (32 * half + i) * HG_PT + 2 * lane) = (bf16_t)f2bf(val); }
        }
#pragma unroll
        for (int isub = 0; isub < 4; ++isub) {
            const int nrows = 16 * (isub + 1) - 32 * half;
#pragma unroll
            for (int i = 0; i < 32; ++i) { if (i < nrows) { const float e = fminf(rf[isub] - bb[i], 60.f); const float val = kk[i] * fast_exp(e);
                    *(LAS bf16_t*)(hb + HG_K + (32 * half + i) * HG_PT + 2 * lane) = (bf16_t)f2bf(val); } }
            __syncthreads();
            {
                bf16x8 bq[2];
#pragma unroll
                for (int ks = 0; ks < 2; ++ks) bq[ks] = *(const LAS bf16x8*)(hb + HG_Q + (16 * isub + fr) * HG_PT + 64 * ks + 16 * fg);
#pragma unroll
                for (int j = 0; j <= isub; ++j) { if ((j & 1) == half) {
                        f32x4 acc = {0.f, 0.f, 0.f, 0.f};
#pragma unroll
                        for (int ks = 0; ks < 2; ++ks) { const bf16x8 ak = *(const LAS bf16x8*)(hb + HG_K + (16 * j + fr) * HG_PT + 64 * ks + 16 * fg);
                            acc = __builtin_amdgcn_mfma_f32_16x16x32_bf16(ak, bq[ks], acc, 0, 0, 0); }
                        if (j == isub) {
#pragma unroll
                            for (int r = 0; r < 4; ++r) if (4 * fg + r > fr) acc[r] = 0.f; }
                        u32x2 w; w.x = cvt_pk_bf16(acc[0], acc[1]); w.y = cvt_pk_bf16(acc[2], acc[3]);
                        *(LAS u32x2*)(hb + HG_P + (16 * isub + fr) * HG_PT + 2 * (16 * j + 4 * fg)) = w;
                    } }
            }
            __syncthreads();
        }
        {
            LAS unsigned char* vt = hb + HG_Q + lane * HG_PT + 64 * half;
#pragma unroll
            for (int q4 = 0; q4 < 4; ++q4) { u32x4 wv; unsigned vw[4];
#pragma unroll
                for (int p = 0; p < 4; ++p) { const int i = q4 * 8 + 2 * p; vw[p] = cvt_pk_bf16(vv[i], vv[i + 1]); }
                wv.x = vw[0]; wv.y = vw[1]; wv.z = vw[2]; wv.w = vw[3]; *(LAS u32x4*)(vt + q4 * 16) = wv; }
#pragma unroll
            for (int i = 0; i < 32; ++i) *(LAS bf16_t*)(hb + HG_K + (32 * half + i) * HG_PT + 2 * lane) = (bf16_t)f2bf(qq[i] * fast_exp(bb[i]));
        }
        __syncthreads();
        {
            const bf16_t* st = (const bf16_t*)(A.ws + WS_ST16) + ci * 4096;
            bf16x8 a_st[4][2];
#pragma unroll
            for (int a = 0; a < 4; ++a)
#pragma unroll
                for (int ks = 0; ks < 2; ++ks) a_st[a][ks] = *(const bf16x8*)(st + (16 * a + fr) * 64 + 32 * ks + 8 * fg);
            bf16_t* YS = (bf16_t*)(A.ws + WS_YS);
            const float* gn = A.in[I_HN] + l * 64;
#pragma unroll
            for (int tt = 0; tt < 2; ++tt) { const int ti = 2 * half + tt;
                bf16x8 bp[2], bqb[2];
#pragma unroll
                for (int ks = 0; ks < 2; ++ks) { bp[ks] = *(const LAS bf16x8*)(hb + HG_P + (16 * ti + fr) * HG_PT + 64 * ks + 16 * fg); bqb[ks] = *(const LAS bf16x8*)(hb + HG_K + (16 * ti + fr) * HG_PT + 64 * ks + 16 * fg); }
                f32x4 o[4]; float ss = 0.f;
#pragma unroll
                for (int a = 0; a < 4; ++a) { f32x4 acc = {0.f, 0.f, 0.f, 0.f};
#pragma unroll
                    for (int ks = 0; ks < 2; ++ks) { const bf16x8 av = *(const LAS bf16x8*)(hb + HG_Q + (16 * a + fr) * HG_PT + 64 * ks + 16 * fg);
                        acc = __builtin_amdgcn_mfma_f32_16x16x32_bf16(av, bp[ks], acc, 0, 0, 0);
                        acc = __builtin_amdgcn_mfma_f32_16x16x32_bf16(a_st[a][ks], bqb[ks], acc, 0, 0, 0); }
                    o[a] = acc; ss += (acc[0] * acc[0] + acc[1] * acc[1]) + (acc[2] * acc[2] + acc[3] * acc[3]); }
                ss += __shfl_xor(ss, 16); ss += __shfl_xor(ss, 32);
                const float rn = 1.0f / sqrtf(ss * (1.0f / 64.0f) + EPS);
                const size_t row = m0 + 16 * ti + fr;
#pragma unroll
                for (int a = 0; a < 4; ++a) { const int dv = 16 * a + 4 * fg;
                    const u32x2 gw = *(const u32x2*)(PROJ + row * NMIX + 1536 + h * 64 + dv);
                    const float g0 = bf2f(gw.x & 0xffffu), g1 = bf2f(gw.x >> 16), g2 = bf2f(gw.y & 0xffffu), g3 = bf2f(gw.y >> 16);
                    const f32x4 gv = *(const f32x4*)(gn + dv);
                    const float y0 = o[a][0] * rn * gv[0] * (g0 * sigmoid_f(g0)), y1 = o[a][1] * rn * gv[1] * (g1 * sigmoid_f(g1));
                    const float y2 = o[a][2] * rn * gv[2] * (g2 * sigmoid_f(g2)), y3 = o[a][3] * rn * gv[3] * (g3 * sigmoid_f(g3));
                    u32x2 w; w.x = cvt_pk_bf16(y0, y1); w.y = cvt_pk_bf16(y2, y3);
                    *(u32x2*)(YS + row * D + 512 + h * 64 + dv) = w; }
            }
        }
        __syncthreads();
    }
}

__device__ __forceinline__ void mix_phase2(const Ctx& C, const Args& A) {
    float* __restrict__ SU = (float*)(A.ws + WS_SU); const float* __restrict__ SD = (const float*)(A.ws + WS_SD);
    int tid_ = C.tid; asm volatile("" : "+v"(tid_));
    const int gt = C.vcu * NTHREADS + tid_, NGT = C.G * NTHREADS;
    for (int e = gt; e < 32 * 4096; e += NGT) {
        const int bh = e >> 12, kv = e & 4095, dk = kv & 63;
        bf16_t* __restrict__ ST16 = (bf16_t*)(A.ws + WS_ST16);
        float s = 0.f;
#pragma unroll 32
        for (int c = 0; c < 64; ++c) { const size_t ci = (size_t)bh * 64 + c; const float u = SU[ci * 4096 + kv]; const float d = SD[ci * 64 + dk]; ST16[ci * 4096 + kv] = (bf16_t)f2bf(s); s = d * s + u; }
    }
    const float* __restrict__ LA = (const float*)(A.ws + WS_LA); const float* __restrict__ LH = (const float*)(A.ws + WS_LH); float* __restrict__ LC = (float*)(A.ws + WS_LC);
    for (int e = gt; e < BATCH * BW; e += NGT) {
        const int b = e >> 8, ch = e & 255; float cr = 0.f;
#pragma unroll 32
        for (int sc = 0; sc < 128; ++sc) { const size_t i = ((size_t)b * 128 + sc) * 256 + ch; const float a = LA[i], hh = LH[i]; LC[i] = cr; cr = a * cr + hh; }
    }
}

#define XB_TMO      128
#define XB_XCNT(j)  (256  + 64 * (j))
#define XB_XSUB(j)  (1280 + 64 * (j))
#define XB_XGEN(j)  (2304 + 64 * (j))
#define XB_TOP      3328
#define XB_TOPGEN   3392
#define XCD_BAR_WORDS 3456
#define XB_SPIN_CAP (1u << 20)
__device__ __forceinline__ unsigned xb_ld(unsigned* p)              { return __hip_atomic_load(p, __ATOMIC_RELAXED, __HIP_MEMORY_SCOPE_AGENT); }
__device__ __forceinline__ unsigned xb_add(unsigned* p, unsigned v) { return __hip_atomic_fetch_add(p, v, __ATOMIC_RELAXED, __HIP_MEMORY_SCOPE_AGENT); }
__device__ __forceinline__ unsigned xb_xcc_id() { return (unsigned)__builtin_amdgcn_s_getreg((3 << 11) | 20) & 0xFu; }
#define XB_SPIN(cond, bar) do { unsigned _sp = 0; while (cond) { __builtin_amdgcn_s_sleep(1); \
    if ((++_sp & 255u) == 0u) { if (xb_ld(&(bar)[XB_TMO])) break; if (_sp > XB_SPIN_CAP) { atomicAdd(&(bar)[XB_TMO], 1u); break; } } } } while (0)
struct XcdBarrier { unsigned* bar; unsigned x; volatile LAS unsigned* st; };
__device__ __forceinline__ XcdBarrier xcd_barrier_post(unsigned* bar, volatile LAS unsigned* st) {
    XcdBarrier b; b.bar = bar; b.x = xb_xcc_id(); b.st = st;
    if (threadIdx.x == 0) (void)xb_add(&bar[XB_XCNT(b.x)], 1u);
    return b;
}
__device__ __forceinline__ void xcd_barrier_complete(unsigned* bar, unsigned x, unsigned& nloc, unsigned& nx) {
    const unsigned G = gridDim.x * gridDim.y * gridDim.z;
    unsigned sum, cnt, mine, sp = 0u;
    for (;;) {
        sum = 0u; cnt = 0u; mine = 0u;
#pragma unroll
        for (unsigned j = 0; j < 16; ++j) { const unsigned c = xb_ld(&bar[XB_XCNT(j)]); sum += c; cnt += (c > 0u) ? 1u : 0u; mine = (j == x) ? c : mine; }
        if (sum == G) break;
        __builtin_amdgcn_s_sleep(1);
        if ((++sp & 255u) == 0u) { if (xb_ld(&bar[XB_TMO])) break; if (sp > XB_SPIN_CAP) { atomicAdd(&bar[XB_TMO], 1u); break; } }
    }
    nloc = mine > 0u ? mine : 1u; nx = cnt > 0u ? cnt : 1u;
}
__device__ __forceinline__ void xcd_barrier(const XcdBarrier& b) {
    asm volatile("s_waitcnt vmcnt(0)" ::: "memory");
    __syncthreads();
    if (threadIdx.x == 0) {
        unsigned* bar = b.bar;
        __builtin_amdgcn_s_waitcnt(0);
        unsigned nloc = b.st[0], nx = b.st[1];
        if (nloc == 0u) { xcd_barrier_complete(bar, b.x, nloc, nx); b.st[0] = nloc; b.st[1] = nx; }
        const unsigned old = xb_add(&bar[XB_XSUB(b.x)], 1u);
        const unsigned gen = old / nloc;
        if (old + 1u == (gen + 1u) * nloc) {
            __builtin_amdgcn_fence(__ATOMIC_RELEASE, "agent");
            asm volatile("s_waitcnt vmcnt(0)" ::: "memory");
            const unsigned og = xb_add(&bar[XB_TOP], 1u);
            const unsigned tg = og / nx;
            if (og + 1u == (tg + 1u) * nx) xb_add(&bar[XB_TOPGEN], 1u);
            else XB_SPIN(xb_ld(&bar[XB_TOPGEN]) == tg, bar);
            __builtin_amdgcn_fence(__ATOMIC_ACQUIRE, "agent");
            xb_add(&bar[XB_XGEN(b.x)], 1u);
            asm volatile("s_waitcnt vmcnt(0)" ::: "memory");
        } else {
            XB_SPIN(xb_ld(&bar[XB_XGEN(b.x)]) == gen, bar);
            __builtin_amdgcn_fence(__ATOMIC_ACQUIRE, "agent");
            asm volatile("s_waitcnt vmcnt(0)" ::: "memory");
        }
    }
    __syncthreads();
}

constexpr int PH_PER_LAYER = 10, N_PHASES = 1 + DEPTH * PH_PER_LAYER;
constexpr int CW_BAR = 4096;
constexpr int CW_SEAM = 16384;

__global__ void __launch_bounds__(NTHREADS, 2) trunk_fwd(Args args) {
    extern __shared__ __attribute__((aligned(16))) unsigned char lds_raw[];
    Ctx C;
    C.lds = (LAS unsigned char*)lds_raw; C.tid = threadIdx.x; C.lane = C.tid & 63; C.wave = __builtin_amdgcn_readfirstlane(C.tid >> 6);
    C.G = gridDim.x; { const int bx = blockIdx.x; C.vcu = (C.G % 8 == 0) ? (bx % 8) * (C.G / 8) + bx / 8 : bx; }
    unsigned char* ws = args.ws;
    volatile LAS unsigned* MISC = (volatile LAS unsigned*)(C.lds + MISC_OFF);
    if (C.tid < 64) MISC[C.tid] = 0u;
    __syncthreads();
#if MK_PER_PHASE
#define GRID_BAR() do { } while (0)
#else
    cg::grid_group grid = cg::this_grid();
    XcdBarrier bar = xcd_barrier_post((unsigned*)(ws + WS_CTL) + CW_BAR, MISC + 8);
    bool first_bar = true;
#define GRID_BAR() do { if (first_bar) { grid.sync(); first_bar = false; } else { xcd_barrier(bar); } } while (0)
#endif
    const int lo = args.ph_lo, hi = args.ph_hi;
    int ph = 0;
#define PHASE_BEGIN if (ph >= lo && ph < hi) { for (int rep_ = 0; rep_ < (((DBG_REPEAT >> ((ph - 1) % PH_PER_LAYER + 1)) & 1) && ph > 0 ? 2 : 1); ++rep_) {
#define PHASE_END   if (rep_ == 0 && (((DBG_REPEAT >> ((ph - 1) % PH_PER_LAYER + 1)) & 1) && ph > 0)) GRID_BAR(); } if (ph + 1 < hi && ph + 1 < N_PHASES) GRID_BAR(); } ++ph;

    PHASE_BEGIN p0_prologue(C, args); PHASE_END

    for (int li = 0; li < DEPTH; ++li) {
        int l = li; asm volatile("" : "+s"(l));
        const unsigned char* wl = ws + WS_W + (size_t)l * W_LAYER;
        const float* RS = (const float*)(ws + WS_X2);
        PHASE_BEGIN {
            pg8::StaticOrder S; S.init(ws + WS_HB, wl + W_IN, M, NMIX, D, C.G, (int)blockIdx.x);
            pg8::EpiRow<1> E{(bf16_t*)(ws + WS_PROJ), NMIX, RS};
            pg8::gemm_phase<pg8::EpiRow<1>, pg8::StaticOrder, true>(C.lds, D, S, E);
        } PHASE_END
        PHASE_BEGIN {
            for (int item = C.vcu; item < BATCH * 64; item += C.G) { const int b = item >> 6, c = item & 63;
                mix1_item(C, args, l, b, c);
                hgrn_item<false>(C, args, l, b, c); }
        } PHASE_END
        PHASE_BEGIN {
            mix_phase2(C, args);
            int lane = C.lane; asm volatile("" : "+v"(lane));
            const int gw = C.vcu * NWAVES + C.wave, NGW = C.G * NWAVES;
            for (int m = gw; m < M; m += NGW) quant_row_i8((const bf16_t*)(ws + WS_HB) + (size_t)m * D, (signed char*)(ws + WS_HB8) + (size_t)m * D, (float*)(ws + WS_SA) + m, lane);
            for (int n = gw; n < NGATE; n += NGW) quant_row_i8((const bf16_t*)(wl + W_IN) + (size_t)(NMIX + n) * D, (signed char*)(ws + WS_WG8) + ((size_t)l * NGATE + n) * D, (float*)(ws + WS_SBG) + l * NGATE + n, lane);
        } PHASE_END
        PHASE_BEGIN {
            for (int item = C.vcu; item < BATCH * 64; item += C.G) { const int b = item >> 6, c = item & 63;
                lru_final_item(C, args, l, b, c);
                hgrn_item<true>(C, args, l, b, c); }
        } PHASE_END
        PHASE_BEGIN {
            unsigned char* gt = (unsigned char*)(ws + WS_G) + (size_t)blockIdx.x * 8 * 65536;
            {
                pg8::GateOrder8 S{(const char*)(ws + WS_HB8), (const char*)(ws + WS_WG8) + (size_t)l * NGATE * D, C.G, C.vcu};
                pg8::EpiGate8 E{gt, RS, (const float*)(ws + WS_SA), (const float*)(ws + WS_SBG) + l * NGATE};
                pg8::gemm_phase<pg8::EpiGate8, pg8::GateOrder8, true, true>(C.lds, D / 2, S, E);
            }
            {
                pg8::MergeOrder S{(const char*)(ws + WS_YS), (const char*)(wl + W_BR), C.G, C.vcu};
                pg8::EpiGate E{gt, (bf16_t*)(ws + WS_MERGED), RS};
                pg8::gemm_phase<pg8::EpiGate, pg8::MergeOrder, true>(C.lds, D, S, E);
            }
        } PHASE_END
        const bool fused_norm = (C.G == 256) && !MK_PER_PHASE;
        if (fused_norm) {
            PHASE_BEGIN {
                { const int half = 0;
                    pg8::PanelOrder S{(const char*)(ws + WS_MERGED), (const char*)(wl + W_OUT), (size_t)pg8::BM * D * 2, D / pg8::BK, half, C.vcu};
                    pg8::EpiNorm E{(bf16_t*)(ws + WS_HB), nullptr, args.in[I_NMIXPOST] + l * D, (float*)(ws + WS_X1), (float*)(ws + WS_X2), (unsigned*)(ws + WS_CTL) + CW_SEAM + (size_t)(l * 2 + 0) * 128 * 64, (unsigned*)(ws + WS_CTL) + 8, C.lds + 131072};
                    pg8::gemm_phase<pg8::EpiNorm, pg8::PanelOrder, true>(C.lds, D, S, E);
                }
            } PHASE_END
            ++ph;
        } else {
        PHASE_BEGIN {
            pg8::StaticOrder S; S.init(ws + WS_MERGED, wl + W_OUT, M, D, D, C.G, (int)blockIdx.x);
            pg8::EpiRow<0> E{(bf16_t*)(ws + WS_MIX), D, nullptr};
            pg8::gemm_phase<pg8::EpiRow<0>, pg8::StaticOrder, true>(C.lds, D, S, E);
        } PHASE_END
        PHASE_BEGIN norm_phase(C, args, (const bf16_t*)(ws + WS_MIX), args.in[I_NMIXPOST] + l * D, false); PHASE_END
        }
        PHASE_BEGIN {
            pg8::StaticOrder S; S.init(ws + WS_HB, wl + W_UP, M, FF, D, C.G, (int)blockIdx.x);
            pg8::EpiRow<2> E{(bf16_t*)(ws + WS_HID), FF, RS};
            pg8::gemm_phase<pg8::EpiRow<2>, pg8::StaticOrder, true>(C.lds, D, S, E);
        } PHASE_END
        if (fused_norm) {
            PHASE_BEGIN {
                { const int half = 0;
                    pg8::PanelOrder S{(const char*)(ws + WS_HID), (const char*)(wl + W_DOWN), (size_t)pg8::BM * FF * 2, FF / pg8::BK, half, C.vcu};
                    pg8::EpiNorm E{(bf16_t*)(ws + WS_HB), (li == DEPTH - 1) ? args.out : nullptr, args.in[I_NMLPPOST] + l * D, (float*)(ws + WS_X1), (float*)(ws + WS_X2), (unsigned*)(ws + WS_CTL) + CW_SEAM + (size_t)(l * 2 + 1) * 128 * 64, (unsigned*)(ws + WS_CTL) + 8, C.lds + 131072};
                    pg8::gemm_phase<pg8::EpiNorm, pg8::PanelOrder, true>(C.lds, FF, S, E);
                }
            } PHASE_END
            ++ph;
        } else {
        PHASE_BEGIN {
            pg8::StaticOrder S; S.init(ws + WS_HID, wl + W_DOWN, M, D, FF, C.G, (int)blockIdx.x);
            pg8::EpiRow<0> E{(bf16_t*)(ws + WS_MOUT), D, nullptr};
            pg8::gemm_phase<pg8::EpiRow<0>, pg8::StaticOrder, true>(C.lds, FF, S, E);
        } PHASE_END
        PHASE_BEGIN norm_phase(C, args, (const bf16_t*)(ws + WS_MOUT), args.in[I_NMLPPOST] + l * D, li == DEPTH - 1); PHASE_END
        }
    }
}

extern "C" void kernel_launch(void* const* d_in, const int* in_sizes, int n_in, void* d_out, int out_size, void* d_ws, size_t ws_size, hipStream_t stream) {
    static int grid = 0;
    if (grid == 0) {
        if (n_in != 22 || in_sizes[0] != M * D || out_size != M * D || ws_size < WS_END) { fprintf(stderr, "kernel_launch: unexpected shapes (n_in %d, in0 %d, out %d, ws %zu)\n", n_in, n_in > 0 ? in_sizes[0] : -1, out_size, ws_size); grid = -1; return; }
        int dev = 0, cus = 0, per_cu = 0;
        if (hipGetDevice(&dev) != hipSuccess || hipDeviceGetAttribute(&cus, hipDeviceAttributeMultiprocessorCount, dev) != hipSuccess) { grid = -1; return; }
        if (hipFuncSetAttribute((const void*)trunk_fwd, hipFuncAttributeMaxDynamicSharedMemorySize, LDS_BYTES) != hipSuccess) { fprintf(stderr, "kernel_launch: hipFuncSetAttribute failed\n"); grid = -1; return; }
        if (hipOccupancyMaxActiveBlocksPerMultiprocessor(&per_cu, (const void*)trunk_fwd, NTHREADS, LDS_BYTES) != hipSuccess || per_cu < 1) { fprintf(stderr, "kernel_launch: occupancy query says %d blocks per CU\n", per_cu); (void)hipGetLastError(); grid = -1; return; }
        grid = cus;
    }
    if (grid < 0) return;
    (void)hipMemsetAsync((char*)d_ws + WS_CTL, 0, CTL_ZERO_BYTES, stream);
    Args a{};
    for (int i = 0; i < 22; ++i) a.in[i] = (const float*)d_in[i];
    a.out = (float*)d_out; a.ws = (unsigned char*)d_ws;
#if MK_PER_PHASE
#ifndef DBG_MAXPH
#define DBG_MAXPH N_PHASES
#endif
    for (int p = 0; p < DBG_MAXPH; ++p) { a.ph_lo = p; a.ph_hi = p + 1; hipLaunchKernelGGL(trunk_fwd, dim3(grid), dim3(NTHREADS), LDS_BYTES, stream, a); }
#else
    a.ph_lo = 0; a.ph_hi = N_PHASES;
    void* kargs[] = {&a};
    hipError_t e = hipLaunchCooperativeKernel((const void*)trunk_fwd, dim3(grid), dim3(NTHREADS), kargs, LDS_BYTES, stream);
    if (e != hipSuccess) fprintf(stderr, "kernel_launch: cooperative launch failed: %s (grid %d)\n", hipGetErrorString(e), grid);
#endif
}
```

```cpp
#include <hip/hip_runtime.h>
#include <hip/hip_cooperative_groups.h>
#include <cstdio>
#include <cstdint>
namespace cg = cooperative_groups;

#ifndef DBG_ZERO
#define DBG_ZERO -1
#endif
#ifndef DBG_REPEAT
#define DBG_REPEAT 0
#endif
#ifndef MK_PER_PHASE
#define MK_PER_PHASE 0
#endif

#define LAS __attribute__((address_space(3)))
#define GAS __attribute__((address_space(1)))
typedef unsigned short bf16_t;
typedef short bf16x8 __attribute__((ext_vector_type(8)));
typedef float f32x4 __attribute__((ext_vector_type(4)));
typedef float f32x2 __attribute__((ext_vector_type(2)));
typedef unsigned u32x4 __attribute__((ext_vector_type(4)));
typedef unsigned u32x2 __attribute__((ext_vector_type(2)));

constexpr int BATCH = 8, T = 4096, D = 1024, M = BATCH * T, DEPTH = 2, BW = 256;
constexpr int NMIX = 2560, NGATE = 4096, INW = NMIX + NGATE, FF = 4096;
constexpr float EPS = 1e-6f;
constexpr int NWAVES = 8, NTHREADS = 512;

constexpr size_t MiB = 1u << 20;
constexpr size_t WS_CTL = 0, CTL_ZERO_BYTES = 1 * MiB;
constexpr size_t WS_XM = 1 * MiB;
constexpr size_t WS_SD = 1 * MiB + 512 * 1024;
constexpr size_t WS_LA = 2 * MiB, WS_LH = 3 * MiB, WS_LC = 4 * MiB;
constexpr size_t WS_SP8 = 7 * MiB;
constexpr size_t WS_X1 = 5 * MiB;
constexpr size_t WS_X2 = 6 * MiB;
constexpr size_t WS_W = 8 * MiB;
constexpr size_t W_IN = 0, W_BR = 13 * MiB, W_OUT = 15 * MiB, W_UP = 17 * MiB, W_DOWN = 25 * MiB, W_LAYER = 33 * MiB;
constexpr size_t WS_HB = 76 * MiB;
constexpr size_t WS_PROJ = 140 * MiB;
constexpr size_t WS_G = WS_PROJ;
constexpr size_t WS_YS = 300 * MiB;
constexpr size_t WS_MERGED = 364 * MiB;
constexpr size_t WS_SU = WS_MERGED;
constexpr size_t WS_MIX = WS_PROJ;
constexpr size_t WS_MOUT = 396 * MiB;
constexpr size_t WS_HID = WS_PROJ;
constexpr size_t WS_HB8 = 460 * MiB;
constexpr size_t WS_WG8 = 492 * MiB;
constexpr size_t WS_SA = 7 * MiB + 64 * 1024;
constexpr size_t WS_SBG = 7 * MiB + 256 * 1024;
constexpr size_t WS_SBU = 7 * MiB + 320 * 1024;
constexpr size_t WS_WU8 = 500 * MiB;
constexpr size_t WS_END = 508 * MiB;

constexpr int LDS_BYTES = 155648;
constexpr int MISC_OFF = 154624;

__device__ __forceinline__ float bf2f(unsigned b) { return __uint_as_float(b << 16); }
__device__ __forceinline__ unsigned f2bf(float f) { unsigned u = __float_as_uint(f); return (u + 0x7fffu + ((u >> 16) & 1u)) >> 16; }
__device__ __forceinline__ unsigned pk2(float lo, float hi) { return f2bf(lo) | (f2bf(hi) << 16); }
typedef __bf16 bf16x2_t __attribute__((ext_vector_type(2)));
__device__ __forceinline__ unsigned cvt_pk_bf16(float lo, float hi) { f32x2 v = {lo, hi}; bf16x2_t b = __builtin_convertvector(v, bf16x2_t); return __builtin_bit_cast(unsigned, b); }
__device__ __forceinline__ float fast_exp(float x) { return __builtin_amdgcn_exp2f(x * 1.4426950408889634f); }
__device__ __forceinline__ float sigmoid_f(float x) { return __builtin_amdgcn_rcpf(1.0f + fast_exp(-x)); }
__device__ __forceinline__ void ld8bf(const bf16_t* p, float (&o)[8]) {
    const u32x4 v = *(const u32x4*)p;
    o[0] = bf2f(v.x & 0xffffu); o[1] = bf2f(v.x >> 16); o[2] = bf2f(v.y & 0xffffu); o[3] = bf2f(v.y >> 16);
    o[4] = bf2f(v.z & 0xffffu); o[5] = bf2f(v.z >> 16); o[6] = bf2f(v.w & 0xffffu); o[7] = bf2f(v.w >> 16);
}
__device__ __forceinline__ float rs_of(const float* X2, int row) { const f32x4 x = *(const f32x4*)(X2 + (size_t)row * 4); return 1.0f / sqrtf(((x[0] + x[1]) + (x[2] + x[3])) * (1.0f / D) + EPS); }
typedef int i32x4 __attribute__((ext_vector_type(4)));
__device__ __forceinline__ void quant_row_i8(const bf16_t* src, signed char* dst, float* scale_out, int lane) {
    float x[16]; ld8bf(src + 16 * lane, *(float(*)[8])&x[0]); ld8bf(src + 16 * lane + 8, *(float(*)[8])&x[8]);
    float mx = 0.f;
#pragma unroll
    for (int j = 0; j < 16; ++j) mx = fmaxf(mx, fabsf(x[j]));
#pragma unroll
    for (int o = 1; o < 64; o <<= 1) mx = fmaxf(mx, __shfl_xor(mx, o));
    const float sc = (mx > 0.f) ? mx * (1.0f / 127.0f) : 1.0f, inv = 1.0f / sc;
    unsigned w[4];
#pragma unroll
    for (int p = 0; p < 4; ++p) { unsigned v = 0u;
#pragma unroll
        for (int e = 0; e < 4; ++e) { const int q = (int)__builtin_rintf(x[4 * p + e] * inv); v |= ((unsigned)q & 0xffu) << (8 * e); }
        w[p] = v; }
    *(u32x4*)(dst + 16 * lane) = (u32x4){w[0], w[1], w[2], w[3]};
    if (lane == 0) *scale_out = sc;
}
__device__ __forceinline__ unsigned q4_i8(const f32x4 v, float inv) { unsigned w = 0u;
#pragma unroll
    for (int e = 0; e < 4; ++e) { const int q = (int)__builtin_rintf(v[e] * inv); w |= ((unsigned)q & 0xffu) << (8 * e); }
    return w; }
__device__ __forceinline__ float wave_sum(float v) {
#pragma unroll
    for (int o = 1; o < 64; o <<= 1) v += __shfl_xor(v, o);
    return v;
}

namespace pg8 {
constexpr int BM = 256, BK = 64, HALF = 128, HTB = HALF * BK * 2, STAGE_BYTES = 8 * HTB, NXCD = 8, WGM = 4;
__host__ __device__ __forceinline__ int lds_byte(int r, int c) { const int st = (r >> 4) * 2 + (c >> 5), rr = r & 15, cc = c & 31, ob = rr * 64 + cc * 2; return st * 1024 + (ob ^ (((ob >> 9) & 1) << 5)); }
__host__ __device__ __forceinline__ void stage_rc(int b, int& R, int& C) { const int st = b / 1024, sb = b % 1024, swz = sb ^ (((sb >> 9) & 1) << 5); R = (st >> 1) * 16 + swz / 64; C = (st & 1) * 32 + (swz % 64) / 2; }
__host__ __device__ __forceinline__ int perm32(int rho) { const int n = rho >> 4, i = rho & 15; return 8 * (i >> 2) + 4 * n + (i & 3); }

struct Unit { int pm, pn, kind; };

struct StaticOrder {
    const char* A; const char* Bt; size_t tstep;
    int nM, nN, nwg, G, c;
    __device__ void init(const void* A_, const void* Bt_, int M_, int N_, int K_, int G_, int c_) { A = (const char*)A_; Bt = (const char*)Bt_; tstep = (size_t)BM * K_ * 2; nt = K_ / BK; nM = M_ / BM; nN = N_ / BM; nwg = nM * nN; G = G_; c = c_; }
    __device__ bool next(int i, Unit& u) const {
        const long L = (long)i * G + c; if (L >= nwg) return false;
        int wgid = (int)L; { const int q = nwg / NXCD, r = nwg % NXCD, xcd = wgid % NXCD, off = wgid / NXCD; wgid = (xcd < r ? xcd * (q + 1) : r * (q + 1) + (xcd - r) * q) + off; }
        const int nig = WGM * nN, gid = wgid / nig, fm = gid * WGM, gsz = (nM - fm) < WGM ? (nM - fm) : WGM;
        u.pm = fm + ((wgid % nig) % gsz); u.pn = (wgid % nig) / gsz; u.kind = 0; return true;
    }
    __device__ __forceinline__ void tiles(const Unit& u, const char*& a, const char*& b) const { a = A + (size_t)u.pm * tstep; b = Bt + (size_t)u.pn * tstep; }
    int nt;
    __device__ __forceinline__ int ntiles(const Unit&) const { return nt; }
    __device__ __forceinline__ bool keep_acc(const Unit&) const { return false; }
};

struct GateOrder {
    const char* HB; const char* WGt; const char* YS; const char* WB; int G, vcu;
    __device__ bool next(int i, Unit& u) const {
        const int r = i / 16, ii = i % 16, su = vcu + r * G; if (su >= 256) return false;
        const int half = ii / 8, j = ii % 8;
        u.pm = half * 64 + (su >> 2); u.kind = j; u.pn = (j < 4) ? (j * 4 + (su & 3)) : (su & 3); return true;
    }
    __device__ __forceinline__ int ntiles(const Unit& u) const { return u.kind < 4 ? 16 : 4; }
    __device__ __forceinline__ bool keep_acc(const Unit& nx) const { return nx.kind > 4; }
    __device__ __forceinline__ void tiles(const Unit& u, const char*& a, const char*& b) const {
        const size_t ts = (size_t)BM * 1024 * 2;
        if (u.kind < 4) { a = HB + (size_t)u.pm * ts; b = WGt + (size_t)u.pn * ts; } else { a = YS + (size_t)u.pm * ts + (size_t)(u.kind - 4) * 512; b = WB + (size_t)u.pn * ts + (size_t)(u.kind - 4) * 512; }
    }
};

struct GateOrder8 {
    const char* HB8; const char* WG8; int G, vcu;
    __device__ bool next(int i, Unit& u) const {
        const int r = i / 8, ii = i % 8, su = vcu + r * G; if (su >= 256) return false;
        u.pm = (ii >> 2) * 64 + (su >> 2); u.kind = ii; u.pn = (ii & 3) * 4 + (su & 3); return true;
    }
    __device__ __forceinline__ int ntiles(const Unit&) const { return 8; }
    __device__ __forceinline__ bool keep_acc(const Unit&) const { return false; }
    __device__ __forceinline__ void tiles(const Unit& u, const char*& a, const char*& b) const { a = HB8 + (size_t)u.pm * 262144; b = WG8 + (size_t)u.pn * 262144; }
};
struct MergeOrder {
    const char* YS; const char* WB; int G, vcu;
    __device__ bool next(int i, Unit& u) const {
        const int r = i / 8, ii = i % 8, su = vcu + r * G; if (su >= 256) return false;
        u.pm = (ii >> 2) * 64 + (su >> 2); u.kind = 4 + (ii & 3); u.pn = su & 3; return true;
    }
    __device__ __forceinline__ int ntiles(const Unit&) const { return 4; }
    __device__ __forceinline__ bool keep_acc(const Unit& nx) const { return nx.kind > 4; }
    __device__ __forceinline__ void tiles(const Unit& u, const char*& a, const char*& b) const {
        const size_t ts = (size_t)BM * 1024 * 2; a = YS + (size_t)u.pm * ts + (size_t)(u.kind - 4) * 512; b = WB + (size_t)u.pn * ts + (size_t)(u.kind - 4) * 512; }
};

template <int MODE  > struct EpiRow {
    static constexpr bool PERM = true;
    bf16_t* O; int ldc; const float* rs;
    __device__ __forceinline__ void operator()(f32x4 (&acc)[2][2][4][2], const Unit& u, int wr, int wc, int fr, int fq) const {
        const int row0 = u.pm * BM + wr * 64 + fr, col0 = u.pn * BM + wc * 32 + 8 * fq;
#pragma unroll
        for (int ai = 0; ai < 2; ++ai)
#pragma unroll
            for (int m = 0; m < 4; ++m) {
                const int row = row0 + ai * HALF + m * 16; const float sc = (MODE != 0) ? rs_of(rs, row) : 1.0f;
                bf16_t* rowp = O + (size_t)row * ldc + col0;
#pragma unroll
                for (int bj = 0; bj < 2; ++bj) {
                    f32x4 v0 = acc[ai][bj][m][0], v1 = acc[ai][bj][m][1];
                    if (MODE != 0) { v0 = v0 * sc; v1 = v1 * sc; }
                    if (MODE == 2) {
#pragma unroll
                        for (int j = 0; j < 4; ++j) { const float a = fmaxf(v0[j], 0.f), b = fmaxf(v1[j], 0.f); v0[j] = a * a; v1[j] = b * b; }
                    }
                    u32x4 w; w.x = cvt_pk_bf16(v0[0], v0[1]); w.y = cvt_pk_bf16(v0[2], v0[3]); w.z = cvt_pk_bf16(v1[0], v1[1]); w.w = cvt_pk_bf16(v1[2], v1[3]);
                    __builtin_nontemporal_store(w, (u32x4*)(rowp + bj * HALF));
                }
            }
    }
};

__device__ __forceinline__ unsigned pack_u8x4(float a, float b, float c, float d) { unsigned w = 0u;
    w = __builtin_amdgcn_cvt_pk_u8_f32(a * 256.0f - 0.5f, 0, w); w = __builtin_amdgcn_cvt_pk_u8_f32(b * 256.0f - 0.5f, 1, w); w = __builtin_amdgcn_cvt_pk_u8_f32(c * 256.0f - 0.5f, 2, w); w = __builtin_amdgcn_cvt_pk_u8_f32(d * 256.0f - 0.5f, 3, w); return w; }
__device__ __forceinline__ f32x4 unpack_u8x4(unsigned w) { return (f32x4){(float)(w & 0xffu) + 0.5f, (float)((w >> 8) & 0xffu) + 0.5f, (float)((w >> 16) & 0xffu) + 0.5f, (float)(w >> 24) + 0.5f}; }
struct EpiGate {
    static constexpr bool PERM = true;
    unsigned char* Gt;
    bf16_t* MERGED;
    const float* rs;
    __device__ __forceinline__ void rescale(f32x4 (&acc)[2][2][4][2], int hsel, int j, int wr, int wc, int fr, int fq) const {
        int lane_off = (wr * 64 + fr) * 256 + wc * 32 + 8 * fq; asm volatile("" : "+v"(lane_off));
        const unsigned char* g0 = Gt + (size_t)(hsel * 4 + j) * 65536; const unsigned char* g1 = g0 + 65536;
#pragma unroll
        for (int ai = 0; ai < 2; ++ai) {
            u32x2 a[4][2], b[4][2];
#pragma unroll
            for (int m = 0; m < 4; ++m)
#pragma unroll
                for (int bj = 0; bj < 2; ++bj) { const int off = lane_off + (ai * HALF + m * 16) * 256 + bj * HALF; a[m][bj] = *(const u32x2*)(g0 + off); b[m][bj] = *(const u32x2*)(g1 + off); }
#pragma unroll
            for (int m = 0; m < 4; ++m)
#pragma unroll
                for (int bj = 0; bj < 2; ++bj) {
                    const f32x4 a0 = unpack_u8x4(a[m][bj].x), a1 = unpack_u8x4(a[m][bj].y), b0 = unpack_u8x4(b[m][bj].x), b1 = unpack_u8x4(b[m][bj].y);
#pragma unroll
                    for (int q = 0; q < 4; ++q) { acc[ai][bj][m][0][q] *= a0[q] * __builtin_amdgcn_rcpf(b0[q]); acc[ai][bj][m][1][q] *= a1[q] * __builtin_amdgcn_rcpf(b1[q]); }
                }
            asm volatile("" ::: "memory");
        }
    }
    __device__ __forceinline__ void operator()(f32x4 (&acc)[2][2][4][2], const Unit& u, int wr, int wc, int fr, int fq) const {
        if (u.kind >= 4 && u.kind < 7) { rescale(acc, u.pm >> 6, u.kind - 4, wr, wc, fr, fq); return; }
        int rl0 = wr * 64 + fr, cl0 = wc * 32 + 8 * fq; asm volatile("" : "+v"(rl0), "+v"(cl0));
        if (u.kind < 4) {
            unsigned char* gt = Gt + (size_t)u.kind * 65536;
#pragma unroll
            for (int ai = 0; ai < 2; ++ai)
#pragma unroll
                for (int m = 0; m < 4; ++m) {
                    const int rl = rl0 + ai * HALF + m * 16; const float sc = rs_of(rs, u.pm * BM + rl);
#pragma unroll
                    for (int bj = 0; bj < 2; ++bj) {
                        f32x4 v0 = acc[ai][bj][m][0] * sc, v1 = acc[ai][bj][m][1] * sc;
#pragma unroll
                        for (int j = 0; j < 4; ++j) { v0[j] = sigmoid_f(fmaxf(v0[j], -60.f)); v1[j] = sigmoid_f(fmaxf(v1[j], -60.f)); }
                        u32x2 w; w.x = pack_u8x4(v0[0], v0[1], v0[2], v0[3]); w.y = pack_u8x4(v1[0], v1[1], v1[2], v1[3]);
                        *(u32x2*)(gt + rl * 256 + cl0 + bj * HALF) = w;
                    }
                }
        } else {
            const unsigned char* g3 = Gt + (size_t)((u.pm >> 6) * 4 + 3) * 65536;
#pragma unroll
            for (int ai = 0; ai < 2; ++ai)
#pragma unroll
                for (int m = 0; m < 4; ++m) {
                    const int rl = rl0 + ai * HALF + m * 16;
                    bf16_t* rowp = MERGED + (size_t)(u.pm * BM + rl) * 1024 + u.pn * BM + cl0;
#pragma unroll
                    for (int bj = 0; bj < 2; ++bj) {
                        const u32x2 sw = *(const u32x2*)(g3 + rl * 256 + cl0 + bj * HALF);
                        const f32x4 s0 = unpack_u8x4(sw.x) * (1.0f / 256.0f), s1 = unpack_u8x4(sw.y) * (1.0f / 256.0f);
                        const f32x4 v0 = acc[ai][bj][m][0] * s0, v1 = acc[ai][bj][m][1] * s1;
                        u32x4 w; w.x = cvt_pk_bf16(v0[0], v0[1]); w.y = cvt_pk_bf16(v0[2], v0[3]); w.z = cvt_pk_bf16(v1[0], v1[1]); w.w = cvt_pk_bf16(v1[2], v1[3]);
                        *(u32x4*)(rowp + bj * HALF) = w;
                    }
                }
        }
    }
};

struct EpiGate8 {
    static constexpr bool PERM = true;
    unsigned char* Gt;
    const float* rs; const float* sa; const float* sb;
    __device__ __forceinline__ void operator()(f32x4 (&acc)[2][2][4][2], const Unit& u, int wr, int wc, int fr, int fq) const {
        int rl0 = wr * 64 + fr, cl0 = wc * 32 + 8 * fq; asm volatile("" : "+v"(rl0), "+v"(cl0));
        unsigned char* gt = Gt + (size_t)u.kind * 65536;
        f32x4 cs[2][2];
#pragma unroll
        for (int bj = 0; bj < 2; ++bj) { cs[bj][0] = *(const f32x4*)(sb + u.pn * BM + cl0 + bj * HALF); cs[bj][1] = *(const f32x4*)(sb + u.pn * BM + cl0 + bj * HALF + 4); }
#pragma unroll
        for (int ai = 0; ai < 2; ++ai)
#pragma unroll
            for (int m = 0; m < 4; ++m) {
                const int rl = rl0 + ai * HALF + m * 16; const float sc = rs_of(rs, u.pm * BM + rl) * sa[u.pm * BM + rl];
#pragma unroll
                for (int bj = 0; bj < 2; ++bj) {
                    const i32x4 i0 = __builtin_bit_cast(i32x4, acc[ai][bj][m][0]), i1 = __builtin_bit_cast(i32x4, acc[ai][bj][m][1]);
                    f32x4 v0, v1;
#pragma unroll
                    for (int j = 0; j < 4; ++j) { v0[j] = sigmoid_f(fmaxf((float)i0[j] * (sc * cs[bj][0][j]), -60.f)); v1[j] = sigmoid_f(fmaxf((float)i1[j] * (sc * cs[bj][1][j]), -60.f)); }
                    u32x2 w; w.x = pack_u8x4(v0[0], v0[1], v0[2], v0[3]); w.y = pack_u8x4(v1[0], v1[1], v1[2], v1[3]);
                    *(u32x2*)(gt + rl * 256 + cl0 + bj * HALF) = w;
                }
            }
    }
};

struct EpiUp8 {
    static constexpr bool PERM = true;
    bf16_t* O; int ldc; const float* rs; const float* sa; const float* sb;
    __device__ __forceinline__ void operator()(f32x4 (&acc)[2][2][4][2], const Unit& u, int wr, int wc, int fr, int fq) const {
        int rl0 = wr * 64 + fr, cl0 = wc * 32 + 8 * fq; asm volatile("" : "+v"(rl0), "+v"(cl0));
        f32x4 cs[2][2];
#pragma unroll
        for (int bj = 0; bj < 2; ++bj) { cs[bj][0] = *(const f32x4*)(sb + u.pn * BM + cl0 + bj * HALF); cs[bj][1] = *(const f32x4*)(sb + u.pn * BM + cl0 + bj * HALF + 4); }
#pragma unroll
        for (int ai = 0; ai < 2; ++ai)
#pragma unroll
            for (int m = 0; m < 4; ++m) {
                const int row = u.pm * BM + rl0 + ai * HALF + m * 16; const float sc = rs_of(rs, row) * sa[row];
                bf16_t* rowp = O + (size_t)row * ldc + u.pn * BM + cl0;
#pragma unroll
                for (int bj = 0; bj < 2; ++bj) {
                    const i32x4 i0 = __builtin_bit_cast(i32x4, acc[ai][bj][m][0]), i1 = __builtin_bit_cast(i32x4, acc[ai][bj][m][1]);
                    f32x4 v0, v1;
#pragma unroll
                    for (int j = 0; j < 4; ++j) { const float a = fmaxf((float)i0[j] * (sc * cs[bj][0][j]), 0.f), b = fmaxf((float)i1[j] * (sc * cs[bj][1][j]), 0.f); v0[j] = a * a; v1[j] = b * b; }
                    u32x4 w; w.x = cvt_pk_bf16(v0[0], v0[1]); w.y = cvt_pk_bf16(v0[2], v0[3]); w.z = cvt_pk_bf16(v1[0], v1[1]); w.w = cvt_pk_bf16(v1[2], v1[3]);
                    __builtin_nontemporal_store(w, (u32x4*)(rowp + bj * HALF));
                }
            }
    }
};

struct PanelOrder {
    const char* A; const char* Bt; size_t tstep; int nt, half, vcu;
    __device__ bool next(int i, Unit& u) const { if (i > 1) return false; u.pm = i * 64 + (vcu >> 2); u.pn = vcu & 3; u.kind = 0; return true; }
    __device__ __forceinline__ void tiles(const Unit& u, const char*& a, const char*& b) const { a = A + (size_t)u.pm * tstep; b = Bt + (size_t)u.pn * tstep; }
    __device__ __forceinline__ int ntiles(const Unit&) const { return nt; }
    __device__ __forceinline__ bool keep_acc(const Unit&) const { return false; }
};
struct EpiNorm {
    static constexpr bool PERM = true;
    bf16_t* HB; float* OUTF; const float* gain; float* X1; float* X2; unsigned* cnt; unsigned* tmo; LAS unsigned char* sp;
    float* XM; unsigned* cnt2; signed char* HB8; float* SA;
    __device__ __forceinline__ void operator()(f32x4 (&acc)[2][2][4][2], const Unit& u, int wr, int wc, int fr, int fq) const {
        LAS float* P = (LAS float*)sp;
        LAS float* R = (LAS float*)(sp + 4096);
        LAS float* PM = (LAS float*)(sp + 5120);
        const int tid = (wr * 4 + wc) * 64 + fq * 16 + fr;
#pragma unroll
        for (int ai = 0; ai < 2; ++ai)
#pragma unroll
            for (int m = 0; m < 4; ++m) { float s = 0.f;
#pragma unroll
                for (int bj = 0; bj < 2; ++bj)
#pragma unroll
                    for (int n = 0; n < 2; ++n) { const f32x4 x = acc[ai][bj][m][n]; s += (x[0] * x[0] + x[1] * x[1]) + (x[2] * x[2] + x[3] * x[3]); }
                s += __shfl_xor(s, 16); s += __shfl_xor(s, 32);
                if (fq == 0) P[(ai * HALF + wr * 64 + m * 16 + fr) * 4 + wc] = s; }
        asm volatile("s_waitcnt lgkmcnt(0)" ::: "memory"); __builtin_amdgcn_s_barrier(); asm volatile("" ::: "memory");
        if (tid < 256) {
            const f32x4 p = *(const LAS f32x4*)(P + tid * 4); const float tot = (p[0] + p[1]) + (p[2] + p[3]);
            __hip_atomic_store(X1 + ((size_t)u.pm * BM + tid) * 4 + u.pn, tot, __ATOMIC_RELAXED, __HIP_MEMORY_SCOPE_AGENT);
            asm volatile("s_waitcnt vmcnt(0)" ::: "memory");
            if ((tid & 63) == 0) __hip_atomic_fetch_add(cnt + 64 * u.pm, 1u, __ATOMIC_RELAXED, __HIP_MEMORY_SCOPE_AGENT);
        }
        if (tid < 64) {
            unsigned spins = 0;
            while ((unsigned)__builtin_amdgcn_readfirstlane(__hip_atomic_load(cnt + 64 * u.pm, __ATOMIC_RELAXED, __HIP_MEMORY_SCOPE_AGENT)) < 16u) {
                __builtin_amdgcn_s_sleep(2);
                if (++spins > (1u << 22)) { if (tid == 0) __hip_atomic_store(tmo, 1u, __ATOMIC_RELAXED, __HIP_MEMORY_SCOPE_AGENT); break; } }
            __builtin_amdgcn_fence(__ATOMIC_ACQUIRE, "agent");
        }
        asm volatile("s_waitcnt vmcnt(0) lgkmcnt(0)" ::: "memory"); __builtin_amdgcn_s_barrier(); asm volatile("" ::: "memory");
        if (tid < 256) { const float* sl = X1 + ((size_t)u.pm * BM + tid) * 4; float t4[4];
#pragma unroll
            for (int t = 0; t < 4; ++t) t4[t] = __hip_atomic_load(sl + t, __ATOMIC_RELAXED, __HIP_MEMORY_SCOPE_AGENT);
            R[tid] = 1.0f / sqrtf(((t4[0] + t4[1]) + (t4[2] + t4[3])) * (1.0f / 1024.0f) + 1e-6f); }
        asm volatile("s_waitcnt vmcnt(0) lgkmcnt(0)" ::: "memory"); __builtin_amdgcn_s_barrier(); asm volatile("" ::: "memory");
        int rl0 = wr * 64 + fr, cl0 = wc * 32 + 8 * fq; asm volatile("" : "+v"(rl0), "+v"(cl0));
        f32x4 gv[2][2];
#pragma unroll
        for (int bj = 0; bj < 2; ++bj) { gv[bj][0] = *(const f32x4*)(gain + u.pn * BM + cl0 + bj * HALF); gv[bj][1] = *(const f32x4*)(gain + u.pn * BM + cl0 + bj * HALF + 4); }
#pragma unroll
        for (int ai = 0; ai < 2; ++ai)
#pragma unroll
            for (int m = 0; m < 4; ++m) { const int rl = rl0 + ai * HALF + m * 16; const float r = R[rl]; const size_t go = ((size_t)u.pm * BM + rl) * 1024 + u.pn * BM + cl0;
                float s2 = 0.f, mx = 0.f;
#pragma unroll
                for (int bj = 0; bj < 2; ++bj) { const u32x4 hw = *(const u32x4*)(HB + go + bj * HALF);
                    f32x4 h0 = {bf2f(hw.x & 0xffffu), bf2f(hw.x >> 16), bf2f(hw.y & 0xffffu), bf2f(hw.y >> 16)}, h1 = {bf2f(hw.z & 0xffffu), bf2f(hw.z >> 16), bf2f(hw.w & 0xffffu), bf2f(hw.w >> 16)};
                    h0 = h0 + gv[bj][0] * acc[ai][bj][m][0] * r; h1 = h1 + gv[bj][1] * acc[ai][bj][m][1] * r;
                    s2 += (h0[0] * h0[0] + h0[1] * h0[1]) + (h0[2] * h0[2] + h0[3] * h0[3]) + (h1[0] * h1[0] + h1[1] * h1[1]) + (h1[2] * h1[2] + h1[3] * h1[3]);
                    if (OUTF) { *(f32x4*)(OUTF + go + bj * HALF) = h0; *(f32x4*)(OUTF + go + bj * HALF + 4) = h1; }
                    else { u32x4 w; w.x = cvt_pk_bf16(h0[0], h0[1]); w.y = cvt_pk_bf16(h0[2], h0[3]); w.z = cvt_pk_bf16(h1[0], h1[1]); w.w = cvt_pk_bf16(h1[2], h1[3]); __builtin_nontemporal_store(w, (u32x4*)(HB + go + bj * HALF));
                        mx = fmaxf(fmaxf(mx, fmaxf(fmaxf(fabsf(h0[0]), fabsf(h0[1])), fmaxf(fabsf(h0[2]), fabsf(h0[3])))), fmaxf(fmaxf(fabsf(h1[0]), fabsf(h1[1])), fmaxf(fabsf(h1[2]), fabsf(h1[3]))));
                        acc[ai][bj][m][0] = h0; acc[ai][bj][m][1] = h1; } }
                s2 += __shfl_xor(s2, 16); s2 += __shfl_xor(s2, 32);
                mx = fmaxf(mx, __shfl_xor(mx, 16)); mx = fmaxf(mx, __shfl_xor(mx, 32));
                if (fq == 0) { P[rl * 4 + wc] = s2; PM[rl * 4 + wc] = mx; } }
        asm volatile("s_waitcnt lgkmcnt(0)" ::: "memory"); __builtin_amdgcn_s_barrier(); asm volatile("" ::: "memory");
        if (tid < 256) { const f32x4 p = *(const LAS f32x4*)(P + tid * 4); X2[((size_t)u.pm * BM + tid) * 4 + u.pn] = (p[0] + p[1]) + (p[2] + p[3]);
            if (!OUTF) {
                const f32x4 q = *(const LAS f32x4*)(PM + tid * 4);
                __hip_atomic_store(XM + ((size_t)u.pm * BM + tid) * 4 + u.pn, fmaxf(fmaxf(q[0], q[1]), fmaxf(q[2], q[3])), __ATOMIC_RELAXED, __HIP_MEMORY_SCOPE_AGENT);
                asm volatile("s_waitcnt vmcnt(0)" ::: "memory");
                if ((tid & 63) == 0) __hip_atomic_fetch_add(cnt2 + 64 * u.pm, 1u, __ATOMIC_RELAXED, __HIP_MEMORY_SCOPE_AGENT); } }
        if (OUTF) return;
        if (tid < 64) {
            unsigned spins = 0;
            while ((unsigned)__builtin_amdgcn_readfirstlane(__hip_atomic_load(cnt2 + 64 * u.pm, __ATOMIC_RELAXED, __HIP_MEMORY_SCOPE_AGENT)) < 16u) {
                __builtin_amdgcn_s_sleep(2);
                if (++spins > (1u << 22)) { if (tid == 0) __hip_atomic_store(tmo, 1u, __ATOMIC_RELAXED, __HIP_MEMORY_SCOPE_AGENT); break; } }
            __builtin_amdgcn_fence(__ATOMIC_ACQUIRE, "agent");
        }
        asm volatile("s_waitcnt vmcnt(0) lgkmcnt(0)" ::: "memory"); __builtin_amdgcn_s_barrier(); asm volatile("" ::: "memory");
        if (tid < 256) { const float* sl = XM + ((size_t)u.pm * BM + tid) * 4; float t4[4];
#pragma unroll
            for (int t = 0; t < 4; ++t) t4[t] = __hip_atomic_load(sl + t, __ATOMIC_RELAXED, __HIP_MEMORY_SCOPE_AGENT);
            const float mxr = fmaxf(fmaxf(t4[0], t4[1]), fmaxf(t4[2], t4[3])); const float sc = (mxr > 0.f) ? mxr * (1.0f / 127.0f) : 1.0f;
            R[tid] = 1.0f / sc; if (u.pn == 0) SA[(size_t)u.pm * BM + tid] = sc; }
        asm volatile("s_waitcnt vmcnt(0) lgkmcnt(0)" ::: "memory"); __builtin_amdgcn_s_barrier(); asm volatile("" ::: "memory");
#pragma unroll
        for (int ai = 0; ai < 2; ++ai)
#pragma unroll
            for (int m = 0; m < 4; ++m) { const int rl = rl0 + ai * HALF + m * 16; const float inv = R[rl]; signed char* qrow = HB8 + ((size_t)u.pm * BM + rl) * 1024 + u.pn * BM + cl0;
#pragma unroll
                for (int bj = 0; bj < 2; ++bj) { u32x2 w; w.x = q4_i8(acc[ai][bj][m][0], inv); w.y = q4_i8(acc[ai][bj][m][1], inv); *(u32x2*)(qrow + bj * HALF) = w; } }
    }
};

template <class Epi, class Sched, bool ALIGN_EPI, bool I8 = false>
__device__ __forceinline__ void gemm_phase(LAS unsigned char* lds, const int K, const Sched& S, const Epi& E) {
    int tid = threadIdx.x; asm volatile("" : "+v"(tid));
    const int wid = __builtin_amdgcn_readfirstlane(tid >> 6), lane = tid & 63, wr = wid >> 2, wc = wid & 3, fr = lane & 15, fq = lane >> 4;
    unsigned voffA[2], voffB[2];
#pragma unroll
    for (int i = 0; i < 2; ++i) { int R, C; stage_rc(tid * 16 + i * 8192, R, C); const int Rb = Epi::PERM ? ((R & ~31) + perm32(R & 31)) : R;
        voffA[i] = (unsigned)(R * K + C) * 2u; voffB[i] = (unsigned)(Rb * K + C) * 2u; }
    const size_t kstep = (size_t)(BK * 2);
    const size_t hstep = (size_t)HALF * K * 2;
    const unsigned ldsw = (unsigned)wid * 1024u;
    const int aoff = lds_byte(wr * 64 + fr, fq * 8), boff = lds_byte(wc * 32 + fr, fq * 8);
#define PG8_SA(b, h) (((b) * 2 + (h)) * HTB)
#define PG8_SB(b, h) ((4 + (b) * 2 + (h)) * HTB)
#define PG8_STAGE(bufoff, gbase, voff) do { _Pragma("unroll") for (int _i = 0; _i < 2; ++_i) \
        __builtin_amdgcn_global_load_lds((const unsigned*)((const char*)(gbase) + (voff)[_i]), (LAS unsigned*)(lds + (bufoff) + ldsw + _i * 8192), 16, 0, 0); } while (0)
#define PG8_LDA(dst, b, h) do { _Pragma("unroll") for (int m = 0; m < 4; ++m) _Pragma("unroll") for (int k = 0; k < 2; ++k) dst[m][k] = *(const LAS bf16x8*)(lds + PG8_SA(b, h) + aoff + m * 2048 + k * 1024); } while (0)
#define PG8_LDB(dst, b, h) do { _Pragma("unroll") for (int n = 0; n < 2; ++n) _Pragma("unroll") for (int k = 0; k < 2; ++k) dst[n][k] = *(const LAS bf16x8*)(lds + PG8_SB(b, h) + boff + n * 2048 + k * 1024); } while (0)
#define PG8_MMA(ai, bj, At, Bt) do { __builtin_amdgcn_s_setprio(1); _Pragma("unroll") for (int m = 0; m < 4; ++m) _Pragma("unroll") for (int n = 0; n < 2; ++n) _Pragma("unroll") for (int k = 0; k < 2; ++k) \
        { if constexpr (I8) acc[ai][bj][m][n] = __builtin_bit_cast(f32x4, __builtin_amdgcn_mfma_i32_16x16x64_i8(__builtin_bit_cast(i32x4, Bt[n][k]), __builtin_bit_cast(i32x4, At[m][k]), __builtin_bit_cast(i32x4, acc[ai][bj][m][n]), 0, 0, 0)); \
          else acc[ai][bj][m][n] = __builtin_amdgcn_mfma_f32_16x16x32_bf16(Bt[n][k], At[m][k], acc[ai][bj][m][n], 0, 0, 0); } __builtin_amdgcn_s_setprio(0); } while (0)
#define PG8_WAIT_V(n) asm volatile("s_waitcnt vmcnt(" #n ")" ::: "memory")
#define PG8_WAIT_L(n) asm volatile("s_waitcnt lgkmcnt(" #n ")" ::: "memory")
#define PG8_BAR __builtin_amdgcn_s_barrier()
#define PG8_SCHED __builtin_amdgcn_sched_barrier(0)
    Unit cur, nxt; int ui = 0;
    if (!S.next(0, cur)) return;
    f32x4 acc[2][2][4][2];
#pragma unroll
    for (int a = 0; a < 2; ++a)
#pragma unroll
        for (int b = 0; b < 2; ++b)
#pragma unroll
            for (int m = 0; m < 4; ++m)
#pragma unroll
                for (int n = 0; n < 2; ++n) acc[a][b][m][n] = (f32x4){0.f, 0.f, 0.f, 0.f};
    bf16x8 At[4][2], B0[2][2], B1[2][2];
    const char* cA; const char* cB; S.tiles(cur, cA, cB);
    PG8_STAGE(PG8_SB(0, 0), cB, voffB); PG8_STAGE(PG8_SB(0, 1), cB + hstep, voffB); PG8_STAGE(PG8_SA(0, 0), cA, voffA); PG8_STAGE(PG8_SA(0, 1), cA + hstep, voffA);
    if (wr == 1) PG8_BAR;
    PG8_WAIT_V(2); PG8_BAR;
    PG8_STAGE(PG8_SB(1, 0), cB + kstep, voffB); PG8_STAGE(PG8_SA(1, 0), cA + kstep, voffA); PG8_STAGE(PG8_SB(1, 1), cB + hstep + kstep, voffB);
    PG8_WAIT_V(6); PG8_BAR;
    for (;;) {
        const bool has_next = S.next(ui + 1, nxt);
        const char* nA = cA; const char* nB = cB; if (has_next) S.tiles(nxt, nA, nB);
#define PG8_KT2(t, last) do { \
            const char* a1 = cA + (size_t)((t) + 1) * kstep; \
            const char* a2 = (last) ? nA : cA + (size_t)((t) + 2) * kstep; const char* b2 = (last) ? nB : cB + (size_t)((t) + 2) * kstep; \
            const char* a3 = a2 + kstep; const char* b3 = b2 + kstep; \
            PG8_LDB(B0, 0, 0); PG8_LDB(B1, 0, 1); PG8_SCHED; PG8_LDA(At, 0, 0); PG8_STAGE(PG8_SA(1, 1), a1 + hstep, voffA); \
            PG8_WAIT_V(8); PG8_WAIT_L(0); PG8_BAR; PG8_MMA(0, 0, At, B0); PG8_MMA(0, 1, At, B1); PG8_BAR; PG8_SCHED; \
            PG8_LDA(At, 0, 1); PG8_STAGE(PG8_SB(0, 0), b2, voffB); PG8_STAGE(PG8_SB(0, 1), b2 + hstep, voffB); PG8_STAGE(PG8_SA(0, 0), a2, voffA); \
            PG8_WAIT_V(8); PG8_WAIT_L(0); PG8_BAR; PG8_MMA(1, 0, At, B0); PG8_MMA(1, 1, At, B1); PG8_BAR; PG8_SCHED; \
            PG8_LDB(B0, 1, 0); PG8_LDB(B1, 1, 1); PG8_SCHED; PG8_LDA(At, 1, 0); PG8_STAGE(PG8_SA(0, 1), a2 + hstep, voffA); \
            PG8_WAIT_V(8); PG8_WAIT_L(0); PG8_BAR; PG8_MMA(0, 0, At, B0); PG8_MMA(0, 1, At, B1); PG8_BAR; PG8_SCHED; \
            PG8_LDA(At, 1, 1); PG8_STAGE(PG8_SB(1, 0), b3, voffB); PG8_STAGE(PG8_SB(1, 1), b3 + hstep, voffB); PG8_STAGE(PG8_SA(1, 0), a3, voffA); \
            PG8_WAIT_V(8); PG8_WAIT_L(0); PG8_BAR; PG8_MMA(1, 0, At, B0); PG8_MMA(1, 1, At, B1); PG8_BAR; PG8_SCHED; } while (0)
        {
            const int ntc = S.ntiles(cur);
#pragma unroll 1
            for (int t = 0; t < ntc; t += 2) { const bool last = (t == ntc - 2); PG8_KT2(t, last); }
        }
        if constexpr (ALIGN_EPI) { if (wr == 0) PG8_BAR; }
        E(acc, cur, wr, wc, fr, fq);
        if (!has_next) break;
        if (!S.keep_acc(nxt)) {
#pragma unroll
        for (int a = 0; a < 2; ++a)
#pragma unroll
            for (int b = 0; b < 2; ++b)
#pragma unroll
                for (int m = 0; m < 4; ++m)
#pragma unroll
                    for (int n = 0; n < 2; ++n) acc[a][b][m][n] = (f32x4){0.f, 0.f, 0.f, 0.f};
        }
        cur = nxt; cA = nA; cB = nB; ++ui;
        if constexpr (ALIGN_EPI) { if (wr == 1) PG8_BAR; }
    }
    PG8_WAIT_V(0);
    if constexpr (!ALIGN_EPI) { if (wr == 0) PG8_BAR; }
    PG8_BAR;
#undef PG8_KT2
#undef PG8_SA
#undef PG8_SB
#undef PG8_STAGE
#undef PG8_LDA
#undef PG8_LDB
#undef PG8_MMA
#undef PG8_WAIT_V
#undef PG8_WAIT_L
#undef PG8_BAR
#undef PG8_SCHED
}
}

struct Args {
    const float* in[22]; float* out; unsigned char* ws; int ph_lo, ph_hi;
};
enum { I_X = 0, I_NMIXPRE, I_NMIXPOST, I_NMLPPRE, I_NMLPPOST, I_WIN, I_LCW, I_LCB, I_LWA, I_LBA, I_LWX, I_LBX, I_LLAM, I_PW, I_PS, I_HLB, I_HN, I_SW, I_WBR, I_WOUT, I_WUP, I_WDOWN };

struct Ctx {
    LAS unsigned char* lds; int tid, lane, wave, vcu, G;
};

__device__ __forceinline__ void transpose_item(const float* W, int ldw, const float* gain, bf16_t* WT, int ldo, int col_off, int k0, int n0, LAS float* scr, int lane) {
    float wv[32];
#pragma unroll
    for (int i = 0; i < 32; ++i) { const int kk = 2 * i + (lane >> 5); wv[i] = W[(size_t)(k0 + kk) * ldw + n0 + (lane & 31)]; }
#pragma unroll
    for (int i = 0; i < 32; ++i) { const int kk = 2 * i + (lane >> 5); const float g = gain ? gain[k0 + kk] : 1.0f; scr[kk * 33 + (lane & 31)] = g * wv[i]; }
    asm volatile("s_waitcnt lgkmcnt(0)" ::: "memory");
    const int c = lane & 7;
#pragma unroll
    for (int j = 0; j < 4; ++j) { const int n = (lane >> 3) + 8 * j; const LAS float* s = scr + (8 * c) * 33 + n;
        u32x4 o; o.x = pk2(s[0 * 33], s[1 * 33]); o.y = pk2(s[2 * 33], s[3 * 33]); o.z = pk2(s[4 * 33], s[5 * 33]); o.w = pk2(s[6 * 33], s[7 * 33]);
        *(u32x4*)(WT + (size_t)(n0 + n) * ldo + col_off + k0 + 8 * c) = o; }
    asm volatile("s_waitcnt lgkmcnt(0)" ::: "memory");
}

__device__ __forceinline__ void p0_prologue(const Ctx& C, const Args& A) {
    LAS float* scr = (LAS float*)(C.lds + C.wave * 16384);
    const int gw = C.vcu * NWAVES + C.wave, NGW = C.G * NWAVES;
    constexpr int I_IN = (D / 64) * (INW / 32), I_BR1 = (BW / 64) * (D / 32), I_OUT = (D / 64) * (D / 32), I_UP = (D / 64) * (FF / 32), I_DN = (FF / 64) * (D / 32);
    constexpr int PER_LAYER = I_IN + 4 * I_BR1 + I_OUT + I_UP + I_DN;
    for (int it = gw; it < DEPTH * PER_LAYER; it += NGW) {
        const int l = it / PER_LAYER; int r = it % PER_LAYER;
        bf16_t* wl = (bf16_t*)(A.ws + WS_W + (size_t)l * W_LAYER);
        if (r < I_IN) { const int nb = INW / 32; transpose_item(A.in[I_WIN] + (size_t)l * D * INW, INW, A.in[I_NMIXPRE] + l * D, wl + W_IN / 2, D, 0, 64 * (r / nb), 32 * (r % nb), scr, C.lane); continue; } r -= I_IN;
        if (r < 4 * I_BR1) { const int k = r / I_BR1, rr = r % I_BR1, nb = D / 32; transpose_item(A.in[I_WBR] + ((size_t)l * 4 + k) * BW * D, D, nullptr, wl + W_BR / 2, D, k * BW, 64 * (rr / nb), 32 * (rr % nb), scr, C.lane); continue; } r -= 4 * I_BR1;
        if (r < I_OUT) { const int nb = D / 32; transpose_item(A.in[I_WOUT] + (size_t)l * D * D, D, nullptr, wl + W_OUT / 2, D, 0, 64 * (r / nb), 32 * (r % nb), scr, C.lane); continue; } r -= I_OUT;
        if (r < I_UP) { const int nb = FF / 32; transpose_item(A.in[I_WUP] + (size_t)l * D * FF, FF, A.in[I_NMLPPRE] + l * D, wl + W_UP / 2, D, 0, 64 * (r / nb), 32 * (r % nb), scr, C.lane); continue; } r -= I_UP;
        { const int nb = D / 32; transpose_item(A.in[I_WDOWN] + (size_t)l * FF * D, D, nullptr, wl + W_DOWN / 2, FF, 0, 64 * (r / nb), 32 * (r % nb), scr, C.lane); }
    }
    { const int gt = gw * 64 + C.lane; if (gt < DEPTH * BW) { const float lam = A.in[I_LLAM][gt]; ((float*)(A.ws + WS_SP8))[gt] = -8.0f * ((-lam > 20.f) ? -lam : log1pf(expf(-lam))); } }
    bf16_t* HB = (bf16_t*)(A.ws + WS_HB); float* RS = (float*)(A.ws + WS_X2);
    for (int m0 = gw; m0 < M; m0 += 4 * NGW) {
        f32x4 v[4][4];
#pragma unroll
        for (int q = 0; q < 4; ++q) { const int m = m0 + q * NGW; const f32x4* xr = (const f32x4*)(A.in[I_X] + (size_t)(m < M ? m : 0) * D) + C.lane;
#pragma unroll
            for (int j = 0; j < 4; ++j) v[q][j] = xr[64 * j]; }
#pragma unroll
        for (int q = 0; q < 4; ++q) { const int m = m0 + q * NGW; if (m < M) { float s = 0.f;
#pragma unroll
            for (int j = 0; j < 4; ++j) s += (v[q][j].x * v[q][j].x + v[q][j].y * v[q][j].y) + (v[q][j].z * v[q][j].z + v[q][j].w * v[q][j].w);
            s = wave_sum(s);
            u32x2* o8 = (u32x2*)(HB + (size_t)m * D) + C.lane;
#pragma unroll
            for (int j = 0; j < 4; ++j) { u32x2 w; w.x = pk2(v[q][j].x, v[q][j].y); w.y = pk2(v[q][j].z, v[q][j].w); o8[64 * j] = w; }
            float mx = 0.f;
#pragma unroll
            for (int j = 0; j < 4; ++j) mx = fmaxf(fmaxf(mx, fmaxf(fabsf(v[q][j].x), fabsf(v[q][j].y))), fmaxf(fabsf(v[q][j].z), fabsf(v[q][j].w)));
#pragma unroll
            for (int o = 1; o < 64; o <<= 1) mx = fmaxf(mx, __shfl_xor(mx, o));
            const float sc = (mx > 0.f) ? mx * (1.0f / 127.0f) : 1.0f, inv = 1.0f / sc;
            unsigned* o4 = (unsigned*)(A.ws + WS_HB8 + (size_t)m * D) + C.lane;
#pragma unroll
            for (int j = 0; j < 4; ++j) o4[64 * j] = q4_i8(v[q][j], inv);
            if (C.lane == 0) { *(f32x4*)(RS + (size_t)m * 4) = (f32x4){s, 0.f, 0.f, 0.f}; ((float*)(A.ws + WS_SA))[m] = sc; } } }
    }
}

__device__ __forceinline__ void norm_phase(const Ctx& C, const Args& A, const bf16_t* VIN, const float* gain, bool write_out) {
    bf16_t* HB = (bf16_t*)(A.ws + WS_HB); float* RS = (float*)(A.ws + WS_X2); float* OUT = A.out;
    int lane = C.lane; asm volatile("" : "+v"(lane));
    const int gw = C.vcu * NWAVES + C.wave, NGW = C.G * NWAVES;
    f32x4 g[4];
#pragma unroll
    for (int j = 0; j < 4; ++j) g[j] = ((const f32x4*)gain)[lane + 64 * j];
    for (int m = gw; m < M; m += NGW) {
        u32x2* hb = (u32x2*)(HB + (size_t)m * D) + lane;
        const u32x2* vb = (const u32x2*)(VIN + (size_t)m * D) + lane;
        f32x4 v[4], h[4]; float s = 0.f;
#pragma unroll
        for (int j = 0; j < 4; ++j) { const u32x2 w = vb[64 * j], hw = hb[64 * j];
            v[j] = (f32x4){bf2f(w.x & 0xffffu), bf2f(w.x >> 16), bf2f(w.y & 0xffffu), bf2f(w.y >> 16)};
            h[j] = (f32x4){bf2f(hw.x & 0xffffu), bf2f(hw.x >> 16), bf2f(hw.y & 0xffffu), bf2f(hw.y >> 16)};
            s += (v[j].x * v[j].x + v[j].y * v[j].y) + (v[j].z * v[j].z + v[j].w * v[j].w); }
        const float r = 1.0f / sqrtf(wave_sum(s) * (1.0f / D) + EPS);
        float s2 = 0.f;
#pragma unroll
        for (int j = 0; j < 4; ++j) { h[j] = h[j] + g[j] * v[j] * r; s2 += (h[j].x * h[j].x + h[j].y * h[j].y) + (h[j].z * h[j].z + h[j].w * h[j].w); }
        s2 = wave_sum(s2);
        if (write_out) { f32x4* orow = (f32x4*)(OUT + (size_t)m * D) + lane;
#pragma unroll
            for (int j = 0; j < 4; ++j) orow[64 * j] = h[j]; }
        else {
#pragma unroll
            for (int j = 0; j < 4; ++j) { u32x2 w; w.x = pk2(h[j].x, h[j].y); w.y = pk2(h[j].z, h[j].w); hb[64 * j] = w; }
            float mx = 0.f;
#pragma unroll
            for (int j = 0; j < 4; ++j) mx = fmaxf(fmaxf(mx, fmaxf(fabsf(h[j].x), fabsf(h[j].y))), fmaxf(fabsf(h[j].z), fabsf(h[j].w)));
#pragma unroll
            for (int o = 1; o < 64; o <<= 1) mx = fmaxf(mx, __shfl_xor(mx, o));
            const float sc = (mx > 0.f) ? mx * (1.0f / 127.0f) : 1.0f, inv = 1.0f / sc;
            unsigned* o4 = (unsigned*)(A.ws + WS_HB8 + (size_t)m * D) + lane;
#pragma unroll
            for (int j = 0; j < 4; ++j) o4[64 * j] = q4_i8(h[j], inv);
            if (lane == 0) { *(f32x4*)(RS + (size_t)m * 4) = (f32x4){s2, 0.f, 0.f, 0.f}; ((float*)(A.ws + WS_SA))[m] = sc; } }
    }
}

__device__ __forceinline__ float gelu_tanh(float x) {
    const float u = 0.7978845608028654f * (x + 0.044715f * x * x * x);
    const float e = fast_exp(2.0f * u);
    const float th = 1.0f - 2.0f * __builtin_amdgcn_rcpf(e + 1.0f);
    return 0.5f * x * (1.0f + th);
}

constexpr size_t WS_LRA = 428 * MiB, WS_LRU = 444 * MiB;
constexpr int MX_PT = 528;
__device__ __forceinline__ bf16x8 gather_wfrag(const float* w, int stride) {
    union { bf16x8 v; unsigned u[4]; } r;
#pragma unroll
    for (int p = 0; p < 4; ++p) r.u[p] = pk2(w[(2 * p) * stride], w[(2 * p + 1) * stride]);
    return r.v;
}
__device__ __forceinline__ void mix1_item(const Ctx& C, const Args& A, int l, int b, int c) {
    const bf16_t* PROJ = (const bf16_t*)(A.ws + WS_PROJ);
    bf16_t* YS = (bf16_t*)(A.ws + WS_YS);
    int tid = C.tid; asm volatile("" : "+v"(tid));
    const int lane = tid & 63, wave = C.wave, fr = lane & 15, fg = lane >> 4;
    const size_t m0 = (size_t)b * T + (size_t)c * 64;
    LAS unsigned char* XC = C.lds;
    LAS unsigned char* LAi = C.lds + 34816;
    LAS unsigned char* LUi = C.lds + 34816 + 32768;
    {
        const float* cw = A.in[I_LCW] + (size_t)l * 4 * BW; const float* cbp = A.in[I_LCB] + l * BW;
#pragma unroll
        for (int k = 0; k < 4; ++k) { const int idx = tid + NTHREADS * k; const int t = idx >> 5, c8 = (idx & 31) * 8;
            float acc[8];
            { const f32x4 b0 = *(const f32x4*)(cbp + c8), b1 = *(const f32x4*)(cbp + c8 + 4); acc[0] = b0[0]; acc[1] = b0[1]; acc[2] = b0[2]; acc[3] = b0[3]; acc[4] = b1[0]; acc[5] = b1[1]; acc[6] = b1[2]; acc[7] = b1[3]; }
#pragma unroll
            for (int j = 0; j < 4; ++j) { const int tok = c * 64 + t - 3 + j;
                if (tok >= 0) { float x[8]; ld8bf(PROJ + ((size_t)b * T + tok) * NMIX + c8, x); const f32x4 w0 = *(const f32x4*)(cw + j * BW + c8), w1 = *(const f32x4*)(cw + j * BW + c8 + 4);
                    acc[0] += w0[0] * x[0]; acc[1] += w0[1] * x[1]; acc[2] += w0[2] * x[2]; acc[3] += w0[3] * x[3]; acc[4] += w1[0] * x[4]; acc[5] += w1[1] * x[5]; acc[6] += w1[2] * x[6]; acc[7] += w1[3] * x[7]; } }
            u32x4 w; w.x = cvt_pk_bf16(acc[0], acc[1]); w.y = cvt_pk_bf16(acc[2], acc[3]); w.z = cvt_pk_bf16(acc[4], acc[5]); w.w = cvt_pk_bf16(acc[6], acc[7]);
            *(LAS u32x4*)(XC + t * MX_PT + c8 * 2) = w; }
    }
    __syncthreads();
    {
        const int blk = wave;
        const float* wa = A.in[I_LWA] + (((size_t)l * 8 + blk) * 32) * 32; const float* wx = A.in[I_LWX] + (((size_t)l * 8 + blk) * 32) * 32;
        bf16x8 fa[2], fx[2];
#pragma unroll
        for (int nt = 0; nt < 2; ++nt) { fa[nt] = gather_wfrag(wa + (8 * fg) * 32 + 16 * nt + fr, 32); fx[nt] = gather_wfrag(wx + (8 * fg) * 32 + 16 * nt + fr, 32); }
        bf16_t* LRA = (bf16_t*)(A.ws + WS_LRA); bf16_t* LRU = (bf16_t*)(A.ws + WS_LRU);
#pragma unroll
        for (int nt = 0; nt < 2; ++nt) { const int ch = 32 * blk + 16 * nt + 4 * fg;
            const f32x4 ba = *(const f32x4*)(A.in[I_LBA] + l * BW + ch), bx = *(const f32x4*)(A.in[I_LBX] + l * BW + ch), sp8 = *(const f32x4*)((const float*)(A.ws + WS_SP8) + l * BW + ch);
#pragma unroll
            for (int mt = 0; mt < 4; ++mt) { const int tok = 16 * mt + fr;
                const bf16x8 bxc = *(const LAS bf16x8*)(XC + tok * MX_PT + (32 * blk + 8 * fg) * 2);
                f32x4 ar = {0.f, 0.f, 0.f, 0.f}, ai = {0.f, 0.f, 0.f, 0.f};
                ar = __builtin_amdgcn_mfma_f32_16x16x32_bf16(fa[nt], bxc, ar, 0, 0, 0); ai = __builtin_amdgcn_mfma_f32_16x16x32_bf16(fx[nt], bxc, ai, 0, 0, 0);
                const u32x2 xw = *(const LAS u32x2*)(XC + tok * MX_PT + ch * 2);
                const float xc[4] = {bf2f(xw.x & 0xffffu), bf2f(xw.x >> 16), bf2f(xw.y & 0xffffu), bf2f(xw.y >> 16)};
                float la[4], uu[4];
#pragma unroll
                for (int r = 0; r < 4; ++r) { const float rg = sigmoid_f(ar[r] + ba[r]), ig = sigmoid_f(ai[r] + bx[r]);
                    la[r] = sp8[r] * rg; const float x2 = 2.0f * la[r];
                    const float om = (x2 > -0.02f) ? -x2 * (1.0f + 0.5f * x2 * (1.0f + x2 * (1.0f / 3.0f))) : 1.0f - fast_exp(x2);
                    uu[r] = sqrtf(om) * ig * xc[r]; }
                u32x2 wl, wu; wl.x = cvt_pk_bf16(la[0], la[1]); wl.y = cvt_pk_bf16(la[2], la[3]); wu.x = cvt_pk_bf16(uu[0], uu[1]); wu.y = cvt_pk_bf16(uu[2], uu[3]);
                *(LAS u32x2*)(LAi + tok * 512 + ch * 2) = wl; *(LAS u32x2*)(LUi + tok * 512 + ch * 2) = wu;
                *(u32x2*)(LRA + (m0 + tok) * BW + ch) = wl; *(u32x2*)(LRU + (m0 + tok) * BW + ch) = wu; }
        }
    }
    __syncthreads();
    {
        const int ch = tid & 255, half = tid >> 8; float P = 1.f, hst = 0.f;
#pragma unroll
        for (int i = 0; i < 32; ++i) { const int t = 32 * half + i; const float a = fast_exp(bf2f(*(const LAS bf16_t*)(LAi + t * 512 + ch * 2))); const float u = bf2f(*(const LAS bf16_t*)(LUi + t * 512 + ch * 2));
            hst = a * hst + u; P *= a; }
        const size_t aggi = ((size_t)b * 128 + c * 2 + half) * 256 + ch;
        ((float*)(A.ws + WS_LA))[aggi] = P; ((float*)(A.ws + WS_LH))[aggi] = hst;
    }
    __syncthreads();
    LAS unsigned char* PX = C.lds;
    LAS unsigned char* DD = C.lds + 43008;
    { u32x4 pv[5];
#pragma unroll
        for (int k = 0; k < 5; ++k) { const int idx = tid + NTHREADS * k; const int r = idx >> 5, c8 = (idx & 31) * 8; const int tok = c * 64 - 15 + r;
            pv[k] = (u32x4){0u, 0u, 0u, 0u}; if (idx < 79 * 32 && tok >= 0) pv[k] = *(const u32x4*)(PROJ + ((size_t)b * T + tok) * NMIX + 512 + c8); }
#pragma unroll
        for (int k = 0; k < 5; ++k) { const int idx = tid + NTHREADS * k; const int r = idx >> 5, c8 = (idx & 31) * 8; if (idx < 79 * 32) *(LAS u32x4*)(PX + r * MX_PT + c8 * 2) = pv[k]; } }
    __syncthreads();
#pragma unroll 1
    for (int k = 0; k < 4; ++k) { const int idx = tid + NTHREADS * k; const int t = idx >> 5, c8 = (idx & 31) * 8; const int g = c8 >> 6, win = 2 << g;
        float sum[8], x0[8];
#pragma unroll
        for (int e = 0; e < 8; ++e) sum[e] = 0.f;
        for (int j = 0; j < win; ++j) { const u32x4 v = *(const LAS u32x4*)(PX + (t + 15 - j) * MX_PT + c8 * 2);
            const float x[8] = {bf2f(v.x & 0xffffu), bf2f(v.x >> 16), bf2f(v.y & 0xffffu), bf2f(v.y >> 16), bf2f(v.z & 0xffffu), bf2f(v.z >> 16), bf2f(v.w & 0xffffu), bf2f(v.w >> 16)};
#pragma unroll
            for (int e = 0; e < 8; ++e) { sum[e] += x[e]; if (j == 0) x0[e] = x[e]; } }
        const int pos = c * 64 + t + 1; const float inv = 1.0f / (float)(pos < win ? pos : win);
        u32x4 w; w.x = cvt_pk_bf16(sum[0] * inv - x0[0], sum[1] * inv - x0[1]); w.y = cvt_pk_bf16(sum[2] * inv - x0[2], sum[3] * inv - x0[3]);
        w.z = cvt_pk_bf16(sum[4] * inv - x0[4], sum[5] * inv - x0[5]); w.w = cvt_pk_bf16(sum[6] * inv - x0[6], sum[7] * inv - x0[7]);
        *(LAS u32x4*)(DD + t * MX_PT + c8 * 2) = w; }
    __syncthreads();
    {
        const int g = wave >> 1, nb = (wave & 1) * 2;
        const float* pw = A.in[I_PW] + (((size_t)l * 4 + g) * 64) * 64;
        bf16x8 fw[2][2];
#pragma unroll
        for (int nn = 0; nn < 2; ++nn)
#pragma unroll
            for (int ks = 0; ks < 2; ++ks) fw[nn][ks] = gather_wfrag(pw + (32 * ks + 8 * fg) * 64 + 16 * (nb + nn) + fr, 64);
#pragma unroll
        for (int nn = 0; nn < 2; ++nn) { const int ch = 64 * g + 16 * (nb + nn) + 4 * fg; const f32x4 scl = *(const f32x4*)(A.in[I_PS] + l * BW + ch);
#pragma unroll
            for (int mt = 0; mt < 4; ++mt) { const int tok = 16 * mt + fr; f32x4 acc = {0.f, 0.f, 0.f, 0.f};
#pragma unroll
                for (int ks = 0; ks < 2; ++ks) { const bf16x8 bd = *(const LAS bf16x8*)(DD + tok * MX_PT + (64 * g + 32 * ks + 8 * fg) * 2); acc = __builtin_amdgcn_mfma_f32_16x16x32_bf16(fw[nn][ks], bd, acc, 0, 0, 0); }
                u32x2 w; w.x = cvt_pk_bf16(acc[0] * scl[0], acc[1] * scl[1]); w.y = cvt_pk_bf16(acc[2] * scl[2], acc[3] * scl[3]);
                *(u32x2*)(YS + (m0 + tok) * D + 256 + ch) = w; } }
    }
    {
        const float* sw = A.in[I_SW] + (size_t)l * 3 * BW;
#pragma unroll 2
        for (int k = 0; k < 4; ++k) { const int idx = tid + NTHREADS * k; const int t = idx >> 5, c8 = (idx & 31) * 8;
            float acc[8];
#pragma unroll
            for (int e = 0; e < 8; ++e) acc[e] = 0.f;
#pragma unroll
            for (int j = 0; j < 3; ++j) { const int tok = c * 64 + t - 2 + j;
                if (tok >= 0) { const bf16_t* p = PROJ + ((size_t)b * T + tok) * NMIX; float sc[8], sx[8]; ld8bf(p + 2048 + c8, sc); ld8bf(p + 2304 + c8, sx);
                    const f32x4 w0 = *(const f32x4*)(sw + j * BW + c8), w1 = *(const f32x4*)(sw + j * BW + c8 + 4);
                    acc[0] += w0[0] * sc[0] * sx[0]; acc[1] += w0[1] * sc[1] * sx[1]; acc[2] += w0[2] * sc[2] * sx[2]; acc[3] += w0[3] * sc[3] * sx[3];
                    acc[4] += w1[0] * sc[4] * sx[4]; acc[5] += w1[1] * sc[5] * sx[5]; acc[6] += w1[2] * sc[6] * sx[6]; acc[7] += w1[3] * sc[7] * sx[7]; } }
            float sb[8]; ld8bf(PROJ + (m0 + t) * NMIX + 1792 + c8, sb);
            u32x4 w; w.x = cvt_pk_bf16(sb[0] * acc[0], sb[1] * acc[1]); w.y = cvt_pk_bf16(sb[2] * acc[2], sb[3] * acc[3]); w.z = cvt_pk_bf16(sb[4] * acc[4], sb[5] * acc[5]); w.w = cvt_pk_bf16(sb[6] * acc[6], sb[7] * acc[7]);
            *(u32x4*)(YS + (m0 + t) * D + 768 + c8) = w; }
    }
    __syncthreads();
}
__device__ __forceinline__ void lru_final_item(const Ctx& C, const Args& A, int l, int b, int c) {
    const bf16_t* PROJ = (const bf16_t*)(A.ws + WS_PROJ);
    const bf16_t* LRA = (const bf16_t*)(A.ws + WS_LRA); const bf16_t* LRU = (const bf16_t*)(A.ws + WS_LRU);
    bf16_t* YS = (bf16_t*)(A.ws + WS_YS);
    int tid = C.tid; asm volatile("" : "+v"(tid));
    const int ch = tid & 255, half = tid >> 8;
    const size_t m0 = (size_t)b * T + (size_t)c * 64 + 32 * half;
    float hst = ((const float*)(A.ws + WS_LC))[((size_t)b * 128 + c * 2 + half) * 256 + ch];
    unsigned short la[32], lu[32], lg[32];
#pragma unroll
    for (int i = 0; i < 32; ++i) { la[i] = LRA[(m0 + i) * BW + ch]; lu[i] = LRU[(m0 + i) * BW + ch]; lg[i] = PROJ[(m0 + i) * NMIX + 256 + ch]; }
#pragma unroll
    for (int i = 0; i < 32; ++i) { const float a = fast_exp(bf2f(la[i])), u = bf2f(lu[i]);
        hst = a * hst + u;
        YS[(m0 + i) * D + ch] = (bf16_t)f2bf(hst * gelu_tanh(bf2f(lg[i]))); }
}

constexpr int HG_PT = 144;
constexpr int HG_IMG = 64 * HG_PT;
constexpr int HG_Q = 0, HG_K = HG_IMG, HG_P = 2 * HG_IMG, HG_BEND = 3 * HG_IMG, HG_REF = HG_BEND + 512, HG_HSZ = 29696;
constexpr size_t WS_ST16 = WS_MERGED + 32 * MiB;
__device__ __forceinline__ float hgrn_lb(const Args& A, int l, int w) {
    if (l == 0) return 0.f;
    const float a0 = A.in[I_HLB][w], a1 = A.in[I_HLB][BW + w];
    return 1.0f / (1.0f + expf(a0 - a1));
}
template <bool FINAL>
__device__ __forceinline__ void hgrn_item(const Ctx& C, const Args& A, int l, int b, int c) {
    const bf16_t* PROJ = (const bf16_t*)(A.ws + WS_PROJ);
    int lane = C.lane; asm volatile("" : "+v"(lane));
    const int wave = C.wave, h = wave >> 1, half = wave & 1, fr = lane & 15, fg = lane >> 4;
    LAS unsigned char* hb = C.lds + h * HG_HSZ;
    LAS float* BEND = (LAS float*)(hb + HG_BEND); LAS float* REF = (LAS float*)(hb + HG_REF);
    const size_t m0 = (size_t)b * T + (size_t)c * 64;
    const bf16_t* pr = PROJ + (m0 + 32 * half) * NMIX + h * 64 + lane;
    const int bh = b * 4 + h; const size_t ci = (size_t)bh * 64 + c;
    float bb[32], kk[32], vv[32];
    {
        const float lbv = hgrn_lb(A, l, h * 64 + lane);
        float acc = 0.f;
#pragma unroll
        for (int i = 0; i < 32; ++i) { const float x = bf2f(pr[(size_t)i * NMIX + 1024]); const float f = fmaxf(lbv + (1.0f - lbv) * sigmoid_f(x), 1e-30f);
            acc += __logf(f); bb[i] = acc; kk[i] = 1.0f - f; }
#pragma unroll
        for (int i = 0; i < 32; ++i) vv[i] = bf2f(pr[(size_t)i * NMIX + 1280]);
        BEND[half * 64 + lane] = acc;
    }
    __syncthreads();
    const float bend0 = BEND[lane], blast = bend0 + BEND[64 + lane];
    if (half) {
#pragma unroll
        for (int i = 0; i < 32; ++i) bb[i] += bend0;
    }
    if (!FINAL) {
        LAS unsigned char* kt = hb + HG_K + lane * HG_PT + 64 * half; LAS unsigned char* vt = hb + HG_Q + lane * HG_PT + 64 * half;
#pragma unroll
        for (int q4 = 0; q4 < 4; ++q4) { u32x4 wk, wv; unsigned kw[4], vw[4];
#pragma unroll
            for (int p = 0; p < 4; ++p) { const int i = q4 * 8 + 2 * p;
                kw[p] = cvt_pk_bf16(kk[i] * fast_exp(blast - bb[i]), kk[i + 1] * fast_exp(blast - bb[i + 1])); vw[p] = cvt_pk_bf16(vv[i], vv[i + 1]); }
            wk.x = kw[0]; wk.y = kw[1]; wk.z = kw[2]; wk.w = kw[3]; wv.x = vw[0]; wv.y = vw[1]; wv.z = vw[2]; wv.w = vw[3];
            *(LAS u32x4*)(kt + q4 * 16) = wk; *(LAS u32x4*)(vt + q4 * 16) = wv; }
        if (half == 0) ((float*)(A.ws + WS_SD))[ci * 64 + lane] = fast_exp(blast);
        __syncthreads();
        float* su = (float*)(A.ws + WS_SU) + ci * 4096;
#pragma unroll
        for (int aa = 0; aa < 2; ++aa) { const int a = 2 * half + aa;
            bf16x8 av[2];
#pragma unroll
            for (int ks = 0; ks < 2; ++ks) av[ks] = *(const LAS bf16x8*)(hb + HG_Q + (16 * a + fr) * HG_PT + 64 * ks + 16 * fg);
#pragma unroll
            for (int d = 0; d < 4; ++d) { f32x4 acc = {0.f, 0.f, 0.f, 0.f};
#pragma unroll
                for (int ks = 0; ks < 2; ++ks) { const bf16x8 bk = *(const LAS bf16x8*)(hb + HG_K + (16 * d + fr) * HG_PT + 64 * ks + 16 * fg);
                    acc = __builtin_amdgcn_mfma_f32_16x16x32_bf16(av[ks], bk, acc, 0, 0, 0); }
#pragma unroll
                for (int r = 0; r < 4; ++r) su[(16 * a + 4 * fg + r) * 64 + 16 * d + fr] = acc[r];
            } }
        __syncthreads();
    } else {
        float qq[32];
#pragma unroll
        for (int i = 0; i < 32; ++i) qq[i] = bf2f(pr[(size_t)i * NMIX + 768]);
        if (half == 0) { REF[64 + lane] = bb[15]; REF[128 + lane] = bb[31]; } else REF[192 + lane] = bb[15];
        { const u32x4 z = {0u, 0u, 0u, 0u};
#pragma unroll
            for (int k2 = 0; k2 < 5; ++k2) { const int idx = lane + 64 * k2; if (idx < 32 * 9) *(LAS u32x4*)(hb + HG_P + 32 * half * HG_PT + idx * 16) = z; } }
        __syncthreads();
        float rf[4]; rf[0] = 0.f; rf[1] = REF[64 + lane]; rf[2] = REF[128 + lane]; rf[3] = REF[192 + lane];
        {
            const float r_lo = half ? rf[2] : rf[0], r_hi = half ? rf[3] : rf[1];
#pragma unroll
            for (int i = 0; i < 32; ++i) { const float rr = (i < 16) ? r_lo : r_hi; const float val = qq[i] * fast_exp(bb[i] - rr);
                *(LAS bf16_t*)(hb + HG_Q + (32 * half + i) * HG_PT + 2 * lane) = (bf16_t)f2bf(val); }
        }
#pragma unroll
        for (int isub = 0; isub < 4; ++isub) {
            const int nrows = 16 * (isub + 1) - 32 * half;
#pragma unroll
            for (int i = 0; i < 32; ++i) { if (i < nrows) { const float e = fminf(rf[isub] - bb[i], 60.f); const float val = kk[i] * fast_exp(e);
                    *(LAS bf16_t*)(hb + HG_K + (32 * half + i) * HG_PT + 2 * lane) = (bf16_t)f2bf(val); } }
            __syncthreads();
            {
                bf16x8 bq[2];
#pragma unroll
                for (int ks = 0; ks < 2; ++ks) bq[ks] = *(const LAS bf16x8*)(hb + HG_Q + (16 * isub + fr) * HG_PT + 64 * ks + 16 * fg);
#pragma unroll
                for (int j = 0; j <= isub; ++j) { if ((j & 1) == half) {
                        f32x4 acc = {0.f, 0.f, 0.f, 0.f};
#pragma unroll
                        for (int ks = 0; ks < 2; ++ks) { const bf16x8 ak = *(const LAS bf16x8*)(hb + HG_K + (16 * j + fr) * HG_PT + 64 * ks + 16 * fg);
                            acc = __builtin_amdgcn_mfma_f32_16x16x32_bf16(ak, bq[ks], acc, 0, 0, 0); }
                        if (j == isub) {
#pragma unroll
                            for (int r = 0; r < 4; ++r) if (4 * fg + r > fr) acc[r] = 0.f; }
                        u32x2 w; w.x = cvt_pk_bf16(acc[0], acc[1]); w.y = cvt_pk_bf16(acc[2], acc[3]);
                        *(LAS u32x2*)(hb + HG_P + (16 * isub + fr) * HG_PT + 2 * (16 * j + 4 * fg)) = w;
                    } }
            }
            __syncthreads();
        }
        {
            LAS unsigned char* vt = hb + HG_Q + lane * HG_PT + 64 * half;
#pragma unroll
            for (int q4 = 0; q4 < 4; ++q4) { u32x4 wv; unsigned vw[4];
#pragma unroll
                for (int p = 0; p < 4; ++p) { const int i = q4 * 8 + 2 * p; vw[p] = cvt_pk_bf16(vv[i], vv[i + 1]); }
                wv.x = vw[0]; wv.y = vw[1]; wv.z = vw[2]; wv.w = vw[3]; *(LAS u32x4*)(vt + q4 * 16) = wv; }
#pragma unroll
            for (int i = 0; i < 32; ++i) *(LAS bf16_t*)(hb + HG_K + (32 * half + i) * HG_PT + 2 * lane) = (bf16_t)f2bf(qq[i] * fast_exp(bb[i]));
        }
        __syncthreads();
        {
            const bf16_t* st = (const bf16_t*)(A.ws + WS_ST16) + ci * 4096;
            bf16x8 a_st[4][2];
#pragma unroll
            for (int a = 0; a < 4; ++a)
#pragma unroll
                for (int ks = 0; ks < 2; ++ks) a_st[a][ks] = *(const bf16x8*)(st + (16 * a + fr) * 64 + 32 * ks + 8 * fg);
            bf16_t* YS = (bf16_t*)(A.ws + WS_YS);
            const float* gn = A.in[I_HN] + l * 64;
#pragma unroll
            for (int tt = 0; tt < 2; ++tt) { const int ti = 2 * half + tt;
                bf16x8 bp[2], bqb[2];
#pragma unroll
                for (int ks = 0; ks < 2; ++ks) { bp[ks] = *(const LAS bf16x8*)(hb + HG_P + (16 * ti + fr) * HG_PT + 64 * ks + 16 * fg); bqb[ks] = *(const LAS bf16x8*)(hb + HG_K + (16 * ti + fr) * HG_PT + 64 * ks + 16 * fg); }
                f32x4 o[4]; float ss = 0.f;
#pragma unroll
                for (int a = 0; a < 4; ++a) { f32x4 acc = {0.f, 0.f, 0.f, 0.f};
#pragma unroll
                    for (int ks = 0; ks < 2; ++ks) { const bf16x8 av = *(const LAS bf16x8*)(hb + HG_Q + (16 * a + fr) * HG_PT + 64 * ks + 16 * fg);
                        acc = __builtin_amdgcn_mfma_f32_16x16x32_bf16(av, bp[ks], acc, 0, 0, 0);
                        acc = __builtin_amdgcn_mfma_f32_16x16x32_bf16(a_st[a][ks], bqb[ks], acc, 0, 0, 0); }
                    o[a] = acc; ss += (acc[0] * acc[0] + acc[1] * acc[1]) + (acc[2] * acc[2] + acc[3] * acc[3]); }
                ss += __shfl_xor(ss, 16); ss += __shfl_xor(ss, 32);
                const float rn = 1.0f / sqrtf(ss * (1.0f / 64.0f) + EPS);
                const size_t row = m0 + 16 * ti + fr;
#pragma unroll
                for (int a = 0; a < 4; ++a) { const int dv = 16 * a + 4 * fg;
                    const u32x2 gw = *(const u32x2*)(PROJ + row * NMIX + 1536 + h * 64 + dv);
                    const float g0 = bf2f(gw.x & 0xffffu), g1 = bf2f(gw.x >> 16), g2 = bf2f(gw.y & 0xffffu), g3 = bf2f(gw.y >> 16);
                    const f32x4 gv = *(const f32x4*)(gn + dv);
                    const float y0 = o[a][0] * rn * gv[0] * (g0 * sigmoid_f(g0)), y1 = o[a][1] * rn * gv[1] * (g1 * sigmoid_f(g1));
                    const float y2 = o[a][2] * rn * gv[2] * (g2 * sigmoid_f(g2)), y3 = o[a][3] * rn * gv[3] * (g3 * sigmoid_f(g3));
                    u32x2 w; w.x = cvt_pk_bf16(y0, y1); w.y = cvt_pk_bf16(y2, y3);
                    *(u32x2*)(YS + row * D + 512 + h * 64 + dv) = w; }
            }
        }
        __syncthreads();
    }
}

__device__ __forceinline__ void mix_phase2(const Ctx& C, const Args& A) {
    float* __restrict__ SU = (float*)(A.ws + WS_SU); const float* __restrict__ SD = (const float*)(A.ws + WS_SD);
    int tid_ = C.tid; asm volatile("" : "+v"(tid_));
    const int gt = C.vcu * NTHREADS + tid_, NGT = C.G * NTHREADS;
    for (int e = gt; e < 32 * 4096; e += NGT) {
        const int bh = e >> 12, kv = e & 4095, dk = kv & 63;
        bf16_t* __restrict__ ST16 = (bf16_t*)(A.ws + WS_ST16);
        float s = 0.f;
#pragma unroll 32
        for (int c = 0; c < 64; ++c) { const size_t ci = (size_t)bh * 64 + c; const float u = SU[ci * 4096 + kv]; const float d = SD[ci * 64 + dk]; ST16[ci * 4096 + kv] = (bf16_t)f2bf(s); s = d * s + u; }
    }
    const float* __restrict__ LA = (const float*)(A.ws + WS_LA); const float* __restrict__ LH = (const float*)(A.ws + WS_LH); float* __restrict__ LC = (float*)(A.ws + WS_LC);
    for (int e = gt; e < BATCH * BW; e += NGT) {
        const int b = e >> 8, ch = e & 255; float cr = 0.f;
#pragma unroll 32
        for (int sc = 0; sc < 128; ++sc) { const size_t i = ((size_t)b * 128 + sc) * 256 + ch; const float a = LA[i], hh = LH[i]; LC[i] = cr; cr = a * cr + hh; }
    }
}

#define XB_TMO      128
#define XB_XCNT(j)  (256  + 64 * (j))
#define XB_XSUB(j)  (1280 + 64 * (j))
#define XB_XGEN(j)  (2304 + 64 * (j))
#define XB_TOP      3328
#define XB_TOPGEN   3392
#define XCD_BAR_WORDS 3456
#define XB_SPIN_CAP (1u << 20)
__device__ __forceinline__ unsigned xb_ld(unsigned* p)              { return __hip_atomic_load(p, __ATOMIC_RELAXED, __HIP_MEMORY_SCOPE_AGENT); }
__device__ __forceinline__ unsigned xb_add(unsigned* p, unsigned v) { return __hip_atomic_fetch_add(p, v, __ATOMIC_RELAXED, __HIP_MEMORY_SCOPE_AGENT); }
__device__ __forceinline__ unsigned xb_xcc_id() { return (unsigned)__builtin_amdgcn_s_getreg((3 << 11) | 20) & 0xFu; }
#define XB_SPIN(cond, bar) do { unsigned _sp = 0; while (cond) { __builtin_amdgcn_s_sleep(1); \
    if ((++_sp & 255u) == 0u) { if (xb_ld(&(bar)[XB_TMO])) break; if (_sp > XB_SPIN_CAP) { atomicAdd(&(bar)[XB_TMO], 1u); break; } } } } while (0)
struct XcdBarrier { unsigned* bar; unsigned x; volatile LAS unsigned* st; };
__device__ __forceinline__ XcdBarrier xcd_barrier_post(unsigned* bar, volatile LAS unsigned* st) {
    XcdBarrier b; b.bar = bar; b.x = xb_xcc_id(); b.st = st;
    if (threadIdx.x == 0) (void)xb_add(&bar[XB_XCNT(b.x)], 1u);
    return b;
}
__device__ __forceinline__ void xcd_barrier_complete(unsigned* bar, unsigned x, unsigned& nloc, unsigned& nx) {
    const unsigned G = gridDim.x * gridDim.y * gridDim.z;
    unsigned sum, cnt, mine, sp = 0u;
    for (;;) {
        sum = 0u; cnt = 0u; mine = 0u;
#pragma unroll
        for (unsigned j = 0; j < 16; ++j) { const unsigned c = xb_ld(&bar[XB_XCNT(j)]); sum += c; cnt += (c > 0u) ? 1u : 0u; mine = (j == x) ? c : mine; }
        if (sum == G) break;
        __builtin_amdgcn_s_sleep(1);
        if ((++sp & 255u) == 0u) { if (xb_ld(&bar[XB_TMO])) break; if (sp > XB_SPIN_CAP) { atomicAdd(&bar[XB_TMO], 1u); break; } }
    }
    nloc = mine > 0u ? mine : 1u; nx = cnt > 0u ? cnt : 1u;
}
__device__ __forceinline__ void xcd_barrier(const XcdBarrier& b) {
    asm volatile("s_waitcnt vmcnt(0)" ::: "memory");
    __syncthreads();
    if (threadIdx.x == 0) {
        unsigned* bar = b.bar;
        __builtin_amdgcn_s_waitcnt(0);
        unsigned nloc = b.st[0], nx = b.st[1];
        if (nloc == 0u) { xcd_barrier_complete(bar, b.x, nloc, nx); b.st[0] = nloc; b.st[1] = nx; }
        const unsigned old = xb_add(&bar[XB_XSUB(b.x)], 1u);
        const unsigned gen = old / nloc;
        if (old + 1u == (gen + 1u) * nloc) {
            __builtin_amdgcn_fence(__ATOMIC_RELEASE, "agent");
            asm volatile("s_waitcnt vmcnt(0)" ::: "memory");
            const unsigned og = xb_add(&bar[XB_TOP], 1u);
            const unsigned tg = og / nx;
            if (og + 1u == (tg + 1u) * nx) xb_add(&bar[XB_TOPGEN], 1u);
            else XB_SPIN(xb_ld(&bar[XB_TOPGEN]) == tg, bar);
            __builtin_amdgcn_fence(__ATOMIC_ACQUIRE, "agent");
            xb_add(&bar[XB_XGEN(b.x)], 1u);
            asm volatile("s_waitcnt vmcnt(0)" ::: "memory");
        } else {
            XB_SPIN(xb_ld(&bar[XB_XGEN(b.x)]) == gen, bar);
            __builtin_amdgcn_fence(__ATOMIC_ACQUIRE, "agent");
            asm volatile("s_waitcnt vmcnt(0)" ::: "memory");
        }
    }
    __syncthreads();
}

constexpr int PH_PER_LAYER = 10, N_PHASES = 1 + DEPTH * PH_PER_LAYER;
constexpr int CW_BAR = 4096;
constexpr int CW_SEAM = 16384;
constexpr int CW_SEAM2 = 65536;

__global__ void __launch_bounds__(NTHREADS, 2) trunk_fwd(Args args) {
    extern __shared__ __attribute__((aligned(16))) unsigned char lds_raw[];
    Ctx C;
    C.lds = (LAS unsigned char*)lds_raw; C.tid = threadIdx.x; C.lane = C.tid & 63; C.wave = __builtin_amdgcn_readfirstlane(C.tid >> 6);
    C.G = gridDim.x; { const int bx = blockIdx.x; C.vcu = (C.G % 8 == 0) ? (bx % 8) * (C.G / 8) + bx / 8 : bx; }
    unsigned char* ws = args.ws;
    volatile LAS unsigned* MISC = (volatile LAS unsigned*)(C.lds + MISC_OFF);
    if (C.tid < 64) MISC[C.tid] = 0u;
    __syncthreads();
#if MK_PER_PHASE
#define GRID_BAR() do { } while (0)
#else
    cg::grid_group grid = cg::this_grid();
    XcdBarrier bar = xcd_barrier_post((unsigned*)(ws + WS_CTL) + CW_BAR, MISC + 8);
    bool first_bar = true;
#define GRID_BAR() do { if (first_bar) { grid.sync(); first_bar = false; } else { xcd_barrier(bar); } } while (0)
#endif
    const int lo = args.ph_lo, hi = args.ph_hi;
    int ph = 0;
#define PHASE_BEGIN if (ph >= lo && ph < hi) { for (int rep_ = 0; rep_ < (((DBG_REPEAT >> ((ph - 1) % PH_PER_LAYER + 1)) & 1) && ph > 0 ? 2 : 1); ++rep_) {
#define PHASE_END   if (rep_ == 0 && (((DBG_REPEAT >> ((ph - 1) % PH_PER_LAYER + 1)) & 1) && ph > 0)) GRID_BAR(); } if (ph + 1 < hi && ph + 1 < N_PHASES) GRID_BAR(); } ++ph;

    PHASE_BEGIN p0_prologue(C, args); PHASE_END

    for (int li = 0; li < DEPTH; ++li) {
        int l = li; asm volatile("" : "+s"(l));
        const unsigned char* wl = ws + WS_W + (size_t)l * W_LAYER;
        const float* RS = (const float*)(ws + WS_X2);
        PHASE_BEGIN {
            pg8::StaticOrder S; S.init(ws + WS_HB, wl + W_IN, M, NMIX, D, C.G, (int)blockIdx.x);
            pg8::EpiRow<1> E{(bf16_t*)(ws + WS_PROJ), NMIX, RS};
            pg8::gemm_phase<pg8::EpiRow<1>, pg8::StaticOrder, true>(C.lds, D, S, E);
        } PHASE_END
        PHASE_BEGIN {
            for (int item = C.vcu; item < BATCH * 64; item += C.G) { const int b = item >> 6, c = item & 63;
                mix1_item(C, args, l, b, c);
                hgrn_item<false>(C, args, l, b, c); }
        } PHASE_END
        PHASE_BEGIN {
            mix_phase2(C, args);
            int lane = C.lane; asm volatile("" : "+v"(lane));
            const int gw = C.vcu * NWAVES + C.wave, NGW = C.G * NWAVES;
            if (li == 0) {
                for (int it = gw; it < DEPTH * 2 * 4096; it += NGW) { const int ll = it >> 13, r = it & 8191, n = r & 4095;
                    const unsigned char* wll = ws + WS_W + (size_t)ll * W_LAYER;
                    if (r < 4096) quant_row_i8((const bf16_t*)(wll + W_IN) + (size_t)(NMIX + n) * D, (signed char*)(ws + WS_WG8) + ((size_t)ll * NGATE + n) * D, (float*)(ws + WS_SBG) + ll * NGATE + n, lane);
                    else quant_row_i8((const bf16_t*)(wll + W_UP) + (size_t)n * D, (signed char*)(ws + WS_WU8) + ((size_t)ll * FF + n) * D, (float*)(ws + WS_SBU) + ll * FF + n, lane); }
            }
        } PHASE_END
        PHASE_BEGIN {
            for (int item = C.vcu; item < BATCH * 64; item += C.G) { const int b = item >> 6, c = item & 63;
                lru_final_item(C, args, l, b, c);
                hgrn_item<true>(C, args, l, b, c); }
        } PHASE_END
        PHASE_BEGIN {
            unsigned char* gt = (unsigned char*)(ws + WS_G) + (size_t)blockIdx.x * 8 * 65536;
            {
                pg8::GateOrder8 S{(const char*)(ws + WS_HB8), (const char*)(ws + WS_WG8) + (size_t)l * NGATE * D, C.G, C.vcu};
                pg8::EpiGate8 E{gt, RS, (const float*)(ws + WS_SA), (const float*)(ws + WS_SBG) + l * NGATE};
                pg8::gemm_phase<pg8::EpiGate8, pg8::GateOrder8, true, true>(C.lds, D / 2, S, E);
            }
            {
                pg8::MergeOrder S{(const char*)(ws + WS_YS), (const char*)(wl + W_BR), C.G, C.vcu};
                pg8::EpiGate E{gt, (bf16_t*)(ws + WS_MERGED), RS};
                pg8::gemm_phase<pg8::EpiGate, pg8::MergeOrder, true>(C.lds, D, S, E);
            }
        } PHASE_END
        const bool fused_norm = (C.G == 256) && !MK_PER_PHASE;
        if (fused_norm) {
            PHASE_BEGIN {
                { const int half = 0;
                    pg8::PanelOrder S{(const char*)(ws + WS_MERGED), (const char*)(wl + W_OUT), (size_t)pg8::BM * D * 2, D / pg8::BK, half, C.vcu};
                    pg8::EpiNorm E{(bf16_t*)(ws + WS_HB), nullptr, args.in[I_NMIXPOST] + l * D, (float*)(ws + WS_X1), (float*)(ws + WS_X2), (unsigned*)(ws + WS_CTL) + CW_SEAM + (size_t)(l * 2 + 0) * 128 * 64, (unsigned*)(ws + WS_CTL) + 8, C.lds + 131072,
                                   (float*)(ws + WS_XM), (unsigned*)(ws + WS_CTL) + CW_SEAM2 + (size_t)(l * 2 + 0) * 128 * 64, (signed char*)(ws + WS_HB8), (float*)(ws + WS_SA)};
                    pg8::gemm_phase<pg8::EpiNorm, pg8::PanelOrder, true>(C.lds, D, S, E);
                }
            } PHASE_END
            ++ph;
        } else {
        PHASE_BEGIN {
            pg8::StaticOrder S; S.init(ws + WS_MERGED, wl + W_OUT, M, D, D, C.G, (int)blockIdx.x);
            pg8::EpiRow<0> E{(bf16_t*)(ws + WS_MIX), D, nullptr};
            pg8::gemm_phase<pg8::EpiRow<0>, pg8::StaticOrder, true>(C.lds, D, S, E);
        } PHASE_END
        PHASE_BEGIN norm_phase(C, args, (const bf16_t*)(ws + WS_MIX), args.in[I_NMIXPOST] + l * D, false); PHASE_END
        }
        PHASE_BEGIN {
            pg8::StaticOrder S; S.init(ws + WS_HB8, ws + WS_WU8 + (size_t)l * FF * D, M, FF, D / 2, C.G, (int)blockIdx.x);
            pg8::EpiUp8 E{(bf16_t*)(ws + WS_HID), FF, RS, (const float*)(ws + WS_SA), (const float*)(ws + WS_SBU) + l * FF};
            pg8::gemm_phase<pg8::EpiUp8, pg8::StaticOrder, true, true>(C.lds, D / 2, S, E);
        } PHASE_END
        if (fused_norm) {
            PHASE_BEGIN {
                { const int half = 0;
                    pg8::PanelOrder S{(const char*)(ws + WS_HID), (const char*)(wl + W_DOWN), (size_t)pg8::BM * FF * 2, FF / pg8::BK, half, C.vcu};
                    pg8::EpiNorm E{(bf16_t*)(ws + WS_HB), (li == DEPTH - 1) ? args.out : nullptr, args.in[I_NMLPPOST] + l * D, (float*)(ws + WS_X1), (float*)(ws + WS_X2), (unsigned*)(ws + WS_CTL) + CW_SEAM + (size_t)(l * 2 + 1) * 128 * 64, (unsigned*)(ws + WS_CTL) + 8, C.lds + 131072,
                                   (float*)(ws + WS_XM), (unsigned*)(ws + WS_CTL) + CW_SEAM2 + (size_t)(l * 2 + 1) * 128 * 64, (signed char*)(ws + WS_HB8), (float*)(ws + WS_SA)};
                    pg8::gemm_phase<pg8::EpiNorm, pg8::PanelOrder, true>(C.lds, FF, S, E);
                }
            } PHASE_END
            ++ph;
        } else {
        PHASE_BEGIN {
            pg8::StaticOrder S; S.init(ws + WS_HID, wl + W_DOWN, M, D, FF, C.G, (int)blockIdx.x);
            pg8::EpiRow<0> E{(bf16_t*)(ws + WS_MOUT), D, nullptr};
            pg8::gemm_phase<pg8::EpiRow<0>, pg8::StaticOrder, true>(C.lds, FF, S, E);
        } PHASE_END
        PHASE_BEGIN norm_phase(C, args, (const bf16_t*)(ws + WS_MOUT), args.in[I_NMLPPOST] + l * D, li == DEPTH - 1); PHASE_END
        }
    }
}

extern "C" void kernel_launch(void* const* d_in, const int* in_sizes, int n_in, void* d_out, int out_size, void* d_ws, size_t ws_size, hipStream_t stream) {
    static int grid = 0;
    if (grid == 0) {
        if (n_in != 22 || in_sizes[0] != M * D || out_size != M * D || ws_size < WS_END) { fprintf(stderr, "kernel_launch: unexpected shapes (n_in %d, in0 %d, out %d, ws %zu)\n", n_in, n_in > 0 ? in_sizes[0] : -1, out_size, ws_size); grid = -1; return; }
        int dev = 0, cus = 0, per_cu = 0;
        if (hipGetDevice(&dev) != hipSuccess || hipDeviceGetAttribute(&cus, hipDeviceAttributeMultiprocessorCount, dev) != hipSuccess) { grid = -1; return; }
        if (hipFuncSetAttribute((const void*)trunk_fwd, hipFuncAttributeMaxDynamicSharedMemorySize, LDS_BYTES) != hipSuccess) { fprintf(stderr, "kernel_launch: hipFuncSetAttribute failed\n"); grid = -1; return; }
        if (hipOccupancyMaxActiveBlocksPerMultiprocessor(&per_cu, (const void*)trunk_fwd, NTHREADS, LDS_BYTES) != hipSuccess || per_cu < 1) { fprintf(stderr, "kernel_launch: occupancy query says %d blocks per CU\n", per_cu); (void)hipGetLastError(); grid = -1; return; }
        grid = cus;
    }
    if (grid < 0) return;
    (void)hipMemsetAsync((char*)d_ws + WS_CTL, 0, CTL_ZERO_BYTES, stream);
    Args a{};
    for (int i = 0; i < 22; ++i) a.in[i] = (const float*)d_in[i];
    a.out = (float*)d_out; a.ws = (unsigned char*)d_ws;
#if MK_PER_PHASE
#ifndef DBG_MAXPH
#define DBG_MAXPH N_PHASES
#endif
    for (int p = 0; p < DBG_MAXPH; ++p) { a.ph_lo = p; a.ph_hi = p + 1; hipLaunchKernelGGL(trunk_fwd, dim3(grid), dim3(NTHREADS), LDS_BYTES, stream, a); }
#else
    a.ph_lo = 0; a.ph_hi = N_PHASES;
    void* kargs[] = {&a};
    hipError_t e = hipLaunchCooperativeKernel((const void*)trunk_fwd, dim3(grid), dim3(NTHREADS), kargs, LDS_BYTES, stream);
    if (e != hipSuccess) fprintf(stderr, "kernel_launch: cooperative launch failed: %s (grid %d)\n", hipGetErrorString(e), grid);
#endif
}
```

```cpp
#include <hip/hip_runtime.h>
#include <hip/hip_cooperative_groups.h>
#include <cstdio>
#include <cstdint>
namespace cg = cooperative_groups;

#ifndef DBG_ZERO
#define DBG_ZERO -1
#endif
#ifndef DBG_REPEAT
#define DBG_REPEAT 0
#endif
#ifndef MK_PER_PHASE
#define MK_PER_PHASE 0
#endif
#ifndef DBG_PREFIX
#define DBG_PREFIX 0
#endif

#define LAS __attribute__((address_space(3)))
#define GAS __attribute__((address_space(1)))
typedef unsigned short bf16_t;
typedef short bf16x8 __attribute__((ext_vector_type(8)));
typedef float f32x4 __attribute__((ext_vector_type(4)));
typedef float f32x2 __attribute__((ext_vector_type(2)));
typedef unsigned u32x4 __attribute__((ext_vector_type(4)));
typedef unsigned u32x2 __attribute__((ext_vector_type(2)));

constexpr int BATCH = 8, T = 4096, D = 1024, M = BATCH * T, DEPTH = 2, BW = 256;
constexpr int NMIX = 2560, NGATE = 4096, INW = NMIX + NGATE, FF = 4096;
constexpr float EPS = 1e-6f;
constexpr int NWAVES = 8, NTHREADS = 512;

constexpr size_t MiB = 1u << 20;
constexpr size_t WS_CTL = 0, CTL_ZERO_BYTES = 1 * MiB;
constexpr size_t WS_XM = 1 * MiB;
constexpr size_t WS_SD = 1 * MiB + 512 * 1024;
constexpr size_t WS_LA = 2 * MiB, WS_LH = 3 * MiB, WS_LC = 4 * MiB;
constexpr size_t WS_SP8 = 7 * MiB;
constexpr size_t WS_X1 = 5 * MiB;
constexpr size_t WS_X2 = 6 * MiB;
constexpr size_t WS_W = 8 * MiB;
constexpr size_t W_IN = 0, W_BR = 13 * MiB, W_OUT = 15 * MiB, W_UP = 17 * MiB, W_DOWN = 25 * MiB, W_LAYER = 33 * MiB;
constexpr size_t WS_HB = 76 * MiB;
constexpr size_t WS_PROJ = 140 * MiB;
constexpr size_t WS_G = WS_PROJ;
constexpr size_t WS_YS = 300 * MiB;
constexpr size_t WS_MERGED = 364 * MiB;
constexpr size_t WS_SU = WS_MERGED;
constexpr size_t WS_MIX = WS_PROJ;
constexpr size_t WS_MOUT = 396 * MiB;
constexpr size_t WS_HID = WS_PROJ;
constexpr size_t WS_HB8 = 460 * MiB;
constexpr size_t WS_WG8 = 492 * MiB;
constexpr size_t WS_SA = 7 * MiB + 64 * 1024;
constexpr size_t WS_SBG = 7 * MiB + 256 * 1024;
constexpr size_t WS_SBU = 7 * MiB + 320 * 1024;
constexpr size_t WS_WU8 = 500 * MiB;
constexpr size_t WS_XS0 = 428 * MiB, WS_XS1 = 444 * MiB;
constexpr size_t WS_END = 508 * MiB;

constexpr int LDS_BYTES = 155648;
constexpr int MISC_OFF = 154624;

__device__ __forceinline__ float bf2f(unsigned b) { return __uint_as_float(b << 16); }
__device__ __forceinline__ unsigned f2bf(float f) { unsigned u = __float_as_uint(f); return (u + 0x7fffu + ((u >> 16) & 1u)) >> 16; }
__device__ __forceinline__ unsigned pk2(float lo, float hi) { return f2bf(lo) | (f2bf(hi) << 16); }
typedef __bf16 bf16x2_t __attribute__((ext_vector_type(2)));
__device__ __forceinline__ unsigned cvt_pk_bf16(float lo, float hi) { f32x2 v = {lo, hi}; bf16x2_t b = __builtin_convertvector(v, bf16x2_t); return __builtin_bit_cast(unsigned, b); }
__device__ __forceinline__ float fast_exp(float x) { return __builtin_amdgcn_exp2f(x * 1.4426950408889634f); }
__device__ __forceinline__ float sigmoid_f(float x) { return __builtin_amdgcn_rcpf(1.0f + fast_exp(-x)); }
__device__ __forceinline__ void ld8bf(const bf16_t* p, float (&o)[8]) {
    const u32x4 v = *(const u32x4*)p;
    o[0] = bf2f(v.x & 0xffffu); o[1] = bf2f(v.x >> 16); o[2] = bf2f(v.y & 0xffffu); o[3] = bf2f(v.y >> 16);
    o[4] = bf2f(v.z & 0xffffu); o[5] = bf2f(v.z >> 16); o[6] = bf2f(v.w & 0xffffu); o[7] = bf2f(v.w >> 16);
}
__device__ __forceinline__ float rs_of(const float* X2, int row) { const f32x4 x = *(const f32x4*)(X2 + (size_t)row * 4); return 1.0f / sqrtf(((x[0] + x[1]) + (x[2] + x[3])) * (1.0f / D) + EPS); }
typedef int i32x4 __attribute__((ext_vector_type(4)));
__device__ __forceinline__ void quant_row_i8(const bf16_t* src, signed char* dst, float* scale_out, int lane) {
    float x[16]; ld8bf(src + 16 * lane, *(float(*)[8])&x[0]); ld8bf(src + 16 * lane + 8, *(float(*)[8])&x[8]);
    float mx = 0.f;
#pragma unroll
    for (int j = 0; j < 16; ++j) mx = fmaxf(mx, fabsf(x[j]));
#pragma unroll
    for (int o = 1; o < 64; o <<= 1) mx = fmaxf(mx, __shfl_xor(mx, o));
    const float sc = (mx > 0.f) ? mx * (1.0f / 127.0f) : 1.0f, inv = 1.0f / sc;
    unsigned w[4];
#pragma unroll
    for (int p = 0; p < 4; ++p) { unsigned v = 0u;
#pragma unroll
        for (int e = 0; e < 4; ++e) { const int q = (int)__builtin_rintf(x[4 * p + e] * inv); v |= ((unsigned)q & 0xffu) << (8 * e); }
        w[p] = v; }
    *(u32x4*)(dst + 16 * lane) = (u32x4){w[0], w[1], w[2], w[3]};
    if (lane == 0) *scale_out = sc;
}
__device__ __forceinline__ unsigned q4_i8(const f32x4 v, float inv) { unsigned w = 0u;
#pragma unroll
    for (int e = 0; e < 4; ++e) { const int q = (int)__builtin_rintf(v[e] * inv); w |= ((unsigned)q & 0xffu) << (8 * e); }
    return w; }
__device__ __forceinline__ float wave_sum(float v) {
#pragma unroll
    for (int o = 1; o < 64; o <<= 1) v += __shfl_xor(v, o);
    return v;
}

namespace pg8 {
constexpr int BM = 256, BK = 64, HALF = 128, HTB = HALF * BK * 2, STAGE_BYTES = 8 * HTB, NXCD = 8, WGM = 4;
__host__ __device__ __forceinline__ int lds_byte(int r, int c) { const int st = (r >> 4) * 2 + (c >> 5), rr = r & 15, cc = c & 31, ob = rr * 64 + cc * 2; return st * 1024 + (ob ^ (((ob >> 9) & 1) << 5)); }
__host__ __device__ __forceinline__ void stage_rc(int b, int& R, int& C) { const int st = b / 1024, sb = b % 1024, swz = sb ^ (((sb >> 9) & 1) << 5); R = (st >> 1) * 16 + swz / 64; C = (st & 1) * 32 + (swz % 64) / 2; }
__host__ __device__ __forceinline__ int perm32(int rho) { const int n = rho >> 4, i = rho & 15; return 8 * (i >> 2) + 4 * n + (i & 3); }

struct Unit { int pm, pn, kind; };

struct StaticOrder {
    const char* A; const char* Bt; size_t tstep;
    int nM, nN, nwg, G, c;
    __device__ void init(const void* A_, const void* Bt_, int M_, int N_, int K_, int G_, int c_) { A = (const char*)A_; Bt = (const char*)Bt_; tstep = (size_t)BM * K_ * 2; nt = K_ / BK; nM = M_ / BM; nN = N_ / BM; nwg = nM * nN; G = G_; c = c_; }
    __device__ bool next(int i, Unit& u) const {
        const long L = (long)i * G + c; if (L >= nwg) return false;
        int wgid = (int)L; { const int q = nwg / NXCD, r = nwg % NXCD, xcd = wgid % NXCD, off = wgid / NXCD; wgid = (xcd < r ? xcd * (q + 1) : r * (q + 1) + (xcd - r) * q) + off; }
        const int nig = WGM * nN, gid = wgid / nig, fm = gid * WGM, gsz = (nM - fm) < WGM ? (nM - fm) : WGM;
        u.pm = fm + ((wgid % nig) % gsz); u.pn = (wgid % nig) / gsz; u.kind = 0; return true;
    }
    __device__ __forceinline__ void tiles(const Unit& u, const char*& a, const char*& b) const { a = A + (size_t)u.pm * tstep; b = Bt + (size_t)u.pn * tstep; }
    int nt;
    __device__ __forceinline__ int ntiles(const Unit&) const { return nt; }
    __device__ __forceinline__ bool keep_acc(const Unit&) const { return false; }
};

struct GateOrder {
    const char* HB; const char* WGt; const char* YS; const char* WB; int G, vcu;
    __device__ bool next(int i, Unit& u) const {
        const int r = i / 16, ii = i % 16, su = vcu + r * G; if (su >= 256) return false;
        const int half = ii / 8, j = ii % 8;
        u.pm = half * 64 + (su >> 2); u.kind = j; u.pn = (j < 4) ? (j * 4 + (su & 3)) : (su & 3); return true;
    }
    __device__ __forceinline__ int ntiles(const Unit& u) const { return u.kind < 4 ? 16 : 4; }
    __device__ __forceinline__ bool keep_acc(const Unit& nx) const { return nx.kind > 4; }
    __device__ __forceinline__ void tiles(const Unit& u, const char*& a, const char*& b) const {
        const size_t ts = (size_t)BM * 1024 * 2;
        if (u.kind < 4) { a = HB + (size_t)u.pm * ts; b = WGt + (size_t)u.pn * ts; } else { a = YS + (size_t)u.pm * ts + (size_t)(u.kind - 4) * 512; b = WB + (size_t)u.pn * ts + (size_t)(u.kind - 4) * 512; }
    }
};

struct GateOrder8 {
    const char* HB8; const char* WG8; int G, vcu;
    __device__ bool next(int i, Unit& u) const {
        const int r = i / 8, ii = i % 8, su = vcu + r * G; if (su >= 256) return false;
        u.pm = (ii >> 2) * 64 + (su >> 2); u.kind = ii; u.pn = (ii & 3) * 4 + (su & 3); return true;
    }
    __device__ __forceinline__ int ntiles(const Unit&) const { return 8; }
    __device__ __forceinline__ bool keep_acc(const Unit&) const { return false; }
    __device__ __forceinline__ void tiles(const Unit& u, const char*& a, const char*& b) const { a = HB8 + (size_t)u.pm * 262144; b = WG8 + (size_t)u.pn * 262144; }
};
struct MergeOrder {
    const char* YS; const char* WB; int G, vcu;
    __device__ bool next(int i, Unit& u) const {
        const int r = i / 8, ii = i % 8, su = vcu + r * G; if (su >= 256) return false;
        u.pm = (ii >> 2) * 64 + (su >> 2); u.kind = 4 + (ii & 3); u.pn = su & 3; return true;
    }
    __device__ __forceinline__ int ntiles(const Unit&) const { return 4; }
    __device__ __forceinline__ bool keep_acc(const Unit& nx) const { return nx.kind > 4; }
    __device__ __forceinline__ void tiles(const Unit& u, const char*& a, const char*& b) const {
        const size_t ts = (size_t)BM * 1024 * 2; a = YS + (size_t)u.pm * ts + (size_t)(u.kind - 4) * 512; b = WB + (size_t)u.pn * ts + (size_t)(u.kind - 4) * 512; }
};

template <int MODE  > struct EpiRow {
    static constexpr bool PERM = true;
    bf16_t* O; int ldc; const float* rs;
    __device__ __forceinline__ void operator()(f32x4 (&acc)[2][2][4][2], const Unit& u, int wr, int wc, int fr, int fq) const {
        const int row0 = u.pm * BM + wr * 64 + fr, col0 = u.pn * BM + wc * 32 + 8 * fq;
#pragma unroll
        for (int ai = 0; ai < 2; ++ai)
#pragma unroll
            for (int m = 0; m < 4; ++m) {
                const int row = row0 + ai * HALF + m * 16; const float sc = (MODE != 0) ? rs_of(rs, row) : 1.0f;
                bf16_t* rowp = O + (size_t)row * ldc + col0;
#pragma unroll
                for (int bj = 0; bj < 2; ++bj) {
                    f32x4 v0 = acc[ai][bj][m][0], v1 = acc[ai][bj][m][1];
                    if (MODE != 0) { v0 = v0 * sc; v1 = v1 * sc; }
                    if (MODE == 2) {
#pragma unroll
                        for (int j = 0; j < 4; ++j) { const float a = fmaxf(v0[j], 0.f), b = fmaxf(v1[j], 0.f); v0[j] = a * a; v1[j] = b * b; }
                    }
                    u32x4 w; w.x = cvt_pk_bf16(v0[0], v0[1]); w.y = cvt_pk_bf16(v0[2], v0[3]); w.z = cvt_pk_bf16(v1[0], v1[1]); w.w = cvt_pk_bf16(v1[2], v1[3]);
                    __builtin_nontemporal_store(w, (u32x4*)(rowp + bj * HALF));
                }
            }
    }
};

__device__ __forceinline__ unsigned pack_u8x4(float a, float b, float c, float d) { unsigned w = 0u;
    w = __builtin_amdgcn_cvt_pk_u8_f32(a * 256.0f - 0.5f, 0, w); w = __builtin_amdgcn_cvt_pk_u8_f32(b * 256.0f - 0.5f, 1, w); w = __builtin_amdgcn_cvt_pk_u8_f32(c * 256.0f - 0.5f, 2, w); w = __builtin_amdgcn_cvt_pk_u8_f32(d * 256.0f - 0.5f, 3, w); return w; }
__device__ __forceinline__ f32x4 unpack_u8x4(unsigned w) { return (f32x4){(float)(w & 0xffu) + 0.5f, (float)((w >> 8) & 0xffu) + 0.5f, (float)((w >> 16) & 0xffu) + 0.5f, (float)(w >> 24) + 0.5f}; }
struct EpiGate {
    static constexpr bool PERM = true;
    unsigned char* Gt;
    bf16_t* MERGED;
    const float* rs;
    __device__ __forceinline__ void rescale(f32x4 (&acc)[2][2][4][2], int hsel, int j, int wr, int wc, int fr, int fq) const {
        int lane_off = (wr * 64 + fr) * 256 + wc * 32 + 8 * fq; asm volatile("" : "+v"(lane_off));
        const unsigned char* g0 = Gt + (size_t)(hsel * 4 + j) * 65536; const unsigned char* g1 = g0 + 65536;
#pragma unroll
        for (int ai = 0; ai < 2; ++ai) {
            u32x2 a[4][2], b[4][2];
#pragma unroll
            for (int m = 0; m < 4; ++m)
#pragma unroll
                for (int bj = 0; bj < 2; ++bj) { const int off = lane_off + (ai * HALF + m * 16) * 256 + bj * HALF; a[m][bj] = *(const u32x2*)(g0 + off); b[m][bj] = *(const u32x2*)(g1 + off); }
#pragma unroll
            for (int m = 0; m < 4; ++m)
#pragma unroll
                for (int bj = 0; bj < 2; ++bj) {
                    const f32x4 a0 = unpack_u8x4(a[m][bj].x), a1 = unpack_u8x4(a[m][bj].y), b0 = unpack_u8x4(b[m][bj].x), b1 = unpack_u8x4(b[m][bj].y);
#pragma unroll
                    for (int q = 0; q < 4; ++q) { acc[ai][bj][m][0][q] *= a0[q] * __builtin_amdgcn_rcpf(b0[q]); acc[ai][bj][m][1][q] *= a1[q] * __builtin_amdgcn_rcpf(b1[q]); }
                }
            asm volatile("" ::: "memory");
        }
    }
    __device__ __forceinline__ void operator()(f32x4 (&acc)[2][2][4][2], const Unit& u, int wr, int wc, int fr, int fq) const {
        if (u.kind >= 4 && u.kind < 7) { rescale(acc, u.pm >> 6, u.kind - 4, wr, wc, fr, fq); return; }
        int rl0 = wr * 64 + fr, cl0 = wc * 32 + 8 * fq; asm volatile("" : "+v"(rl0), "+v"(cl0));
        if (u.kind < 4) {
            unsigned char* gt = Gt + (size_t)u.kind * 65536;
#pragma unroll
            for (int ai = 0; ai < 2; ++ai)
#pragma unroll
                for (int m = 0; m < 4; ++m) {
                    const int rl = rl0 + ai * HALF + m * 16; const float sc = rs_of(rs, u.pm * BM + rl);
#pragma unroll
                    for (int bj = 0; bj < 2; ++bj) {
                        f32x4 v0 = acc[ai][bj][m][0] * sc, v1 = acc[ai][bj][m][1] * sc;
#pragma unroll
                        for (int j = 0; j < 4; ++j) { v0[j] = sigmoid_f(fmaxf(v0[j], -60.f)); v1[j] = sigmoid_f(fmaxf(v1[j], -60.f)); }
                        u32x2 w; w.x = pack_u8x4(v0[0], v0[1], v0[2], v0[3]); w.y = pack_u8x4(v1[0], v1[1], v1[2], v1[3]);
                        *(u32x2*)(gt + rl * 256 + cl0 + bj * HALF) = w;
                    }
                }
        } else {
            const unsigned char* g3 = Gt + (size_t)((u.pm >> 6) * 4 + 3) * 65536;
#pragma unroll
            for (int ai = 0; ai < 2; ++ai)
#pragma unroll
                for (int m = 0; m < 4; ++m) {
                    const int rl = rl0 + ai * HALF + m * 16;
                    bf16_t* rowp = MERGED + (size_t)(u.pm * BM + rl) * 1024 + u.pn * BM + cl0;
#pragma unroll
                    for (int bj = 0; bj < 2; ++bj) {
                        const u32x2 sw = *(const u32x2*)(g3 + rl * 256 + cl0 + bj * HALF);
                        const f32x4 s0 = unpack_u8x4(sw.x) * (1.0f / 256.0f), s1 = unpack_u8x4(sw.y) * (1.0f / 256.0f);
                        const f32x4 v0 = acc[ai][bj][m][0] * s0, v1 = acc[ai][bj][m][1] * s1;
                        u32x4 w; w.x = cvt_pk_bf16(v0[0], v0[1]); w.y = cvt_pk_bf16(v0[2], v0[3]); w.z = cvt_pk_bf16(v1[0], v1[1]); w.w = cvt_pk_bf16(v1[2], v1[3]);
                        *(u32x4*)(rowp + bj * HALF) = w;
                    }
                }
        }
    }
};

struct EpiGate8 {
    static constexpr bool PERM = true;
    unsigned char* Gt;
    const float* rs; const float* sa; const float* sb;
    __device__ __forceinline__ void operator()(f32x4 (&acc)[2][2][4][2], const Unit& u, int wr, int wc, int fr, int fq) const {
        int rl0 = wr * 64 + fr, cl0 = wc * 32 + 8 * fq; asm volatile("" : "+v"(rl0), "+v"(cl0));
        unsigned char* gt = Gt + (size_t)u.kind * 65536;
        f32x4 cs[2][2];
#pragma unroll
        for (int bj = 0; bj < 2; ++bj) { cs[bj][0] = *(const f32x4*)(sb + u.pn * BM + cl0 + bj * HALF); cs[bj][1] = *(const f32x4*)(sb + u.pn * BM + cl0 + bj * HALF + 4); }
#pragma unroll
        for (int ai = 0; ai < 2; ++ai)
#pragma unroll
            for (int m = 0; m < 4; ++m) {
                const int rl = rl0 + ai * HALF + m * 16; const float sc = -1.4426950408889634f * rs_of(rs, u.pm * BM + rl) * sa[u.pm * BM + rl];
#pragma unroll
                for (int bj = 0; bj < 2; ++bj) {
                    const i32x4 i0 = __builtin_bit_cast(i32x4, acc[ai][bj][m][0]), i1 = __builtin_bit_cast(i32x4, acc[ai][bj][m][1]);
                    f32x4 v0, v1;
#pragma unroll
                    for (int j = 0; j < 4; ++j) { v0[j] = __builtin_amdgcn_rcpf(1.0f + __builtin_amdgcn_exp2f((float)i0[j] * (sc * cs[bj][0][j]))); v1[j] = __builtin_amdgcn_rcpf(1.0f + __builtin_amdgcn_exp2f((float)i1[j] * (sc * cs[bj][1][j]))); }
                    u32x2 w; w.x = pack_u8x4(v0[0], v0[1], v0[2], v0[3]); w.y = pack_u8x4(v1[0], v1[1], v1[2], v1[3]);
                    *(u32x2*)(gt + rl * 256 + cl0 + bj * HALF) = w;
                }
            }
    }
};

struct EpiUp8 {
    static constexpr bool PERM = true;
    bf16_t* O; int ldc; const float* rs; const float* sa; const float* sb;
    __device__ __forceinline__ void operator()(f32x4 (&acc)[2][2][4][2], const Unit& u, int wr, int wc, int fr, int fq) const {
        int rl0 = wr * 64 + fr, cl0 = wc * 32 + 8 * fq; asm volatile("" : "+v"(rl0), "+v"(cl0));
        f32x4 cs[2][2];
#pragma unroll
        for (int bj = 0; bj < 2; ++bj) { cs[bj][0] = *(const f32x4*)(sb + u.pn * BM + cl0 + bj * HALF); cs[bj][1] = *(const f32x4*)(sb + u.pn * BM + cl0 + bj * HALF + 4); }
#pragma unroll
        for (int ai = 0; ai < 2; ++ai)
#pragma unroll
            for (int m = 0; m < 4; ++m) {
                const int row = u.pm * BM + rl0 + ai * HALF + m * 16; const float sc = rs_of(rs, row) * sa[row];
                bf16_t* rowp = O + (size_t)row * ldc + u.pn * BM + cl0;
#pragma unroll
                for (int bj = 0; bj < 2; ++bj) {
                    const i32x4 i0 = __builtin_bit_cast(i32x4, acc[ai][bj][m][0]), i1 = __builtin_bit_cast(i32x4, acc[ai][bj][m][1]);
                    f32x4 v0, v1;
#pragma unroll
                    for (int j = 0; j < 4; ++j) { const float a = fmaxf((float)i0[j] * (sc * cs[bj][0][j]), 0.f), b = fmaxf((float)i1[j] * (sc * cs[bj][1][j]), 0.f); v0[j] = a * a; v1[j] = b * b; }
                    u32x4 w; w.x = cvt_pk_bf16(v0[0], v0[1]); w.y = cvt_pk_bf16(v0[2], v0[3]); w.z = cvt_pk_bf16(v1[0], v1[1]); w.w = cvt_pk_bf16(v1[2], v1[3]);
                    __builtin_nontemporal_store(w, (u32x4*)(rowp + bj * HALF));
                }
            }
    }
};

struct PanelOrder {
    const char* A; const char* Bt; size_t tstep; int nt, half, vcu;
    __device__ bool next(int i, Unit& u) const { if (i > 1) return false; u.pm = i * 64 + (vcu >> 2); u.pn = vcu & 3; u.kind = 0; return true; }
    __device__ __forceinline__ void tiles(const Unit& u, const char*& a, const char*& b) const { a = A + (size_t)u.pm * tstep; b = Bt + (size_t)u.pn * tstep; }
    __device__ __forceinline__ int ntiles(const Unit&) const { return nt; }
    __device__ __forceinline__ bool keep_acc(const Unit&) const { return false; }
};
__device__ __forceinline__ void st_sys16(float* p, f32x4 v) { asm volatile("global_store_dwordx4 %0, %1, off sc0 sc1" :: "v"(p), "v"(v) : "memory"); }
__device__ __forceinline__ void ld_sys16x4(const float* p, f32x4 (&v)[4]) {
    asm volatile("global_load_dwordx4 %0, %4, off sc0 sc1\n\tglobal_load_dwordx4 %1, %4, off offset:16 sc0 sc1\n\tglobal_load_dwordx4 %2, %4, off offset:32 sc0 sc1\n\tglobal_load_dwordx4 %3, %4, off offset:48 sc0 sc1\n\ts_waitcnt vmcnt(0)"
                 : "=&v"(v[0]), "=&v"(v[1]), "=&v"(v[2]), "=&v"(v[3]) : "v"(p) : "memory"); }
struct EpiNorm {
    static constexpr bool PERM = true;
    bf16_t* HB; float* OUTF; const float* gain; float* XS; float* X2; unsigned* tmo; LAS unsigned char* sp;
    signed char* HB8; float* SA;
    __device__ __forceinline__ void operator()(f32x4 (&acc)[2][2][4][2], const Unit& u, int wr, int wc, int fr, int fq) const {
        LAS float* P = (LAS float*)sp;
        LAS float* PM = (LAS float*)(sp + 4096);
        LAS float* PB = (LAS float*)(sp + 8192);
        LAS float* R = (LAS float*)(sp + 12288);
        LAS float* RI = (LAS float*)(sp + 13312);
        LAS float* P2 = (LAS float*)(sp + 14336);
        const int tid = (wr * 4 + wc) * 64 + fq * 16 + fr;
        int rl0 = wr * 64 + fr, cl0 = wc * 32 + 8 * fq; asm volatile("" : "+v"(rl0), "+v"(cl0));
        f32x4 gv[2][2];
#pragma unroll
        for (int bj = 0; bj < 2; ++bj) { gv[bj][0] = *(const f32x4*)(gain + u.pn * BM + cl0 + bj * HALF); gv[bj][1] = *(const f32x4*)(gain + u.pn * BM + cl0 + bj * HALF + 4); }
#pragma unroll
        for (int ai = 0; ai < 2; ++ai)
#pragma unroll
            for (int m = 0; m < 4; ++m) { float s = 0.f;
#pragma unroll
                for (int bj = 0; bj < 2; ++bj)
#pragma unroll
                    for (int n = 0; n < 2; ++n) { const f32x4 x = acc[ai][bj][m][n]; s += (x[0] * x[0] + x[1] * x[1]) + (x[2] * x[2] + x[3] * x[3]); }
                s += __shfl_xor(s, 16); s += __shfl_xor(s, 32);
                if (fq == 0) P[(ai * HALF + wr * 64 + m * 16 + fr) * 4 + wc] = s; }
        asm volatile("s_waitcnt lgkmcnt(0)" ::: "memory"); __builtin_amdgcn_s_barrier(); asm volatile("" ::: "memory");
#pragma unroll
        for (int ai = 0; ai < 2; ++ai)
#pragma unroll
            for (int m = 0; m < 4; ++m) { const int rl = rl0 + ai * HALF + m * 16;
                const f32x4 p = *(const LAS f32x4*)(P + rl * 4); const float re = 1.0f / sqrtf(((p[0] + p[1]) + (p[2] + p[3])) * (1.0f / 256.0f) + 1e-6f);
                float mx = 0.f, bx = 0.f;
#pragma unroll
                for (int bj = 0; bj < 2; ++bj) { const u32x4 w = *(const u32x4*)(HB + ((size_t)u.pm * BM + rl) * 1024 + u.pn * BM + cl0 + bj * HALF);
                    const f32x4 h0 = {bf2f(w.x & 0xffffu), bf2f(w.x >> 16), bf2f(w.y & 0xffffu), bf2f(w.y >> 16)}, h1 = {bf2f(w.z & 0xffffu), bf2f(w.z >> 16), bf2f(w.w & 0xffffu), bf2f(w.w >> 16)};
                    const f32x4 a0 = gv[bj][0] * acc[ai][bj][m][0], a1 = gv[bj][1] * acc[ai][bj][m][1]; acc[ai][bj][m][0] = a0; acc[ai][bj][m][1] = a1;
                    const f32x4 t0 = h0 + a0 * re, t1 = h1 + a1 * re;
#pragma unroll
                    for (int q = 0; q < 4; ++q) { mx = fmaxf(mx, fmaxf(fabsf(t0[q]), fabsf(t1[q]))); bx = fmaxf(bx, fmaxf(fabsf(a0[q]), fabsf(a1[q]))); } }
                mx = fmaxf(mx, __shfl_xor(mx, 16)); mx = fmaxf(mx, __shfl_xor(mx, 32)); bx = fmaxf(bx, __shfl_xor(bx, 16)); bx = fmaxf(bx, __shfl_xor(bx, 32));
                if (fq == 0) { PM[rl * 4 + wc] = mx; PB[rl * 4 + wc] = bx; } }
        asm volatile("s_waitcnt lgkmcnt(0)" ::: "memory"); __builtin_amdgcn_s_barrier(); asm volatile("" ::: "memory");
        if (tid < 256) {
            const f32x4 p = *(const LAS f32x4*)(P + tid * 4), pm4 = *(const LAS f32x4*)(PM + tid * 4), pb4 = *(const LAS f32x4*)(PB + tid * 4);
            const float ss = (p[0] + p[1]) + (p[2] + p[3]);
            float* slots = XS + ((size_t)u.pm * BM + tid) * 16;
            st_sys16(slots + u.pn * 4, (f32x4){ss, fmaxf(fmaxf(pm4[0], pm4[1]), fmaxf(pm4[2], pm4[3])), fmaxf(fmaxf(pb4[0], pb4[1]), fmaxf(pb4[2], pb4[3])), 1.0f / sqrtf(ss * (1.0f / 256.0f) + 1e-6f)});
            f32x4 s4[4]; unsigned spins = 0;
            for (;;) {
                bool ok = true;
                ld_sys16x4(slots, s4);
#pragma unroll
                for (int t = 0; t < 4; ++t) ok = ok && (s4[t][0] >= 0.f) && (s4[t][1] >= 0.f) && (s4[t][2] >= 0.f) && (s4[t][3] >= 0.f);
                if (__builtin_amdgcn_ballot_w64(!ok) == 0ull) break;
                __builtin_amdgcn_s_sleep(1);
                if (++spins > (1u << 20)) { __hip_atomic_store(tmo, 1u, __ATOMIC_RELAXED, __HIP_MEMORY_SCOPE_AGENT); break; }
            }
            const float r = 1.0f / sqrtf(((s4[0][0] + s4[1][0]) + (s4[2][0] + s4[3][0])) * (1.0f / 1024.0f) + 1e-6f);
            float bound = 0.f;
#pragma unroll
            for (int t = 0; t < 4; ++t) bound = fmaxf(bound, s4[t][1] + s4[t][2] * fabsf(r - s4[t][3]));
            bound *= 1.00001f;
            const float sc = (bound > 0.f) ? bound * (1.0f / 127.0f) : 1.0f;
            R[tid] = r; RI[tid] = 1.0f / sc; if (u.pn == 0 && !OUTF) SA[(size_t)u.pm * BM + tid] = sc;
        }
        asm volatile("s_waitcnt lgkmcnt(0)" ::: "memory"); __builtin_amdgcn_s_barrier(); asm volatile("" ::: "memory");
#pragma unroll
        for (int ai = 0; ai < 2; ++ai)
#pragma unroll
            for (int m = 0; m < 4; ++m) { const int rl = rl0 + ai * HALF + m * 16; const float r = R[rl], inv = RI[rl]; const size_t go = ((size_t)u.pm * BM + rl) * 1024 + u.pn * BM + cl0;
                float s2 = 0.f;
#pragma unroll
                for (int bj = 0; bj < 2; ++bj) { const u32x4 w = *(const u32x4*)(HB + go + bj * HALF);
                    f32x4 h0 = {bf2f(w.x & 0xffffu), bf2f(w.x >> 16), bf2f(w.y & 0xffffu), bf2f(w.y >> 16)}, h1 = {bf2f(w.z & 0xffffu), bf2f(w.z >> 16), bf2f(w.w & 0xffffu), bf2f(w.w >> 16)};
                    h0 = h0 + acc[ai][bj][m][0] * r; h1 = h1 + acc[ai][bj][m][1] * r;
                    s2 += (h0[0] * h0[0] + h0[1] * h0[1]) + (h0[2] * h0[2] + h0[3] * h0[3]) + (h1[0] * h1[0] + h1[1] * h1[1]) + (h1[2] * h1[2] + h1[3] * h1[3]);
                    if (OUTF) { *(f32x4*)(OUTF + go + bj * HALF) = h0; *(f32x4*)(OUTF + go + bj * HALF + 4) = h1; }
                    else { u32x4 o; o.x = cvt_pk_bf16(h0[0], h0[1]); o.y = cvt_pk_bf16(h0[2], h0[3]); o.z = cvt_pk_bf16(h1[0], h1[1]); o.w = cvt_pk_bf16(h1[2], h1[3]); __builtin_nontemporal_store(o, (u32x4*)(HB + go + bj * HALF));
                        u32x2 q; q.x = q4_i8(h0, inv); q.y = q4_i8(h1, inv); *(u32x2*)(HB8 + go + bj * HALF) = q; } }
                s2 += __shfl_xor(s2, 16); s2 += __shfl_xor(s2, 32);
                if (fq == 0) P2[rl * 4 + wc] = s2; }
        asm volatile("s_waitcnt lgkmcnt(0)" ::: "memory"); __builtin_amdgcn_s_barrier(); asm volatile("" ::: "memory");
        if (tid < 256) { const f32x4 p = *(const LAS f32x4*)(P2 + tid * 4); X2[((size_t)u.pm * BM + tid) * 4 + u.pn] = (p[0] + p[1]) + (p[2] + p[3]); }
    }
};

template <class Epi, class Sched, bool ALIGN_EPI, bool I8 = false>
__device__ __forceinline__ void gemm_phase(LAS unsigned char* lds, const int K, const Sched& S, const Epi& E) {
    int tid = threadIdx.x; asm volatile("" : "+v"(tid));
    const int wid = __builtin_amdgcn_readfirstlane(tid >> 6), lane = tid & 63, wr = wid >> 2, wc = wid & 3, fr = lane & 15, fq = lane >> 4;
    unsigned voffA[2], voffB[2];
#pragma unroll
    for (int i = 0; i < 2; ++i) { int R, C; stage_rc(tid * 16 + i * 8192, R, C); const int Rb = Epi::PERM ? ((R & ~31) + perm32(R & 31)) : R;
        voffA[i] = (unsigned)(R * K + C) * 2u; voffB[i] = (unsigned)(Rb * K + C) * 2u; }
    const size_t kstep = (size_t)(BK * 2);
    const size_t hstep = (size_t)HALF * K * 2;
    const unsigned ldsw = (unsigned)wid * 1024u;
    const int aoff = lds_byte(wr * 64 + fr, fq * 8), boff = lds_byte(wc * 32 + fr, fq * 8);
#define PG8_SA(b, h) (((b) * 2 + (h)) * HTB)
#define PG8_SB(b, h) ((4 + (b) * 2 + (h)) * HTB)
#define PG8_STAGE(bufoff, gbase, voff) do { _Pragma("unroll") for (int _i = 0; _i < 2; ++_i) \
        __builtin_amdgcn_global_load_lds((const unsigned*)((const char*)(gbase) + (voff)[_i]), (LAS unsigned*)(lds + (bufoff) + ldsw + _i * 8192), 16, 0, 0); } while (0)
#define PG8_LDA(dst, b, h) do { _Pragma("unroll") for (int m = 0; m < 4; ++m) _Pragma("unroll") for (int k = 0; k < 2; ++k) dst[m][k] = *(const LAS bf16x8*)(lds + PG8_SA(b, h) + aoff + m * 2048 + k * 1024); } while (0)
#define PG8_LDB(dst, b, h) do { _Pragma("unroll") for (int n = 0; n < 2; ++n) _Pragma("unroll") for (int k = 0; k < 2; ++k) dst[n][k] = *(const LAS bf16x8*)(lds + PG8_SB(b, h) + boff + n * 2048 + k * 1024); } while (0)
#define PG8_MMA(ai, bj, At, Bt) do { __builtin_amdgcn_s_setprio(1); _Pragma("unroll") for (int m = 0; m < 4; ++m) _Pragma("unroll") for (int n = 0; n < 2; ++n) _Pragma("unroll") for (int k = 0; k < 2; ++k) \
        { if constexpr (I8) acc[ai][bj][m][n] = __builtin_bit_cast(f32x4, __builtin_amdgcn_mfma_i32_16x16x64_i8(__builtin_bit_cast(i32x4, Bt[n][k]), __builtin_bit_cast(i32x4, At[m][k]), __builtin_bit_cast(i32x4, acc[ai][bj][m][n]), 0, 0, 0)); \
          else acc[ai][bj][m][n] = __builtin_amdgcn_mfma_f32_16x16x32_bf16(Bt[n][k], At[m][k], acc[ai][bj][m][n], 0, 0, 0); } __builtin_amdgcn_s_setprio(0); } while (0)
#define PG8_WAIT_V(n) asm volatile("s_waitcnt vmcnt(" #n ")" ::: "memory")
#define PG8_WAIT_L(n) asm volatile("s_waitcnt lgkmcnt(" #n ")" ::: "memory")
#define PG8_BAR __builtin_amdgcn_s_barrier()
#define PG8_SCHED __builtin_amdgcn_sched_barrier(0)
    Unit cur, nxt; int ui = 0;
    if (!S.next(0, cur)) return;
    f32x4 acc[2][2][4][2];
#pragma unroll
    for (int a = 0; a < 2; ++a)
#pragma unroll
        for (int b = 0; b < 2; ++b)
#pragma unroll
            for (int m = 0; m < 4; ++m)
#pragma unroll
                for (int n = 0; n < 2; ++n) acc[a][b][m][n] = (f32x4){0.f, 0.f, 0.f, 0.f};
    bf16x8 At[4][2], B0[2][2], B1[2][2];
    const char* cA; const char* cB; S.tiles(cur, cA, cB);
    PG8_STAGE(PG8_SB(0, 0), cB, voffB); PG8_STAGE(PG8_SB(0, 1), cB + hstep, voffB); PG8_STAGE(PG8_SA(0, 0), cA, voffA); PG8_STAGE(PG8_SA(0, 1), cA + hstep, voffA);
    if (wr == 1) PG8_BAR;
    PG8_WAIT_V(2); PG8_BAR;
    PG8_STAGE(PG8_SB(1, 0), cB + kstep, voffB); PG8_STAGE(PG8_SA(1, 0), cA + kstep, voffA); PG8_STAGE(PG8_SB(1, 1), cB + hstep + kstep, voffB);
    PG8_WAIT_V(6); PG8_BAR;
    for (;;) {
        const bool has_next = S.next(ui + 1, nxt);
        const char* nA = cA; const char* nB = cB; if (has_next) S.tiles(nxt, nA, nB);
#define PG8_KT2(t, last) do { \
            const char* a1 = cA + (size_t)((t) + 1) * kstep; \
            const char* a2 = (last) ? nA : cA + (size_t)((t) + 2) * kstep; const char* b2 = (last) ? nB : cB + (size_t)((t) + 2) * kstep; \
            const char* a3 = a2 + kstep; const char* b3 = b2 + kstep; \
            PG8_LDB(B0, 0, 0); PG8_LDB(B1, 0, 1); PG8_SCHED; PG8_LDA(At, 0, 0); PG8_STAGE(PG8_SA(1, 1), a1 + hstep, voffA); \
            PG8_WAIT_V(8); PG8_WAIT_L(0); PG8_BAR; PG8_MMA(0, 0, At, B0); PG8_MMA(0, 1, At, B1); PG8_BAR; PG8_SCHED; \
            PG8_LDA(At, 0, 1); PG8_STAGE(PG8_SB(0, 0), b2, voffB); PG8_STAGE(PG8_SB(0, 1), b2 + hstep, voffB); PG8_STAGE(PG8_SA(0, 0), a2, voffA); \
            PG8_WAIT_V(8); PG8_WAIT_L(0); PG8_BAR; PG8_MMA(1, 0, At, B0); PG8_MMA(1, 1, At, B1); PG8_BAR; PG8_SCHED; \
            PG8_LDB(B0, 1, 0); PG8_LDB(B1, 1, 1); PG8_SCHED; PG8_LDA(At, 1, 0); PG8_STAGE(PG8_SA(0, 1), a2 + hstep, voffA); \
            PG8_WAIT_V(8); PG8_WAIT_L(0); PG8_BAR; PG8_MMA(0, 0, At, B0); PG8_MMA(0, 1, At, B1); PG8_BAR; PG8_SCHED; \
            PG8_LDA(At, 1, 1); PG8_STAGE(PG8_SB(1, 0), b3, voffB); PG8_STAGE(PG8_SB(1, 1), b3 + hstep, voffB); PG8_STAGE(PG8_SA(1, 0), a3, voffA); \
            PG8_WAIT_V(8); PG8_WAIT_L(0); PG8_BAR; PG8_MMA(1, 0, At, B0); PG8_MMA(1, 1, At, B1); PG8_BAR; PG8_SCHED; } while (0)
        {
            const int ntc = S.ntiles(cur);
#pragma unroll 1
            for (int t = 0; t < ntc; t += 2) { const bool last = (t == ntc - 2); PG8_KT2(t, last); }
        }
        if constexpr (ALIGN_EPI) { if (wr == 0) PG8_BAR; }
        E(acc, cur, wr, wc, fr, fq);
        if (!has_next) break;
        if (!S.keep_acc(nxt)) {
#pragma unroll
        for (int a = 0; a < 2; ++a)
#pragma unroll
            for (int b = 0; b < 2; ++b)
#pragma unroll
                for (int m = 0; m < 4; ++m)
#pragma unroll
                    for (int n = 0; n < 2; ++n) acc[a][b][m][n] = (f32x4){0.f, 0.f, 0.f, 0.f};
        }
        cur = nxt; cA = nA; cB = nB; ++ui;
        if constexpr (ALIGN_EPI) { if (wr == 1) PG8_BAR; }
    }
    PG8_WAIT_V(0);
    if constexpr (!ALIGN_EPI) { if (wr == 0) PG8_BAR; }
    PG8_BAR;
#undef PG8_KT2
#undef PG8_SA
#undef PG8_SB
#undef PG8_STAGE
#undef PG8_LDA
#undef PG8_LDB
#undef PG8_MMA
#undef PG8_WAIT_V
#undef PG8_WAIT_L
#undef PG8_BAR
#undef PG8_SCHED
}
}

struct Args {
    const float* in[22]; float* out; unsigned char* ws; int ph_lo, ph_hi;
};
enum { I_X = 0, I_NMIXPRE, I_NMIXPOST, I_NMLPPRE, I_NMLPPOST, I_WIN, I_LCW, I_LCB, I_LWA, I_LBA, I_LWX, I_LBX, I_LLAM, I_PW, I_PS, I_HLB, I_HN, I_SW, I_WBR, I_WOUT, I_WUP, I_WDOWN };

struct Ctx {
    LAS unsigned char* lds; int tid, lane, wave, vcu, G;
};

__device__ __forceinline__ void transpose_item(const float* W, int ldw, const float* gain, bf16_t* WT, int ldo, int col_off, int k0, int n0, LAS float* scr, int lane) {
    float wv[32];
#pragma unroll
    for (int i = 0; i < 32; ++i) { const int kk = 2 * i + (lane >> 5); wv[i] = W[(size_t)(k0 + kk) * ldw + n0 + (lane & 31)]; }
#pragma unroll
    for (int i = 0; i < 32; ++i) { const int kk = 2 * i + (lane >> 5); const float g = gain ? gain[k0 + kk] : 1.0f; scr[kk * 33 + (lane & 31)] = g * wv[i]; }
    asm volatile("s_waitcnt lgkmcnt(0)" ::: "memory");
    const int c = lane & 7;
#pragma unroll
    for (int j = 0; j < 4; ++j) { const int n = (lane >> 3) + 8 * j; const LAS float* s = scr + (8 * c) * 33 + n;
        u32x4 o; o.x = pk2(s[0 * 33], s[1 * 33]); o.y = pk2(s[2 * 33], s[3 * 33]); o.z = pk2(s[4 * 33], s[5 * 33]); o.w = pk2(s[6 * 33], s[7 * 33]);
        *(u32x4*)(WT + (size_t)(n0 + n) * ldo + col_off + k0 + 8 * c) = o; }
    asm volatile("s_waitcnt lgkmcnt(0)" ::: "memory");
}

__device__ __forceinline__ void p0_prologue(const Ctx& C, const Args& A) {
    LAS float* scr = (LAS float*)(C.lds + C.wave * 16384);
    const int gw = C.vcu * NWAVES + C.wave, NGW = C.G * NWAVES;
    constexpr int I_IN = (D / 64) * (INW / 32), I_BR1 = (BW / 64) * (D / 32), I_OUT = (D / 64) * (D / 32), I_UP = (D / 64) * (FF / 32), I_DN = (FF / 64) * (D / 32);
    constexpr int PER_LAYER = I_IN + 4 * I_BR1 + I_OUT + I_UP + I_DN;
    for (int it = gw; it < DEPTH * PER_LAYER; it += NGW) {
        const int l = it / PER_LAYER; int r = it % PER_LAYER;
        bf16_t* wl = (bf16_t*)(A.ws + WS_W + (size_t)l * W_LAYER);
        if (r < I_IN) { const int nb = INW / 32; transpose_item(A.in[I_WIN] + (size_t)l * D * INW, INW, A.in[I_NMIXPRE] + l * D, wl + W_IN / 2, D, 0, 64 * (r / nb), 32 * (r % nb), scr, C.lane); continue; } r -= I_IN;
        if (r < 4 * I_BR1) { const int k = r / I_BR1, rr = r % I_BR1, nb = D / 32; transpose_item(A.in[I_WBR] + ((size_t)l * 4 + k) * BW * D, D, nullptr, wl + W_BR / 2, D, k * BW, 64 * (rr / nb), 32 * (rr % nb), scr, C.lane); continue; } r -= 4 * I_BR1;
        if (r < I_OUT) { const int nb = D / 32; transpose_item(A.in[I_WOUT] + (size_t)l * D * D, D, nullptr, wl + W_OUT / 2, D, 0, 64 * (r / nb), 32 * (r % nb), scr, C.lane); continue; } r -= I_OUT;
        if (r < I_UP) { const int nb = FF / 32; transpose_item(A.in[I_WUP] + (size_t)l * D * FF, FF, A.in[I_NMLPPRE] + l * D, wl + W_UP / 2, D, 0, 64 * (r / nb), 32 * (r % nb), scr, C.lane); continue; } r -= I_UP;
        { const int nb = D / 32; transpose_item(A.in[I_WDOWN] + (size_t)l * FF * D, D, nullptr, wl + W_DOWN / 2, FF, 0, 64 * (r / nb), 32 * (r % nb), scr, C.lane); }
    }
    { const int gt = gw * 64 + C.lane; if (gt < DEPTH * BW) { const float lam = A.in[I_LLAM][gt]; ((float*)(A.ws + WS_SP8))[gt] = -8.0f * ((-lam > 20.f) ? -lam : log1pf(expf(-lam))); } }
    bf16_t* HB = (bf16_t*)(A.ws + WS_HB); float* RS = (float*)(A.ws + WS_X2);
    for (int m0 = gw; m0 < M; m0 += 4 * NGW) {
        f32x4 v[4][4];
#pragma unroll
        for (int q = 0; q < 4; ++q) { const int m = m0 + q * NGW; const f32x4* xr = (const f32x4*)(A.in[I_X] + (size_t)(m < M ? m : 0) * D) + C.lane;
#pragma unroll
            for (int j = 0; j < 4; ++j) v[q][j] = xr[64 * j]; }
#pragma unroll
        for (int q = 0; q < 4; ++q) { const int m = m0 + q * NGW; if (m < M) { float s = 0.f;
#pragma unroll
            for (int j = 0; j < 4; ++j) s += (v[q][j].x * v[q][j].x + v[q][j].y * v[q][j].y) + (v[q][j].z * v[q][j].z + v[q][j].w * v[q][j].w);
            s = wave_sum(s);
            u32x2* o8 = (u32x2*)(HB + (size_t)m * D) + C.lane;
#pragma unroll
            for (int j = 0; j < 4; ++j) { u32x2 w; w.x = pk2(v[q][j].x, v[q][j].y); w.y = pk2(v[q][j].z, v[q][j].w); o8[64 * j] = w; }
            float mx = 0.f;
#pragma unroll
            for (int j = 0; j < 4; ++j) mx = fmaxf(fmaxf(mx, fmaxf(fabsf(v[q][j].x), fabsf(v[q][j].y))), fmaxf(fabsf(v[q][j].z), fabsf(v[q][j].w)));
#pragma unroll
            for (int o = 1; o < 64; o <<= 1) mx = fmaxf(mx, __shfl_xor(mx, o));
            const float sc = (mx > 0.f) ? mx * (1.0f / 127.0f) : 1.0f, inv = 1.0f / sc;
            unsigned* o4 = (unsigned*)(A.ws + WS_HB8 + (size_t)m * D) + C.lane;
#pragma unroll
            for (int j = 0; j < 4; ++j) o4[64 * j] = q4_i8(v[q][j], inv);
            if (C.lane == 0) { *(f32x4*)(RS + (size_t)m * 4) = (f32x4){s, 0.f, 0.f, 0.f}; ((float*)(A.ws + WS_SA))[m] = sc; } } }
    }
}

__device__ __forceinline__ void norm_phase(const Ctx& C, const Args& A, const bf16_t* VIN, const float* gain, bool write_out) {
    bf16_t* HB = (bf16_t*)(A.ws + WS_HB); float* RS = (float*)(A.ws + WS_X2); float* OUT = A.out;
    int lane = C.lane; asm volatile("" : "+v"(lane));
    const int gw = C.vcu * NWAVES + C.wave, NGW = C.G * NWAVES;
    f32x4 g[4];
#pragma unroll
    for (int j = 0; j < 4; ++j) g[j] = ((const f32x4*)gain)[lane + 64 * j];
    for (int m = gw; m < M; m += NGW) {
        u32x2* hb = (u32x2*)(HB + (size_t)m * D) + lane;
        const u32x2* vb = (const u32x2*)(VIN + (size_t)m * D) + lane;
        f32x4 v[4], h[4]; float s = 0.f;
#pragma unroll
        for (int j = 0; j < 4; ++j) { const u32x2 w = vb[64 * j], hw = hb[64 * j];
            v[j] = (f32x4){bf2f(w.x & 0xffffu), bf2f(w.x >> 16), bf2f(w.y & 0xffffu), bf2f(w.y >> 16)};
            h[j] = (f32x4){bf2f(hw.x & 0xffffu), bf2f(hw.x >> 16), bf2f(hw.y & 0xffffu), bf2f(hw.y >> 16)};
            s += (v[j].x * v[j].x + v[j].y * v[j].y) + (v[j].z * v[j].z + v[j].w * v[j].w); }
        const float r = 1.0f / sqrtf(wave_sum(s) * (1.0f / D) + EPS);
        float s2 = 0.f;
#pragma unroll
        for (int j = 0; j < 4; ++j) { h[j] = h[j] + g[j] * v[j] * r; s2 += (h[j].x * h[j].x + h[j].y * h[j].y) + (h[j].z * h[j].z + h[j].w * h[j].w); }
        s2 = wave_sum(s2);
        if (write_out) { f32x4* orow = (f32x4*)(OUT + (size_t)m * D) + lane;
#pragma unroll
            for (int j = 0; j < 4; ++j) orow[64 * j] = h[j]; }
        else {
#pragma unroll
            for (int j = 0; j < 4; ++j) { u32x2 w; w.x = pk2(h[j].x, h[j].y); w.y = pk2(h[j].z, h[j].w); hb[64 * j] = w; }
            float mx = 0.f;
#pragma unroll
            for (int j = 0; j < 4; ++j) mx = fmaxf(fmaxf(mx, fmaxf(fabsf(h[j].x), fabsf(h[j].y))), fmaxf(fabsf(h[j].z), fabsf(h[j].w)));
#pragma unroll
            for (int o = 1; o < 64; o <<= 1) mx = fmaxf(mx, __shfl_xor(mx, o));
            const float sc = (mx > 0.f) ? mx * (1.0f / 127.0f) : 1.0f, inv = 1.0f / sc;
            unsigned* o4 = (unsigned*)(A.ws + WS_HB8 + (size_t)m * D) + lane;
#pragma unroll
            for (int j = 0; j < 4; ++j) o4[64 * j] = q4_i8(h[j], inv);
            if (lane == 0) { *(f32x4*)(RS + (size_t)m * 4) = (f32x4){s2, 0.f, 0.f, 0.f}; ((float*)(A.ws + WS_SA))[m] = sc; } }
    }
}

__device__ __forceinline__ float gelu_tanh(float x) {
    const float u = 0.7978845608028654f * (x + 0.044715f * x * x * x);
    const float e = fast_exp(2.0f * u);
    const float th = 1.0f - 2.0f * __builtin_amdgcn_rcpf(e + 1.0f);
    return 0.5f * x * (1.0f + th);
}

constexpr size_t WS_LRA = 428 * MiB, WS_LRU = 444 * MiB;
constexpr int MX_PT = 528;
__device__ __forceinline__ bf16x8 gather_wfrag(const float* w, int stride) {
    union { bf16x8 v; unsigned u[4]; } r;
#pragma unroll
    for (int p = 0; p < 4; ++p) r.u[p] = pk2(w[(2 * p) * stride], w[(2 * p + 1) * stride]);
    return r.v;
}
__device__ __forceinline__ void mix1_item(const Ctx& C, const Args& A, int l, int b, int c) {
    const bf16_t* PROJ = (const bf16_t*)(A.ws + WS_PROJ);
    bf16_t* YS = (bf16_t*)(A.ws + WS_YS);
    int tid = C.tid; asm volatile("" : "+v"(tid));
    const int lane = tid & 63, wave = C.wave, fr = lane & 15, fg = lane >> 4;
    const size_t m0 = (size_t)b * T + (size_t)c * 64;
    LAS unsigned char* XC = C.lds;
    LAS unsigned char* LAi = C.lds + 34816;
    LAS unsigned char* LUi = C.lds + 34816 + 32768;
    {
        const float* cw = A.in[I_LCW] + (size_t)l * 4 * BW; const float* cbp = A.in[I_LCB] + l * BW;
#pragma unroll
        for (int k = 0; k < 4; ++k) { const int idx = tid + NTHREADS * k; const int t = idx >> 5, c8 = (idx & 31) * 8;
            float acc[8];
            { const f32x4 b0 = *(const f32x4*)(cbp + c8), b1 = *(const f32x4*)(cbp + c8 + 4); acc[0] = b0[0]; acc[1] = b0[1]; acc[2] = b0[2]; acc[3] = b0[3]; acc[4] = b1[0]; acc[5] = b1[1]; acc[6] = b1[2]; acc[7] = b1[3]; }
#pragma unroll
            for (int j = 0; j < 4; ++j) { const int tok = c * 64 + t - 3 + j;
                if (tok >= 0) { float x[8]; ld8bf(PROJ + ((size_t)b * T + tok) * NMIX + c8, x); const f32x4 w0 = *(const f32x4*)(cw + j * BW + c8), w1 = *(const f32x4*)(cw + j * BW + c8 + 4);
                    acc[0] += w0[0] * x[0]; acc[1] += w0[1] * x[1]; acc[2] += w0[2] * x[2]; acc[3] += w0[3] * x[3]; acc[4] += w1[0] * x[4]; acc[5] += w1[1] * x[5]; acc[6] += w1[2] * x[6]; acc[7] += w1[3] * x[7]; } }
            u32x4 w; w.x = cvt_pk_bf16(acc[0], acc[1]); w.y = cvt_pk_bf16(acc[2], acc[3]); w.z = cvt_pk_bf16(acc[4], acc[5]); w.w = cvt_pk_bf16(acc[6], acc[7]);
            *(LAS u32x4*)(XC + t * MX_PT + c8 * 2) = w; }
    }
    __syncthreads();
    {
        const int blk = wave;
        const float* wa = A.in[I_LWA] + (((size_t)l * 8 + blk) * 32) * 32; const float* wx = A.in[I_LWX] + (((size_t)l * 8 + blk) * 32) * 32;
        bf16x8 fa[2], fx[2];
#pragma unroll
        for (int nt = 0; nt < 2; ++nt) { fa[nt] = gather_wfrag(wa + (8 * fg) * 32 + 16 * nt + fr, 32); fx[nt] = gather_wfrag(wx + (8 * fg) * 32 + 16 * nt + fr, 32); }
        bf16_t* LRA = (bf16_t*)(A.ws + WS_LRA); bf16_t* LRU = (bf16_t*)(A.ws + WS_LRU);
#pragma unroll
        for (int nt = 0; nt < 2; ++nt) { const int ch = 32 * blk + 16 * nt + 4 * fg;
            const f32x4 ba = *(const f32x4*)(A.in[I_LBA] + l * BW + ch), bx = *(const f32x4*)(A.in[I_LBX] + l * BW + ch), sp8 = *(const f32x4*)((const float*)(A.ws + WS_SP8) + l * BW + ch);
#pragma unroll
            for (int mt = 0; mt < 4; ++mt) { const int tok = 16 * mt + fr;
                const bf16x8 bxc = *(const LAS bf16x8*)(XC + tok * MX_PT + (32 * blk + 8 * fg) * 2);
                f32x4 ar = {0.f, 0.f, 0.f, 0.f}, ai = {0.f, 0.f, 0.f, 0.f};
                ar = __builtin_amdgcn_mfma_f32_16x16x32_bf16(fa[nt], bxc, ar, 0, 0, 0); ai = __builtin_amdgcn_mfma_f32_16x16x32_bf16(fx[nt], bxc, ai, 0, 0, 0);
                const u32x2 xw = *(const LAS u32x2*)(XC + tok * MX_PT + ch * 2);
                const float xc[4] = {bf2f(xw.x & 0xffffu), bf2f(xw.x >> 16), bf2f(xw.y & 0xffffu), bf2f(xw.y >> 16)};
                float la[4], uu[4];
#pragma unroll
                for (int r = 0; r < 4; ++r) { const float rg = sigmoid_f(ar[r] + ba[r]), ig = sigmoid_f(ai[r] + bx[r]);
                    la[r] = sp8[r] * rg; const float x2 = 2.0f * la[r];
                    const float om = (x2 > -0.02f) ? -x2 * (1.0f + 0.5f * x2 * (1.0f + x2 * (1.0f / 3.0f))) : 1.0f - fast_exp(x2);
                    uu[r] = sqrtf(om) * ig * xc[r]; }
                u32x2 wl, wu; wl.x = cvt_pk_bf16(la[0], la[1]); wl.y = cvt_pk_bf16(la[2], la[3]); wu.x = cvt_pk_bf16(uu[0], uu[1]); wu.y = cvt_pk_bf16(uu[2], uu[3]);
                *(LAS u32x2*)(LAi + tok * 512 + ch * 2) = wl; *(LAS u32x2*)(LUi + tok * 512 + ch * 2) = wu;
                *(u32x2*)(LRA + (m0 + tok) * BW + ch) = wl; *(u32x2*)(LRU + (m0 + tok) * BW + ch) = wu; }
        }
    }
    __syncthreads();
    {
        const int ch = tid & 255, half = tid >> 8; float P = 1.f, hst = 0.f;
#pragma unroll
        for (int i = 0; i < 32; ++i) { const int t = 32 * half + i; const float a = fast_exp(bf2f(*(const LAS bf16_t*)(LAi + t * 512 + ch * 2))); const float u = bf2f(*(const LAS bf16_t*)(LUi + t * 512 + ch * 2));
            hst = a * hst + u; P *= a; }
        const size_t aggi = ((size_t)b * 128 + c * 2 + half) * 256 + ch;
        ((float*)(A.ws + WS_LA))[aggi] = P; ((float*)(A.ws + WS_LH))[aggi] = hst;
    }
    __syncthreads();
    LAS unsigned char* PX = C.lds;
    LAS unsigned char* DD = C.lds + 43008;
    { u32x4 pv[5];
#pragma unroll
        for (int k = 0; k < 5; ++k) { const int idx = tid + NTHREADS * k; const int r = idx >> 5, c8 = (idx & 31) * 8; const int tok = c * 64 - 15 + r;
            pv[k] = (u32x4){0u, 0u, 0u, 0u}; if (idx < 79 * 32 && tok >= 0) pv[k] = *(const u32x4*)(PROJ + ((size_t)b * T + tok) * NMIX + 512 + c8); }
#pragma unroll
        for (int k = 0; k < 5; ++k) { const int idx = tid + NTHREADS * k; const int r = idx >> 5, c8 = (idx & 31) * 8; if (idx < 79 * 32) *(LAS u32x4*)(PX + r * MX_PT + c8 * 2) = pv[k]; } }
    __syncthreads();
#pragma unroll 1
    for (int k = 0; k < 4; ++k) { const int idx = tid + NTHREADS * k; const int t = idx >> 5, c8 = (idx & 31) * 8; const int g = c8 >> 6, win = 2 << g;
        float sum[8], x0[8];
#pragma unroll
        for (int e = 0; e < 8; ++e) sum[e] = 0.f;
        for (int j = 0; j < win; ++j) { const u32x4 v = *(const LAS u32x4*)(PX + (t + 15 - j) * MX_PT + c8 * 2);
            const float x[8] = {bf2f(v.x & 0xffffu), bf2f(v.x >> 16), bf2f(v.y & 0xffffu), bf2f(v.y >> 16), bf2f(v.z & 0xffffu), bf2f(v.z >> 16), bf2f(v.w & 0xffffu), bf2f(v.w >> 16)};
#pragma unroll
            for (int e = 0; e < 8; ++e) { sum[e] += x[e]; if (j == 0) x0[e] = x[e]; } }
        const int pos = c * 64 + t + 1; const float inv = 1.0f / (float)(pos < win ? pos : win);
        u32x4 w; w.x = cvt_pk_bf16(sum[0] * inv - x0[0], sum[1] * inv - x0[1]); w.y = cvt_pk_bf16(sum[2] * inv - x0[2], sum[3] * inv - x0[3]);
        w.z = cvt_pk_bf16(sum[4] * inv - x0[4], sum[5] * inv - x0[5]); w.w = cvt_pk_bf16(sum[6] * inv - x0[6], sum[7] * inv - x0[7]);
        *(LAS u32x4*)(DD + t * MX_PT + c8 * 2) = w; }
    __syncthreads();
    {
        const int g = wave >> 1, nb = (wave & 1) * 2;
        const float* pw = A.in[I_PW] + (((size_t)l * 4 + g) * 64) * 64;
        bf16x8 fw[2][2];
#pragma unroll
        for (int nn = 0; nn < 2; ++nn)
#pragma unroll
            for (int ks = 0; ks < 2; ++ks) fw[nn][ks] = gather_wfrag(pw + (32 * ks + 8 * fg) * 64 + 16 * (nb + nn) + fr, 64);
#pragma unroll
        for (int nn = 0; nn < 2; ++nn) { const int ch = 64 * g + 16 * (nb + nn) + 4 * fg; const f32x4 scl = *(const f32x4*)(A.in[I_PS] + l * BW + ch);
#pragma unroll
            for (int mt = 0; mt < 4; ++mt) { const int tok = 16 * mt + fr; f32x4 acc = {0.f, 0.f, 0.f, 0.f};
#pragma unroll
                for (int ks = 0; ks < 2; ++ks) { const bf16x8 bd = *(const LAS bf16x8*)(DD + tok * MX_PT + (64 * g + 32 * ks + 8 * fg) * 2); acc = __builtin_amdgcn_mfma_f32_16x16x32_bf16(fw[nn][ks], bd, acc, 0, 0, 0); }
                u32x2 w; w.x = cvt_pk_bf16(acc[0] * scl[0], acc[1] * scl[1]); w.y = cvt_pk_bf16(acc[2] * scl[2], acc[3] * scl[3]);
                *(u32x2*)(YS + (m0 + tok) * D + 256 + ch) = w; } }
    }
    {
        const float* sw = A.in[I_SW] + (size_t)l * 3 * BW;
#pragma unroll 2
        for (int k = 0; k < 4; ++k) { const int idx = tid + NTHREADS * k; const int t = idx >> 5, c8 = (idx & 31) * 8;
            float acc[8];
#pragma unroll
            for (int e = 0; e < 8; ++e) acc[e] = 0.f;
#pragma unroll
            for (int j = 0; j < 3; ++j) { const int tok = c * 64 + t - 2 + j;
                if (tok >= 0) { const bf16_t* p = PROJ + ((size_t)b * T + tok) * NMIX; float sc[8], sx[8]; ld8bf(p + 2048 + c8, sc); ld8bf(p + 2304 + c8, sx);
                    const f32x4 w0 = *(const f32x4*)(sw + j * BW + c8), w1 = *(const f32x4*)(sw + j * BW + c8 + 4);
                    acc[0] += w0[0] * sc[0] * sx[0]; acc[1] += w0[1] * sc[1] * sx[1]; acc[2] += w0[2] * sc[2] * sx[2]; acc[3] += w0[3] * sc[3] * sx[3];
                    acc[4] += w1[0] * sc[4] * sx[4]; acc[5] += w1[1] * sc[5] * sx[5]; acc[6] += w1[2] * sc[6] * sx[6]; acc[7] += w1[3] * sc[7] * sx[7]; } }
            float sb[8]; ld8bf(PROJ + (m0 + t) * NMIX + 1792 + c8, sb);
            u32x4 w; w.x = cvt_pk_bf16(sb[0] * acc[0], sb[1] * acc[1]); w.y = cvt_pk_bf16(sb[2] * acc[2], sb[3] * acc[3]); w.z = cvt_pk_bf16(sb[4] * acc[4], sb[5] * acc[5]); w.w = cvt_pk_bf16(sb[6] * acc[6], sb[7] * acc[7]);
            *(u32x4*)(YS + (m0 + t) * D + 768 + c8) = w; }
    }
    __syncthreads();
}
__device__ __forceinline__ void lru_final_item(const Ctx& C, const Args& A, int l, int b, int c) {
    const bf16_t* PROJ = (const bf16_t*)(A.ws + WS_PROJ);
    const bf16_t* LRA = (const bf16_t*)(A.ws + WS_LRA); const bf16_t* LRU = (const bf16_t*)(A.ws + WS_LRU);
    bf16_t* YS = (bf16_t*)(A.ws + WS_YS);
    int tid = C.tid; asm volatile("" : "+v"(tid));
    const int ch = tid & 255, half = tid >> 8;
    const size_t m0 = (size_t)b * T + (size_t)c * 64 + 32 * half;
    float hst = ((const float*)(A.ws + WS_LC))[((size_t)b * 128 + c * 2 + half) * 256 + ch];
    unsigned short la[32], lu[32], lg[32];
#pragma unroll
    for (int i = 0; i < 32; ++i) { la[i] = LRA[(m0 + i) * BW + ch]; lu[i] = LRU[(m0 + i) * BW + ch]; lg[i] = PROJ[(m0 + i) * NMIX + 256 + ch]; }
#pragma unroll
    for (int i = 0; i < 32; ++i) { const float a = fast_exp(bf2f(la[i])), u = bf2f(lu[i]);
        hst = a * hst + u;
        YS[(m0 + i) * D + ch] = (bf16_t)f2bf(hst * gelu_tanh(bf2f(lg[i]))); }
}

constexpr int HG_PT = 144;
constexpr int HG_IMG = 64 * HG_PT;
constexpr int HG_Q = 0, HG_K = HG_IMG, HG_P = 2 * HG_IMG, HG_BEND = 3 * HG_IMG, HG_REF = HG_BEND + 512, HG_HSZ = 29696;
constexpr size_t WS_ST16 = WS_MERGED + 32 * MiB;
__device__ __forceinline__ float hgrn_lb(const Args& A, int l, int w) {
    if (l == 0) return 0.f;
    const float a0 = A.in[I_HLB][w], a1 = A.in[I_HLB][BW + w];
    return 1.0f / (1.0f + expf(a0 - a1));
}
template <bool FINAL>
__device__ __forceinline__ void hgrn_item(const Ctx& C, const Args& A, int l, int b, int c) {
    const bf16_t* PROJ = (const bf16_t*)(A.ws + WS_PROJ);
    int lane = C.lane; asm volatile("" : "+v"(lane));
    const int wave = C.wave, h = wave >> 1, half = wave & 1, fr = lane & 15, fg = lane >> 4;
    LAS unsigned char* hb = C.lds + h * HG_HSZ;
    LAS float* BEND = (LAS float*)(hb + HG_BEND); LAS float* REF = (LAS float*)(hb + HG_REF);
    const size_t m0 = (size_t)b * T + (size_t)c * 64;
    const bf16_t* pr = PROJ + (m0 + 32 * half) * NMIX + h * 64 + lane;
    const int bh = b * 4 + h; const size_t ci = (size_t)bh * 64 + c;
    float bb[32], kk[32], vv[32];
    {
        const float lbv = hgrn_lb(A, l, h * 64 + lane);
        float acc = 0.f;
#pragma unroll
        for (int i = 0; i < 32; ++i) { const float x = bf2f(pr[(size_t)i * NMIX + 1024]); const float f = fmaxf(lbv + (1.0f - lbv) * sigmoid_f(x), 1e-30f);
            acc += __logf(f); bb[i] = acc; kk[i] = 1.0f - f; }
#pragma unroll
        for (int i = 0; i < 32; ++i) vv[i] = bf2f(pr[(size_t)i * NMIX + 1280]);
        BEND[half * 64 + lane] = acc;
    }
    __syncthreads();
    const float bend0 = BEND[lane], blast = bend0 + BEND[64 + lane];
    if (half) {
#pragma unroll
        for (int i = 0; i < 32; ++i) bb[i] += bend0;
    }
    if (!FINAL) {
        LAS unsigned char* kt = hb + HG_K + lane * HG_PT + 64 * half; LAS unsigned char* vt = hb + HG_Q + lane * HG_PT + 64 * half;
#pragma unroll
        for (int q4 = 0; q4 < 4; ++q4) { u32x4 wk, wv; unsigned kw[4], vw[4];
#pragma unroll
            for (int p = 0; p < 4; ++p) { const int i = q4 * 8 + 2 * p;
                kw[p] = cvt_pk_bf16(kk[i] * fast_exp(blast - bb[i]), kk[i + 1] * fast_exp(blast - bb[i + 1])); vw[p] = cvt_pk_bf16(vv[i], vv[i + 1]); }
            wk.x = kw[0]; wk.y = kw[1]; wk.z = kw[2]; wk.w = kw[3]; wv.x = vw[0]; wv.y = vw[1]; wv.z = vw[2]; wv.w = vw[3];
            *(LAS u32x4*)(kt + q4 * 16) = wk; *(LAS u32x4*)(vt + q4 * 16) = wv; }
        if (half == 0) ((float*)(A.ws + WS_SD))[ci * 64 + lane] = fast_exp(blast);
        __syncthreads();
        float* su = (float*)(A.ws + WS_SU) + ci * 4096;
#pragma unroll
        for (int aa = 0; aa < 2; ++aa) { const int a = 2 * half + aa;
            bf16x8 av[2];
#pragma unroll
            for (int ks = 0; ks < 2; ++ks) av[ks] = *(const LAS bf16x8*)(hb + HG_Q + (16 * a + fr) * HG_PT + 64 * ks + 16 * fg);
#pragma unroll
            for (int d = 0; d < 4; ++d) { f32x4 acc = {0.f, 0.f, 0.f, 0.f};
#pragma unroll
                for (int ks = 0; ks < 2; ++ks) { const bf16x8 bk = *(const LAS bf16x8*)(hb + HG_K + (16 * d + fr) * HG_PT + 64 * ks + 16 * fg);
                    acc = __builtin_amdgcn_mfma_f32_16x16x32_bf16(av[ks], bk, acc, 0, 0, 0); }
#pragma unroll
                for (int r = 0; r < 4; ++r) su[(16 * a + 4 * fg + r) * 64 + 16 * d + fr] = acc[r];
            } }
        __syncthreads();
    } else {
        float qq[32];
#pragma unroll
        for (int i = 0; i < 32; ++i) qq[i] = bf2f(pr[(size_t)i * NMIX + 768]);
        if (half == 0) { REF[64 + lane] = bb[15]; REF[128 + lane] = bb[31]; } else REF[192 + lane] = bb[15];
        { const u32x4 z = {0u, 0u, 0u, 0u};
#pragma unroll
            for (int k2 = 0; k2 < 5; ++k2) { const int idx = lane + 64 * k2; if (idx < 32 * 9) *(LAS u32x4*)(hb + HG_P + 32 * half * HG_PT + idx * 16) = z; } }
        __syncthreads();
        float rf[4]; rf[0] = 0.f; rf[1] = REF[64 + lane]; rf[2] = REF[128 + lane]; rf[3] = REF[192 + lane];
        {
            const float r_lo = half ? rf[2] : rf[0], r_hi = half ? rf[3] : rf[1];
#pragma unroll
            for (int i = 0; i < 32; ++i) { const float rr = (i < 16) ? r_lo : r_hi; const float val = qq[i] * fast_exp(bb[i] - rr);
                *(LAS bf16_t*)(hb + HG_Q + (32 * half + i) * HG_PT + 2 * lane) = (bf16_t)f2bf(val); }
        }
#pragma unroll
        for (int isub = 0; isub < 4; ++isub) {
            const int nrows = 16 * (isub + 1) - 32 * half;
#pragma unroll
            for (int i = 0; i < 32; ++i) { if (i < nrows) { const float e = fminf(rf[isub] - bb[i], 60.f); const float val = kk[i] * fast_exp(e);
                    *(LAS bf16_t*)(hb + HG_K + (32 * half + i) * HG_PT + 2 * lane) = (bf16_t)f2bf(val); } }
            __syncthreads();
            {
                bf16x8 bq[2];
#pragma unroll
                for (int ks = 0; ks < 2; ++ks) bq[ks] = *(const LAS bf16x8*)(hb + HG_Q + (16 * isub + fr) * HG_PT + 64 * ks + 16 * fg);
#pragma unroll
                for (int j = 0; j <= isub; ++j) { if ((j & 1) == half) {
                        f32x4 acc = {0.f, 0.f, 0.f, 0.f};
#pragma unroll
                        for (int ks = 0; ks < 2; ++ks) { const bf16x8 ak = *(const LAS bf16x8*)(hb + HG_K + (16 * j + fr) * HG_PT + 64 * ks + 16 * fg);
                            acc = __builtin_amdgcn_mfma_f32_16x16x32_bf16(ak, bq[ks], acc, 0, 0, 0); }
                        if (j == isub) {
#pragma unroll
                            for (int r = 0; r < 4; ++r) if (4 * fg + r > fr) acc[r] = 0.f; }
                        u32x2 w; w.x = cvt_pk_bf16(acc[0], acc[1]); w.y = cvt_pk_bf16(acc[2], acc[3]);
                        *(LAS u32x2*)(hb + HG_P + (16 * isub + fr) * HG_PT + 2 * (16 * j + 4 * fg)) = w;
                    } }
            }
            __syncthreads();
        }
        {
            LAS unsigned char* vt = hb + HG_Q + lane * HG_PT + 64 * half;
#pragma unroll
            for (int q4 = 0; q4 < 4; ++q4) { u32x4 wv; unsigned vw[4];
#pragma unroll
                for (int p = 0; p < 4; ++p) { const int i = q4 * 8 + 2 * p; vw[p] = cvt_pk_bf16(vv[i], vv[i + 1]); }
                wv.x = vw[0]; wv.y = vw[1]; wv.z = vw[2]; wv.w = vw[3]; *(LAS u32x4*)(vt + q4 * 16) = wv; }
#pragma unroll
            for (int i = 0; i < 32; ++i) *(LAS bf16_t*)(hb + HG_K + (32 * half + i) * HG_PT + 2 * lane) = (bf16_t)f2bf(qq[i] * fast_exp(bb[i]));
        }
        __syncthreads();
        {
            const bf16_t* st = (const bf16_t*)(A.ws + WS_ST16) + ci * 4096;
            bf16x8 a_st[4][2];
#pragma unroll
            for (int a = 0; a < 4; ++a)
#pragma unroll
                for (int ks = 0; ks < 2; ++ks) a_st[a][ks] = *(const bf16x8*)(st + (16 * a + fr) * 64 + 32 * ks + 8 * fg);
            bf16_t* YS = (bf16_t*)(A.ws + WS_YS);
            const float* gn = A.in[I_HN] + l * 64;
#pragma unroll
            for (int tt = 0; tt < 2; ++tt) { const int ti = 2 * half + tt;
                bf16x8 bp[2], bqb[2];
#pragma unroll
                for (int ks = 0; ks < 2; ++ks) { bp[ks] = *(const LAS bf16x8*)(hb + HG_P + (16 * ti + fr) * HG_PT + 64 * ks + 16 * fg); bqb[ks] = *(const LAS bf16x8*)(hb + HG_K + (16 * ti + fr) * HG_PT + 64 * ks + 16 * fg); }
                f32x4 o[4]; float ss = 0.f;
#pragma unroll
                for (int a = 0; a < 4; ++a) { f32x4 acc = {0.f, 0.f, 0.f, 0.f};
#pragma unroll
                    for (int ks = 0; ks < 2; ++ks) { const bf16x8 av = *(const LAS bf16x8*)(hb + HG_Q + (16 * a + fr) * HG_PT + 64 * ks + 16 * fg);
                        acc = __builtin_amdgcn_mfma_f32_16x16x32_bf16(av, bp[ks], acc, 0, 0, 0);
                        acc = __builtin_amdgcn_mfma_f32_16x16x32_bf16(a_st[a][ks], bqb[ks], acc, 0, 0, 0); }
                    o[a] = acc; ss += (acc[0] * acc[0] + acc[1] * acc[1]) + (acc[2] * acc[2] + acc[3] * acc[3]); }
                ss += __shfl_xor(ss, 16); ss += __shfl_xor(ss, 32);
                const float rn = 1.0f / sqrtf(ss * (1.0f / 64.0f) + EPS);
                const size_t row = m0 + 16 * ti + fr;
#pragma unroll
                for (int a = 0; a < 4; ++a) { const int dv = 16 * a + 4 * fg;
                    const u32x2 gw = *(const u32x2*)(PROJ + row * NMIX + 1536 + h * 64 + dv);
                    const float g0 = bf2f(gw.x & 0xffffu), g1 = bf2f(gw.x >> 16), g2 = bf2f(gw.y & 0xffffu), g3 = bf2f(gw.y >> 16);
                    const f32x4 gv = *(const f32x4*)(gn + dv);
                    const float y0 = o[a][0] * rn * gv[0] * (g0 * sigmoid_f(g0)), y1 = o[a][1] * rn * gv[1] * (g1 * sigmoid_f(g1));
                    const float y2 = o[a][2] * rn * gv[2] * (g2 * sigmoid_f(g2)), y3 = o[a][3] * rn * gv[3] * (g3 * sigmoid_f(g3));
                    u32x2 w; w.x = cvt_pk_bf16(y0, y1); w.y = cvt_pk_bf16(y2, y3);
                    *(u32x2*)(YS + row * D + 512 + h * 64 + dv) = w; }
            }
        }
        __syncthreads();
    }
}

__device__ __forceinline__ void mix_phase2(const Ctx& C, const Args& A) {
    float* __restrict__ SU = (float*)(A.ws + WS_SU); const float* __restrict__ SD = (const float*)(A.ws + WS_SD);
    int tid_ = C.tid; asm volatile("" : "+v"(tid_));
    const int gt = C.vcu * NTHREADS + tid_, NGT = C.G * NTHREADS;
    for (int e = gt; e < 32 * 4096; e += NGT) {
        const int bh = e >> 12, kv = e & 4095, dk = kv & 63;
        bf16_t* __restrict__ ST16 = (bf16_t*)(A.ws + WS_ST16);
        float s = 0.f;
#pragma unroll 32
        for (int c = 0; c < 64; ++c) { const size_t ci = (size_t)bh * 64 + c; const float u = SU[ci * 4096 + kv]; const float d = SD[ci * 64 + dk]; ST16[ci * 4096 + kv] = (bf16_t)f2bf(s); s = d * s + u; }
    }
    const float* __restrict__ LA = (const float*)(A.ws + WS_LA); const float* __restrict__ LH = (const float*)(A.ws + WS_LH); float* __restrict__ LC = (float*)(A.ws + WS_LC);
    for (int e = gt; e < BATCH * BW; e += NGT) {
        const int b = e >> 8, ch = e & 255; float cr = 0.f;
#pragma unroll 32
        for (int sc = 0; sc < 128; ++sc) { const size_t i = ((size_t)b * 128 + sc) * 256 + ch; const float a = LA[i], hh = LH[i]; LC[i] = cr; cr = a * cr + hh; }
    }
}

#define XB_TMO      128
#define XB_XCNT(j)  (256  + 64 * (j))
#define XB_XSUB(j)  (1280 + 64 * (j))
#define XB_XGEN(j)  (2304 + 64 * (j))
#define XB_TOP      3328
#define XB_TOPGEN   3392
#define XCD_BAR_WORDS 3456
#define XB_SPIN_CAP (1u << 20)
__device__ __forceinline__ unsigned xb_ld(unsigned* p)              { return __hip_atomic_load(p, __ATOMIC_RELAXED, __HIP_MEMORY_SCOPE_AGENT); }
__device__ __forceinline__ unsigned xb_add(unsigned* p, unsigned v) { return __hip_atomic_fetch_add(p, v, __ATOMIC_RELAXED, __HIP_MEMORY_SCOPE_AGENT); }
__device__ __forceinline__ unsigned xb_xcc_id() { return (unsigned)__builtin_amdgcn_s_getreg((3 << 11) | 20) & 0xFu; }
#define XB_SPIN(cond, bar) do { unsigned _sp = 0; while (cond) { __builtin_amdgcn_s_sleep(1); \
    if ((++_sp & 255u) == 0u) { if (xb_ld(&(bar)[XB_TMO])) break; if (_sp > XB_SPIN_CAP) { atomicAdd(&(bar)[XB_TMO], 1u); break; } } } } while (0)
struct XcdBarrier { unsigned* bar; unsigned x; volatile LAS unsigned* st; };
__device__ __forceinline__ XcdBarrier xcd_barrier_post(unsigned* bar, volatile LAS unsigned* st) {
    XcdBarrier b; b.bar = bar; b.x = xb_xcc_id(); b.st = st;
    if (threadIdx.x == 0) (void)xb_add(&bar[XB_XCNT(b.x)], 1u);
    return b;
}
__device__ __forceinline__ void xcd_barrier_complete(unsigned* bar, unsigned x, unsigned& nloc, unsigned& nx) {
    const unsigned G = gridDim.x * gridDim.y * gridDim.z;
    unsigned sum, cnt, mine, sp = 0u;
    for (;;) {
        sum = 0u; cnt = 0u; mine = 0u;
#pragma unroll
        for (unsigned j = 0; j < 16; ++j) { const unsigned c = xb_ld(&bar[XB_XCNT(j)]); sum += c; cnt += (c > 0u) ? 1u : 0u; mine = (j == x) ? c : mine; }
        if (sum == G) break;
        __builtin_amdgcn_s_sleep(1);
        if ((++sp & 255u) == 0u) { if (xb_ld(&bar[XB_TMO])) break; if (sp > XB_SPIN_CAP) { atomicAdd(&bar[XB_TMO], 1u); break; } }
    }
    nloc = mine > 0u ? mine : 1u; nx = cnt > 0u ? cnt : 1u;
}
__device__ __forceinline__ void xcd_barrier(const XcdBarrier& b) {
    asm volatile("s_waitcnt vmcnt(0)" ::: "memory");
    __syncthreads();
    if (threadIdx.x == 0) {
        unsigned* bar = b.bar;
        __builtin_amdgcn_s_waitcnt(0);
        unsigned nloc = b.st[0], nx = b.st[1];
        if (nloc == 0u) { xcd_barrier_complete(bar, b.x, nloc, nx); b.st[0] = nloc; b.st[1] = nx; }
        const unsigned old = xb_add(&bar[XB_XSUB(b.x)], 1u);
        const unsigned gen = old / nloc;
        if (old + 1u == (gen + 1u) * nloc) {
            __builtin_amdgcn_fence(__ATOMIC_RELEASE, "agent");
            asm volatile("s_waitcnt vmcnt(0)" ::: "memory");
            const unsigned og = xb_add(&bar[XB_TOP], 1u);
            const unsigned tg = og / nx;
            if (og + 1u == (tg + 1u) * nx) xb_add(&bar[XB_TOPGEN], 1u);
            else XB_SPIN(xb_ld(&bar[XB_TOPGEN]) == tg, bar);
            __builtin_amdgcn_fence(__ATOMIC_ACQUIRE, "agent");
            xb_add(&bar[XB_XGEN(b.x)], 1u);
            asm volatile("s_waitcnt vmcnt(0)" ::: "memory");
        } else {
            XB_SPIN(xb_ld(&bar[XB_XGEN(b.x)]) == gen, bar);
            __builtin_amdgcn_fence(__ATOMIC_ACQUIRE, "agent");
            asm volatile("s_waitcnt vmcnt(0)" ::: "memory");
        }
    }
    __syncthreads();
}

constexpr int PH_PER_LAYER = 10, N_PHASES = 1 + DEPTH * PH_PER_LAYER;
constexpr int CW_BAR = 4096;
constexpr int CW_SEAM = 16384;
constexpr int CW_SEAM2 = 65536;

__global__ void __launch_bounds__(NTHREADS, 2) trunk_fwd(Args args) {
    extern __shared__ __attribute__((aligned(16))) unsigned char lds_raw[];
    Ctx C;
    C.lds = (LAS unsigned char*)lds_raw; C.tid = threadIdx.x; C.lane = C.tid & 63; C.wave = __builtin_amdgcn_readfirstlane(C.tid >> 6);
    C.G = gridDim.x; { const int bx = blockIdx.x; C.vcu = (C.G % 8 == 0) ? (bx % 8) * (C.G / 8) + bx / 8 : bx; }
    unsigned char* ws = args.ws;
    volatile LAS unsigned* MISC = (volatile LAS unsigned*)(C.lds + MISC_OFF);
    if (C.tid < 64) MISC[C.tid] = 0u;
    __syncthreads();
#if MK_PER_PHASE
#define GRID_BAR() do { } while (0)
#else
    cg::grid_group grid = cg::this_grid();
    XcdBarrier bar = xcd_barrier_post((unsigned*)(ws + WS_CTL) + CW_BAR, MISC + 8);
    bool first_bar = true;
#define GRID_BAR() do { if (first_bar) { grid.sync(); first_bar = false; } else { xcd_barrier(bar); } } while (0)
#endif
    const int lo = args.ph_lo, hi = args.ph_hi;
    int ph = 0;
#define PHASE_BEGIN if (ph >= lo && ph < hi) { for (int rep_ = 0; rep_ < (((DBG_REPEAT >> ((ph - 1) % PH_PER_LAYER + 1)) & 1) && ph > 0 ? 2 : 1); ++rep_) {
#define PHASE_END   if (rep_ == 0 && (((DBG_REPEAT >> ((ph - 1) % PH_PER_LAYER + 1)) & 1) && ph > 0)) GRID_BAR(); } if (ph + 1 < hi && ph + 1 < N_PHASES) GRID_BAR(); } ++ph;

    PHASE_BEGIN p0_prologue(C, args); PHASE_END

    for (int li = 0; li < DEPTH; ++li) {
        int l = li; asm volatile("" : "+s"(l));
        const unsigned char* wl = ws + WS_W + (size_t)l * W_LAYER;
        const float* RS = (const float*)(ws + WS_X2);
        PHASE_BEGIN {
            pg8::StaticOrder S; S.init(ws + WS_HB, wl + W_IN, M, NMIX, D, C.G, (int)blockIdx.x);
            pg8::EpiRow<1> E{(bf16_t*)(ws + WS_PROJ), NMIX, RS};
            pg8::gemm_phase<pg8::EpiRow<1>, pg8::StaticOrder, true>(C.lds, D, S, E);
        } PHASE_END
        PHASE_BEGIN {
            for (int item = C.vcu; item < BATCH * 64; item += C.G) { const int b = item >> 6, c = item & 63;
                mix1_item(C, args, l, b, c);
                hgrn_item<false>(C, args, l, b, c); }
        } PHASE_END
        PHASE_BEGIN {
            mix_phase2(C, args);
            int lane = C.lane; asm volatile("" : "+v"(lane));
            const int gw = C.vcu * NWAVES + C.wave, NGW = C.G * NWAVES;
            if (li == 0) {
                for (int it = gw; it < DEPTH * 2 * 4096; it += NGW) { const int ll = it >> 13, r = it & 8191, n = r & 4095;
                    const unsigned char* wll = ws + WS_W + (size_t)ll * W_LAYER;
                    if (r < 4096) quant_row_i8((const bf16_t*)(wll + W_IN) + (size_t)(NMIX + n) * D, (signed char*)(ws + WS_WG8) + ((size_t)ll * NGATE + n) * D, (float*)(ws + WS_SBG) + ll * NGATE + n, lane);
                    else quant_row_i8((const bf16_t*)(wll + W_UP) + (size_t)n * D, (signed char*)(ws + WS_WU8) + ((size_t)ll * FF + n) * D, (float*)(ws + WS_SBU) + ll * FF + n, lane); }
            }
        } PHASE_END
        PHASE_BEGIN {
            for (int item = C.vcu; item < BATCH * 64; item += C.G) { const int b = item >> 6, c = item & 63;
                lru_final_item(C, args, l, b, c);
                hgrn_item<true>(C, args, l, b, c); }
        } PHASE_END
        PHASE_BEGIN {
            unsigned char* gt = (unsigned char*)(ws + WS_G) + (size_t)blockIdx.x * 8 * 65536;
            {
                int t_ = C.tid; asm volatile("" : "+v"(t_));
                float nv = -1.f; asm volatile("" : "+v"(nv)); const f32x4 neg = {nv, nv, nv, nv};
                for (int i = C.vcu * NTHREADS + t_; i < 2 * M * 4; i += C.G * NTHREADS) *(f32x4*)(ws + (i < M * 4 ? WS_XS0 : WS_XS1 - (size_t)M * 64) + (size_t)i * 16) = neg;
            }
            {
                pg8::GateOrder8 S{(const char*)(ws + WS_HB8), (const char*)(ws + WS_WG8) + (size_t)l * NGATE * D, C.G, C.vcu};
                pg8::EpiGate8 E{gt, RS, (const float*)(ws + WS_SA), (const float*)(ws + WS_SBG) + l * NGATE};
                pg8::gemm_phase<pg8::EpiGate8, pg8::GateOrder8, true, true>(C.lds, D / 2, S, E);
            }
            {
                pg8::MergeOrder S{(const char*)(ws + WS_YS), (const char*)(wl + W_BR), C.G, C.vcu};
                pg8::EpiGate E{gt, (bf16_t*)(ws + WS_MERGED), RS};
                pg8::gemm_phase<pg8::EpiGate, pg8::MergeOrder, true>(C.lds, D, S, E);
            }
        } PHASE_END
        const bool fused_norm = (C.G == 256) && !MK_PER_PHASE;
        if (fused_norm) {
            PHASE_BEGIN {
                { const int half = 0;
                    pg8::PanelOrder S{(const char*)(ws + WS_MERGED), (const char*)(wl + W_OUT), (size_t)pg8::BM * D * 2, D / pg8::BK, half, C.vcu};
                    pg8::EpiNorm E{(bf16_t*)(ws + WS_HB), nullptr, args.in[I_NMIXPOST] + l * D, (float*)(ws + WS_XS0), (float*)(ws + WS_X2), (unsigned*)(ws + WS_CTL) + 8, C.lds + 131072, (signed char*)(ws + WS_HB8), (float*)(ws + WS_SA)};
                    pg8::gemm_phase<pg8::EpiNorm, pg8::PanelOrder, true>(C.lds, D, S, E);
                }
            } PHASE_END
            ++ph;
        } else {
        PHASE_BEGIN {
            pg8::StaticOrder S; S.init(ws + WS_MERGED, wl + W_OUT, M, D, D, C.G, (int)blockIdx.x);
            pg8::EpiRow<0> E{(bf16_t*)(ws + WS_MIX), D, nullptr};
            pg8::gemm_phase<pg8::EpiRow<0>, pg8::StaticOrder, true>(C.lds, D, S, E);
        } PHASE_END
        PHASE_BEGIN norm_phase(C, args, (const bf16_t*)(ws + WS_MIX), args.in[I_NMIXPOST] + l * D, false); PHASE_END
        }
        PHASE_BEGIN {
            pg8::StaticOrder S; S.init(ws + WS_HB8, ws + WS_WU8 + (size_t)l * FF * D, M, FF, D / 2, C.G, (int)blockIdx.x);
            pg8::EpiUp8 E{(bf16_t*)(ws + WS_HID), FF, RS, (const float*)(ws + WS_SA), (const float*)(ws + WS_SBU) + l * FF};
            pg8::gemm_phase<pg8::EpiUp8, pg8::StaticOrder, true, true>(C.lds, D / 2, S, E);
        } PHASE_END
        if (fused_norm) {
            PHASE_BEGIN {
                { const int half = 0;
                    pg8::PanelOrder S{(const char*)(ws + WS_HID), (const char*)(wl + W_DOWN), (size_t)pg8::BM * FF * 2, FF / pg8::BK, half, C.vcu};
                    pg8::EpiNorm E{(bf16_t*)(ws + WS_HB), (li == DEPTH - 1) ? args.out : nullptr, args.in[I_NMLPPOST] + l * D, (float*)(ws + WS_XS1), (float*)(ws + WS_X2), (unsigned*)(ws + WS_CTL) + 8, C.lds + 131072, (signed char*)(ws + WS_HB8), (float*)(ws + WS_SA)};
                    pg8::gemm_phase<pg8::EpiNorm, pg8::PanelOrder, true>(C.lds, FF, S, E);
                }
            } PHASE_END
            ++ph;
        } else {
        PHASE_BEGIN {
            pg8::StaticOrder S; S.init(ws + WS_HID, wl + W_DOWN, M, D, FF, C.G, (int)blockIdx.x);
            pg8::EpiRow<0> E{(bf16_t*)(ws + WS_MOUT), D, nullptr};
            pg8::gemm_phase<pg8::EpiRow<0>, pg8::StaticOrder, true>(C.lds, FF, S, E);
        } PHASE_END
        PHASE_BEGIN norm_phase(C, args, (const bf16_t*)(ws + WS_MOUT), args.in[I_NMLPPOST] + l * D, li == DEPTH - 1); PHASE_END
        }
    }
}

extern "C" void kernel_launch(void* const* d_in, const int* in_sizes, int n_in, void* d_out, int out_size, void* d_ws, size_t ws_size, hipStream_t stream) {
    static int grid = 0;
    if (grid == 0) {
        if (n_in != 22 || in_sizes[0] != M * D || out_size != M * D || ws_size < WS_END) { fprintf(stderr, "kernel_launch: unexpected shapes (n_in %d, in0 %d, out %d, ws %zu)\n", n_in, n_in > 0 ? in_sizes[0] : -1, out_size, ws_size); grid = -1; return; }
        int dev = 0, cus = 0, per_cu = 0;
        if (hipGetDevice(&dev) != hipSuccess || hipDeviceGetAttribute(&cus, hipDeviceAttributeMultiprocessorCount, dev) != hipSuccess) { grid = -1; return; }
        if (hipFuncSetAttribute((const void*)trunk_fwd, hipFuncAttributeMaxDynamicSharedMemorySize, LDS_BYTES) != hipSuccess) { fprintf(stderr, "kernel_launch: hipFuncSetAttribute failed\n"); grid = -1; return; }
        if (hipOccupancyMaxActiveBlocksPerMultiprocessor(&per_cu, (const void*)trunk_fwd, NTHREADS, LDS_BYTES) != hipSuccess || per_cu < 1) { fprintf(stderr, "kernel_launch: occupancy query says %d blocks per CU\n", per_cu); (void)hipGetLastError(); grid = -1; return; }
        grid = cus;
    }
    if (grid < 0) return;
    (void)hipMemsetAsync((char*)d_ws + WS_CTL, 0, CTL_ZERO_BYTES, stream);
    Args a{};
    for (int i = 0; i < 22; ++i) a.in[i] = (const float*)d_in[i];
    a.out = (float*)d_out; a.ws = (unsigned char*)d_ws;
#if MK_PER_PHASE
#ifndef DBG_MAXPH
#define DBG_MAXPH N_PHASES
#endif
    for (int p = 0; p < DBG_MAXPH; ++p) { a.ph_lo = p; a.ph_hi = p + 1; hipLaunchKernelGGL(trunk_fwd, dim3(grid), dim3(NTHREADS), LDS_BYTES, stream, a); }
#else
#if DBG_PREFIX > 0
    { a.ph_lo = 0; a.ph_hi = DBG_PREFIX; void* kargs0[] = {&a};
      (void)hipLaunchCooperativeKernel((const void*)trunk_fwd, dim3(grid), dim3(NTHREADS), kargs0, LDS_BYTES, stream);
      (void)hipMemsetAsync((char*)d_ws + WS_CTL, 0, CTL_ZERO_BYTES, stream); }
#endif
    a.ph_lo = 0; a.ph_hi = N_PHASES;
    void* kargs[] = {&a};
    hipError_t e = hipLaunchCooperativeKernel((const void*)trunk_fwd, dim3(grid), dim3(NTHREADS), kargs, LDS_BYTES, stream);
    if (e != hipSuccess) fprintf(stderr, "kernel_launch: cooperative launch failed: %s (grid %d)\n", hipGetErrorString(e), grid);
#endif
}
```

```cpp
#include <hip/hip_runtime.h>
#include <hip/hip_cooperative_groups.h>
#include <cstdio>
#include <cstdint>
namespace cg = cooperative_groups;

#ifndef DBG_ZERO
#define DBG_ZERO -1
#endif
#ifndef DBG_REPEAT
#define DBG_REPEAT 0
#endif
#ifndef MK_PER_PHASE
#define MK_PER_PHASE 0
#endif
#ifndef DBG_PREFIX
#define DBG_PREFIX 0
#endif

#define LAS __attribute__((address_space(3)))
#define GAS __attribute__((address_space(1)))
typedef unsigned short bf16_t;
typedef short bf16x8 __attribute__((ext_vector_type(8)));
typedef float f32x4 __attribute__((ext_vector_type(4)));
typedef float f32x2 __attribute__((ext_vector_type(2)));
typedef unsigned u32x4 __attribute__((ext_vector_type(4)));
typedef unsigned u32x2 __attribute__((ext_vector_type(2)));

constexpr int BATCH = 8, T = 4096, D = 1024, M = BATCH * T, DEPTH = 2, BW = 256;
constexpr int NMIX = 2560, NGATE = 4096, INW = NMIX + NGATE, FF = 4096;
constexpr float EPS = 1e-6f;
constexpr int NWAVES = 8, NTHREADS = 512;

constexpr size_t MiB = 1u << 20;
constexpr size_t WS_CTL = 0, CTL_ZERO_BYTES = 1 * MiB;
constexpr size_t WS_XM = 1 * MiB;
constexpr size_t WS_SD = 1 * MiB + 512 * 1024;
constexpr size_t WS_LA = 2 * MiB, WS_LH = 3 * MiB, WS_LC = 4 * MiB;
constexpr size_t WS_SP8 = 7 * MiB;
constexpr size_t WS_X1 = 5 * MiB;
constexpr size_t WS_X2 = 6 * MiB;
constexpr size_t WS_W = 8 * MiB;
constexpr size_t W_IN = 0, W_BR = 13 * MiB, W_OUT = 15 * MiB, W_UP = 17 * MiB, W_DOWN = 25 * MiB, W_LAYER = 33 * MiB;
constexpr size_t WS_HB = 76 * MiB;
constexpr size_t WS_PROJ = 140 * MiB;
constexpr size_t WS_G = WS_PROJ;
constexpr size_t WS_YS = 300 * MiB;
constexpr size_t WS_MERGED = 364 * MiB;
constexpr size_t WS_SU = WS_MERGED;
constexpr size_t WS_MIX = WS_PROJ;
constexpr size_t WS_MOUT = 396 * MiB;
constexpr size_t WS_HID = WS_PROJ;
constexpr size_t WS_HB8 = 460 * MiB;
constexpr size_t WS_WG8 = 492 * MiB;
constexpr size_t WS_SA = 7 * MiB + 64 * 1024;
constexpr size_t WS_SBG = 7 * MiB + 256 * 1024;
constexpr size_t WS_SBU = 7 * MiB + 320 * 1024;
constexpr size_t WS_WU8 = 500 * MiB;
constexpr size_t WS_XS0 = 428 * MiB, WS_XS1 = 444 * MiB;
constexpr size_t WS_END = 508 * MiB;

constexpr int LDS_BYTES = 155648;
constexpr int MISC_OFF = 154624;

__device__ __forceinline__ float bf2f(unsigned b) { return __uint_as_float(b << 16); }
__device__ __forceinline__ unsigned f2bf(float f) { unsigned u = __float_as_uint(f); return (u + 0x7fffu + ((u >> 16) & 1u)) >> 16; }
__device__ __forceinline__ unsigned pk2(float lo, float hi) { return f2bf(lo) | (f2bf(hi) << 16); }
typedef __bf16 bf16x2_t __attribute__((ext_vector_type(2)));
__device__ __forceinline__ unsigned cvt_pk_bf16(float lo, float hi) { f32x2 v = {lo, hi}; bf16x2_t b = __builtin_convertvector(v, bf16x2_t); return __builtin_bit_cast(unsigned, b); }
__device__ __forceinline__ float fast_exp(float x) { return __builtin_amdgcn_exp2f(x * 1.4426950408889634f); }
__device__ __forceinline__ float sigmoid_f(float x) { return __builtin_amdgcn_rcpf(1.0f + fast_exp(-x)); }
__device__ __forceinline__ void ld8bf(const bf16_t* p, float (&o)[8]) {
    const u32x4 v = *(const u32x4*)p;
    o[0] = bf2f(v.x & 0xffffu); o[1] = bf2f(v.x >> 16); o[2] = bf2f(v.y & 0xffffu); o[3] = bf2f(v.y >> 16);
    o[4] = bf2f(v.z & 0xffffu); o[5] = bf2f(v.z >> 16); o[6] = bf2f(v.w & 0xffffu); o[7] = bf2f(v.w >> 16);
}
__device__ __forceinline__ float rs_of(const float* X2, int row) { const f32x4 x = *(const f32x4*)(X2 + (size_t)row * 4); return 1.0f / sqrtf(((x[0] + x[1]) + (x[2] + x[3])) * (1.0f / D) + EPS); }
typedef int i32x4 __attribute__((ext_vector_type(4)));
__device__ __forceinline__ void quant_row_i8(const bf16_t* src, signed char* dst, float* scale_out, int lane) {
    float x[16]; ld8bf(src + 16 * lane, *(float(*)[8])&x[0]); ld8bf(src + 16 * lane + 8, *(float(*)[8])&x[8]);
    float mx = 0.f;
#pragma unroll
    for (int j = 0; j < 16; ++j) mx = fmaxf(mx, fabsf(x[j]));
#pragma unroll
    for (int o = 1; o < 64; o <<= 1) mx = fmaxf(mx, __shfl_xor(mx, o));
    const float sc = (mx > 0.f) ? mx * (1.0f / 127.0f) : 1.0f, inv = 1.0f / sc;
    unsigned w[4];
#pragma unroll
    for (int p = 0; p < 4; ++p) { unsigned v = 0u;
#pragma unroll
        for (int e = 0; e < 4; ++e) { const int q = (int)__builtin_rintf(x[4 * p + e] * inv); v |= ((unsigned)q & 0xffu) << (8 * e); }
        w[p] = v; }
    *(u32x4*)(dst + 16 * lane) = (u32x4){w[0], w[1], w[2], w[3]};
    if (lane == 0) *scale_out = sc;
}
__device__ __forceinline__ unsigned q4_i8(const f32x4 v, float inv) { unsigned w = 0u;
#pragma unroll
    for (int e = 0; e < 4; ++e) { const int q = (int)__builtin_rintf(v[e] * inv); w |= ((unsigned)q & 0xffu) << (8 * e); }
    return w; }
__device__ __forceinline__ float wave_sum(float v) {
#pragma unroll
    for (int o = 1; o < 64; o <<= 1) v += __shfl_xor(v, o);
    return v;
}

namespace pg8 {
constexpr int BM = 256, BK = 64, HALF = 128, HTB = HALF * BK * 2, STAGE_BYTES = 8 * HTB, NXCD = 8, WGM = 4;
__host__ __device__ __forceinline__ int lds_byte(int r, int c) { const int st = (r >> 4) * 2 + (c >> 5), rr = r & 15, cc = c & 31, ob = rr * 64 + cc * 2; return st * 1024 + (ob ^ (((ob >> 9) & 1) << 5)); }
__host__ __device__ __forceinline__ void stage_rc(int b, int& R, int& C) { const int st = b / 1024, sb = b % 1024, swz = sb ^ (((sb >> 9) & 1) << 5); R = (st >> 1) * 16 + swz / 64; C = (st & 1) * 32 + (swz % 64) / 2; }
__host__ __device__ __forceinline__ int perm32(int rho) { const int n = rho >> 4, i = rho & 15; return 8 * (i >> 2) + 4 * n + (i & 3); }

struct Unit { int pm, pn, kind; };

struct StaticOrder {
    const char* A; const char* Bt; size_t tstep;
    int nM, nN, nwg, G, c;
    __device__ void init(const void* A_, const void* Bt_, int M_, int N_, int K_, int G_, int c_) { A = (const char*)A_; Bt = (const char*)Bt_; tstep = (size_t)BM * K_ * 2; nt = K_ / BK; nM = M_ / BM; nN = N_ / BM; nwg = nM * nN; G = G_; c = c_; }
    __device__ bool next(int i, Unit& u) const {
        const long L = (long)i * G + c; if (L >= nwg) return false;
        int wgid = (int)L; { const int q = nwg / NXCD, r = nwg % NXCD, xcd = wgid % NXCD, off = wgid / NXCD; wgid = (xcd < r ? xcd * (q + 1) : r * (q + 1) + (xcd - r) * q) + off; }
        const int nig = WGM * nN, gid = wgid / nig, fm = gid * WGM, gsz = (nM - fm) < WGM ? (nM - fm) : WGM;
        u.pm = fm + ((wgid % nig) % gsz); u.pn = (wgid % nig) / gsz; u.kind = 0; return true;
    }
    __device__ __forceinline__ void tiles(const Unit& u, const char*& a, const char*& b) const { a = A + (size_t)u.pm * tstep; b = Bt + (size_t)u.pn * tstep; }
    int nt;
    __device__ __forceinline__ int ntiles(const Unit&) const { return nt; }
    __device__ __forceinline__ bool keep_acc(const Unit&) const { return false; }
};

struct GateOrder {
    const char* HB; const char* WGt; const char* YS; const char* WB; int G, vcu;
    __device__ bool next(int i, Unit& u) const {
        const int r = i / 16, ii = i % 16, su = vcu + r * G; if (su >= 256) return false;
        const int half = ii / 8, j = ii % 8;
        u.pm = half * 64 + (su >> 2); u.kind = j; u.pn = (j < 4) ? (j * 4 + (su & 3)) : (su & 3); return true;
    }
    __device__ __forceinline__ int ntiles(const Unit& u) const { return u.kind < 4 ? 16 : 4; }
    __device__ __forceinline__ bool keep_acc(const Unit& nx) const { return nx.kind > 4; }
    __device__ __forceinline__ void tiles(const Unit& u, const char*& a, const char*& b) const {
        const size_t ts = (size_t)BM * 1024 * 2;
        if (u.kind < 4) { a = HB + (size_t)u.pm * ts; b = WGt + (size_t)u.pn * ts; } else { a = YS + (size_t)u.pm * ts + (size_t)(u.kind - 4) * 512; b = WB + (size_t)u.pn * ts + (size_t)(u.kind - 4) * 512; }
    }
};

struct GateOrder8 {
    const char* HB8; const char* WG8; int G, vcu;
    __device__ bool next(int i, Unit& u) const {
        const int r = i / 8, ii = i % 8, su = vcu + r * G; if (su >= 256) return false;
        u.pm = (ii >> 2) * 64 + (su >> 2); u.kind = ii; u.pn = (ii & 3) * 4 + (su & 3); return true;
    }
    __device__ __forceinline__ int ntiles(const Unit&) const { return 8; }
    __device__ __forceinline__ bool keep_acc(const Unit&) const { return false; }
    __device__ __forceinline__ void tiles(const Unit& u, const char*& a, const char*& b) const { a = HB8 + (size_t)u.pm * 262144; b = WG8 + (size_t)u.pn * 262144; }
};
struct MergeOrder {
    const char* YS; const char* WB; int G, vcu;
    __device__ bool next(int i, Unit& u) const {
        const int r = i / 8, ii = i % 8, su = vcu + r * G; if (su >= 256) return false;
        u.pm = (ii >> 2) * 64 + (su >> 2); u.kind = 4 + (ii & 3); u.pn = su & 3; return true;
    }
    __device__ __forceinline__ int ntiles(const Unit&) const { return 4; }
    __device__ __forceinline__ bool keep_acc(const Unit& nx) const { return nx.kind > 4; }
    __device__ __forceinline__ void tiles(const Unit& u, const char*& a, const char*& b) const {
        const size_t ts = (size_t)BM * 1024 * 2; a = YS + (size_t)u.pm * ts + (size_t)(u.kind - 4) * 512; b = WB + (size_t)u.pn * ts + (size_t)(u.kind - 4) * 512; }
};

template <int MODE  > struct EpiRow {
    static constexpr bool PERM = true;
    bf16_t* O; int ldc; const float* rs;
    __device__ __forceinline__ void operator()(f32x4 (&acc)[2][2][4][2], const Unit& u, int wr, int wc, int fr, int fq) const {
        const int row0 = u.pm * BM + wr * 64 + fr, col0 = u.pn * BM + wc * 32 + 8 * fq;
#pragma unroll
        for (int ai = 0; ai < 2; ++ai)
#pragma unroll
            for (int m = 0; m < 4; ++m) {
                const int row = row0 + ai * HALF + m * 16; const float sc = (MODE != 0) ? rs_of(rs, row) : 1.0f;
                bf16_t* rowp = O + (size_t)row * ldc + col0;
#pragma unroll
                for (int bj = 0; bj < 2; ++bj) {
                    f32x4 v0 = acc[ai][bj][m][0], v1 = acc[ai][bj][m][1];
                    if (MODE != 0) { v0 = v0 * sc; v1 = v1 * sc; }
                    if (MODE == 2) {
#pragma unroll
                        for (int j = 0; j < 4; ++j) { const float a = fmaxf(v0[j], 0.f), b = fmaxf(v1[j], 0.f); v0[j] = a * a; v1[j] = b * b; }
                    }
                    u32x4 w; w.x = cvt_pk_bf16(v0[0], v0[1]); w.y = cvt_pk_bf16(v0[2], v0[3]); w.z = cvt_pk_bf16(v1[0], v1[1]); w.w = cvt_pk_bf16(v1[2], v1[3]);
                    __builtin_nontemporal_store(w, (u32x4*)(rowp + bj * HALF));
                }
            }
    }
};

__device__ __forceinline__ unsigned pack_u8x4(float a, float b, float c, float d) { unsigned w = 0u;
    w = __builtin_amdgcn_cvt_pk_u8_f32(a * 256.0f - 0.5f, 0, w); w = __builtin_amdgcn_cvt_pk_u8_f32(b * 256.0f - 0.5f, 1, w); w = __builtin_amdgcn_cvt_pk_u8_f32(c * 256.0f - 0.5f, 2, w); w = __builtin_amdgcn_cvt_pk_u8_f32(d * 256.0f - 0.5f, 3, w); return w; }
__device__ __forceinline__ f32x4 unpack_u8x4(unsigned w) { return (f32x4){(float)(w & 0xffu) + 0.5f, (float)((w >> 8) & 0xffu) + 0.5f, (float)((w >> 16) & 0xffu) + 0.5f, (float)(w >> 24) + 0.5f}; }
struct EpiGate {
    static constexpr bool PERM = true;
    unsigned char* Gt;
    bf16_t* MERGED;
    const float* rs;
    __device__ __forceinline__ void rescale(f32x4 (&acc)[2][2][4][2], int hsel, int j, int wr, int wc, int fr, int fq) const {
        int lane_off = (wr * 64 + fr) * 256 + wc * 32 + 8 * fq; asm volatile("" : "+v"(lane_off));
        const unsigned char* g0 = Gt + (size_t)(hsel * 4 + j) * 65536; const unsigned char* g1 = g0 + 65536;
#pragma unroll
        for (int ai = 0; ai < 2; ++ai) {
            u32x2 a[4][2], b[4][2];
#pragma unroll
            for (int m = 0; m < 4; ++m)
#pragma unroll
                for (int bj = 0; bj < 2; ++bj) { const int off = lane_off + (ai * HALF + m * 16) * 256 + bj * HALF; a[m][bj] = *(const u32x2*)(g0 + off); b[m][bj] = *(const u32x2*)(g1 + off); }
#pragma unroll
            for (int m = 0; m < 4; ++m)
#pragma unroll
                for (int bj = 0; bj < 2; ++bj) {
                    const f32x4 a0 = unpack_u8x4(a[m][bj].x), a1 = unpack_u8x4(a[m][bj].y), b0 = unpack_u8x4(b[m][bj].x), b1 = unpack_u8x4(b[m][bj].y);
#pragma unroll
                    for (int q = 0; q < 4; ++q) { acc[ai][bj][m][0][q] *= a0[q] * __builtin_amdgcn_rcpf(b0[q]); acc[ai][bj][m][1][q] *= a1[q] * __builtin_amdgcn_rcpf(b1[q]); }
                }
            asm volatile("" ::: "memory");
        }
    }
    __device__ __forceinline__ void operator()(f32x4 (&acc)[2][2][4][2], const Unit& u, int wr, int wc, int fr, int fq) const {
        if (u.kind >= 4 && u.kind < 7) { rescale(acc, u.pm >> 6, u.kind - 4, wr, wc, fr, fq); return; }
        int rl0 = wr * 64 + fr, cl0 = wc * 32 + 8 * fq; asm volatile("" : "+v"(rl0), "+v"(cl0));
        if (u.kind < 4) {
            unsigned char* gt = Gt + (size_t)u.kind * 65536;
#pragma unroll
            for (int ai = 0; ai < 2; ++ai)
#pragma unroll
                for (int m = 0; m < 4; ++m) {
                    const int rl = rl0 + ai * HALF + m * 16; const float sc = rs_of(rs, u.pm * BM + rl);
#pragma unroll
                    for (int bj = 0; bj < 2; ++bj) {
                        f32x4 v0 = acc[ai][bj][m][0] * sc, v1 = acc[ai][bj][m][1] * sc;
#pragma unroll
                        for (int j = 0; j < 4; ++j) { v0[j] = sigmoid_f(fmaxf(v0[j], -60.f)); v1[j] = sigmoid_f(fmaxf(v1[j], -60.f)); }
                        u32x2 w; w.x = pack_u8x4(v0[0], v0[1], v0[2], v0[3]); w.y = pack_u8x4(v1[0], v1[1], v1[2], v1[3]);
                        *(u32x2*)(gt + rl * 256 + cl0 + bj * HALF) = w;
                    }
                }
        } else {
            const unsigned char* g3 = Gt + (size_t)((u.pm >> 6) * 4 + 3) * 65536;
#pragma unroll
            for (int ai = 0; ai < 2; ++ai)
#pragma unroll
                for (int m = 0; m < 4; ++m) {
                    const int rl = rl0 + ai * HALF + m * 16;
                    bf16_t* rowp = MERGED + (size_t)(u.pm * BM + rl) * 1024 + u.pn * BM + cl0;
#pragma unroll
                    for (int bj = 0; bj < 2; ++bj) {
                        const u32x2 sw = *(const u32x2*)(g3 + rl * 256 + cl0 + bj * HALF);
                        const f32x4 s0 = unpack_u8x4(sw.x) * (1.0f / 256.0f), s1 = unpack_u8x4(sw.y) * (1.0f / 256.0f);
                        const f32x4 v0 = acc[ai][bj][m][0] * s0, v1 = acc[ai][bj][m][1] * s1;
                        u32x4 w; w.x = cvt_pk_bf16(v0[0], v0[1]); w.y = cvt_pk_bf16(v0[2], v0[3]); w.z = cvt_pk_bf16(v1[0], v1[1]); w.w = cvt_pk_bf16(v1[2], v1[3]);
                        *(u32x4*)(rowp + bj * HALF) = w;
                    }
                }
        }
    }
};

struct EpiGate8 {
    static constexpr bool PERM = true;
    unsigned char* Gt;
    const float* rs; const float* sa; const float* sb;
    __device__ __forceinline__ void operator()(f32x4 (&acc)[2][2][4][2], const Unit& u, int wr, int wc, int fr, int fq) const {
        int rl0 = wr * 64 + fr, cl0 = wc * 32 + 8 * fq; asm volatile("" : "+v"(rl0), "+v"(cl0));
        unsigned char* gt = Gt + (size_t)u.kind * 65536;
        f32x4 cs[2][2];
#pragma unroll
        for (int bj = 0; bj < 2; ++bj) { cs[bj][0] = *(const f32x4*)(sb + u.pn * BM + cl0 + bj * HALF); cs[bj][1] = *(const f32x4*)(sb + u.pn * BM + cl0 + bj * HALF + 4); }
#pragma unroll
        for (int ai = 0; ai < 2; ++ai)
#pragma unroll
            for (int m = 0; m < 4; ++m) {
                const int rl = rl0 + ai * HALF + m * 16; const float sc = -1.4426950408889634f * rs_of(rs, u.pm * BM + rl) * sa[u.pm * BM + rl];
#pragma unroll
                for (int bj = 0; bj < 2; ++bj) {
                    const i32x4 i0 = __builtin_bit_cast(i32x4, acc[ai][bj][m][0]), i1 = __builtin_bit_cast(i32x4, acc[ai][bj][m][1]);
                    f32x4 v0, v1;
#pragma unroll
                    for (int j = 0; j < 4; ++j) { v0[j] = __builtin_amdgcn_rcpf(1.0f + __builtin_amdgcn_exp2f((float)i0[j] * (sc * cs[bj][0][j]))); v1[j] = __builtin_amdgcn_rcpf(1.0f + __builtin_amdgcn_exp2f((float)i1[j] * (sc * cs[bj][1][j]))); }
                    u32x2 w; w.x = pack_u8x4(v0[0], v0[1], v0[2], v0[3]); w.y = pack_u8x4(v1[0], v1[1], v1[2], v1[3]);
                    *(u32x2*)(gt + rl * 256 + cl0 + bj * HALF) = w;
                }
            }
    }
};

struct EpiUp8 {
    static constexpr bool PERM = true;
    bf16_t* O; int ldc; const float* rs; const float* sa; const float* sb;
    __device__ __forceinline__ void operator()(f32x4 (&acc)[2][2][4][2], const Unit& u, int wr, int wc, int fr, int fq) const {
        int rl0 = wr * 64 + fr, cl0 = wc * 32 + 8 * fq; asm volatile("" : "+v"(rl0), "+v"(cl0));
        f32x4 cs[2][2];
#pragma unroll
        for (int bj = 0; bj < 2; ++bj) { cs[bj][0] = *(const f32x4*)(sb + u.pn * BM + cl0 + bj * HALF); cs[bj][1] = *(const f32x4*)(sb + u.pn * BM + cl0 + bj * HALF + 4); }
#pragma unroll
        for (int ai = 0; ai < 2; ++ai)
#pragma unroll
            for (int m = 0; m < 4; ++m) {
                const int row = u.pm * BM + rl0 + ai * HALF + m * 16; const float sc = rs_of(rs, row) * sa[row];
                bf16_t* rowp = O + (size_t)row * ldc + u.pn * BM + cl0;
#pragma unroll
                for (int bj = 0; bj < 2; ++bj) {
                    const i32x4 i0 = __builtin_bit_cast(i32x4, acc[ai][bj][m][0]), i1 = __builtin_bit_cast(i32x4, acc[ai][bj][m][1]);
                    f32x4 v0, v1;
#pragma unroll
                    for (int j = 0; j < 4; ++j) { const float a = fmaxf((float)i0[j] * (sc * cs[bj][0][j]), 0.f), b = fmaxf((float)i1[j] * (sc * cs[bj][1][j]), 0.f); v0[j] = a * a; v1[j] = b * b; }
                    u32x4 w; w.x = cvt_pk_bf16(v0[0], v0[1]); w.y = cvt_pk_bf16(v0[2], v0[3]); w.z = cvt_pk_bf16(v1[0], v1[1]); w.w = cvt_pk_bf16(v1[2], v1[3]);
                    __builtin_nontemporal_store(w, (u32x4*)(rowp + bj * HALF));
                }
            }
    }
};

struct PanelOrder {
    const char* A; const char* Bt; size_t tstep; int nt, half, vcu;
    __device__ bool next(int i, Unit& u) const { if (i > 1) return false; u.pm = i * 64 + (vcu >> 2); u.pn = vcu & 3; u.kind = 0; return true; }
    __device__ __forceinline__ void tiles(const Unit& u, const char*& a, const char*& b) const { a = A + (size_t)u.pm * tstep; b = Bt + (size_t)u.pn * tstep; }
    __device__ __forceinline__ int ntiles(const Unit&) const { return nt; }
    __device__ __forceinline__ bool keep_acc(const Unit&) const { return false; }
};
__device__ __forceinline__ void st_sys16(float* p, f32x4 v) { asm volatile("global_store_dwordx4 %0, %1, off sc0 sc1" :: "v"(p), "v"(v) : "memory"); }
__device__ __forceinline__ void ld_sys16x4(const float* p, f32x4 (&v)[4]) {
    asm volatile("global_load_dwordx4 %0, %4, off sc0 sc1\n\tglobal_load_dwordx4 %1, %4, off offset:16 sc0 sc1\n\tglobal_load_dwordx4 %2, %4, off offset:32 sc0 sc1\n\tglobal_load_dwordx4 %3, %4, off offset:48 sc0 sc1\n\ts_waitcnt vmcnt(0)"
                 : "=&v"(v[0]), "=&v"(v[1]), "=&v"(v[2]), "=&v"(v[3]) : "v"(p) : "memory"); }
struct EpiNorm {
    static constexpr bool PERM = true;
    bf16_t* HB; float* OUTF; const float* gain; float* XS; float* X2; unsigned* tmo; LAS unsigned char* sp;
    signed char* HB8; float* SA;
    __device__ __forceinline__ void operator()(f32x4 (&acc)[2][2][4][2], const Unit& u, int wr, int wc, int fr, int fq) const {
        LAS float* P = (LAS float*)sp;
        LAS float* PM = (LAS float*)(sp + 4096);
        LAS float* PB = (LAS float*)(sp + 8192);
        LAS float* R = (LAS float*)(sp + 12288);
        LAS float* RI = (LAS float*)(sp + 13312);
        LAS float* P2 = (LAS float*)(sp + 14336);
        const int tid = (wr * 4 + wc) * 64 + fq * 16 + fr;
        int rl0 = wr * 64 + fr, cl0 = wc * 32 + 8 * fq; asm volatile("" : "+v"(rl0), "+v"(cl0));
        f32x4 gv[2][2];
#pragma unroll
        for (int bj = 0; bj < 2; ++bj) { gv[bj][0] = *(const f32x4*)(gain + u.pn * BM + cl0 + bj * HALF); gv[bj][1] = *(const f32x4*)(gain + u.pn * BM + cl0 + bj * HALF + 4); }
#pragma unroll
        for (int ai = 0; ai < 2; ++ai)
#pragma unroll
            for (int m = 0; m < 4; ++m) { float s = 0.f;
#pragma unroll
                for (int bj = 0; bj < 2; ++bj)
#pragma unroll
                    for (int n = 0; n < 2; ++n) { const f32x4 x = acc[ai][bj][m][n]; s += (x[0] * x[0] + x[1] * x[1]) + (x[2] * x[2] + x[3] * x[3]); }
                s += __shfl_xor(s, 16); s += __shfl_xor(s, 32);
                if (fq == 0) P[(ai * HALF + wr * 64 + m * 16 + fr) * 4 + wc] = s; }
        asm volatile("s_waitcnt lgkmcnt(0)" ::: "memory"); __builtin_amdgcn_s_barrier(); asm volatile("" ::: "memory");
#pragma unroll
        for (int ai = 0; ai < 2; ++ai)
#pragma unroll
            for (int m = 0; m < 4; ++m) { const int rl = rl0 + ai * HALF + m * 16;
                const f32x4 p = *(const LAS f32x4*)(P + rl * 4); const float re = 1.0f / sqrtf(((p[0] + p[1]) + (p[2] + p[3])) * (1.0f / 256.0f) + 1e-6f);
                float mx = 0.f, bx = 0.f;
#pragma unroll
                for (int bj = 0; bj < 2; ++bj) { const u32x4 w = *(const u32x4*)(HB + ((size_t)u.pm * BM + rl) * 1024 + u.pn * BM + cl0 + bj * HALF);
                    const f32x4 h0 = {bf2f(w.x & 0xffffu), bf2f(w.x >> 16), bf2f(w.y & 0xffffu), bf2f(w.y >> 16)}, h1 = {bf2f(w.z & 0xffffu), bf2f(w.z >> 16), bf2f(w.w & 0xffffu), bf2f(w.w >> 16)};
                    const f32x4 a0 = gv[bj][0] * acc[ai][bj][m][0], a1 = gv[bj][1] * acc[ai][bj][m][1]; acc[ai][bj][m][0] = a0; acc[ai][bj][m][1] = a1;
                    const f32x4 t0 = h0 + a0 * re, t1 = h1 + a1 * re;
#pragma unroll
                    for (int q = 0; q < 4; ++q) { mx = fmaxf(mx, fmaxf(fabsf(t0[q]), fabsf(t1[q]))); bx = fmaxf(bx, fmaxf(fabsf(a0[q]), fabsf(a1[q]))); } }
                mx = fmaxf(mx, __shfl_xor(mx, 16)); mx = fmaxf(mx, __shfl_xor(mx, 32)); bx = fmaxf(bx, __shfl_xor(bx, 16)); bx = fmaxf(bx, __shfl_xor(bx, 32));
                if (fq == 0) { PM[rl * 4 + wc] = mx; PB[rl * 4 + wc] = bx; } }
        asm volatile("s_waitcnt lgkmcnt(0)" ::: "memory"); __builtin_amdgcn_s_barrier(); asm volatile("" ::: "memory");
        if (tid < 256) {
            const f32x4 p = *(const LAS f32x4*)(P + tid * 4), pm4 = *(const LAS f32x4*)(PM + tid * 4), pb4 = *(const LAS f32x4*)(PB + tid * 4);
            const float ss = (p[0] + p[1]) + (p[2] + p[3]);
            float* slots = XS + ((size_t)u.pm * BM + tid) * 16;
            st_sys16(slots + u.pn * 4, (f32x4){ss, fmaxf(fmaxf(pm4[0], pm4[1]), fmaxf(pm4[2], pm4[3])), fmaxf(fmaxf(pb4[0], pb4[1]), fmaxf(pb4[2], pb4[3])), 1.0f / sqrtf(ss * (1.0f / 256.0f) + 1e-6f)});
            f32x4 s4[4]; unsigned spins = 0;
            for (;;) {
                bool ok = true;
                ld_sys16x4(slots, s4);
#pragma unroll
                for (int t = 0; t < 4; ++t) ok = ok && (s4[t][0] >= 0.f) && (s4[t][1] >= 0.f) && (s4[t][2] >= 0.f) && (s4[t][3] >= 0.f);
                if (__builtin_amdgcn_ballot_w64(!ok) == 0ull) break;
                __builtin_amdgcn_s_sleep(1);
                if (++spins > (1u << 20)) { __hip_atomic_store(tmo, 1u, __ATOMIC_RELAXED, __HIP_MEMORY_SCOPE_AGENT); break; }
            }
            const float r = 1.0f / sqrtf(((s4[0][0] + s4[1][0]) + (s4[2][0] + s4[3][0])) * (1.0f / 1024.0f) + 1e-6f);
            float bound = 0.f;
#pragma unroll
            for (int t = 0; t < 4; ++t) bound = fmaxf(bound, s4[t][1] + s4[t][2] * fabsf(r - s4[t][3]));
            bound *= 1.00001f;
            const float sc = (bound > 0.f) ? bound * (1.0f / 127.0f) : 1.0f;
            R[tid] = r; RI[tid] = 1.0f / sc; if (u.pn == 0 && !OUTF) SA[(size_t)u.pm * BM + tid] = sc;
        }
        asm volatile("s_waitcnt lgkmcnt(0)" ::: "memory"); __builtin_amdgcn_s_barrier(); asm volatile("" ::: "memory");
#pragma unroll
        for (int ai = 0; ai < 2; ++ai)
#pragma unroll
            for (int m = 0; m < 4; ++m) { const int rl = rl0 + ai * HALF + m * 16; const float r = R[rl], inv = RI[rl]; const size_t go = ((size_t)u.pm * BM + rl) * 1024 + u.pn * BM + cl0;
                float s2 = 0.f;
#pragma unroll
                for (int bj = 0; bj < 2; ++bj) { const u32x4 w = *(const u32x4*)(HB + go + bj * HALF);
                    f32x4 h0 = {bf2f(w.x & 0xffffu), bf2f(w.x >> 16), bf2f(w.y & 0xffffu), bf2f(w.y >> 16)}, h1 = {bf2f(w.z & 0xffffu), bf2f(w.z >> 16), bf2f(w.w & 0xffffu), bf2f(w.w >> 16)};
                    h0 = h0 + acc[ai][bj][m][0] * r; h1 = h1 + acc[ai][bj][m][1] * r;
                    s2 += (h0[0] * h0[0] + h0[1] * h0[1]) + (h0[2] * h0[2] + h0[3] * h0[3]) + (h1[0] * h1[0] + h1[1] * h1[1]) + (h1[2] * h1[2] + h1[3] * h1[3]);
                    if (OUTF) { *(f32x4*)(OUTF + go + bj * HALF) = h0; *(f32x4*)(OUTF + go + bj * HALF + 4) = h1; }
                    else { u32x4 o; o.x = cvt_pk_bf16(h0[0], h0[1]); o.y = cvt_pk_bf16(h0[2], h0[3]); o.z = cvt_pk_bf16(h1[0], h1[1]); o.w = cvt_pk_bf16(h1[2], h1[3]); __builtin_nontemporal_store(o, (u32x4*)(HB + go + bj * HALF));
                        u32x2 q; q.x = q4_i8(h0, inv); q.y = q4_i8(h1, inv); *(u32x2*)(HB8 + go + bj * HALF) = q; } }
                s2 += __shfl_xor(s2, 16); s2 += __shfl_xor(s2, 32);
                if (fq == 0) P2[rl * 4 + wc] = s2; }
        asm volatile("s_waitcnt lgkmcnt(0)" ::: "memory"); __builtin_amdgcn_s_barrier(); asm volatile("" ::: "memory");
        if (tid < 256) { const f32x4 p = *(const LAS f32x4*)(P2 + tid * 4); X2[((size_t)u.pm * BM + tid) * 4 + u.pn] = (p[0] + p[1]) + (p[2] + p[3]); }
    }
};

template <class Epi, class Sched, bool ALIGN_EPI, bool I8 = false>
__device__ __forceinline__ void gemm_phase(LAS unsigned char* lds, const int K, const Sched& S, const Epi& E) {
    int tid = threadIdx.x; asm volatile("" : "+v"(tid));
    const int wid = __builtin_amdgcn_readfirstlane(tid >> 6), lane = tid & 63, wr = wid >> 2, wc = wid & 3, fr = lane & 15, fq = lane >> 4;
    unsigned voffA[2], voffB[2];
#pragma unroll
    for (int i = 0; i < 2; ++i) { int R, C; stage_rc(tid * 16 + i * 8192, R, C); const int Rb = Epi::PERM ? ((R & ~31) + perm32(R & 31)) : R;
        voffA[i] = (unsigned)(R * K + C) * 2u; voffB[i] = (unsigned)(Rb * K + C) * 2u; }
    const size_t kstep = (size_t)(BK * 2);
    const size_t hstep = (size_t)HALF * K * 2;
    const unsigned ldsw = (unsigned)wid * 1024u;
    const int aoff = lds_byte(wr * 64 + fr, fq * 8), boff = lds_byte(wc * 32 + fr, fq * 8);
#define PG8_SA(b, h) (((b) * 2 + (h)) * HTB)
#define PG8_SB(b, h) ((4 + (b) * 2 + (h)) * HTB)
#define PG8_STAGE(bufoff, gbase, voff) do { _Pragma("unroll") for (int _i = 0; _i < 2; ++_i) \
        __builtin_amdgcn_global_load_lds((const unsigned*)((const char*)(gbase) + (voff)[_i]), (LAS unsigned*)(lds + (bufoff) + ldsw + _i * 8192), 16, 0, 0); } while (0)
#define PG8_LDA(dst, b, h) do { _Pragma("unroll") for (int m = 0; m < 4; ++m) _Pragma("unroll") for (int k = 0; k < 2; ++k) dst[m][k] = *(const LAS bf16x8*)(lds + PG8_SA(b, h) + aoff + m * 2048 + k * 1024); } while (0)
#define PG8_LDB(dst, b, h) do { _Pragma("unroll") for (int n = 0; n < 2; ++n) _Pragma("unroll") for (int k = 0; k < 2; ++k) dst[n][k] = *(const LAS bf16x8*)(lds + PG8_SB(b, h) + boff + n * 2048 + k * 1024); } while (0)
#define PG8_MMA(ai, bj, At, Bt) do { __builtin_amdgcn_s_setprio(1); _Pragma("unroll") for (int m = 0; m < 4; ++m) _Pragma("unroll") for (int n = 0; n < 2; ++n) _Pragma("unroll") for (int k = 0; k < 2; ++k) \
        { if constexpr (I8) acc[ai][bj][m][n] = __builtin_bit_cast(f32x4, __builtin_amdgcn_mfma_i32_16x16x64_i8(__builtin_bit_cast(i32x4, Bt[n][k]), __builtin_bit_cast(i32x4, At[m][k]), __builtin_bit_cast(i32x4, acc[ai][bj][m][n]), 0, 0, 0)); \
          else acc[ai][bj][m][n] = __builtin_amdgcn_mfma_f32_16x16x32_bf16(Bt[n][k], At[m][k], acc[ai][bj][m][n], 0, 0, 0); } __builtin_amdgcn_s_setprio(0); } while (0)
#define PG8_WAIT_V(n) asm volatile("s_waitcnt vmcnt(" #n ")" ::: "memory")
#define PG8_WAIT_L(n) asm volatile("s_waitcnt lgkmcnt(" #n ")" ::: "memory")
#define PG8_BAR __builtin_amdgcn_s_barrier()
#define PG8_SCHED __builtin_amdgcn_sched_barrier(0)
    Unit cur, nxt; int ui = 0;
    if (!S.next(0, cur)) return;
    f32x4 acc[2][2][4][2];
#pragma unroll
    for (int a = 0; a < 2; ++a)
#pragma unroll
        for (int b = 0; b < 2; ++b)
#pragma unroll
            for (int m = 0; m < 4; ++m)
#pragma unroll
                for (int n = 0; n < 2; ++n) acc[a][b][m][n] = (f32x4){0.f, 0.f, 0.f, 0.f};
    bf16x8 At[4][2], B0[2][2], B1[2][2];
    const char* cA; const char* cB; S.tiles(cur, cA, cB);
    PG8_STAGE(PG8_SB(0, 0), cB, voffB); PG8_STAGE(PG8_SB(0, 1), cB + hstep, voffB); PG8_STAGE(PG8_SA(0, 0), cA, voffA); PG8_STAGE(PG8_SA(0, 1), cA + hstep, voffA);
    if (wr == 1) PG8_BAR;
    PG8_WAIT_V(2); PG8_BAR;
    PG8_STAGE(PG8_SB(1, 0), cB + kstep, voffB); PG8_STAGE(PG8_SA(1, 0), cA + kstep, voffA); PG8_STAGE(PG8_SB(1, 1), cB + hstep + kstep, voffB);
    PG8_WAIT_V(6); PG8_BAR;
    for (;;) {
        const bool has_next = S.next(ui + 1, nxt);
        const char* nA = cA; const char* nB = cB; if (has_next) S.tiles(nxt, nA, nB);
#define PG8_KT2(t, last) do { \
            const char* a1 = cA + (size_t)((t) + 1) * kstep; \
            const char* a2 = (last) ? nA : cA + (size_t)((t) + 2) * kstep; const char* b2 = (last) ? nB : cB + (size_t)((t) + 2) * kstep; \
            const char* a3 = a2 + kstep; const char* b3 = b2 + kstep; \
            PG8_LDB(B0, 0, 0); PG8_LDB(B1, 0, 1); PG8_SCHED; PG8_LDA(At, 0, 0); PG8_STAGE(PG8_SA(1, 1), a1 + hstep, voffA); \
            PG8_WAIT_V(8); PG8_WAIT_L(0); PG8_BAR; PG8_MMA(0, 0, At, B0); PG8_MMA(0, 1, At, B1); PG8_BAR; PG8_SCHED; \
            PG8_LDA(At, 0, 1); PG8_STAGE(PG8_SB(0, 0), b2, voffB); PG8_STAGE(PG8_SB(0, 1), b2 + hstep, voffB); PG8_STAGE(PG8_SA(0, 0), a2, voffA); \
            PG8_WAIT_V(8); PG8_WAIT_L(0); PG8_BAR; PG8_MMA(1, 0, At, B0); PG8_MMA(1, 1, At, B1); PG8_BAR; PG8_SCHED; \
            PG8_LDB(B0, 1, 0); PG8_LDB(B1, 1, 1); PG8_SCHED; PG8_LDA(At, 1, 0); PG8_STAGE(PG8_SA(0, 1), a2 + hstep, voffA); \
            PG8_WAIT_V(8); PG8_WAIT_L(0); PG8_BAR; PG8_MMA(0, 0, At, B0); PG8_MMA(0, 1, At, B1); PG8_BAR; PG8_SCHED; \
            PG8_LDA(At, 1, 1); PG8_STAGE(PG8_SB(1, 0), b3, voffB); PG8_STAGE(PG8_SB(1, 1), b3 + hstep, voffB); PG8_STAGE(PG8_SA(1, 0), a3, voffA); \
            PG8_WAIT_V(8); PG8_WAIT_L(0); PG8_BAR; PG8_MMA(1, 0, At, B0); PG8_MMA(1, 1, At, B1); PG8_BAR; PG8_SCHED; } while (0)
        {
            const int ntc = S.ntiles(cur);
#pragma unroll 1
            for (int t = 0; t < ntc; t += 2) { const bool last = (t == ntc - 2); PG8_KT2(t, last); }
        }
        if constexpr (ALIGN_EPI) { if (wr == 0) PG8_BAR; }
        E(acc, cur, wr, wc, fr, fq);
        if (!has_next) break;
        if (!S.keep_acc(nxt)) {
#pragma unroll
        for (int a = 0; a < 2; ++a)
#pragma unroll
            for (int b = 0; b < 2; ++b)
#pragma unroll
                for (int m = 0; m < 4; ++m)
#pragma unroll
                    for (int n = 0; n < 2; ++n) acc[a][b][m][n] = (f32x4){0.f, 0.f, 0.f, 0.f};
        }
        cur = nxt; cA = nA; cB = nB; ++ui;
        if constexpr (ALIGN_EPI) { if (wr == 1) PG8_BAR; }
    }
    PG8_WAIT_V(0);
    if constexpr (!ALIGN_EPI) { if (wr == 0) PG8_BAR; }
    PG8_BAR;
#undef PG8_KT2
#undef PG8_SA
#undef PG8_SB
#undef PG8_STAGE
#undef PG8_LDA
#undef PG8_LDB
#undef PG8_MMA
#undef PG8_WAIT_V
#undef PG8_WAIT_L
#undef PG8_BAR
#undef PG8_SCHED
}
}

struct Args {
    const float* in[22]; float* out; unsigned char* ws; int ph_lo, ph_hi;
};
enum { I_X = 0, I_NMIXPRE, I_NMIXPOST, I_NMLPPRE, I_NMLPPOST, I_WIN, I_LCW, I_LCB, I_LWA, I_LBA, I_LWX, I_LBX, I_LLAM, I_PW, I_PS, I_HLB, I_HN, I_SW, I_WBR, I_WOUT, I_WUP, I_WDOWN };

struct Ctx {
    LAS unsigned char* lds; int tid, lane, wave, vcu, G;
};

__device__ __forceinline__ void transpose_item(const float* W, int ldw, const float* gain, bf16_t* WT, int ldo, int col_off, int k0, int n0, LAS float* scr, int lane) {
    float wv[32];
#pragma unroll
    for (int i = 0; i < 32; ++i) { const int kk = 2 * i + (lane >> 5); wv[i] = W[(size_t)(k0 + kk) * ldw + n0 + (lane & 31)]; }
#pragma unroll
    for (int i = 0; i < 32; ++i) { const int kk = 2 * i + (lane >> 5); const float g = gain ? gain[k0 + kk] : 1.0f; scr[kk * 33 + (lane & 31)] = g * wv[i]; }
    asm volatile("s_waitcnt lgkmcnt(0)" ::: "memory");
    const int c = lane & 7;
#pragma unroll
    for (int j = 0; j < 4; ++j) { const int n = (lane >> 3) + 8 * j; const LAS float* s = scr + (8 * c) * 33 + n;
        u32x4 o; o.x = pk2(s[0 * 33], s[1 * 33]); o.y = pk2(s[2 * 33], s[3 * 33]); o.z = pk2(s[4 * 33], s[5 * 33]); o.w = pk2(s[6 * 33], s[7 * 33]);
        *(u32x4*)(WT + (size_t)(n0 + n) * ldo + col_off + k0 + 8 * c) = o; }
    asm volatile("s_waitcnt lgkmcnt(0)" ::: "memory");
}

__device__ __forceinline__ void p0_prologue(const Ctx& C, const Args& A) {
    LAS float* scr = (LAS float*)(C.lds + C.wave * 16384);
    const int gw = C.vcu * NWAVES + C.wave, NGW = C.G * NWAVES;
    constexpr int I_IN = (D / 64) * (INW / 32), I_BR1 = (BW / 64) * (D / 32), I_OUT = (D / 64) * (D / 32), I_UP = (D / 64) * (FF / 32), I_DN = (FF / 64) * (D / 32);
    constexpr int PER_LAYER = I_IN + 4 * I_BR1 + I_OUT + I_UP + I_DN;
    for (int it = gw; it < DEPTH * PER_LAYER; it += NGW) {
        const int l = it / PER_LAYER; int r = it % PER_LAYER;
        bf16_t* wl = (bf16_t*)(A.ws + WS_W + (size_t)l * W_LAYER);
        if (r < I_IN) { const int nb = INW / 32; transpose_item(A.in[I_WIN] + (size_t)l * D * INW, INW, A.in[I_NMIXPRE] + l * D, wl + W_IN / 2, D, 0, 64 * (r / nb), 32 * (r % nb), scr, C.lane); continue; } r -= I_IN;
        if (r < 4 * I_BR1) { const int k = r / I_BR1, rr = r % I_BR1, nb = D / 32; transpose_item(A.in[I_WBR] + ((size_t)l * 4 + k) * BW * D, D, nullptr, wl + W_BR / 2, D, k * BW, 64 * (rr / nb), 32 * (rr % nb), scr, C.lane); continue; } r -= 4 * I_BR1;
        if (r < I_OUT) { const int nb = D / 32; transpose_item(A.in[I_WOUT] + (size_t)l * D * D, D, nullptr, wl + W_OUT / 2, D, 0, 64 * (r / nb), 32 * (r % nb), scr, C.lane); continue; } r -= I_OUT;
        if (r < I_UP) { const int nb = FF / 32; transpose_item(A.in[I_WUP] + (size_t)l * D * FF, FF, A.in[I_NMLPPRE] + l * D, wl + W_UP / 2, D, 0, 64 * (r / nb), 32 * (r % nb), scr, C.lane); continue; } r -= I_UP;
        { const int nb = D / 32; transpose_item(A.in[I_WDOWN] + (size_t)l * FF * D, D, nullptr, wl + W_DOWN / 2, FF, 0, 64 * (r / nb), 32 * (r % nb), scr, C.lane); }
    }
    { const int gt = gw * 64 + C.lane; if (gt < DEPTH * BW) { const float lam = A.in[I_LLAM][gt]; ((float*)(A.ws + WS_SP8))[gt] = -8.0f * ((-lam > 20.f) ? -lam : log1pf(expf(-lam))); } }
    bf16_t* HB = (bf16_t*)(A.ws + WS_HB); float* RS = (float*)(A.ws + WS_X2);
    for (int m0 = gw; m0 < M; m0 += 4 * NGW) {
        f32x4 v[4][4];
#pragma unroll
        for (int q = 0; q < 4; ++q) { const int m = m0 + q * NGW; const f32x4* xr = (const f32x4*)(A.in[I_X] + (size_t)(m < M ? m : 0) * D) + C.lane;
#pragma unroll
            for (int j = 0; j < 4; ++j) v[q][j] = xr[64 * j]; }
#pragma unroll
        for (int q = 0; q < 4; ++q) { const int m = m0 + q * NGW; if (m < M) { float s = 0.f;
#pragma unroll
            for (int j = 0; j < 4; ++j) s += (v[q][j].x * v[q][j].x + v[q][j].y * v[q][j].y) + (v[q][j].z * v[q][j].z + v[q][j].w * v[q][j].w);
            s = wave_sum(s);
            u32x2* o8 = (u32x2*)(HB + (size_t)m * D) + C.lane;
#pragma unroll
            for (int j = 0; j < 4; ++j) { u32x2 w; w.x = pk2(v[q][j].x, v[q][j].y); w.y = pk2(v[q][j].z, v[q][j].w); o8[64 * j] = w; }
            float mx = 0.f;
#pragma unroll
            for (int j = 0; j < 4; ++j) mx = fmaxf(fmaxf(mx, fmaxf(fabsf(v[q][j].x), fabsf(v[q][j].y))), fmaxf(fabsf(v[q][j].z), fabsf(v[q][j].w)));
#pragma unroll
            for (int o = 1; o < 64; o <<= 1) mx = fmaxf(mx, __shfl_xor(mx, o));
            const float sc = (mx > 0.f) ? mx * (1.0f / 127.0f) : 1.0f, inv = 1.0f / sc;
            unsigned* o4 = (unsigned*)(A.ws + WS_HB8 + (size_t)m * D) + C.lane;
#pragma unroll
            for (int j = 0; j < 4; ++j) o4[64 * j] = q4_i8(v[q][j], inv);
            if (C.lane == 0) { *(f32x4*)(RS + (size_t)m * 4) = (f32x4){s, 0.f, 0.f, 0.f}; ((float*)(A.ws + WS_SA))[m] = sc; } } }
    }
}

__device__ __forceinline__ void norm_phase(const Ctx& C, const Args& A, const bf16_t* VIN, const float* gain, bool write_out) {
    bf16_t* HB = (bf16_t*)(A.ws + WS_HB); float* RS = (float*)(A.ws + WS_X2); float* OUT = A.out;
    int lane = C.lane; asm volatile("" : "+v"(lane));
    const int gw = C.vcu * NWAVES + C.wave, NGW = C.G * NWAVES;
    f32x4 g[4];
#pragma unroll
    for (int j = 0; j < 4; ++j) g[j] = ((const f32x4*)gain)[lane + 64 * j];
    for (int m = gw; m < M; m += NGW) {
        u32x2* hb = (u32x2*)(HB + (size_t)m * D) + lane;
        const u32x2* vb = (const u32x2*)(VIN + (size_t)m * D) + lane;
        f32x4 v[4], h[4]; float s = 0.f;
#pragma unroll
        for (int j = 0; j < 4; ++j) { const u32x2 w = vb[64 * j], hw = hb[64 * j];
            v[j] = (f32x4){bf2f(w.x & 0xffffu), bf2f(w.x >> 16), bf2f(w.y & 0xffffu), bf2f(w.y >> 16)};
            h[j] = (f32x4){bf2f(hw.x & 0xffffu), bf2f(hw.x >> 16), bf2f(hw.y & 0xffffu), bf2f(hw.y >> 16)};
            s += (v[j].x * v[j].x + v[j].y * v[j].y) + (v[j].z * v[j].z + v[j].w * v[j].w); }
        const float r = 1.0f / sqrtf(wave_sum(s) * (1.0f / D) + EPS);
        float s2 = 0.f;
#pragma unroll
        for (int j = 0; j < 4; ++j) { h[j] = h[j] + g[j] * v[j] * r; s2 += (h[j].x * h[j].x + h[j].y * h[j].y) + (h[j].z * h[j].z + h[j].w * h[j].w); }
        s2 = wave_sum(s2);
        if (write_out) { f32x4* orow = (f32x4*)(OUT + (size_t)m * D) + lane;
#pragma unroll
            for (int j = 0; j < 4; ++j) orow[64 * j] = h[j]; }
        else {
#pragma unroll
            for (int j = 0; j < 4; ++j) { u32x2 w; w.x = pk2(h[j].x, h[j].y); w.y = pk2(h[j].z, h[j].w); hb[64 * j] = w; }
            float mx = 0.f;
#pragma unroll
            for (int j = 0; j < 4; ++j) mx = fmaxf(fmaxf(mx, fmaxf(fabsf(h[j].x), fabsf(h[j].y))), fmaxf(fabsf(h[j].z), fabsf(h[j].w)));
#pragma unroll
            for (int o = 1; o < 64; o <<= 1) mx = fmaxf(mx, __shfl_xor(mx, o));
            const float sc = (mx > 0.f) ? mx * (1.0f / 127.0f) : 1.0f, inv = 1.0f / sc;
            unsigned* o4 = (unsigned*)(A.ws + WS_HB8 + (size_t)m * D) + lane;
#pragma unroll
            for (int j = 0; j < 4; ++j) o4[64 * j] = q4_i8(h[j], inv);
            if (lane == 0) { *(f32x4*)(RS + (size_t)m * 4) = (f32x4){s2, 0.f, 0.f, 0.f}; ((float*)(A.ws + WS_SA))[m] = sc; } }
    }
}

__device__ __forceinline__ float gelu_tanh(float x) {
    const float u = 0.7978845608028654f * (x + 0.044715f * x * x * x);
    const float e = fast_exp(2.0f * u);
    const float th = 1.0f - 2.0f * __builtin_amdgcn_rcpf(e + 1.0f);
    return 0.5f * x * (1.0f + th);
}

constexpr size_t WS_LRA = 428 * MiB, WS_LRU = 444 * MiB;
constexpr int MX_PT = 528;
__device__ __forceinline__ bf16x8 gather_wfrag(const float* w, int stride) {
    union { bf16x8 v; unsigned u[4]; } r;
#pragma unroll
    for (int p = 0; p < 4; ++p) r.u[p] = pk2(w[(2 * p) * stride], w[(2 * p + 1) * stride]);
    return r.v;
}
__device__ __forceinline__ void mix1_item(const Ctx& C, const Args& A, int l, int b, int c) {
    const bf16_t* PROJ = (const bf16_t*)(A.ws + WS_PROJ);
    bf16_t* YS = (bf16_t*)(A.ws + WS_YS);
    int tid = C.tid; asm volatile("" : "+v"(tid));
    const int lane = tid & 63, wave = C.wave, fr = lane & 15, fg = lane >> 4;
    const size_t m0 = (size_t)b * T + (size_t)c * 64;
    LAS unsigned char* XC = C.lds;
    LAS unsigned char* LAi = C.lds + 34816;
    LAS unsigned char* LUi = C.lds + 34816 + 32768;
    {
        const float* cw = A.in[I_LCW] + (size_t)l * 4 * BW; const float* cbp = A.in[I_LCB] + l * BW;
#pragma unroll
        for (int k = 0; k < 4; ++k) { const int idx = tid + NTHREADS * k; const int t = idx >> 5, c8 = (idx & 31) * 8;
            float acc[8];
            { const f32x4 b0 = *(const f32x4*)(cbp + c8), b1 = *(const f32x4*)(cbp + c8 + 4); acc[0] = b0[0]; acc[1] = b0[1]; acc[2] = b0[2]; acc[3] = b0[3]; acc[4] = b1[0]; acc[5] = b1[1]; acc[6] = b1[2]; acc[7] = b1[3]; }
#pragma unroll
            for (int j = 0; j < 4; ++j) { const int tok = c * 64 + t - 3 + j;
                if (tok >= 0) { float x[8]; ld8bf(PROJ + ((size_t)b * T + tok) * NMIX + c8, x); const f32x4 w0 = *(const f32x4*)(cw + j * BW + c8), w1 = *(const f32x4*)(cw + j * BW + c8 + 4);
                    acc[0] += w0[0] * x[0]; acc[1] += w0[1] * x[1]; acc[2] += w0[2] * x[2]; acc[3] += w0[3] * x[3]; acc[4] += w1[0] * x[4]; acc[5] += w1[1] * x[5]; acc[6] += w1[2] * x[6]; acc[7] += w1[3] * x[7]; } }
            u32x4 w; w.x = cvt_pk_bf16(acc[0], acc[1]); w.y = cvt_pk_bf16(acc[2], acc[3]); w.z = cvt_pk_bf16(acc[4], acc[5]); w.w = cvt_pk_bf16(acc[6], acc[7]);
            *(LAS u32x4*)(XC + t * MX_PT + c8 * 2) = w; }
    }
    __syncthreads();
    {
        const int blk = wave;
        const float* wa = A.in[I_LWA] + (((size_t)l * 8 + blk) * 32) * 32; const float* wx = A.in[I_LWX] + (((size_t)l * 8 + blk) * 32) * 32;
        bf16x8 fa[2], fx[2];
#pragma unroll
        for (int nt = 0; nt < 2; ++nt) { fa[nt] = gather_wfrag(wa + (8 * fg) * 32 + 16 * nt + fr, 32); fx[nt] = gather_wfrag(wx + (8 * fg) * 32 + 16 * nt + fr, 32); }
        bf16_t* LRA = (bf16_t*)(A.ws + WS_LRA); bf16_t* LRU = (bf16_t*)(A.ws + WS_LRU);
#pragma unroll
        for (int nt = 0; nt < 2; ++nt) { const int ch = 32 * blk + 16 * nt + 4 * fg;
            const f32x4 ba = *(const f32x4*)(A.in[I_LBA] + l * BW + ch), bx = *(const f32x4*)(A.in[I_LBX] + l * BW + ch), sp8 = *(const f32x4*)((const float*)(A.ws + WS_SP8) + l * BW + ch);
#pragma unroll
            for (int mt = 0; mt < 4; ++mt) { const int tok = 16 * mt + fr;
                const bf16x8 bxc = *(const LAS bf16x8*)(XC + tok * MX_PT + (32 * blk + 8 * fg) * 2);
                f32x4 ar = {0.f, 0.f, 0.f, 0.f}, ai = {0.f, 0.f, 0.f, 0.f};
                ar = __builtin_amdgcn_mfma_f32_16x16x32_bf16(fa[nt], bxc, ar, 0, 0, 0); ai = __builtin_amdgcn_mfma_f32_16x16x32_bf16(fx[nt], bxc, ai, 0, 0, 0);
                const u32x2 xw = *(const LAS u32x2*)(XC + tok * MX_PT + ch * 2);
                const float xc[4] = {bf2f(xw.x & 0xffffu), bf2f(xw.x >> 16), bf2f(xw.y & 0xffffu), bf2f(xw.y >> 16)};
                float la[4], uu[4];
#pragma unroll
                for (int r = 0; r < 4; ++r) { const float rg = sigmoid_f(ar[r] + ba[r]), ig = sigmoid_f(ai[r] + bx[r]);
                    la[r] = sp8[r] * rg; const float x2 = 2.0f * la[r];
                    const float om = (x2 > -0.02f) ? -x2 * (1.0f + 0.5f * x2 * (1.0f + x2 * (1.0f / 3.0f))) : 1.0f - fast_exp(x2);
                    uu[r] = sqrtf(om) * ig * xc[r]; }
                u32x2 wl, wu; wl.x = cvt_pk_bf16(la[0], la[1]); wl.y = cvt_pk_bf16(la[2], la[3]); wu.x = cvt_pk_bf16(uu[0], uu[1]); wu.y = cvt_pk_bf16(uu[2], uu[3]);
                *(LAS u32x2*)(LAi + tok * 512 + ch * 2) = wl; *(LAS u32x2*)(LUi + tok * 512 + ch * 2) = wu;
                *(u32x2*)(LRA + (m0 + tok) * BW + ch) = wl; *(u32x2*)(LRU + (m0 + tok) * BW + ch) = wu; }
        }
    }
    __syncthreads();
    {
        const int ch = tid & 255, half = tid >> 8; float P = 1.f, hst = 0.f;
#pragma unroll
        for (int i = 0; i < 32; ++i) { const int t = 32 * half + i; const float a = fast_exp(bf2f(*(const LAS bf16_t*)(LAi + t * 512 + ch * 2))); const float u = bf2f(*(const LAS bf16_t*)(LUi + t * 512 + ch * 2));
            hst = a * hst + u; P *= a; }
        const size_t aggi = ((size_t)b * 128 + c * 2 + half) * 256 + ch;
        ((float*)(A.ws + WS_LA))[aggi] = P; ((float*)(A.ws + WS_LH))[aggi] = hst;
    }
    __syncthreads();
    LAS unsigned char* PX = C.lds;
    LAS unsigned char* DD = C.lds + 43008;
    { u32x4 pv[5];
#pragma unroll
        for (int k = 0; k < 5; ++k) { const int idx = tid + NTHREADS * k; const int r = idx >> 5, c8 = (idx & 31) * 8; const int tok = c * 64 - 15 + r;
            pv[k] = (u32x4){0u, 0u, 0u, 0u}; if (idx < 79 * 32 && tok >= 0) pv[k] = *(const u32x4*)(PROJ + ((size_t)b * T + tok) * NMIX + 512 + c8); }
#pragma unroll
        for (int k = 0; k < 5; ++k) { const int idx = tid + NTHREADS * k; const int r = idx >> 5, c8 = (idx & 31) * 8; if (idx < 79 * 32) *(LAS u32x4*)(PX + r * MX_PT + c8 * 2) = pv[k]; } }
    __syncthreads();
#pragma unroll 1
    for (int k = 0; k < 4; ++k) { const int idx = tid + NTHREADS * k; const int t = idx >> 5, c8 = (idx & 31) * 8; const int g = c8 >> 6, win = 2 << g;
        float sum[8], x0[8];
#pragma unroll
        for (int e = 0; e < 8; ++e) sum[e] = 0.f;
        for (int j = 0; j < win; ++j) { const u32x4 v = *(const LAS u32x4*)(PX + (t + 15 - j) * MX_PT + c8 * 2);
            const float x[8] = {bf2f(v.x & 0xffffu), bf2f(v.x >> 16), bf2f(v.y & 0xffffu), bf2f(v.y >> 16), bf2f(v.z & 0xffffu), bf2f(v.z >> 16), bf2f(v.w & 0xffffu), bf2f(v.w >> 16)};
#pragma unroll
            for (int e = 0; e < 8; ++e) { sum[e] += x[e]; if (j == 0) x0[e] = x[e]; } }
        const int pos = c * 64 + t + 1; const float inv = 1.0f / (float)(pos < win ? pos : win);
        u32x4 w; w.x = cvt_pk_bf16(sum[0] * inv - x0[0], sum[1] * inv - x0[1]); w.y = cvt_pk_bf16(sum[2] * inv - x0[2], sum[3] * inv - x0[3]);
        w.z = cvt_pk_bf16(sum[4] * inv - x0[4], sum[5] * inv - x0[5]); w.w = cvt_pk_bf16(sum[6] * inv - x0[6], sum[7] * inv - x0[7]);
        *(LAS u32x4*)(DD + t * MX_PT + c8 * 2) = w; }
    __syncthreads();
    {
        const int g = wave >> 1, nb = (wave & 1) * 2;
        const float* pw = A.in[I_PW] + (((size_t)l * 4 + g) * 64) * 64;
        bf16x8 fw[2][2];
#pragma unroll
        for (int nn = 0; nn < 2; ++nn)
#pragma unroll
            for (int ks = 0; ks < 2; ++ks) fw[nn][ks] = gather_wfrag(pw + (32 * ks + 8 * fg) * 64 + 16 * (nb + nn) + fr, 64);
#pragma unroll
        for (int nn = 0; nn < 2; ++nn) { const int ch = 64 * g + 16 * (nb + nn) + 4 * fg; const f32x4 scl = *(const f32x4*)(A.in[I_PS] + l * BW + ch);
#pragma unroll
            for (int mt = 0; mt < 4; ++mt) { const int tok = 16 * mt + fr; f32x4 acc = {0.f, 0.f, 0.f, 0.f};
#pragma unroll
                for (int ks = 0; ks < 2; ++ks) { const bf16x8 bd = *(const LAS bf16x8*)(DD + tok * MX_PT + (64 * g + 32 * ks + 8 * fg) * 2); acc = __builtin_amdgcn_mfma_f32_16x16x32_bf16(fw[nn][ks], bd, acc, 0, 0, 0); }
                u32x2 w; w.x = cvt_pk_bf16(acc[0] * scl[0], acc[1] * scl[1]); w.y = cvt_pk_bf16(acc[2] * scl[2], acc[3] * scl[3]);
                *(u32x2*)(YS + (m0 + tok) * D + 256 + ch) = w; } }
    }
    {
        const float* sw = A.in[I_SW] + (size_t)l * 3 * BW;
#pragma unroll 2
        for (int k = 0; k < 4; ++k) { const int idx = tid + NTHREADS * k; const int t = idx >> 5, c8 = (idx & 31) * 8;
            float acc[8];
#pragma unroll
            for (int e = 0; e < 8; ++e) acc[e] = 0.f;
#pragma unroll
            for (int j = 0; j < 3; ++j) { const int tok = c * 64 + t - 2 + j;
                if (tok >= 0) { const bf16_t* p = PROJ + ((size_t)b * T + tok) * NMIX; float sc[8], sx[8]; ld8bf(p + 2048 + c8, sc); ld8bf(p + 2304 + c8, sx);
                    const f32x4 w0 = *(const f32x4*)(sw + j * BW + c8), w1 = *(const f32x4*)(sw + j * BW + c8 + 4);
                    acc[0] += w0[0] * sc[0] * sx[0]; acc[1] += w0[1] * sc[1] * sx[1]; acc[2] += w0[2] * sc[2] * sx[2]; acc[3] += w0[3] * sc[3] * sx[3];
                    acc[4] += w1[0] * sc[4] * sx[4]; acc[5] += w1[1] * sc[5] * sx[5]; acc[6] += w1[2] * sc[6] * sx[6]; acc[7] += w1[3] * sc[7] * sx[7]; } }
            float sb[8]; ld8bf(PROJ + (m0 + t) * NMIX + 1792 + c8, sb);
            u32x4 w; w.x = cvt_pk_bf16(sb[0] * acc[0], sb[1] * acc[1]); w.y = cvt_pk_bf16(sb[2] * acc[2], sb[3] * acc[3]); w.z = cvt_pk_bf16(sb[4] * acc[4], sb[5] * acc[5]); w.w = cvt_pk_bf16(sb[6] * acc[6], sb[7] * acc[7]);
            *(u32x4*)(YS + (m0 + t) * D + 768 + c8) = w; }
    }
    __syncthreads();
}
__device__ __forceinline__ void lru_final_item(const Ctx& C, const Args& A, int l, int b, int c) {
    const bf16_t* PROJ = (const bf16_t*)(A.ws + WS_PROJ);
    const bf16_t* LRA = (const bf16_t*)(A.ws + WS_LRA); const bf16_t* LRU = (const bf16_t*)(A.ws + WS_LRU);
    bf16_t* YS = (bf16_t*)(A.ws + WS_YS);
    int tid = C.tid; asm volatile("" : "+v"(tid));
    const int ch = tid & 255, half = tid >> 8;
    const size_t m0 = (size_t)b * T + (size_t)c * 64 + 32 * half;
    float hst = ((const float*)(A.ws + WS_LC))[((size_t)b * 128 + c * 2 + half) * 256 + ch];
    unsigned short la[32], lu[32], lg[32];
#pragma unroll
    for (int i = 0; i < 32; ++i) { la[i] = LRA[(m0 + i) * BW + ch]; lu[i] = LRU[(m0 + i) * BW + ch]; lg[i] = PROJ[(m0 + i) * NMIX + 256 + ch]; }
#pragma unroll
    for (int i = 0; i < 32; ++i) { const float a = fast_exp(bf2f(la[i])), u = bf2f(lu[i]);
        hst = a * hst + u;
        YS[(m0 + i) * D + ch] = (bf16_t)f2bf(hst * gelu_tanh(bf2f(lg[i]))); }
}

constexpr int HG_PT = 144;
constexpr int HG_IMG = 64 * HG_PT;
constexpr int HG_Q = 0, HG_K = HG_IMG, HG_P = 2 * HG_IMG, HG_BEND = 3 * HG_IMG, HG_REF = HG_BEND + 512, HG_HSZ = 29696;
constexpr size_t WS_ST16 = WS_MERGED + 32 * MiB;
__device__ __forceinline__ float hgrn_lb(const Args& A, int l, int w) {
    if (l == 0) return 0.f;
    const float a0 = A.in[I_HLB][w], a1 = A.in[I_HLB][BW + w];
    return 1.0f / (1.0f + expf(a0 - a1));
}
template <bool FINAL>
__device__ __forceinline__ void hgrn_item(const Ctx& C, const Args& A, int l, int b, int c) {
    const bf16_t* PROJ = (const bf16_t*)(A.ws + WS_PROJ);
    int lane = C.lane; asm volatile("" : "+v"(lane));
    const int wave = C.wave, h = wave >> 1, half = wave & 1, fr = lane & 15, fg = lane >> 4;
    LAS unsigned char* hb = C.lds + h * HG_HSZ;
    LAS float* BEND = (LAS float*)(hb + HG_BEND); LAS float* REF = (LAS float*)(hb + HG_REF);
    const size_t m0 = (size_t)b * T + (size_t)c * 64;
    const bf16_t* pr = PROJ + (m0 + 32 * half) * NMIX + h * 64 + lane;
    const int bh = b * 4 + h; const size_t ci = (size_t)bh * 64 + c;
    float bb[32], kk[32], vv[32];
    {
        const float lbv = hgrn_lb(A, l, h * 64 + lane);
        float acc = 0.f;
#pragma unroll
        for (int i = 0; i < 32; ++i) { const float x = bf2f(pr[(size_t)i * NMIX + 1024]); const float f = fmaxf(lbv + (1.0f - lbv) * sigmoid_f(x), 1e-30f);
            acc += __logf(f); bb[i] = acc; kk[i] = 1.0f - f; }
#pragma unroll
        for (int i = 0; i < 32; ++i) vv[i] = bf2f(pr[(size_t)i * NMIX + 1280]);
        BEND[half * 64 + lane] = acc;
    }
    __syncthreads();
    const float bend0 = BEND[lane], blast = bend0 + BEND[64 + lane];
    if (half) {
#pragma unroll
        for (int i = 0; i < 32; ++i) bb[i] += bend0;
    }
    if (!FINAL) {
        LAS unsigned char* kt = hb + HG_K + lane * HG_PT + 64 * half; LAS unsigned char* vt = hb + HG_Q + lane * HG_PT + 64 * half;
#pragma unroll
        for (int q4 = 0; q4 < 4; ++q4) { u32x4 wk, wv; unsigned kw[4], vw[4];
#pragma unroll
            for (int p = 0; p < 4; ++p) { const int i = q4 * 8 + 2 * p;
                kw[p] = cvt_pk_bf16(kk[i] * fast_exp(blast - bb[i]), kk[i + 1] * fast_exp(blast - bb[i + 1])); vw[p] = cvt_pk_bf16(vv[i], vv[i + 1]); }
            wk.x = kw[0]; wk.y = kw[1]; wk.z = kw[2]; wk.w = kw[3]; wv.x = vw[0]; wv.y = vw[1]; wv.z = vw[2]; wv.w = vw[3];
            *(LAS u32x4*)(kt + q4 * 16) = wk; *(LAS u32x4*)(vt + q4 * 16) = wv; }
        if (half == 0) ((float*)(A.ws + WS_SD))[ci * 64 + lane] = fast_exp(blast);
        __syncthreads();
        float* su = (float*)(A.ws + WS_SU) + ci * 4096;
#pragma unroll
        for (int aa = 0; aa < 2; ++aa) { const int a = 2 * half + aa;
            bf16x8 av[2];
#pragma unroll
            for (int ks = 0; ks < 2; ++ks) av[ks] = *(const LAS bf16x8*)(hb + HG_Q + (16 * a + fr) * HG_PT + 64 * ks + 16 * fg);
#pragma unroll
            for (int d = 0; d < 4; ++d) { f32x4 acc = {0.f, 0.f, 0.f, 0.f};
#pragma unroll
                for (int ks = 0; ks < 2; ++ks) { const bf16x8 bk = *(const LAS bf16x8*)(hb + HG_K + (16 * d + fr) * HG_PT + 64 * ks + 16 * fg);
                    acc = __builtin_amdgcn_mfma_f32_16x16x32_bf16(av[ks], bk, acc, 0, 0, 0); }
#pragma unroll
                for (int r = 0; r < 4; ++r) su[(16 * a + 4 * fg + r) * 64 + 16 * d + fr] = acc[r];
            } }
        __syncthreads();
    } else {
        float qq[32];
#pragma unroll
        for (int i = 0; i < 32; ++i) qq[i] = bf2f(pr[(size_t)i * NMIX + 768]);
        if (half == 0) { REF[64 + lane] = bb[15]; REF[128 + lane] = bb[31]; } else REF[192 + lane] = bb[15];
        { const u32x4 z = {0u, 0u, 0u, 0u};
#pragma unroll
            for (int k2 = 0; k2 < 5; ++k2) { const int idx = lane + 64 * k2; if (idx < 32 * 9) *(LAS u32x4*)(hb + HG_P + 32 * half * HG_PT + idx * 16) = z; } }
        __syncthreads();
        float rf[4]; rf[0] = 0.f; rf[1] = REF[64 + lane]; rf[2] = REF[128 + lane]; rf[3] = REF[192 + lane];
        {
            const float r_lo = half ? rf[2] : rf[0], r_hi = half ? rf[3] : rf[1];
#pragma unroll
            for (int i = 0; i < 32; ++i) { const float rr = (i < 16) ? r_lo : r_hi; const float val = qq[i] * fast_exp(bb[i] - rr);
                *(LAS bf16_t*)(hb + HG_Q + (32 * half + i) * HG_PT + 2 * lane) = (bf16_t)f2bf(val); }
        }
#pragma unroll
        for (int isub = 0; isub < 4; ++isub) {
            const int nrows = 16 * (isub + 1) - 32 * half;
#pragma unroll
            for (int i = 0; i < 32; ++i) { if (i < nrows) { const float e = fminf(rf[isub] - bb[i], 60.f); const float val = kk[i] * fast_exp(e);
                    *(LAS bf16_t*)(hb + HG_K + (32 * half + i) * HG_PT + 2 * lane) = (bf16_t)f2bf(val); } }
            __syncthreads();
            {
                bf16x8 bq[2];
#pragma unroll
                for (int ks = 0; ks < 2; ++ks) bq[ks] = *(const LAS bf16x8*)(hb + HG_Q + (16 * isub + fr) * HG_PT + 64 * ks + 16 * fg);
#pragma unroll
                for (int j = 0; j <= isub; ++j) { if ((j & 1) == half) {
                        f32x4 acc = {0.f, 0.f, 0.f, 0.f};
#pragma unroll
                        for (int ks = 0; ks < 2; ++ks) { const bf16x8 ak = *(const LAS bf16x8*)(hb + HG_K + (16 * j + fr) * HG_PT + 64 * ks + 16 * fg);
                            acc = __builtin_amdgcn_mfma_f32_16x16x32_bf16(ak, bq[ks], acc, 0, 0, 0); }
                        if (j == isub) {
#pragma unroll
                            for (int r = 0; r < 4; ++r) if (4 * fg + r > fr) acc[r] = 0.f; }
                        u32x2 w; w.x = cvt_pk_bf16(acc[0], acc[1]); w.y = cvt_pk_bf16(acc[2], acc[3]);
                        *(LAS u32x2*)(hb + HG_P + (16 * isub + fr) * HG_PT + 2 * (16 * j + 4 * fg)) = w;
                    } }
            }
            __syncthreads();
        }
        {
            LAS unsigned char* vt = hb + HG_Q + lane * HG_PT + 64 * half;
#pragma unroll
            for (int q4 = 0; q4 < 4; ++q4) { u32x4 wv; unsigned vw[4];
#pragma unroll
                for (int p = 0; p < 4; ++p) { const int i = q4 * 8 + 2 * p; vw[p] = cvt_pk_bf16(vv[i], vv[i + 1]); }
                wv.x = vw[0]; wv.y = vw[1]; wv.z = vw[2]; wv.w = vw[3]; *(LAS u32x4*)(vt + q4 * 16) = wv; }
#pragma unroll
            for (int i = 0; i < 32; ++i) *(LAS bf16_t*)(hb + HG_K + (32 * half + i) * HG_PT + 2 * lane) = (bf16_t)f2bf(qq[i] * fast_exp(bb[i]));
        }
        __syncthreads();
        {
            const bf16_t* st = (const bf16_t*)(A.ws + WS_ST16) + ci * 4096;
            bf16x8 a_st[4][2];
#pragma unroll
            for (int a = 0; a < 4; ++a)
#pragma unroll
                for (int ks = 0; ks < 2; ++ks) a_st[a][ks] = *(const bf16x8*)(st + (16 * a + fr) * 64 + 32 * ks + 8 * fg);
            bf16_t* YS = (bf16_t*)(A.ws + WS_YS);
            const float* gn = A.in[I_HN] + l * 64;
#pragma unroll
            for (int tt = 0; tt < 2; ++tt) { const int ti = 2 * half + tt;
                bf16x8 bp[2], bqb[2];
#pragma unroll
                for (int ks = 0; ks < 2; ++ks) { bp[ks] = *(const LAS bf16x8*)(hb + HG_P + (16 * ti + fr) * HG_PT + 64 * ks + 16 * fg); bqb[ks] = *(const LAS bf16x8*)(hb + HG_K + (16 * ti + fr) * HG_PT + 64 * ks + 16 * fg); }
                f32x4 o[4]; float ss = 0.f;
#pragma unroll
                for (int a = 0; a < 4; ++a) { f32x4 acc = {0.f, 0.f, 0.f, 0.f};
#pragma unroll
                    for (int ks = 0; ks < 2; ++ks) { const bf16x8 av = *(const LAS bf16x8*)(hb + HG_Q + (16 * a + fr) * HG_PT + 64 * ks + 16 * fg);
                        acc = __builtin_amdgcn_mfma_f32_16x16x32_bf16(av, bp[ks], acc, 0, 0, 0);
                        acc = __builtin_amdgcn_mfma_f32_16x16x32_bf16(a_st[a][ks], bqb[ks], acc, 0, 0, 0); }
                    o[a] = acc; ss += (acc[0] * acc[0] + acc[1] * acc[1]) + (acc[2] * acc[2] + acc[3] * acc[3]); }
                ss += __shfl_xor(ss, 16); ss += __shfl_xor(ss, 32);
                const float rn = 1.0f / sqrtf(ss * (1.0f / 64.0f) + EPS);
                const size_t row = m0 + 16 * ti + fr;
#pragma unroll
                for (int a = 0; a < 4; ++a) { const int dv = 16 * a + 4 * fg;
                    const u32x2 gw = *(const u32x2*)(PROJ + row * NMIX + 1536 + h * 64 + dv);
                    const float g0 = bf2f(gw.x & 0xffffu), g1 = bf2f(gw.x >> 16), g2 = bf2f(gw.y & 0xffffu), g3 = bf2f(gw.y >> 16);
                    const f32x4 gv = *(const f32x4*)(gn + dv);
                    const float y0 = o[a][0] * rn * gv[0] * (g0 * sigmoid_f(g0)), y1 = o[a][1] * rn * gv[1] * (g1 * sigmoid_f(g1));
                    const float y2 = o[a][2] * rn * gv[2] * (g2 * sigmoid_f(g2)), y3 = o[a][3] * rn * gv[3] * (g3 * sigmoid_f(g3));
                    u32x2 w; w.x = cvt_pk_bf16(y0, y1); w.y = cvt_pk_bf16(y2, y3);
                    *(u32x2*)(YS + row * D + 512 + h * 64 + dv) = w; }
            }
        }
        __syncthreads();
    }
}

__device__ __forceinline__ void mix_phase2(const Ctx& C, const Args& A) {
    int tid_ = C.tid; asm volatile("" : "+v"(tid_));
    if (C.G == 256) {
        if (C.vcu < 128) {
            float* __restrict__ SU = (float*)(A.ws + WS_SU); const float* __restrict__ SD = (const float*)(A.ws + WS_SD); bf16_t* __restrict__ ST16 = (bf16_t*)(A.ws + WS_ST16);
            const int e0 = C.vcu * NTHREADS + tid_, e1 = e0 + 65536;
            const int bh0 = e0 >> 12, kv0 = e0 & 4095, bh1 = e1 >> 12, kv1 = e1 & 4095;
            float s0 = 0.f, s1 = 0.f;
#pragma unroll 32
            for (int c = 0; c < 64; ++c) { const size_t c0 = (size_t)bh0 * 64 + c, c1 = (size_t)bh1 * 64 + c;
                const float u0 = SU[c0 * 4096 + kv0], d0 = SD[c0 * 64 + (kv0 & 63)], u1 = SU[c1 * 4096 + kv1], d1 = SD[c1 * 64 + (kv1 & 63)];
                ST16[c0 * 4096 + kv0] = (bf16_t)f2bf(s0); ST16[c1 * 4096 + kv1] = (bf16_t)f2bf(s1); s0 = d0 * s0 + u0; s1 = d1 * s1 + u1; }
        } else if (C.vcu < 144) {
            const float* __restrict__ LA = (const float*)(A.ws + WS_LA); const float* __restrict__ LH = (const float*)(A.ws + WS_LH); float* __restrict__ LC = (float*)(A.ws + WS_LC);
            LAS float* SP = (LAS float*)C.lds; LAS float* SH = SP + 512;
            const int cl = tid_ & 127, seg = tid_ >> 7, chain = (C.vcu - 128) * 128 + cl, b = chain >> 8, ch = chain & 255;
            const size_t i0 = ((size_t)b * 128 + seg * 32) * 256 + ch;
            float a[32], hh[32];
#pragma unroll
            for (int i = 0; i < 32; ++i) { a[i] = LA[i0 + (size_t)i * 256]; hh[i] = LH[i0 + (size_t)i * 256]; }
            float P = 1.f, H = 0.f;
#pragma unroll
            for (int i = 0; i < 32; ++i) { H = a[i] * H + hh[i]; P *= a[i]; }
            SP[seg * 128 + cl] = P; SH[seg * 128 + cl] = H;
            __syncthreads();
            float cr = 0.f;
            for (int sg = 0; sg < seg; ++sg) cr = SP[sg * 128 + cl] * cr + SH[sg * 128 + cl];
#pragma unroll
            for (int i = 0; i < 32; ++i) { LC[i0 + (size_t)i * 256] = cr; cr = a[i] * cr + hh[i]; }
            __syncthreads();
        }
        return;
    }
    float* __restrict__ SU = (float*)(A.ws + WS_SU); const float* __restrict__ SD = (const float*)(A.ws + WS_SD);
    const int gt = C.vcu * NTHREADS + tid_, NGT = C.G * NTHREADS;
    for (int e = gt; e < 32 * 4096; e += NGT) {
        const int bh = e >> 12, kv = e & 4095, dk = kv & 63;
        bf16_t* __restrict__ ST16 = (bf16_t*)(A.ws + WS_ST16);
        float s = 0.f;
#pragma unroll 32
        for (int c = 0; c < 64; ++c) { const size_t ci = (size_t)bh * 64 + c; const float u = SU[ci * 4096 + kv]; const float d = SD[ci * 64 + dk]; ST16[ci * 4096 + kv] = (bf16_t)f2bf(s); s = d * s + u; }
    }
    const float* __restrict__ LA = (const float*)(A.ws + WS_LA); const float* __restrict__ LH = (const float*)(A.ws + WS_LH); float* __restrict__ LC = (float*)(A.ws + WS_LC);
    for (int e = gt; e < BATCH * BW; e += NGT) {
        const int b = e >> 8, ch = e & 255; float cr = 0.f;
#pragma unroll 32
        for (int sc = 0; sc < 128; ++sc) { const size_t i = ((size_t)b * 128 + sc) * 256 + ch; const float a = LA[i], hh = LH[i]; LC[i] = cr; cr = a * cr + hh; }
    }
}

#define XB_TMO      128
#define XB_XCNT(j)  (256  + 64 * (j))
#define XB_XSUB(j)  (1280 + 64 * (j))
#define XB_XGEN(j)  (2304 + 64 * (j))
#define XB_TOP      3328
#define XB_TOPGEN   3392
#define XCD_BAR_WORDS 3456
#define XB_SPIN_CAP (1u << 20)
__device__ __forceinline__ unsigned xb_ld(unsigned* p)              { return __hip_atomic_load(p, __ATOMIC_RELAXED, __HIP_MEMORY_SCOPE_AGENT); }
__device__ __forceinline__ unsigned xb_add(unsigned* p, unsigned v) { return __hip_atomic_fetch_add(p, v, __ATOMIC_RELAXED, __HIP_MEMORY_SCOPE_AGENT); }
__device__ __forceinline__ unsigned xb_xcc_id() { return (unsigned)__builtin_amdgcn_s_getreg((3 << 11) | 20) & 0xFu; }
#define XB_SPIN(cond, bar) do { unsigned _sp = 0; while (cond) { __builtin_amdgcn_s_sleep(1); \
    if ((++_sp & 255u) == 0u) { if (xb_ld(&(bar)[XB_TMO])) break; if (_sp > XB_SPIN_CAP) { atomicAdd(&(bar)[XB_TMO], 1u); break; } } } } while (0)
struct XcdBarrier { unsigned* bar; unsigned x; volatile LAS unsigned* st; };
__device__ __forceinline__ XcdBarrier xcd_barrier_post(unsigned* bar, volatile LAS unsigned* st) {
    XcdBarrier b; b.bar = bar; b.x = xb_xcc_id(); b.st = st;
    if (threadIdx.x == 0) (void)xb_add(&bar[XB_XCNT(b.x)], 1u);
    return b;
}
__device__ __forceinline__ void xcd_barrier_complete(unsigned* bar, unsigned x, unsigned& nloc, unsigned& nx) {
    const unsigned G = gridDim.x * gridDim.y * gridDim.z;
    unsigned sum, cnt, mine, sp = 0u;
    for (;;) {
        sum = 0u; cnt = 0u; mine = 0u;
#pragma unroll
        for (unsigned j = 0; j < 16; ++j) { const unsigned c = xb_ld(&bar[XB_XCNT(j)]); sum += c; cnt += (c > 0u) ? 1u : 0u; mine = (j == x) ? c : mine; }
        if (sum == G) break;
        __builtin_amdgcn_s_sleep(1);
        if ((++sp & 255u) == 0u) { if (xb_ld(&bar[XB_TMO])) break; if (sp > XB_SPIN_CAP) { atomicAdd(&bar[XB_TMO], 1u); break; } }
    }
    nloc = mine > 0u ? mine : 1u; nx = cnt > 0u ? cnt : 1u;
}
__device__ __forceinline__ void xcd_barrier(const XcdBarrier& b) {
    asm volatile("s_waitcnt vmcnt(0)" ::: "memory");
    __syncthreads();
    if (threadIdx.x == 0) {
        unsigned* bar = b.bar;
        __builtin_amdgcn_s_waitcnt(0);
        unsigned nloc = b.st[0], nx = b.st[1];
        if (nloc == 0u) { xcd_barrier_complete(bar, b.x, nloc, nx); b.st[0] = nloc; b.st[1] = nx; }
        const unsigned old = xb_add(&bar[XB_XSUB(b.x)], 1u);
        const unsigned gen = old / nloc;
        if (old + 1u == (gen + 1u) * nloc) {
            __builtin_amdgcn_fence(__ATOMIC_RELEASE, "agent");
            asm volatile("s_waitcnt vmcnt(0)" ::: "memory");
            const unsigned og = xb_add(&bar[XB_TOP], 1u);
            const unsigned tg = og / nx;
            if (og + 1u == (tg + 1u) * nx) xb_add(&bar[XB_TOPGEN], 1u);
            else XB_SPIN(xb_ld(&bar[XB_TOPGEN]) == tg, bar);
            __builtin_amdgcn_fence(__ATOMIC_ACQUIRE, "agent");
            xb_add(&bar[XB_XGEN(b.x)], 1u);
            asm volatile("s_waitcnt vmcnt(0)" ::: "memory");
        } else {
            XB_SPIN(xb_ld(&bar[XB_XGEN(b.x)]) == gen, bar);
            __builtin_amdgcn_fence(__ATOMIC_ACQUIRE, "agent");
            asm volatile("s_waitcnt vmcnt(0)" ::: "memory");
        }
    }
    __syncthreads();
}

constexpr int PH_PER_LAYER = 10, N_PHASES = 1 + DEPTH * PH_PER_LAYER;
constexpr int CW_BAR = 4096;
constexpr int CW_SEAM = 16384;
constexpr int CW_SEAM2 = 65536;

__global__ void __launch_bounds__(NTHREADS, 2) trunk_fwd(Args args) {
    extern __shared__ __attribute__((aligned(16))) unsigned char lds_raw[];
    Ctx C;
    C.lds = (LAS unsigned char*)lds_raw; C.tid = threadIdx.x; C.lane = C.tid & 63; C.wave = __builtin_amdgcn_readfirstlane(C.tid >> 6);
    C.G = gridDim.x; { const int bx = blockIdx.x; C.vcu = (C.G % 8 == 0) ? (bx % 8) * (C.G / 8) + bx / 8 : bx; }
    unsigned char* ws = args.ws;
    volatile LAS unsigned* MISC = (volatile LAS unsigned*)(C.lds + MISC_OFF);
    if (C.tid < 64) MISC[C.tid] = 0u;
    __syncthreads();
#if MK_PER_PHASE
#define GRID_BAR() do { } while (0)
#else
    cg::grid_group grid = cg::this_grid();
    XcdBarrier bar = xcd_barrier_post((unsigned*)(ws + WS_CTL) + CW_BAR, MISC + 8);
    bool first_bar = true;
#define GRID_BAR() do { if (first_bar) { grid.sync(); first_bar = false; } else { xcd_barrier(bar); } } while (0)
#endif
    const int lo = args.ph_lo, hi = args.ph_hi;
    int ph = 0;
#define PHASE_BEGIN if (ph >= lo && ph < hi) { for (int rep_ = 0; rep_ < (((DBG_REPEAT >> ((ph - 1) % PH_PER_LAYER + 1)) & 1) && ph > 0 ? 2 : 1); ++rep_) {
#define PHASE_END   if (rep_ == 0 && (((DBG_REPEAT >> ((ph - 1) % PH_PER_LAYER + 1)) & 1) && ph > 0)) GRID_BAR(); } if (ph + 1 < hi && ph + 1 < N_PHASES) GRID_BAR(); } ++ph;

    PHASE_BEGIN p0_prologue(C, args); PHASE_END

    for (int li = 0; li < DEPTH; ++li) {
        int l = li; asm volatile("" : "+s"(l));
        const unsigned char* wl = ws + WS_W + (size_t)l * W_LAYER;
        const float* RS = (const float*)(ws + WS_X2);
        PHASE_BEGIN {
            pg8::StaticOrder S; S.init(ws + WS_HB, wl + W_IN, M, NMIX, D, C.G, (int)blockIdx.x);
            pg8::EpiRow<1> E{(bf16_t*)(ws + WS_PROJ), NMIX, RS};
            pg8::gemm_phase<pg8::EpiRow<1>, pg8::StaticOrder, true>(C.lds, D, S, E);
        } PHASE_END
        PHASE_BEGIN {
            for (int item = C.vcu; item < BATCH * 64; item += C.G) { const int b = item >> 6, c = item & 63;
                mix1_item(C, args, l, b, c);
                hgrn_item<false>(C, args, l, b, c); }
        } PHASE_END
        PHASE_BEGIN {
            mix_phase2(C, args);
            int lane = C.lane; asm volatile("" : "+v"(lane));
            const int gw = C.vcu * NWAVES + C.wave, NGW = C.G * NWAVES;
            if (li == 0) {
                for (int it = gw; it < DEPTH * 2 * 4096; it += NGW) { const int ll = it >> 13, r = it & 8191, n = r & 4095;
                    const unsigned char* wll = ws + WS_W + (size_t)ll * W_LAYER;
                    if (r < 4096) quant_row_i8((const bf16_t*)(wll + W_IN) + (size_t)(NMIX + n) * D, (signed char*)(ws + WS_WG8) + ((size_t)ll * NGATE + n) * D, (float*)(ws + WS_SBG) + ll * NGATE + n, lane);
                    else quant_row_i8((const bf16_t*)(wll + W_UP) + (size_t)n * D, (signed char*)(ws + WS_WU8) + ((size_t)ll * FF + n) * D, (float*)(ws + WS_SBU) + ll * FF + n, lane); }
            }
        } PHASE_END
        PHASE_BEGIN {
            for (int item = C.vcu; item < BATCH * 64; item += C.G) { const int b = item >> 6, c = item & 63;
                lru_final_item(C, args, l, b, c);
                hgrn_item<true>(C, args, l, b, c); }
        } PHASE_END
        PHASE_BEGIN {
            unsigned char* gt = (unsigned char*)(ws + WS_G) + (size_t)blockIdx.x * 8 * 65536;
            {
                int t_ = C.tid; asm volatile("" : "+v"(t_));
                float nv = -1.f; asm volatile("" : "+v"(nv)); const f32x4 neg = {nv, nv, nv, nv};
                for (int i = C.vcu * NTHREADS + t_; i < 2 * M * 4; i += C.G * NTHREADS) *(f32x4*)(ws + (i < M * 4 ? WS_XS0 : WS_XS1 - (size_t)M * 64) + (size_t)i * 16) = neg;
            }
            {
                pg8::GateOrder8 S{(const char*)(ws + WS_HB8), (const char*)(ws + WS_WG8) + (size_t)l * NGATE * D, C.G, C.vcu};
                pg8::EpiGate8 E{gt, RS, (const float*)(ws + WS_SA), (const float*)(ws + WS_SBG) + l * NGATE};
                pg8::gemm_phase<pg8::EpiGate8, pg8::GateOrder8, true, true>(C.lds, D / 2, S, E);
            }
            {
                pg8::MergeOrder S{(const char*)(ws + WS_YS), (const char*)(wl + W_BR), C.G, C.vcu};
                pg8::EpiGate E{gt, (bf16_t*)(ws + WS_MERGED), RS};
                pg8::gemm_phase<pg8::EpiGate, pg8::MergeOrder, true>(C.lds, D, S, E);
            }
        } PHASE_END
        const bool fused_norm = (C.G == 256) && !MK_PER_PHASE;
        if (fused_norm) {
            PHASE_BEGIN {
                { const int half = 0;
                    pg8::PanelOrder S{(const char*)(ws + WS_MERGED), (const char*)(wl + W_OUT), (size_t)pg8::BM * D * 2, D / pg8::BK, half, C.vcu};
                    pg8::EpiNorm E{(bf16_t*)(ws + WS_HB), nullptr, args.in[I_NMIXPOST] + l * D, (float*)(ws + WS_XS0), (float*)(ws + WS_X2), (unsigned*)(ws + WS_CTL) + 8, C.lds + 131072, (signed char*)(ws + WS_HB8), (float*)(ws + WS_SA)};
                    pg8::gemm_phase<pg8::EpiNorm, pg8::PanelOrder, true>(C.lds, D, S, E);
                }
            } PHASE_END
            ++ph;
        } else {
        PHASE_BEGIN {
            pg8::StaticOrder S; S.init(ws + WS_MERGED, wl + W_OUT, M, D, D, C.G, (int)blockIdx.x);
            pg8::EpiRow<0> E{(bf16_t*)(ws + WS_MIX), D, nullptr};
            pg8::gemm_phase<pg8::EpiRow<0>, pg8::StaticOrder, true>(C.lds, D, S, E);
        } PHASE_END
        PHASE_BEGIN norm_phase(C, args, (const bf16_t*)(ws + WS_MIX), args.in[I_NMIXPOST] + l * D, false); PHASE_END
        }
        PHASE_BEGIN {
            pg8::StaticOrder S; S.init(ws + WS_HB8, ws + WS_WU8 + (size_t)l * FF * D, M, FF, D / 2, C.G, (int)blockIdx.x);
            pg8::EpiUp8 E{(bf16_t*)(ws + WS_HID), FF, RS, (const float*)(ws + WS_SA), (const float*)(ws + WS_SBU) + l * FF};
            pg8::gemm_phase<pg8::EpiUp8, pg8::StaticOrder, true, true>(C.lds, D / 2, S, E);
        } PHASE_END
        if (fused_norm) {
            PHASE_BEGIN {
                { const int half = 0;
                    pg8::PanelOrder S{(const char*)(ws + WS_HID), (const char*)(wl + W_DOWN), (size_t)pg8::BM * FF * 2, FF / pg8::BK, half, C.vcu};
                    pg8::EpiNorm E{(bf16_t*)(ws + WS_HB), (li == DEPTH - 1) ? args.out : nullptr, args.in[I_NMLPPOST] + l * D, (float*)(ws + WS_XS1), (float*)(ws + WS_X2), (unsigned*)(ws + WS_CTL) + 8, C.lds + 131072, (signed char*)(ws + WS_HB8), (float*)(ws + WS_SA)};
                    pg8::gemm_phase<pg8::EpiNorm, pg8::PanelOrder, true>(C.lds, FF, S, E);
                }
            } PHASE_END
            ++ph;
        } else {
        PHASE_BEGIN {
            pg8::StaticOrder S; S.init(ws + WS_HID, wl + W_DOWN, M, D, FF, C.G, (int)blockIdx.x);
            pg8::EpiRow<0> E{(bf16_t*)(ws + WS_MOUT), D, nullptr};
            pg8::gemm_phase<pg8::EpiRow<0>, pg8::StaticOrder, true>(C.lds, FF, S, E);
        } PHASE_END
        PHASE_BEGIN norm_phase(C, args, (const bf16_t*)(ws + WS_MOUT), args.in[I_NMLPPOST] + l * D, li == DEPTH - 1); PHASE_END
        }
    }
}

extern "C" void kernel_launch(void* const* d_in, const int* in_sizes, int n_in, void* d_out, int out_size, void* d_ws, size_t ws_size, hipStream_t stream) {
    static int grid = 0;
    if (grid == 0) {
        if (n_in != 22 || in_sizes[0] != M * D || out_size != M * D || ws_size < WS_END) { fprintf(stderr, "kernel_launch: unexpected shapes (n_in %d, in0 %d, out %d, ws %zu)\n", n_in, n_in > 0 ? in_sizes[0] : -1, out_size, ws_size); grid = -1; return; }
        int dev = 0, cus = 0, per_cu = 0;
        if (hipGetDevice(&dev) != hipSuccess || hipDeviceGetAttribute(&cus, hipDeviceAttributeMultiprocessorCount, dev) != hipSuccess) { grid = -1; return; }
        if (hipFuncSetAttribute((const void*)trunk_fwd, hipFuncAttributeMaxDynamicSharedMemorySize, LDS_BYTES) != hipSuccess) { fprintf(stderr, "kernel_launch: hipFuncSetAttribute failed\n"); grid = -1; return; }
        if (hipOccupancyMaxActiveBlocksPerMultiprocessor(&per_cu, (const void*)trunk_fwd, NTHREADS, LDS_BYTES) != hipSuccess || per_cu < 1) { fprintf(stderr, "kernel_launch: occupancy query says %d blocks per CU\n", per_cu); (void)hipGetLastError(); grid = -1; return; }
        grid = cus;
    }
    if (grid < 0) return;
    (void)hipMemsetAsync((char*)d_ws + WS_CTL, 0, CTL_ZERO_BYTES, stream);
    Args a{};
    for (int i = 0; i < 22; ++i) a.in[i] = (const float*)d_in[i];
    a.out = (float*)d_out; a.ws = (unsigned char*)d_ws;
#if MK_PER_PHASE
#ifndef DBG_MAXPH
#define DBG_MAXPH N_PHASES
#endif
    for (int p = 0; p < DBG_MAXPH; ++p) { a.ph_lo = p; a.ph_hi = p + 1; hipLaunchKernelGGL(trunk_fwd, dim3(grid), dim3(NTHREADS), LDS_BYTES, stream, a); }
#else
#if DBG_PREFIX > 0
    { a.ph_lo = 0; a.ph_hi = DBG_PREFIX; void* kargs0[] = {&a};
      (void)hipLaunchCooperativeKernel((const void*)trunk_fwd, dim3(grid), dim3(NTHREADS), kargs0, LDS_BYTES, stream);
      (void)hipMemsetAsync((char*)d_ws + WS_CTL, 0, CTL_ZERO_BYTES, stream); }
#endif
    a.ph_lo = 0; a.ph_hi = N_PHASES;
    void* kargs[] = {&a};
    hipError_t e = hipLaunchCooperativeKernel((const void*)trunk_fwd, dim3(grid), dim3(NTHREADS), kargs, LDS_BYTES, stream);
    if (e != hipSuccess) fprintf(stderr, "kernel_launch: cooperative launch failed: %s (grid %d)\n", hipGetErrorString(e), grid);
#endif
}
```

```cpp
#include <hip/hip_runtime.h>
#include <hip/hip_cooperative_groups.h>
#include <cstdio>
#include <cstdint>
namespace cg = cooperative_groups;

#ifndef DBG_ZERO
#define DBG_ZERO -1
#endif
#ifndef DBG_REPEAT
#define DBG_REPEAT 0
#endif
#ifndef MK_PER_PHASE
#define MK_PER_PHASE 0
#endif
#ifndef DBG_PREFIX
#define DBG_PREFIX 0
#endif

#define LAS __attribute__((address_space(3)))
#define GAS __attribute__((address_space(1)))
typedef unsigned short bf16_t;
typedef short bf16x8 __attribute__((ext_vector_type(8)));
typedef float f32x4 __attribute__((ext_vector_type(4)));
typedef float f32x2 __attribute__((ext_vector_type(2)));
typedef unsigned u32x4 __attribute__((ext_vector_type(4)));
typedef unsigned u32x2 __attribute__((ext_vector_type(2)));

constexpr int BATCH = 8, T = 4096, D = 1024, M = BATCH * T, DEPTH = 2, BW = 256;
constexpr int NMIX = 2560, NGATE = 4096, INW = NMIX + NGATE, FF = 4096;
constexpr float EPS = 1e-6f;
constexpr int NWAVES = 8, NTHREADS = 512;

constexpr size_t MiB = 1u << 20;
constexpr size_t WS_CTL = 0, CTL_ZERO_BYTES = 1 * MiB;
constexpr size_t WS_XM = 1 * MiB;
constexpr size_t WS_SD = 1 * MiB + 512 * 1024;
constexpr size_t WS_LA = 2 * MiB, WS_LH = 3 * MiB, WS_LC = 4 * MiB;
constexpr size_t WS_SP8 = 7 * MiB;
constexpr size_t WS_X1 = 5 * MiB;
constexpr size_t WS_X2 = 6 * MiB;
constexpr size_t WS_W = 8 * MiB;
constexpr size_t W_IN = 0, W_BR = 13 * MiB, W_OUT = 15 * MiB, W_UP = 17 * MiB, W_DOWN = 25 * MiB, W_LAYER = 33 * MiB;
constexpr size_t WS_HB = 76 * MiB;
constexpr size_t WS_PROJ = 140 * MiB;
constexpr size_t WS_G = WS_PROJ;
constexpr size_t WS_YS = 300 * MiB;
constexpr size_t WS_MERGED = 364 * MiB;
constexpr size_t WS_SU = WS_MERGED;
constexpr size_t WS_MIX = WS_PROJ;
constexpr size_t WS_MOUT = 396 * MiB;
constexpr size_t WS_HID = WS_PROJ;
constexpr size_t WS_HB8 = 460 * MiB;
constexpr size_t WS_WG8 = 492 * MiB;
constexpr size_t WS_SA = 7 * MiB + 64 * 1024;
constexpr size_t WS_SBG = 7 * MiB + 256 * 1024;
constexpr size_t WS_SBU = 7 * MiB + 320 * 1024;
constexpr size_t WS_WU8 = 500 * MiB;
constexpr size_t WS_XS0 = 428 * MiB, WS_XS1 = 444 * MiB;
constexpr size_t WS_END = 508 * MiB;

constexpr int LDS_BYTES = 155648;
constexpr int MISC_OFF = 154624;

__device__ __forceinline__ float bf2f(unsigned b) { return __uint_as_float(b << 16); }
__device__ __forceinline__ unsigned f2bf(float f) { unsigned u = __float_as_uint(f); return (u + 0x7fffu + ((u >> 16) & 1u)) >> 16; }
__device__ __forceinline__ unsigned pk2(float lo, float hi) { return f2bf(lo) | (f2bf(hi) << 16); }
typedef __bf16 bf16x2_t __attribute__((ext_vector_type(2)));
__device__ __forceinline__ unsigned cvt_pk_bf16(float lo, float hi) { f32x2 v = {lo, hi}; bf16x2_t b = __builtin_convertvector(v, bf16x2_t); return __builtin_bit_cast(unsigned, b); }
__device__ __forceinline__ float fast_exp(float x) { return __builtin_amdgcn_exp2f(x * 1.4426950408889634f); }
__device__ __forceinline__ float sigmoid_f(float x) { return __builtin_amdgcn_rcpf(1.0f + fast_exp(-x)); }
__device__ __forceinline__ void ld8bf(const bf16_t* p, float (&o)[8]) {
    const u32x4 v = *(const u32x4*)p;
    o[0] = bf2f(v.x & 0xffffu); o[1] = bf2f(v.x >> 16); o[2] = bf2f(v.y & 0xffffu); o[3] = bf2f(v.y >> 16);
    o[4] = bf2f(v.z & 0xffffu); o[5] = bf2f(v.z >> 16); o[6] = bf2f(v.w & 0xffffu); o[7] = bf2f(v.w >> 16);
}
__device__ __forceinline__ float rs_of(const float* X2, int row) { const f32x4 x = *(const f32x4*)(X2 + (size_t)row * 4); return 1.0f / sqrtf(((x[0] + x[1]) + (x[2] + x[3])) * (1.0f / D) + EPS); }
typedef int i32x4 __attribute__((ext_vector_type(4)));
__device__ __forceinline__ void rs_of8(const float* X2, int row0, float (&o)[2][4]) {
    const float* p = X2 + (size_t)row0 * 4; f32x4 v[2][4];
    asm volatile("global_load_dwordx4 %0, %8, off\n\tglobal_load_dwordx4 %1, %8, off offset:256\n\tglobal_load_dwordx4 %2, %8, off offset:512\n\tglobal_load_dwordx4 %3, %8, off offset:768\n\t"
                 "global_load_dwordx4 %4, %8, off offset:2048\n\tglobal_load_dwordx4 %5, %8, off offset:2304\n\tglobal_load_dwordx4 %6, %8, off offset:2560\n\tglobal_load_dwordx4 %7, %8, off offset:2816\n\ts_waitcnt vmcnt(0)"
                 : "=&v"(v[0][0]), "=&v"(v[0][1]), "=&v"(v[0][2]), "=&v"(v[0][3]), "=&v"(v[1][0]), "=&v"(v[1][1]), "=&v"(v[1][2]), "=&v"(v[1][3]) : "v"(p) : "memory");
#pragma unroll
    for (int ai = 0; ai < 2; ++ai)
#pragma unroll
        for (int m = 0; m < 4; ++m) { const f32x4 x = v[ai][m]; o[ai][m] = 1.0f / sqrtf(((x[0] + x[1]) + (x[2] + x[3])) * (1.0f / D) + EPS); }
}
__device__ __forceinline__ void ld_f32x8_rows(const float* SA_, int row0, float (&o)[2][4]) {
    const float* p = SA_ + row0;
    asm volatile("global_load_dword %0, %8, off\n\tglobal_load_dword %1, %8, off offset:64\n\tglobal_load_dword %2, %8, off offset:128\n\tglobal_load_dword %3, %8, off offset:192\n\t"
                 "global_load_dword %4, %8, off offset:512\n\tglobal_load_dword %5, %8, off offset:576\n\tglobal_load_dword %6, %8, off offset:640\n\tglobal_load_dword %7, %8, off offset:704\n\ts_waitcnt vmcnt(0)"
                 : "=&v"(o[0][0]), "=&v"(o[0][1]), "=&v"(o[0][2]), "=&v"(o[0][3]), "=&v"(o[1][0]), "=&v"(o[1][1]), "=&v"(o[1][2]), "=&v"(o[1][3]) : "v"(p) : "memory");
}
__device__ __forceinline__ void quant_row_i8(const bf16_t* src, signed char* dst, float* scale_out, int lane) {
    float x[16]; ld8bf(src + 16 * lane, *(float(*)[8])&x[0]); ld8bf(src + 16 * lane + 8, *(float(*)[8])&x[8]);
    float mx = 0.f;
#pragma unroll
    for (int j = 0; j < 16; ++j) mx = fmaxf(mx, fabsf(x[j]));
#pragma unroll
    for (int o = 1; o < 64; o <<= 1) mx = fmaxf(mx, __shfl_xor(mx, o));
    const float sc = (mx > 0.f) ? mx * (1.0f / 127.0f) : 1.0f, inv = 1.0f / sc;
    unsigned w[4];
#pragma unroll
    for (int p = 0; p < 4; ++p) { unsigned v = 0u;
#pragma unroll
        for (int e = 0; e < 4; ++e) { const int q = (int)__builtin_rintf(x[4 * p + e] * inv); v |= ((unsigned)q & 0xffu) << (8 * e); }
        w[p] = v; }
    *(u32x4*)(dst + 16 * lane) = (u32x4){w[0], w[1], w[2], w[3]};
    if (lane == 0) *scale_out = sc;
}
__device__ __forceinline__ unsigned q4_i8(const f32x4 v, float inv) { unsigned w = 0u;
#pragma unroll
    for (int e = 0; e < 4; ++e) { const int q = (int)__builtin_rintf(v[e] * inv); w |= ((unsigned)q & 0xffu) << (8 * e); }
    return w; }
__device__ __forceinline__ float wave_sum(float v) {
#pragma unroll
    for (int o = 1; o < 64; o <<= 1) v += __shfl_xor(v, o);
    return v;
}

namespace pg8 {
constexpr int BM = 256, BK = 64, HALF = 128, HTB = HALF * BK * 2, STAGE_BYTES = 8 * HTB, NXCD = 8, WGM = 4;
__host__ __device__ __forceinline__ int lds_byte(int r, int c) { const int st = (r >> 4) * 2 + (c >> 5), rr = r & 15, cc = c & 31, ob = rr * 64 + cc * 2; return st * 1024 + (ob ^ (((ob >> 9) & 1) << 5)); }
__host__ __device__ __forceinline__ void stage_rc(int b, int& R, int& C) { const int st = b / 1024, sb = b % 1024, swz = sb ^ (((sb >> 9) & 1) << 5); R = (st >> 1) * 16 + swz / 64; C = (st & 1) * 32 + (swz % 64) / 2; }
__host__ __device__ __forceinline__ int perm32(int rho) { const int n = rho >> 4, i = rho & 15; return 8 * (i >> 2) + 4 * n + (i & 3); }

struct Unit { int pm, pn, kind; };

struct StaticOrder {
    const char* A; const char* Bt; size_t tstep;
    int nM, nN, nwg, G, c;
    __device__ void init(const void* A_, const void* Bt_, int M_, int N_, int K_, int G_, int c_) { A = (const char*)A_; Bt = (const char*)Bt_; tstep = (size_t)BM * K_ * 2; nt = K_ / BK; nM = M_ / BM; nN = N_ / BM; nwg = nM * nN; G = G_; c = c_; }
    __device__ bool next(int i, Unit& u) const {
        const long L = (long)i * G + c; if (L >= nwg) return false;
        int wgid = (int)L; { const int q = nwg / NXCD, r = nwg % NXCD, xcd = wgid % NXCD, off = wgid / NXCD; wgid = (xcd < r ? xcd * (q + 1) : r * (q + 1) + (xcd - r) * q) + off; }
        const int nig = WGM * nN, gid = wgid / nig, fm = gid * WGM, gsz = (nM - fm) < WGM ? (nM - fm) : WGM;
        u.pm = fm + ((wgid % nig) % gsz); u.pn = (wgid % nig) / gsz; u.kind = 0; return true;
    }
    __device__ __forceinline__ void tiles(const Unit& u, const char*& a, const char*& b) const { a = A + (size_t)u.pm * tstep; b = Bt + (size_t)u.pn * tstep; }
    int nt;
    __device__ __forceinline__ int ntiles(const Unit&) const { return nt; }
    __device__ __forceinline__ bool keep_acc(const Unit&) const { return false; }
};

struct GateOrder {
    const char* HB; const char* WGt; const char* YS; const char* WB; int G, vcu;
    __device__ bool next(int i, Unit& u) const {
        const int r = i / 16, ii = i % 16, su = vcu + r * G; if (su >= 256) return false;
        const int half = ii / 8, j = ii % 8;
        u.pm = half * 64 + (su >> 2); u.kind = j; u.pn = (j < 4) ? (j * 4 + (su & 3)) : (su & 3); return true;
    }
    __device__ __forceinline__ int ntiles(const Unit& u) const { return u.kind < 4 ? 16 : 4; }
    __device__ __forceinline__ bool keep_acc(const Unit& nx) const { return nx.kind > 4; }
    __device__ __forceinline__ void tiles(const Unit& u, const char*& a, const char*& b) const {
        const size_t ts = (size_t)BM * 1024 * 2;
        if (u.kind < 4) { a = HB + (size_t)u.pm * ts; b = WGt + (size_t)u.pn * ts; } else { a = YS + (size_t)u.pm * ts + (size_t)(u.kind - 4) * 512; b = WB + (size_t)u.pn * ts + (size_t)(u.kind - 4) * 512; }
    }
};

struct GateOrder8 {
    const char* HB8; const char* WG8; int G, vcu;
    __device__ bool next(int i, Unit& u) const {
        const int r = i / 8, ii = i % 8, su = vcu + r * G; if (su >= 256) return false;
        u.pm = (ii >> 2) * 64 + (su >> 2); u.kind = ii; u.pn = (ii & 3) * 4 + (su & 3); return true;
    }
    __device__ __forceinline__ int ntiles(const Unit&) const { return 8; }
    __device__ __forceinline__ bool keep_acc(const Unit&) const { return false; }
    __device__ __forceinline__ void tiles(const Unit& u, const char*& a, const char*& b) const { a = HB8 + (size_t)u.pm * 262144; b = WG8 + (size_t)u.pn * 262144; }
};
struct MergeOrder {
    const char* YS; const char* WB; int G, vcu;
    __device__ bool next(int i, Unit& u) const {
        const int r = i / 8, ii = i % 8, su = vcu + r * G; if (su >= 256) return false;
        u.pm = (ii >> 2) * 64 + (su >> 2); u.kind = 4 + (ii & 3); u.pn = su & 3; return true;
    }
    __device__ __forceinline__ int ntiles(const Unit&) const { return 4; }
    __device__ __forceinline__ bool keep_acc(const Unit& nx) const { return nx.kind > 4; }
    __device__ __forceinline__ void tiles(const Unit& u, const char*& a, const char*& b) const {
        const size_t ts = (size_t)BM * 1024 * 2; a = YS + (size_t)u.pm * ts + (size_t)(u.kind - 4) * 512; b = WB + (size_t)u.pn * ts + (size_t)(u.kind - 4) * 512; }
};

template <int MODE  > struct EpiRow {
    static constexpr bool PERM = true;
    bf16_t* O; int ldc; const float* rs;
    __device__ __forceinline__ void operator()(f32x4 (&acc)[2][2][4][2], const Unit& u, int wr, int wc, int fr, int fq) const {
        const int row0 = u.pm * BM + wr * 64 + fr, col0 = u.pn * BM + wc * 32 + 8 * fq;
        float scv[2][4];
        if (MODE != 0) rs_of8(rs, row0, scv);
#pragma unroll
        for (int ai = 0; ai < 2; ++ai)
#pragma unroll
            for (int m = 0; m < 4; ++m) {
                const int row = row0 + ai * HALF + m * 16; const float sc = scv[ai][m];
                bf16_t* rowp = O + (size_t)row * ldc + col0;
#pragma unroll
                for (int bj = 0; bj < 2; ++bj) {
                    f32x4 v0 = acc[ai][bj][m][0], v1 = acc[ai][bj][m][1];
                    if (MODE != 0) { v0 = v0 * sc; v1 = v1 * sc; }
                    if (MODE == 2) {
#pragma unroll
                        for (int j = 0; j < 4; ++j) { const float a = fmaxf(v0[j], 0.f), b = fmaxf(v1[j], 0.f); v0[j] = a * a; v1[j] = b * b; }
                    }
                    u32x4 w; w.x = cvt_pk_bf16(v0[0], v0[1]); w.y = cvt_pk_bf16(v0[2], v0[3]); w.z = cvt_pk_bf16(v1[0], v1[1]); w.w = cvt_pk_bf16(v1[2], v1[3]);
                    __builtin_nontemporal_store(w, (u32x4*)(rowp + bj * HALF));
                }
            }
    }
};

__device__ __forceinline__ unsigned pack_u8x4(float a, float b, float c, float d) { unsigned w = 0u;
    w = __builtin_amdgcn_cvt_pk_u8_f32(a * 256.0f - 0.5f, 0, w); w = __builtin_amdgcn_cvt_pk_u8_f32(b * 256.0f - 0.5f, 1, w); w = __builtin_amdgcn_cvt_pk_u8_f32(c * 256.0f - 0.5f, 2, w); w = __builtin_amdgcn_cvt_pk_u8_f32(d * 256.0f - 0.5f, 3, w); return w; }
__device__ __forceinline__ f32x4 unpack_u8x4(unsigned w) { return (f32x4){(float)(w & 0xffu) + 0.5f, (float)((w >> 8) & 0xffu) + 0.5f, (float)((w >> 16) & 0xffu) + 0.5f, (float)(w >> 24) + 0.5f}; }
struct EpiGate {
    static constexpr bool PERM = true;
    unsigned char* Gt;
    bf16_t* MERGED;
    const float* rs;
    __device__ __forceinline__ void rescale(f32x4 (&acc)[2][2][4][2], int hsel, int j, int wr, int wc, int fr, int fq) const {
        int lane_off = (wr * 64 + fr) * 256 + wc * 32 + 8 * fq; asm volatile("" : "+v"(lane_off));
        const unsigned char* g0 = Gt + (size_t)(hsel * 4 + j) * 65536; const unsigned char* g1 = g0 + 65536;
#pragma unroll
        for (int ai = 0; ai < 2; ++ai) {
            u32x2 a[4][2], b[4][2];
#pragma unroll
            for (int m = 0; m < 4; ++m)
#pragma unroll
                for (int bj = 0; bj < 2; ++bj) { const int off = lane_off + (ai * HALF + m * 16) * 256 + bj * HALF; a[m][bj] = *(const u32x2*)(g0 + off); b[m][bj] = *(const u32x2*)(g1 + off); }
#pragma unroll
            for (int m = 0; m < 4; ++m)
#pragma unroll
                for (int bj = 0; bj < 2; ++bj) {
                    const f32x4 a0 = unpack_u8x4(a[m][bj].x), a1 = unpack_u8x4(a[m][bj].y), b0 = unpack_u8x4(b[m][bj].x), b1 = unpack_u8x4(b[m][bj].y);
#pragma unroll
                    for (int q = 0; q < 4; ++q) { acc[ai][bj][m][0][q] *= a0[q] * __builtin_amdgcn_rcpf(b0[q]); acc[ai][bj][m][1][q] *= a1[q] * __builtin_amdgcn_rcpf(b1[q]); }
                }
            asm volatile("" ::: "memory");
        }
    }
    __device__ __forceinline__ void operator()(f32x4 (&acc)[2][2][4][2], const Unit& u, int wr, int wc, int fr, int fq) const {
        if (u.kind >= 4 && u.kind < 7) { rescale(acc, u.pm >> 6, u.kind - 4, wr, wc, fr, fq); return; }
        int rl0 = wr * 64 + fr, cl0 = wc * 32 + 8 * fq; asm volatile("" : "+v"(rl0), "+v"(cl0));
        if (u.kind < 4) {
            unsigned char* gt = Gt + (size_t)u.kind * 65536;
#pragma unroll
            for (int ai = 0; ai < 2; ++ai)
#pragma unroll
                for (int m = 0; m < 4; ++m) {
                    const int rl = rl0 + ai * HALF + m * 16; const float sc = rs_of(rs, u.pm * BM + rl);
#pragma unroll
                    for (int bj = 0; bj < 2; ++bj) {
                        f32x4 v0 = acc[ai][bj][m][0] * sc, v1 = acc[ai][bj][m][1] * sc;
#pragma unroll
                        for (int j = 0; j < 4; ++j) { v0[j] = sigmoid_f(fmaxf(v0[j], -60.f)); v1[j] = sigmoid_f(fmaxf(v1[j], -60.f)); }
                        u32x2 w; w.x = pack_u8x4(v0[0], v0[1], v0[2], v0[3]); w.y = pack_u8x4(v1[0], v1[1], v1[2], v1[3]);
                        *(u32x2*)(gt + rl * 256 + cl0 + bj * HALF) = w;
                    }
                }
        } else {
            const unsigned char* g3 = Gt + (size_t)((u.pm >> 6) * 4 + 3) * 65536;
#pragma unroll
            for (int ai = 0; ai < 2; ++ai) {
                u32x2 swv[4][2];
#pragma unroll
                for (int m = 0; m < 4; ++m)
#pragma unroll
                    for (int bj = 0; bj < 2; ++bj) swv[m][bj] = *(const u32x2*)(g3 + (rl0 + ai * HALF + m * 16) * 256 + cl0 + bj * HALF);
#pragma unroll
                for (int m = 0; m < 4; ++m) {
                    const int rl = rl0 + ai * HALF + m * 16;
                    bf16_t* rowp = MERGED + (size_t)(u.pm * BM + rl) * 1024 + u.pn * BM + cl0;
#pragma unroll
                    for (int bj = 0; bj < 2; ++bj) {
                        const u32x2 sw = swv[m][bj];
                        const f32x4 s0 = unpack_u8x4(sw.x) * (1.0f / 256.0f), s1 = unpack_u8x4(sw.y) * (1.0f / 256.0f);
                        const f32x4 v0 = acc[ai][bj][m][0] * s0, v1 = acc[ai][bj][m][1] * s1;
                        u32x4 w; w.x = cvt_pk_bf16(v0[0], v0[1]); w.y = cvt_pk_bf16(v0[2], v0[3]); w.z = cvt_pk_bf16(v1[0], v1[1]); w.w = cvt_pk_bf16(v1[2], v1[3]);
                        *(u32x4*)(rowp + bj * HALF) = w;
                    }
                }
            }
        }
    }
};

struct EpiGate8 {
    static constexpr bool PERM = true;
    unsigned char* Gt;
    const float* rs; const float* sa; const float* sb;
    __device__ __forceinline__ void operator()(f32x4 (&acc)[2][2][4][2], const Unit& u, int wr, int wc, int fr, int fq) const {
        int rl0 = wr * 64 + fr, cl0 = wc * 32 + 8 * fq; asm volatile("" : "+v"(rl0), "+v"(cl0));
        unsigned char* gt = Gt + (size_t)u.kind * 65536;
        f32x4 cs[2][2];
#pragma unroll
        for (int bj = 0; bj < 2; ++bj) { cs[bj][0] = *(const f32x4*)(sb + u.pn * BM + cl0 + bj * HALF); cs[bj][1] = *(const f32x4*)(sb + u.pn * BM + cl0 + bj * HALF + 4); }
        float scv[2][4], rsv[2][4], sav[2][4];
        rs_of8(rs, u.pm * BM + rl0, rsv); ld_f32x8_rows(sa, u.pm * BM + rl0, sav);
#pragma unroll
        for (int ai = 0; ai < 2; ++ai)
#pragma unroll
            for (int m = 0; m < 4; ++m) scv[ai][m] = -1.4426950408889634f * rsv[ai][m] * sav[ai][m];
#pragma unroll
        for (int ai = 0; ai < 2; ++ai)
#pragma unroll
            for (int m = 0; m < 4; ++m) {
                const int rl = rl0 + ai * HALF + m * 16; const float sc = scv[ai][m];
#pragma unroll
                for (int bj = 0; bj < 2; ++bj) {
                    const i32x4 i0 = __builtin_bit_cast(i32x4, acc[ai][bj][m][0]), i1 = __builtin_bit_cast(i32x4, acc[ai][bj][m][1]);
                    f32x4 v0, v1;
#pragma unroll
                    for (int j = 0; j < 4; ++j) { v0[j] = __builtin_amdgcn_rcpf(1.0f + __builtin_amdgcn_exp2f((float)i0[j] * (sc * cs[bj][0][j]))); v1[j] = __builtin_amdgcn_rcpf(1.0f + __builtin_amdgcn_exp2f((float)i1[j] * (sc * cs[bj][1][j]))); }
                    u32x2 w; w.x = pack_u8x4(v0[0], v0[1], v0[2], v0[3]); w.y = pack_u8x4(v1[0], v1[1], v1[2], v1[3]);
                    *(u32x2*)(gt + rl * 256 + cl0 + bj * HALF) = w;
                }
            }
    }
};

struct EpiUp8 {
    static constexpr bool PERM = true;
    bf16_t* O; int ldc; const float* rs; const float* sa; const float* sb;
    __device__ __forceinline__ void operator()(f32x4 (&acc)[2][2][4][2], const Unit& u, int wr, int wc, int fr, int fq) const {
        int rl0 = wr * 64 + fr, cl0 = wc * 32 + 8 * fq; asm volatile("" : "+v"(rl0), "+v"(cl0));
        f32x4 cs[2][2];
#pragma unroll
        for (int bj = 0; bj < 2; ++bj) { cs[bj][0] = *(const f32x4*)(sb + u.pn * BM + cl0 + bj * HALF); cs[bj][1] = *(const f32x4*)(sb + u.pn * BM + cl0 + bj * HALF + 4); }
        float scv[2][4], rsv[2][4], sav[2][4];
        rs_of8(rs, u.pm * BM + rl0, rsv); ld_f32x8_rows(sa, u.pm * BM + rl0, sav);
#pragma unroll
        for (int ai = 0; ai < 2; ++ai)
#pragma unroll
            for (int m = 0; m < 4; ++m) scv[ai][m] = rsv[ai][m] * sav[ai][m];
#pragma unroll
        for (int ai = 0; ai < 2; ++ai)
#pragma unroll
            for (int m = 0; m < 4; ++m) {
                const int row = u.pm * BM + rl0 + ai * HALF + m * 16; const float sc = scv[ai][m];
                bf16_t* rowp = O + (size_t)row * ldc + u.pn * BM + cl0;
#pragma unroll
                for (int bj = 0; bj < 2; ++bj) {
                    const i32x4 i0 = __builtin_bit_cast(i32x4, acc[ai][bj][m][0]), i1 = __builtin_bit_cast(i32x4, acc[ai][bj][m][1]);
                    f32x4 v0, v1;
#pragma unroll
                    for (int j = 0; j < 4; ++j) { const float a = fmaxf((float)i0[j] * (sc * cs[bj][0][j]), 0.f), b = fmaxf((float)i1[j] * (sc * cs[bj][1][j]), 0.f); v0[j] = a * a; v1[j] = b * b; }
                    u32x4 w; w.x = cvt_pk_bf16(v0[0], v0[1]); w.y = cvt_pk_bf16(v0[2], v0[3]); w.z = cvt_pk_bf16(v1[0], v1[1]); w.w = cvt_pk_bf16(v1[2], v1[3]);
                    __builtin_nontemporal_store(w, (u32x4*)(rowp + bj * HALF));
                }
            }
    }
};

struct PanelOrder {
    const char* A; const char* Bt; size_t tstep; int nt, half, vcu;
    __device__ bool next(int i, Unit& u) const { if (i > 1) return false; u.pm = i * 64 + (vcu >> 2); u.pn = vcu & 3; u.kind = 0; return true; }
    __device__ __forceinline__ void tiles(const Unit& u, const char*& a, const char*& b) const { a = A + (size_t)u.pm * tstep; b = Bt + (size_t)u.pn * tstep; }
    __device__ __forceinline__ int ntiles(const Unit&) const { return nt; }
    __device__ __forceinline__ bool keep_acc(const Unit&) const { return false; }
};
__device__ __forceinline__ void st_sys16(float* p, f32x4 v) { asm volatile("global_store_dwordx4 %0, %1, off sc0 sc1" :: "v"(p), "v"(v) : "memory"); }
__device__ __forceinline__ void ld_sys16x4(const float* p, f32x4 (&v)[4]) {
    asm volatile("global_load_dwordx4 %0, %4, off sc0 sc1\n\tglobal_load_dwordx4 %1, %4, off offset:16 sc0 sc1\n\tglobal_load_dwordx4 %2, %4, off offset:32 sc0 sc1\n\tglobal_load_dwordx4 %3, %4, off offset:48 sc0 sc1\n\ts_waitcnt vmcnt(0)"
                 : "=&v"(v[0]), "=&v"(v[1]), "=&v"(v[2]), "=&v"(v[3]) : "v"(p) : "memory"); }
struct EpiNorm {
    static constexpr bool PERM = true;
    bf16_t* HB; float* OUTF; const float* gain; float* XS; float* X2; unsigned* tmo; LAS unsigned char* sp;
    signed char* HB8; float* SA;
    __device__ __forceinline__ void operator()(f32x4 (&acc)[2][2][4][2], const Unit& u, int wr, int wc, int fr, int fq) const {
        LAS float* P = (LAS float*)sp;
        LAS float* PM = (LAS float*)(sp + 4096);
        LAS float* PB = (LAS float*)(sp + 8192);
        LAS float* R = (LAS float*)(sp + 12288);
        LAS float* RI = (LAS float*)(sp + 13312);
        LAS float* P2 = (LAS float*)(sp + 14336);
        const int tid = (wr * 4 + wc) * 64 + fq * 16 + fr;
        int rl0 = wr * 64 + fr, cl0 = wc * 32 + 8 * fq; asm volatile("" : "+v"(rl0), "+v"(cl0));
        f32x4 gv[2][2];
#pragma unroll
        for (int bj = 0; bj < 2; ++bj) { gv[bj][0] = *(const f32x4*)(gain + u.pn * BM + cl0 + bj * HALF); gv[bj][1] = *(const f32x4*)(gain + u.pn * BM + cl0 + bj * HALF + 4); }
#pragma unroll
        for (int ai = 0; ai < 2; ++ai)
#pragma unroll
            for (int m = 0; m < 4; ++m) { float s = 0.f;
#pragma unroll
                for (int bj = 0; bj < 2; ++bj)
#pragma unroll
                    for (int n = 0; n < 2; ++n) { const f32x4 x = acc[ai][bj][m][n]; s += (x[0] * x[0] + x[1] * x[1]) + (x[2] * x[2] + x[3] * x[3]); }
                s += __shfl_xor(s, 16); s += __shfl_xor(s, 32);
                if (fq == 0) P[(ai * HALF + wr * 64 + m * 16 + fr) * 4 + wc] = s; }
        asm volatile("s_waitcnt lgkmcnt(0)" ::: "memory"); __builtin_amdgcn_s_barrier(); asm volatile("" ::: "memory");
#pragma unroll
        for (int ai = 0; ai < 2; ++ai) {
            u32x4 hw2[4][2];
#pragma unroll
            for (int m = 0; m < 4; ++m)
#pragma unroll
                for (int bj = 0; bj < 2; ++bj) hw2[m][bj] = *(const u32x4*)(HB + ((size_t)u.pm * BM + rl0 + ai * HALF + m * 16) * 1024 + u.pn * BM + cl0 + bj * HALF);
            asm volatile("s_waitcnt vmcnt(0)" ::: "memory");
#pragma unroll
            for (int m = 0; m < 4; ++m) { const int rl = rl0 + ai * HALF + m * 16;
                const f32x4 p = *(const LAS f32x4*)(P + rl * 4); const float re = 1.0f / sqrtf(((p[0] + p[1]) + (p[2] + p[3])) * (1.0f / 256.0f) + 1e-6f);
                float mx = 0.f, bx = 0.f;
#pragma unroll
                for (int bj = 0; bj < 2; ++bj) { const u32x4 w = hw2[m][bj];
                    const f32x4 h0 = {bf2f(w.x & 0xffffu), bf2f(w.x >> 16), bf2f(w.y & 0xffffu), bf2f(w.y >> 16)}, h1 = {bf2f(w.z & 0xffffu), bf2f(w.z >> 16), bf2f(w.w & 0xffffu), bf2f(w.w >> 16)};
                    const f32x4 a0 = gv[bj][0] * acc[ai][bj][m][0], a1 = gv[bj][1] * acc[ai][bj][m][1]; acc[ai][bj][m][0] = a0; acc[ai][bj][m][1] = a1;
                    const f32x4 t0 = h0 + a0 * re, t1 = h1 + a1 * re;
#pragma unroll
                    for (int q = 0; q < 4; ++q) { mx = fmaxf(mx, fmaxf(fabsf(t0[q]), fabsf(t1[q]))); bx = fmaxf(bx, fmaxf(fabsf(a0[q]), fabsf(a1[q]))); } }
                mx = fmaxf(mx, __shfl_xor(mx, 16)); mx = fmaxf(mx, __shfl_xor(mx, 32)); bx = fmaxf(bx, __shfl_xor(bx, 16)); bx = fmaxf(bx, __shfl_xor(bx, 32));
                if (fq == 0) { PM[rl * 4 + wc] = mx; PB[rl * 4 + wc] = bx; } }
        }
        asm volatile("s_waitcnt lgkmcnt(0)" ::: "memory"); __builtin_amdgcn_s_barrier(); asm volatile("" ::: "memory");
        if (tid < 256) {
            const f32x4 p = *(const LAS f32x4*)(P + tid * 4), pm4 = *(const LAS f32x4*)(PM + tid * 4), pb4 = *(const LAS f32x4*)(PB + tid * 4);
            const float ss = (p[0] + p[1]) + (p[2] + p[3]);
            float* slots = XS + ((size_t)u.pm * BM + tid) * 16;
            st_sys16(slots + u.pn * 4, (f32x4){ss, fmaxf(fmaxf(pm4[0], pm4[1]), fmaxf(pm4[2], pm4[3])), fmaxf(fmaxf(pb4[0], pb4[1]), fmaxf(pb4[2], pb4[3])), 1.0f / sqrtf(ss * (1.0f / 256.0f) + 1e-6f)});
            f32x4 s4[4]; unsigned spins = 0;
            for (;;) {
                bool ok = true;
                ld_sys16x4(slots, s4);
#pragma unroll
                for (int t = 0; t < 4; ++t) ok = ok && (s4[t][0] >= 0.f) && (s4[t][1] >= 0.f) && (s4[t][2] >= 0.f) && (s4[t][3] >= 0.f);
                if (__builtin_amdgcn_ballot_w64(!ok) == 0ull) break;
                __builtin_amdgcn_s_sleep(1);
                if (++spins > (1u << 20)) { __hip_atomic_store(tmo, 1u, __ATOMIC_RELAXED, __HIP_MEMORY_SCOPE_AGENT); break; }
            }
            const float r = 1.0f / sqrtf(((s4[0][0] + s4[1][0]) + (s4[2][0] + s4[3][0])) * (1.0f / 1024.0f) + 1e-6f);
            float bound = 0.f;
#pragma unroll
            for (int t = 0; t < 4; ++t) bound = fmaxf(bound, s4[t][1] + s4[t][2] * fabsf(r - s4[t][3]));
            bound *= 1.00001f;
            const float sc = (bound > 0.f) ? bound * (1.0f / 127.0f) : 1.0f;
            R[tid] = r; RI[tid] = 1.0f / sc; if (u.pn == 0 && !OUTF) SA[(size_t)u.pm * BM + tid] = sc;
        }
        asm volatile("s_waitcnt lgkmcnt(0)" ::: "memory"); __builtin_amdgcn_s_barrier(); asm volatile("" ::: "memory");
#pragma unroll
        for (int ai = 0; ai < 2; ++ai) {
            u32x4 hwv[4][2];
#pragma unroll
            for (int m = 0; m < 4; ++m)
#pragma unroll
                for (int bj = 0; bj < 2; ++bj) hwv[m][bj] = *(const u32x4*)(HB + ((size_t)u.pm * BM + rl0 + ai * HALF + m * 16) * 1024 + u.pn * BM + cl0 + bj * HALF);
#pragma unroll
            for (int m = 0; m < 4; ++m) { const int rl = rl0 + ai * HALF + m * 16; const float r = R[rl], inv = RI[rl]; const size_t go = ((size_t)u.pm * BM + rl) * 1024 + u.pn * BM + cl0;
                float s2 = 0.f;
#pragma unroll
                for (int bj = 0; bj < 2; ++bj) { const u32x4 w = hwv[m][bj];
                    f32x4 h0 = {bf2f(w.x & 0xffffu), bf2f(w.x >> 16), bf2f(w.y & 0xffffu), bf2f(w.y >> 16)}, h1 = {bf2f(w.z & 0xffffu), bf2f(w.z >> 16), bf2f(w.w & 0xffffu), bf2f(w.w >> 16)};
                    h0 = h0 + acc[ai][bj][m][0] * r; h1 = h1 + acc[ai][bj][m][1] * r;
                    s2 += (h0[0] * h0[0] + h0[1] * h0[1]) + (h0[2] * h0[2] + h0[3] * h0[3]) + (h1[0] * h1[0] + h1[1] * h1[1]) + (h1[2] * h1[2] + h1[3] * h1[3]);
                    if (OUTF) { *(f32x4*)(OUTF + go + bj * HALF) = h0; *(f32x4*)(OUTF + go + bj * HALF + 4) = h1; }
                    else { u32x4 o; o.x = cvt_pk_bf16(h0[0], h0[1]); o.y = cvt_pk_bf16(h0[2], h0[3]); o.z = cvt_pk_bf16(h1[0], h1[1]); o.w = cvt_pk_bf16(h1[2], h1[3]); __builtin_nontemporal_store(o, (u32x4*)(HB + go + bj * HALF));
                        u32x2 q; q.x = q4_i8(h0, inv); q.y = q4_i8(h1, inv); *(u32x2*)(HB8 + go + bj * HALF) = q; } }
                s2 += __shfl_xor(s2, 16); s2 += __shfl_xor(s2, 32);
                if (fq == 0) P2[rl * 4 + wc] = s2; }
        }
        asm volatile("s_waitcnt lgkmcnt(0)" ::: "memory"); __builtin_amdgcn_s_barrier(); asm volatile("" ::: "memory");
        if (tid < 256) { const f32x4 p = *(const LAS f32x4*)(P2 + tid * 4); X2[((size_t)u.pm * BM + tid) * 4 + u.pn] = (p[0] + p[1]) + (p[2] + p[3]); }
    }
};

template <class Epi, class Sched, bool ALIGN_EPI, bool I8 = false>
__device__ __forceinline__ void gemm_phase(LAS unsigned char* lds, const int K, const Sched& S, const Epi& E) {
    int tid = threadIdx.x; asm volatile("" : "+v"(tid));
    const int wid = __builtin_amdgcn_readfirstlane(tid >> 6), lane = tid & 63, wr = wid >> 2, wc = wid & 3, fr = lane & 15, fq = lane >> 4;
    unsigned voffA[2], voffB[2];
#pragma unroll
    for (int i = 0; i < 2; ++i) { int R, C; stage_rc(tid * 16 + i * 8192, R, C); const int Rb = Epi::PERM ? ((R & ~31) + perm32(R & 31)) : R;
        voffA[i] = (unsigned)(R * K + C) * 2u; voffB[i] = (unsigned)(Rb * K + C) * 2u; }
    const size_t kstep = (size_t)(BK * 2);
    const size_t hstep = (size_t)HALF * K * 2;
    const unsigned ldsw = (unsigned)wid * 1024u;
    const int aoff = lds_byte(wr * 64 + fr, fq * 8), boff = lds_byte(wc * 32 + fr, fq * 8);
#define PG8_SA(b, h) (((b) * 2 + (h)) * HTB)
#define PG8_SB(b, h) ((4 + (b) * 2 + (h)) * HTB)
#define PG8_STAGE(bufoff, gbase, voff) do { _Pragma("unroll") for (int _i = 0; _i < 2; ++_i) \
        __builtin_amdgcn_global_load_lds((const unsigned*)((const char*)(gbase) + (voff)[_i]), (LAS unsigned*)(lds + (bufoff) + ldsw + _i * 8192), 16, 0, 0); } while (0)
#define PG8_LDA(dst, b, h) do { _Pragma("unroll") for (int m = 0; m < 4; ++m) _Pragma("unroll") for (int k = 0; k < 2; ++k) dst[m][k] = *(const LAS bf16x8*)(lds + PG8_SA(b, h) + aoff + m * 2048 + k * 1024); } while (0)
#define PG8_LDB(dst, b, h) do { _Pragma("unroll") for (int n = 0; n < 2; ++n) _Pragma("unroll") for (int k = 0; k < 2; ++k) dst[n][k] = *(const LAS bf16x8*)(lds + PG8_SB(b, h) + boff + n * 2048 + k * 1024); } while (0)
#define PG8_MMA(ai, bj, At, Bt) do { __builtin_amdgcn_s_setprio(1); _Pragma("unroll") for (int m = 0; m < 4; ++m) _Pragma("unroll") for (int n = 0; n < 2; ++n) _Pragma("unroll") for (int k = 0; k < 2; ++k) \
        { if constexpr (I8) acc[ai][bj][m][n] = __builtin_bit_cast(f32x4, __builtin_amdgcn_mfma_i32_16x16x64_i8(__builtin_bit_cast(i32x4, Bt[n][k]), __builtin_bit_cast(i32x4, At[m][k]), __builtin_bit_cast(i32x4, acc[ai][bj][m][n]), 0, 0, 0)); \
          else acc[ai][bj][m][n] = __builtin_amdgcn_mfma_f32_16x16x32_bf16(Bt[n][k], At[m][k], acc[ai][bj][m][n], 0, 0, 0); } __builtin_amdgcn_s_setprio(0); } while (0)
#define PG8_WAIT_V(n) asm volatile("s_waitcnt vmcnt(" #n ")" ::: "memory")
#define PG8_WAIT_L(n) asm volatile("s_waitcnt lgkmcnt(" #n ")" ::: "memory")
#define PG8_BAR __builtin_amdgcn_s_barrier()
#define PG8_SCHED __builtin_amdgcn_sched_barrier(0)
    Unit cur, nxt; int ui = 0;
    if (!S.next(0, cur)) return;
    f32x4 acc[2][2][4][2];
#pragma unroll
    for (int a = 0; a < 2; ++a)
#pragma unroll
        for (int b = 0; b < 2; ++b)
#pragma unroll
            for (int m = 0; m < 4; ++m)
#pragma unroll
                for (int n = 0; n < 2; ++n) acc[a][b][m][n] = (f32x4){0.f, 0.f, 0.f, 0.f};
    bf16x8 At[4][2], B0[2][2], B1[2][2];
    const char* cA; const char* cB; S.tiles(cur, cA, cB);
    PG8_STAGE(PG8_SB(0, 0), cB, voffB); PG8_STAGE(PG8_SB(0, 1), cB + hstep, voffB); PG8_STAGE(PG8_SA(0, 0), cA, voffA); PG8_STAGE(PG8_SA(0, 1), cA + hstep, voffA);
    if (wr == 1) PG8_BAR;
    PG8_WAIT_V(2); PG8_BAR;
    PG8_STAGE(PG8_SB(1, 0), cB + kstep, voffB); PG8_STAGE(PG8_SA(1, 0), cA + kstep, voffA); PG8_STAGE(PG8_SB(1, 1), cB + hstep + kstep, voffB);
    PG8_WAIT_V(6); PG8_BAR;
    for (;;) {
        const bool has_next = S.next(ui + 1, nxt);
        const char* nA = cA; const char* nB = cB; if (has_next) S.tiles(nxt, nA, nB);
#define PG8_KT2(t, last) do { \
            const char* a1 = cA + (size_t)((t) + 1) * kstep; \
            const char* a2 = (last) ? nA : cA + (size_t)((t) + 2) * kstep; const char* b2 = (last) ? nB : cB + (size_t)((t) + 2) * kstep; \
            const char* a3 = a2 + kstep; const char* b3 = b2 + kstep; \
            PG8_LDB(B0, 0, 0); PG8_LDB(B1, 0, 1); PG8_SCHED; PG8_LDA(At, 0, 0); PG8_STAGE(PG8_SA(1, 1), a1 + hstep, voffA); \
            PG8_WAIT_V(8); PG8_WAIT_L(0); PG8_BAR; PG8_MMA(0, 0, At, B0); PG8_MMA(0, 1, At, B1); PG8_BAR; PG8_SCHED; \
            PG8_LDA(At, 0, 1); PG8_STAGE(PG8_SB(0, 0), b2, voffB); PG8_STAGE(PG8_SB(0, 1), b2 + hstep, voffB); PG8_STAGE(PG8_SA(0, 0), a2, voffA); \
            PG8_WAIT_V(8); PG8_WAIT_L(0); PG8_BAR; PG8_MMA(1, 0, At, B0); PG8_MMA(1, 1, At, B1); PG8_BAR; PG8_SCHED; \
            PG8_LDB(B0, 1, 0); PG8_LDB(B1, 1, 1); PG8_SCHED; PG8_LDA(At, 1, 0); PG8_STAGE(PG8_SA(0, 1), a2 + hstep, voffA); \
            PG8_WAIT_V(8); PG8_WAIT_L(0); PG8_BAR; PG8_MMA(0, 0, At, B0); PG8_MMA(0, 1, At, B1); PG8_BAR; PG8_SCHED; \
            PG8_LDA(At, 1, 1); PG8_STAGE(PG8_SB(1, 0), b3, voffB); PG8_STAGE(PG8_SB(1, 1), b3 + hstep, voffB); PG8_STAGE(PG8_SA(1, 0), a3, voffA); \
            PG8_WAIT_V(8); PG8_WAIT_L(0); PG8_BAR; PG8_MMA(1, 0, At, B0); PG8_MMA(1, 1, At, B1); PG8_BAR; PG8_SCHED; } while (0)
        {
            const int ntc = S.ntiles(cur);
#pragma unroll 1
            for (int t = 0; t < ntc; t += 2) { const bool last = (t == ntc - 2); PG8_KT2(t, last); }
        }
        if constexpr (ALIGN_EPI) { if (wr == 0) PG8_BAR; }
        E(acc, cur, wr, wc, fr, fq);
        if (!has_next) break;
        if (!S.keep_acc(nxt)) {
#pragma unroll
        for (int a = 0; a < 2; ++a)
#pragma unroll
            for (int b = 0; b < 2; ++b)
#pragma unroll
                for (int m = 0; m < 4; ++m)
#pragma unroll
                    for (int n = 0; n < 2; ++n) acc[a][b][m][n] = (f32x4){0.f, 0.f, 0.f, 0.f};
        }
        cur = nxt; cA = nA; cB = nB; ++ui;
        if constexpr (ALIGN_EPI) { if (wr == 1) PG8_BAR; }
    }
    PG8_WAIT_V(0);
    if constexpr (!ALIGN_EPI) { if (wr == 0) PG8_BAR; }
    PG8_BAR;
#undef PG8_KT2
#undef PG8_SA
#undef PG8_SB
#undef PG8_STAGE
#undef PG8_LDA
#undef PG8_LDB
#undef PG8_MMA
#undef PG8_WAIT_V
#undef PG8_WAIT_L
#undef PG8_BAR
#undef PG8_SCHED
}
}

struct Args {
    const float* in[22]; float* out; unsigned char* ws; int ph_lo, ph_hi;
};
enum { I_X = 0, I_NMIXPRE, I_NMIXPOST, I_NMLPPRE, I_NMLPPOST, I_WIN, I_LCW, I_LCB, I_LWA, I_LBA, I_LWX, I_LBX, I_LLAM, I_PW, I_PS, I_HLB, I_HN, I_SW, I_WBR, I_WOUT, I_WUP, I_WDOWN };

struct Ctx {
    LAS unsigned char* lds; int tid, lane, wave, vcu, G;
};

__device__ __forceinline__ void transpose_item(const float* W, int ldw, const float* gain, bf16_t* WT, int ldo, int col_off, int k0, int n0, LAS float* scr, int lane) {
    float wv[32];
#pragma unroll
    for (int i = 0; i < 32; ++i) { const int kk = 2 * i + (lane >> 5); wv[i] = W[(size_t)(k0 + kk) * ldw + n0 + (lane & 31)]; }
#pragma unroll
    for (int i = 0; i < 32; ++i) { const int kk = 2 * i + (lane >> 5); const float g = gain ? gain[k0 + kk] : 1.0f; scr[kk * 33 + (lane & 31)] = g * wv[i]; }
    asm volatile("s_waitcnt lgkmcnt(0)" ::: "memory");
    const int c = lane & 7;
#pragma unroll
    for (int j = 0; j < 4; ++j) { const int n = (lane >> 3) + 8 * j; const LAS float* s = scr + (8 * c) * 33 + n;
        u32x4 o; o.x = pk2(s[0 * 33], s[1 * 33]); o.y = pk2(s[2 * 33], s[3 * 33]); o.z = pk2(s[4 * 33], s[5 * 33]); o.w = pk2(s[6 * 33], s[7 * 33]);
        *(u32x4*)(WT + (size_t)(n0 + n) * ldo + col_off + k0 + 8 * c) = o; }
    asm volatile("s_waitcnt lgkmcnt(0)" ::: "memory");
}

__device__ __forceinline__ void p0_prologue(const Ctx& C, const Args& A) {
    LAS float* scr = (LAS float*)(C.lds + C.wave * 16384);
    const int gw = C.vcu * NWAVES + C.wave, NGW = C.G * NWAVES;
    constexpr int I_IN = (D / 64) * (INW / 32), I_BR1 = (BW / 64) * (D / 32), I_OUT = (D / 64) * (D / 32), I_UP = (D / 64) * (FF / 32), I_DN = (FF / 64) * (D / 32);
    constexpr int PER_LAYER = I_IN + 4 * I_BR1 + I_OUT + I_UP + I_DN;
    for (int it = gw; it < DEPTH * PER_LAYER; it += NGW) {
        const int l = it / PER_LAYER; int r = it % PER_LAYER;
        bf16_t* wl = (bf16_t*)(A.ws + WS_W + (size_t)l * W_LAYER);
        if (r < I_IN) { const int nb = INW / 32; transpose_item(A.in[I_WIN] + (size_t)l * D * INW, INW, A.in[I_NMIXPRE] + l * D, wl + W_IN / 2, D, 0, 64 * (r / nb), 32 * (r % nb), scr, C.lane); continue; } r -= I_IN;
        if (r < 4 * I_BR1) { const int k = r / I_BR1, rr = r % I_BR1, nb = D / 32; transpose_item(A.in[I_WBR] + ((size_t)l * 4 + k) * BW * D, D, nullptr, wl + W_BR / 2, D, k * BW, 64 * (rr / nb), 32 * (rr % nb), scr, C.lane); continue; } r -= 4 * I_BR1;
        if (r < I_OUT) { const int nb = D / 32; transpose_item(A.in[I_WOUT] + (size_t)l * D * D, D, nullptr, wl + W_OUT / 2, D, 0, 64 * (r / nb), 32 * (r % nb), scr, C.lane); continue; } r -= I_OUT;
        if (r < I_UP) { const int nb = FF / 32; transpose_item(A.in[I_WUP] + (size_t)l * D * FF, FF, A.in[I_NMLPPRE] + l * D, wl + W_UP / 2, D, 0, 64 * (r / nb), 32 * (r % nb), scr, C.lane); continue; } r -= I_UP;
        { const int nb = D / 32; transpose_item(A.in[I_WDOWN] + (size_t)l * FF * D, D, nullptr, wl + W_DOWN / 2, FF, 0, 64 * (r / nb), 32 * (r % nb), scr, C.lane); }
    }
    { const int gt = gw * 64 + C.lane; if (gt < DEPTH * BW) { const float lam = A.in[I_LLAM][gt]; ((float*)(A.ws + WS_SP8))[gt] = -8.0f * ((-lam > 20.f) ? -lam : log1pf(expf(-lam))); } }
    bf16_t* HB = (bf16_t*)(A.ws + WS_HB); float* RS = (float*)(A.ws + WS_X2);
    for (int m0 = gw; m0 < M; m0 += 4 * NGW) {
        f32x4 v[4][4];
#pragma unroll
        for (int q = 0; q < 4; ++q) { const int m = m0 + q * NGW; const f32x4* xr = (const f32x4*)(A.in[I_X] + (size_t)(m < M ? m : 0) * D) + C.lane;
#pragma unroll
            for (int j = 0; j < 4; ++j) v[q][j] = xr[64 * j]; }
#pragma unroll
        for (int q = 0; q < 4; ++q) { const int m = m0 + q * NGW; if (m < M) { float s = 0.f;
#pragma unroll
            for (int j = 0; j < 4; ++j) s += (v[q][j].x * v[q][j].x + v[q][j].y * v[q][j].y) + (v[q][j].z * v[q][j].z + v[q][j].w * v[q][j].w);
            s = wave_sum(s);
            u32x2* o8 = (u32x2*)(HB + (size_t)m * D) + C.lane;
#pragma unroll
            for (int j = 0; j < 4; ++j) { u32x2 w; w.x = pk2(v[q][j].x, v[q][j].y); w.y = pk2(v[q][j].z, v[q][j].w); o8[64 * j] = w; }
            float mx = 0.f;
#pragma unroll
            for (int j = 0; j < 4; ++j) mx = fmaxf(fmaxf(mx, fmaxf(fabsf(v[q][j].x), fabsf(v[q][j].y))), fmaxf(fabsf(v[q][j].z), fabsf(v[q][j].w)));
#pragma unroll
            for (int o = 1; o < 64; o <<= 1) mx = fmaxf(mx, __shfl_xor(mx, o));
            const float sc = (mx > 0.f) ? mx * (1.0f / 127.0f) : 1.0f, inv = 1.0f / sc;
            unsigned* o4 = (unsigned*)(A.ws + WS_HB8 + (size_t)m * D) + C.lane;
#pragma unroll
            for (int j = 0; j < 4; ++j) o4[64 * j] = q4_i8(v[q][j], inv);
            if (C.lane == 0) { *(f32x4*)(RS + (size_t)m * 4) = (f32x4){s, 0.f, 0.f, 0.f}; ((float*)(A.ws + WS_SA))[m] = sc; } } }
    }
}

__device__ __forceinline__ void norm_phase(const Ctx& C, const Args& A, const bf16_t* VIN, const float* gain, bool write_out) {
    bf16_t* HB = (bf16_t*)(A.ws + WS_HB); float* RS = (float*)(A.ws + WS_X2); float* OUT = A.out;
    int lane = C.lane; asm volatile("" : "+v"(lane));
    const int gw = C.vcu * NWAVES + C.wave, NGW = C.G * NWAVES;
    f32x4 g[4];
#pragma unroll
    for (int j = 0; j < 4; ++j) g[j] = ((const f32x4*)gain)[lane + 64 * j];
    for (int m = gw; m < M; m += NGW) {
        u32x2* hb = (u32x2*)(HB + (size_t)m * D) + lane;
        const u32x2* vb = (const u32x2*)(VIN + (size_t)m * D) + lane;
        f32x4 v[4], h[4]; float s = 0.f;
#pragma unroll
        for (int j = 0; j < 4; ++j) { const u32x2 w = vb[64 * j], hw = hb[64 * j];
            v[j] = (f32x4){bf2f(w.x & 0xffffu), bf2f(w.x >> 16), bf2f(w.y & 0xffffu), bf2f(w.y >> 16)};
            h[j] = (f32x4){bf2f(hw.x & 0xffffu), bf2f(hw.x >> 16), bf2f(hw.y & 0xffffu), bf2f(hw.y >> 16)};
            s += (v[j].x * v[j].x + v[j].y * v[j].y) + (v[j].z * v[j].z + v[j].w * v[j].w); }
        const float r = 1.0f / sqrtf(wave_sum(s) * (1.0f / D) + EPS);
        float s2 = 0.f;
#pragma unroll
        for (int j = 0; j < 4; ++j) { h[j] = h[j] + g[j] * v[j] * r; s2 += (h[j].x * h[j].x + h[j].y * h[j].y) + (h[j].z * h[j].z + h[j].w * h[j].w); }
        s2 = wave_sum(s2);
        if (write_out) { f32x4* orow = (f32x4*)(OUT + (size_t)m * D) + lane;
#pragma unroll
            for (int j = 0; j < 4; ++j) orow[64 * j] = h[j]; }
        else {
#pragma unroll
            for (int j = 0; j < 4; ++j) { u32x2 w; w.x = pk2(h[j].x, h[j].y); w.y = pk2(h[j].z, h[j].w); hb[64 * j] = w; }
            float mx = 0.f;
#pragma unroll
            for (int j = 0; j < 4; ++j) mx = fmaxf(fmaxf(mx, fmaxf(fabsf(h[j].x), fabsf(h[j].y))), fmaxf(fabsf(h[j].z), fabsf(h[j].w)));
#pragma unroll
            for (int o = 1; o < 64; o <<= 1) mx = fmaxf(mx, __shfl_xor(mx, o));
            const float sc = (mx > 0.f) ? mx * (1.0f / 127.0f) : 1.0f, inv = 1.0f / sc;
            unsigned* o4 = (unsigned*)(A.ws + WS_HB8 + (size_t)m * D) + lane;
#pragma unroll
            for (int j = 0; j < 4; ++j) o4[64 * j] = q4_i8(h[j], inv);
            if (lane == 0) { *(f32x4*)(RS + (size_t)m * 4) = (f32x4){s2, 0.f, 0.f, 0.f}; ((float*)(A.ws + WS_SA))[m] = sc; } }
    }
}

__device__ __forceinline__ float gelu_tanh(float x) {
    const float u = 0.7978845608028654f * (x + 0.044715f * x * x * x);
    const float e = fast_exp(2.0f * u);
    const float th = 1.0f - 2.0f * __builtin_amdgcn_rcpf(e + 1.0f);
    return 0.5f * x * (1.0f + th);
}

constexpr size_t WS_LRA = 428 * MiB, WS_LRU = 444 * MiB;
constexpr int MX_PT = 528;
__device__ __forceinline__ bf16x8 gather_wfrag(const float* w, int stride) {
    union { bf16x8 v; unsigned u[4]; } r;
#pragma unroll
    for (int p = 0; p < 4; ++p) r.u[p] = pk2(w[(2 * p) * stride], w[(2 * p + 1) * stride]);
    return r.v;
}
__device__ __forceinline__ void mix1_item(const Ctx& C, const Args& A, int l, int b, int c) {
    const bf16_t* PROJ = (const bf16_t*)(A.ws + WS_PROJ);
    bf16_t* YS = (bf16_t*)(A.ws + WS_YS);
    int tid = C.tid; asm volatile("" : "+v"(tid));
    const int lane = tid & 63, wave = C.wave, fr = lane & 15, fg = lane >> 4;
    const size_t m0 = (size_t)b * T + (size_t)c * 64;
    LAS unsigned char* XC = C.lds;
    LAS unsigned char* LAi = C.lds + 34816;
    LAS unsigned char* LUi = C.lds + 34816 + 32768;
    {
        const float* cw = A.in[I_LCW] + (size_t)l * 4 * BW; const float* cbp = A.in[I_LCB] + l * BW;
#pragma unroll
        for (int k = 0; k < 4; ++k) { const int idx = tid + NTHREADS * k; const int t = idx >> 5, c8 = (idx & 31) * 8;
            float acc[8];
            { const f32x4 b0 = *(const f32x4*)(cbp + c8), b1 = *(const f32x4*)(cbp + c8 + 4); acc[0] = b0[0]; acc[1] = b0[1]; acc[2] = b0[2]; acc[3] = b0[3]; acc[4] = b1[0]; acc[5] = b1[1]; acc[6] = b1[2]; acc[7] = b1[3]; }
#pragma unroll
            for (int j = 0; j < 4; ++j) { const int tok = c * 64 + t - 3 + j;
                if (tok >= 0) { float x[8]; ld8bf(PROJ + ((size_t)b * T + tok) * NMIX + c8, x); const f32x4 w0 = *(const f32x4*)(cw + j * BW + c8), w1 = *(const f32x4*)(cw + j * BW + c8 + 4);
                    acc[0] += w0[0] * x[0]; acc[1] += w0[1] * x[1]; acc[2] += w0[2] * x[2]; acc[3] += w0[3] * x[3]; acc[4] += w1[0] * x[4]; acc[5] += w1[1] * x[5]; acc[6] += w1[2] * x[6]; acc[7] += w1[3] * x[7]; } }
            u32x4 w; w.x = cvt_pk_bf16(acc[0], acc[1]); w.y = cvt_pk_bf16(acc[2], acc[3]); w.z = cvt_pk_bf16(acc[4], acc[5]); w.w = cvt_pk_bf16(acc[6], acc[7]);
            *(LAS u32x4*)(XC + t * MX_PT + c8 * 2) = w; }
    }
    __syncthreads();
    {
        const int blk = wave;
        const float* wa = A.in[I_LWA] + (((size_t)l * 8 + blk) * 32) * 32; const float* wx = A.in[I_LWX] + (((size_t)l * 8 + blk) * 32) * 32;
        bf16x8 fa[2], fx[2];
#pragma unroll
        for (int nt = 0; nt < 2; ++nt) { fa[nt] = gather_wfrag(wa + (8 * fg) * 32 + 16 * nt + fr, 32); fx[nt] = gather_wfrag(wx + (8 * fg) * 32 + 16 * nt + fr, 32); }
        bf16_t* LRA = (bf16_t*)(A.ws + WS_LRA); bf16_t* LRU = (bf16_t*)(A.ws + WS_LRU);
        f32x4 bav[2], bxv[2], spv[2];
#pragma unroll
        for (int nt = 0; nt < 2; ++nt) { const int ch = 32 * blk + 16 * nt + 4 * fg;
            bav[nt] = *(const f32x4*)(A.in[I_LBA] + l * BW + ch); bxv[nt] = *(const f32x4*)(A.in[I_LBX] + l * BW + ch); spv[nt] = *(const f32x4*)((const float*)(A.ws + WS_SP8) + l * BW + ch); }
#pragma unroll
        for (int nt = 0; nt < 2; ++nt) { const int ch = 32 * blk + 16 * nt + 4 * fg;
            const f32x4 ba = bav[nt], bx = bxv[nt], sp8 = spv[nt];
#pragma unroll
            for (int mt = 0; mt < 4; ++mt) { const int tok = 16 * mt + fr;
                const bf16x8 bxc = *(const LAS bf16x8*)(XC + tok * MX_PT + (32 * blk + 8 * fg) * 2);
                f32x4 ar = {0.f, 0.f, 0.f, 0.f}, ai = {0.f, 0.f, 0.f, 0.f};
                ar = __builtin_amdgcn_mfma_f32_16x16x32_bf16(fa[nt], bxc, ar, 0, 0, 0); ai = __builtin_amdgcn_mfma_f32_16x16x32_bf16(fx[nt], bxc, ai, 0, 0, 0);
                const u32x2 xw = *(const LAS u32x2*)(XC + tok * MX_PT + ch * 2);
                const float xc[4] = {bf2f(xw.x & 0xffffu), bf2f(xw.x >> 16), bf2f(xw.y & 0xffffu), bf2f(xw.y >> 16)};
                float la[4], uu[4];
#pragma unroll
                for (int r = 0; r < 4; ++r) { const float rg = sigmoid_f(ar[r] + ba[r]), ig = sigmoid_f(ai[r] + bx[r]);
                    la[r] = sp8[r] * rg; const float x2 = 2.0f * la[r];
                    const float om = (x2 > -0.02f) ? -x2 * (1.0f + 0.5f * x2 * (1.0f + x2 * (1.0f / 3.0f))) : 1.0f - fast_exp(x2);
                    uu[r] = sqrtf(om) * ig * xc[r]; }
                u32x2 wl, wu; wl.x = cvt_pk_bf16(la[0], la[1]); wl.y = cvt_pk_bf16(la[2], la[3]); wu.x = cvt_pk_bf16(uu[0], uu[1]); wu.y = cvt_pk_bf16(uu[2], uu[3]);
                *(LAS u32x2*)(LAi + tok * 512 + ch * 2) = wl; *(LAS u32x2*)(LUi + tok * 512 + ch * 2) = wu;
                *(u32x2*)(LRA + (m0 + tok) * BW + ch) = wl; *(u32x2*)(LRU + (m0 + tok) * BW + ch) = wu; }
        }
    }
    __syncthreads();
    {
        const int ch = tid & 255, half = tid >> 8; float P = 1.f, hst = 0.f;
#pragma unroll
        for (int i = 0; i < 32; ++i) { const int t = 32 * half + i; const float a = fast_exp(bf2f(*(const LAS bf16_t*)(LAi + t * 512 + ch * 2))); const float u = bf2f(*(const LAS bf16_t*)(LUi + t * 512 + ch * 2));
            hst = a * hst + u; P *= a; }
        const size_t aggi = ((size_t)b * 128 + c * 2 + half) * 256 + ch;
        ((float*)(A.ws + WS_LA))[aggi] = P; ((float*)(A.ws + WS_LH))[aggi] = hst;
    }
    __syncthreads();
    LAS unsigned char* PX = C.lds;
    LAS unsigned char* DD = C.lds + 43008;
    { u32x4 pv[5];
#pragma unroll
        for (int k = 0; k < 5; ++k) { const int idx = tid + NTHREADS * k; const int r = idx >> 5, c8 = (idx & 31) * 8; const int tok = c * 64 - 15 + r;
            pv[k] = (u32x4){0u, 0u, 0u, 0u}; if (idx < 79 * 32 && tok >= 0) pv[k] = *(const u32x4*)(PROJ + ((size_t)b * T + tok) * NMIX + 512 + c8); }
#pragma unroll
        for (int k = 0; k < 5; ++k) { const int idx = tid + NTHREADS * k; const int r = idx >> 5, c8 = (idx & 31) * 8; if (idx < 79 * 32) *(LAS u32x4*)(PX + r * MX_PT + c8 * 2) = pv[k]; } }
    __syncthreads();
#pragma unroll 1
    for (int k = 0; k < 4; ++k) { const int idx = tid + NTHREADS * k; const int t = idx >> 5, c8 = (idx & 31) * 8; const int g = c8 >> 6, win = 2 << g;
        float sum[8], x0[8];
#pragma unroll
        for (int e = 0; e < 8; ++e) sum[e] = 0.f;
        for (int j = 0; j < win; ++j) { const u32x4 v = *(const LAS u32x4*)(PX + (t + 15 - j) * MX_PT + c8 * 2);
            const float x[8] = {bf2f(v.x & 0xffffu), bf2f(v.x >> 16), bf2f(v.y & 0xffffu), bf2f(v.y >> 16), bf2f(v.z & 0xffffu), bf2f(v.z >> 16), bf2f(v.w & 0xffffu), bf2f(v.w >> 16)};
#pragma unroll
            for (int e = 0; e < 8; ++e) { sum[e] += x[e]; if (j == 0) x0[e] = x[e]; } }
        const int pos = c * 64 + t + 1; const float inv = 1.0f / (float)(pos < win ? pos : win);
        u32x4 w; w.x = cvt_pk_bf16(sum[0] * inv - x0[0], sum[1] * inv - x0[1]); w.y = cvt_pk_bf16(sum[2] * inv - x0[2], sum[3] * inv - x0[3]);
        w.z = cvt_pk_bf16(sum[4] * inv - x0[4], sum[5] * inv - x0[5]); w.w = cvt_pk_bf16(sum[6] * inv - x0[6], sum[7] * inv - x0[7]);
        *(LAS u32x4*)(DD + t * MX_PT + c8 * 2) = w; }
    __syncthreads();
    {
        const int g = wave >> 1, nb = (wave & 1) * 2;
        const float* pw = A.in[I_PW] + (((size_t)l * 4 + g) * 64) * 64;
        bf16x8 fw[2][2];
#pragma unroll
        for (int nn = 0; nn < 2; ++nn)
#pragma unroll
            for (int ks = 0; ks < 2; ++ks) fw[nn][ks] = gather_wfrag(pw + (32 * ks + 8 * fg) * 64 + 16 * (nb + nn) + fr, 64);
        f32x4 sclv[2];
#pragma unroll
        for (int nn = 0; nn < 2; ++nn) sclv[nn] = *(const f32x4*)(A.in[I_PS] + l * BW + 64 * g + 16 * (nb + nn) + 4 * fg);
#pragma unroll
        for (int nn = 0; nn < 2; ++nn) { const int ch = 64 * g + 16 * (nb + nn) + 4 * fg; const f32x4 scl = sclv[nn];
#pragma unroll
            for (int mt = 0; mt < 4; ++mt) { const int tok = 16 * mt + fr; f32x4 acc = {0.f, 0.f, 0.f, 0.f};
#pragma unroll
                for (int ks = 0; ks < 2; ++ks) { const bf16x8 bd = *(const LAS bf16x8*)(DD + tok * MX_PT + (64 * g + 32 * ks + 8 * fg) * 2); acc = __builtin_amdgcn_mfma_f32_16x16x32_bf16(fw[nn][ks], bd, acc, 0, 0, 0); }
                u32x2 w; w.x = cvt_pk_bf16(acc[0] * scl[0], acc[1] * scl[1]); w.y = cvt_pk_bf16(acc[2] * scl[2], acc[3] * scl[3]);
                *(u32x2*)(YS + (m0 + tok) * D + 256 + ch) = w; } }
    }
    {
        const float* sw = A.in[I_SW] + (size_t)l * 3 * BW;
        const int c8 = (tid & 31) * 8;
        f32x4 wv[3][2];
#pragma unroll
        for (int j = 0; j < 3; ++j) { wv[j][0] = *(const f32x4*)(sw + j * BW + c8); wv[j][1] = *(const f32x4*)(sw + j * BW + c8 + 4); }
#pragma unroll 1
        for (int kb = 0; kb < 4; kb += 2) {
            u32x4 rc[2][3], rx[2][3], rb[2];
#pragma unroll
            for (int kk = 0; kk < 2; ++kk) { const int t = (tid + NTHREADS * (kb + kk)) >> 5;
#pragma unroll
                for (int j = 0; j < 3; ++j) { const int tok = c * 64 + t - 2 + j; rc[kk][j] = (u32x4){0u, 0u, 0u, 0u}; rx[kk][j] = (u32x4){0u, 0u, 0u, 0u};
                    if (tok >= 0) { const bf16_t* p = PROJ + ((size_t)b * T + tok) * NMIX; rc[kk][j] = *(const u32x4*)(p + 2048 + c8); rx[kk][j] = *(const u32x4*)(p + 2304 + c8); } }
                rb[kk] = *(const u32x4*)(PROJ + (m0 + t) * NMIX + 1792 + c8); }
#pragma unroll
            for (int kk = 0; kk < 2; ++kk) { const int t = (tid + NTHREADS * (kb + kk)) >> 5;
                float acc[8];
#pragma unroll
                for (int e = 0; e < 8; ++e) acc[e] = 0.f;
#pragma unroll
                for (int j = 0; j < 3; ++j) { const u32x4 vc = rc[kk][j], vx = rx[kk][j];
                    const float sc[8] = {bf2f(vc.x & 0xffffu), bf2f(vc.x >> 16), bf2f(vc.y & 0xffffu), bf2f(vc.y >> 16), bf2f(vc.z & 0xffffu), bf2f(vc.z >> 16), bf2f(vc.w & 0xffffu), bf2f(vc.w >> 16)};
                    const float sx[8] = {bf2f(vx.x & 0xffffu), bf2f(vx.x >> 16), bf2f(vx.y & 0xffffu), bf2f(vx.y >> 16), bf2f(vx.z & 0xffffu), bf2f(vx.z >> 16), bf2f(vx.w & 0xffffu), bf2f(vx.w >> 16)};
                    const f32x4 w0 = wv[j][0], w1 = wv[j][1];
                    acc[0] += w0[0] * sc[0] * sx[0]; acc[1] += w0[1] * sc[1] * sx[1]; acc[2] += w0[2] * sc[2] * sx[2]; acc[3] += w0[3] * sc[3] * sx[3];
                    acc[4] += w1[0] * sc[4] * sx[4]; acc[5] += w1[1] * sc[5] * sx[5]; acc[6] += w1[2] * sc[6] * sx[6]; acc[7] += w1[3] * sc[7] * sx[7]; }
                const u32x4 vb = rb[kk];
                const float sb[8] = {bf2f(vb.x & 0xffffu), bf2f(vb.x >> 16), bf2f(vb.y & 0xffffu), bf2f(vb.y >> 16), bf2f(vb.z & 0xffffu), bf2f(vb.z >> 16), bf2f(vb.w & 0xffffu), bf2f(vb.w >> 16)};
                u32x4 w; w.x = cvt_pk_bf16(sb[0] * acc[0], sb[1] * acc[1]); w.y = cvt_pk_bf16(sb[2] * acc[2], sb[3] * acc[3]); w.z = cvt_pk_bf16(sb[4] * acc[4], sb[5] * acc[5]); w.w = cvt_pk_bf16(sb[6] * acc[6], sb[7] * acc[7]);
                *(u32x4*)(YS + (m0 + t) * D + 768 + c8) = w; }
        }
    }
    __syncthreads();
}
__device__ __forceinline__ void lru_final_item(const Ctx& C, const Args& A, int l, int b, int c) {
    const bf16_t* PROJ = (const bf16_t*)(A.ws + WS_PROJ);
    const bf16_t* LRA = (const bf16_t*)(A.ws + WS_LRA); const bf16_t* LRU = (const bf16_t*)(A.ws + WS_LRU);
    bf16_t* YS = (bf16_t*)(A.ws + WS_YS);
    int tid = C.tid; asm volatile("" : "+v"(tid));
    const int ch = tid & 255, half = tid >> 8;
    const size_t m0 = (size_t)b * T + (size_t)c * 64 + 32 * half;
    float hst = ((const float*)(A.ws + WS_LC))[((size_t)b * 128 + c * 2 + half) * 256 + ch];
    unsigned short la[32], lu[32], lg[32];
#pragma unroll
    for (int i = 0; i < 32; ++i) { la[i] = LRA[(m0 + i) * BW + ch]; lu[i] = LRU[(m0 + i) * BW + ch]; lg[i] = PROJ[(m0 + i) * NMIX + 256 + ch]; }
#pragma unroll
    for (int i = 0; i < 32; ++i) { const float a = fast_exp(bf2f(la[i])), u = bf2f(lu[i]);
        hst = a * hst + u;
        YS[(m0 + i) * D + ch] = (bf16_t)f2bf(hst * gelu_tanh(bf2f(lg[i]))); }
}

constexpr int HG_PT = 144;
constexpr int HG_IMG = 64 * HG_PT;
constexpr int HG_Q = 0, HG_K = HG_IMG, HG_P = 2 * HG_IMG, HG_BEND = 3 * HG_IMG, HG_REF = HG_BEND + 512, HG_HSZ = 29696;
constexpr size_t WS_ST16 = WS_MERGED + 32 * MiB;
__device__ __forceinline__ float hgrn_lb(const Args& A, int l, int w) {
    if (l == 0) return 0.f;
    const float a0 = A.in[I_HLB][w], a1 = A.in[I_HLB][BW + w];
    return 1.0f / (1.0f + expf(a0 - a1));
}
template <bool FINAL>
__device__ __forceinline__ void hgrn_item(const Ctx& C, const Args& A, int l, int b, int c) {
    const bf16_t* PROJ = (const bf16_t*)(A.ws + WS_PROJ);
    int lane = C.lane; asm volatile("" : "+v"(lane));
    const int wave = C.wave, h = wave >> 1, half = wave & 1, fr = lane & 15, fg = lane >> 4;
    LAS unsigned char* hb = C.lds + h * HG_HSZ;
    LAS float* BEND = (LAS float*)(hb + HG_BEND); LAS float* REF = (LAS float*)(hb + HG_REF);
    const size_t m0 = (size_t)b * T + (size_t)c * 64;
    const bf16_t* pr = PROJ + (m0 + 32 * half) * NMIX + h * 64 + lane;
    const int bh = b * 4 + h; const size_t ci = (size_t)bh * 64 + c;
    float bb[32], kk[32], vv[32];
    {
        const float lbv = hgrn_lb(A, l, h * 64 + lane);
        float acc = 0.f;
#pragma unroll
        for (int i = 0; i < 32; ++i) { const float x = bf2f(pr[(size_t)i * NMIX + 1024]); const float f = fmaxf(lbv + (1.0f - lbv) * sigmoid_f(x), 1e-30f);
            acc += __logf(f); bb[i] = acc; kk[i] = 1.0f - f; }
#pragma unroll
        for (int i = 0; i < 32; ++i) vv[i] = bf2f(pr[(size_t)i * NMIX + 1280]);
        BEND[half * 64 + lane] = acc;
    }
    __syncthreads();
    const float bend0 = BEND[lane], blast = bend0 + BEND[64 + lane];
    if (half) {
#pragma unroll
        for (int i = 0; i < 32; ++i) bb[i] += bend0;
    }
    if (!FINAL) {
        LAS unsigned char* kt = hb + HG_K + lane * HG_PT + 64 * half; LAS unsigned char* vt = hb + HG_Q + lane * HG_PT + 64 * half;
#pragma unroll
        for (int q4 = 0; q4 < 4; ++q4) { u32x4 wk, wv; unsigned kw[4], vw[4];
#pragma unroll
            for (int p = 0; p < 4; ++p) { const int i = q4 * 8 + 2 * p;
                kw[p] = cvt_pk_bf16(kk[i] * fast_exp(blast - bb[i]), kk[i + 1] * fast_exp(blast - bb[i + 1])); vw[p] = cvt_pk_bf16(vv[i], vv[i + 1]); }
            wk.x = kw[0]; wk.y = kw[1]; wk.z = kw[2]; wk.w = kw[3]; wv.x = vw[0]; wv.y = vw[1]; wv.z = vw[2]; wv.w = vw[3];
            *(LAS u32x4*)(kt + q4 * 16) = wk; *(LAS u32x4*)(vt + q4 * 16) = wv; }
        if (half == 0) ((float*)(A.ws + WS_SD))[ci * 64 + lane] = fast_exp(blast);
        __syncthreads();
        float* su = (float*)(A.ws + WS_SU) + ci * 4096;
#pragma unroll
        for (int aa = 0; aa < 2; ++aa) { const int a = 2 * half + aa;
            bf16x8 av[2];
#pragma unroll
            for (int ks = 0; ks < 2; ++ks) av[ks] = *(const LAS bf16x8*)(hb + HG_Q + (16 * a + fr) * HG_PT + 64 * ks + 16 * fg);
#pragma unroll
            for (int d = 0; d < 4; ++d) { f32x4 acc = {0.f, 0.f, 0.f, 0.f};
#pragma unroll
                for (int ks = 0; ks < 2; ++ks) { const bf16x8 bk = *(const LAS bf16x8*)(hb + HG_K + (16 * d + fr) * HG_PT + 64 * ks + 16 * fg);
                    acc = __builtin_amdgcn_mfma_f32_16x16x32_bf16(av[ks], bk, acc, 0, 0, 0); }
#pragma unroll
                for (int r = 0; r < 4; ++r) su[(16 * a + 4 * fg + r) * 64 + 16 * d + fr] = acc[r];
            } }
        __syncthreads();
    } else {
        float qq[32];
#pragma unroll
        for (int i = 0; i < 32; ++i) qq[i] = bf2f(pr[(size_t)i * NMIX + 768]);
        if (half == 0) { REF[64 + lane] = bb[15]; REF[128 + lane] = bb[31]; } else REF[192 + lane] = bb[15];
        { const u32x4 z = {0u, 0u, 0u, 0u};
#pragma unroll
            for (int k2 = 0; k2 < 5; ++k2) { const int idx = lane + 64 * k2; if (idx < 32 * 9) *(LAS u32x4*)(hb + HG_P + 32 * half * HG_PT + idx * 16) = z; } }
        __syncthreads();
        float rf[4]; rf[0] = 0.f; rf[1] = REF[64 + lane]; rf[2] = REF[128 + lane]; rf[3] = REF[192 + lane];
        {
            const float r_lo = half ? rf[2] : rf[0], r_hi = half ? rf[3] : rf[1];
#pragma unroll
            for (int i = 0; i < 32; ++i) { const float rr = (i < 16) ? r_lo : r_hi; const float val = qq[i] * fast_exp(bb[i] - rr);
                *(LAS bf16_t*)(hb + HG_Q + (32 * half + i) * HG_PT + 2 * lane) = (bf16_t)f2bf(val); }
        }
#pragma unroll
        for (int isub = 0; isub < 4; ++isub) {
            const int nrows = 16 * (isub + 1) - 32 * half;
#pragma unroll
            for (int i = 0; i < 32; ++i) { if (i < nrows) { const float e = fminf(rf[isub] - bb[i], 60.f); const float val = kk[i] * fast_exp(e);
                    *(LAS bf16_t*)(hb + HG_K + (32 * half + i) * HG_PT + 2 * lane) = (bf16_t)f2bf(val); } }
            __syncthreads();
            {
                bf16x8 bq[2];
#pragma unroll
                for (int ks = 0; ks < 2; ++ks) bq[ks] = *(const LAS bf16x8*)(hb + HG_Q + (16 * isub + fr) * HG_PT + 64 * ks + 16 * fg);
#pragma unroll
                for (int j = 0; j <= isub; ++j) { if ((j & 1) == half) {
                        f32x4 acc = {0.f, 0.f, 0.f, 0.f};
#pragma unroll
                        for (int ks = 0; ks < 2; ++ks) { const bf16x8 ak = *(const LAS bf16x8*)(hb + HG_K + (16 * j + fr) * HG_PT + 64 * ks + 16 * fg);
                            acc = __builtin_amdgcn_mfma_f32_16x16x32_bf16(ak, bq[ks], acc, 0, 0, 0); }
                        if (j == isub) {
#pragma unroll
                            for (int r = 0; r < 4; ++r) if (4 * fg + r > fr) acc[r] = 0.f; }
                        u32x2 w; w.x = cvt_pk_bf16(acc[0], acc[1]); w.y = cvt_pk_bf16(acc[2], acc[3]);
                        *(LAS u32x2*)(hb + HG_P + (16 * isub + fr) * HG_PT + 2 * (16 * j + 4 * fg)) = w;
                    } }
            }
            __syncthreads();
        }
        {
            LAS unsigned char* vt = hb + HG_Q + lane * HG_PT + 64 * half;
#pragma unroll
            for (int q4 = 0; q4 < 4; ++q4) { u32x4 wv; unsigned vw[4];
#pragma unroll
                for (int p = 0; p < 4; ++p) { const int i = q4 * 8 + 2 * p; vw[p] = cvt_pk_bf16(vv[i], vv[i + 1]); }
                wv.x = vw[0]; wv.y = vw[1]; wv.z = vw[2]; wv.w = vw[3]; *(LAS u32x4*)(vt + q4 * 16) = wv; }
#pragma unroll
            for (int i = 0; i < 32; ++i) *(LAS bf16_t*)(hb + HG_K + (32 * half + i) * HG_PT + 2 * lane) = (bf16_t)f2bf(qq[i] * fast_exp(bb[i]));
        }
        __syncthreads();
        {
            const bf16_t* st = (const bf16_t*)(A.ws + WS_ST16) + ci * 4096;
            bf16x8 a_st[4][2];
#pragma unroll
            for (int a = 0; a < 4; ++a)
#pragma unroll
                for (int ks = 0; ks < 2; ++ks) a_st[a][ks] = *(const bf16x8*)(st + (16 * a + fr) * 64 + 32 * ks + 8 * fg);
            bf16_t* YS = (bf16_t*)(A.ws + WS_YS);
            const float* gn = A.in[I_HN] + l * 64;
            u32x2 gwv[2][4]; f32x4 gnv[4];
#pragma unroll
            for (int a = 0; a < 4; ++a) { gnv[a] = *(const f32x4*)(gn + 16 * a + 4 * fg);
#pragma unroll
                for (int tt = 0; tt < 2; ++tt) gwv[tt][a] = *(const u32x2*)(PROJ + (m0 + 16 * (2 * half + tt) + fr) * NMIX + 1536 + h * 64 + 16 * a + 4 * fg); }
#pragma unroll
            for (int tt = 0; tt < 2; ++tt) { const int ti = 2 * half + tt;
                bf16x8 bp[2], bqb[2];
#pragma unroll
                for (int ks = 0; ks < 2; ++ks) { bp[ks] = *(const LAS bf16x8*)(hb + HG_P + (16 * ti + fr) * HG_PT + 64 * ks + 16 * fg); bqb[ks] = *(const LAS bf16x8*)(hb + HG_K + (16 * ti + fr) * HG_PT + 64 * ks + 16 * fg); }
                f32x4 o[4]; float ss = 0.f;
#pragma unroll
                for (int a = 0; a < 4; ++a) { f32x4 acc = {0.f, 0.f, 0.f, 0.f};
#pragma unroll
                    for (int ks = 0; ks < 2; ++ks) { const bf16x8 av = *(const LAS bf16x8*)(hb + HG_Q + (16 * a + fr) * HG_PT + 64 * ks + 16 * fg);
                        acc = __builtin_amdgcn_mfma_f32_16x16x32_bf16(av, bp[ks], acc, 0, 0, 0);
                        acc = __builtin_amdgcn_mfma_f32_16x16x32_bf16(a_st[a][ks], bqb[ks], acc, 0, 0, 0); }
                    o[a] = acc; ss += (acc[0] * acc[0] + acc[1] * acc[1]) + (acc[2] * acc[2] + acc[3] * acc[3]); }
                ss += __shfl_xor(ss, 16); ss += __shfl_xor(ss, 32);
                const float rn = 1.0f / sqrtf(ss * (1.0f / 64.0f) + EPS);
                const size_t row = m0 + 16 * ti + fr;
#pragma unroll
                for (int a = 0; a < 4; ++a) { const int dv = 16 * a + 4 * fg;
                    const u32x2 gw = gwv[tt][a];
                    const float g0 = bf2f(gw.x & 0xffffu), g1 = bf2f(gw.x >> 16), g2 = bf2f(gw.y & 0xffffu), g3 = bf2f(gw.y >> 16);
                    const f32x4 gv = gnv[a];
                    const float y0 = o[a][0] * rn * gv[0] * (g0 * sigmoid_f(g0)), y1 = o[a][1] * rn * gv[1] * (g1 * sigmoid_f(g1));
                    const float y2 = o[a][2] * rn * gv[2] * (g2 * sigmoid_f(g2)), y3 = o[a][3] * rn * gv[3] * (g3 * sigmoid_f(g3));
                    u32x2 w; w.x = cvt_pk_bf16(y0, y1); w.y = cvt_pk_bf16(y2, y3);
                    *(u32x2*)(YS + row * D + 512 + h * 64 + dv) = w; }
            }
        }
        __syncthreads();
    }
}

__device__ __forceinline__ void mix_phase2(const Ctx& C, const Args& A) {
    int tid_ = C.tid; asm volatile("" : "+v"(tid_));
    if (C.G == 256) {
        if (C.vcu < 128) {
            float* __restrict__ SU = (float*)(A.ws + WS_SU); const float* __restrict__ SD = (const float*)(A.ws + WS_SD); bf16_t* __restrict__ ST16 = (bf16_t*)(A.ws + WS_ST16);
            const int e0 = C.vcu * NTHREADS + tid_, e1 = e0 + 65536;
            const int bh0 = e0 >> 12, kv0 = e0 & 4095, bh1 = e1 >> 12, kv1 = e1 & 4095;
            float s0 = 0.f, s1 = 0.f;
#pragma unroll 1
            for (int cb = 0; cb < 64; cb += 16) {
                float u0[16], d0[16], u1[16], d1[16];
#pragma unroll
                for (int i = 0; i < 16; ++i) { const size_t c0 = (size_t)bh0 * 64 + cb + i, c1 = (size_t)bh1 * 64 + cb + i;
                    u0[i] = SU[c0 * 4096 + kv0]; d0[i] = SD[c0 * 64 + (kv0 & 63)]; u1[i] = SU[c1 * 4096 + kv1]; d1[i] = SD[c1 * 64 + (kv1 & 63)]; }
#pragma unroll
                for (int i = 0; i < 16; ++i) { const size_t c0 = (size_t)bh0 * 64 + cb + i, c1 = (size_t)bh1 * 64 + cb + i;
                    ST16[c0 * 4096 + kv0] = (bf16_t)f2bf(s0); ST16[c1 * 4096 + kv1] = (bf16_t)f2bf(s1); s0 = d0[i] * s0 + u0[i]; s1 = d1[i] * s1 + u1[i]; }
            }
        } else if (C.vcu < 144) {
            const float* __restrict__ LA = (const float*)(A.ws + WS_LA); const float* __restrict__ LH = (const float*)(A.ws + WS_LH); float* __restrict__ LC = (float*)(A.ws + WS_LC);
            LAS float* SP = (LAS float*)C.lds; LAS float* SH = SP + 512;
            const int cl = tid_ & 127, seg = tid_ >> 7, chain = (C.vcu - 128) * 128 + cl, b = chain >> 8, ch = chain & 255;
            const size_t i0 = ((size_t)b * 128 + seg * 32) * 256 + ch;
            float a[32], hh[32];
#pragma unroll
            for (int i = 0; i < 32; ++i) { a[i] = LA[i0 + (size_t)i * 256]; hh[i] = LH[i0 + (size_t)i * 256]; }
            float P = 1.f, H = 0.f;
#pragma unroll
            for (int i = 0; i < 32; ++i) { H = a[i] * H + hh[i]; P *= a[i]; }
            SP[seg * 128 + cl] = P; SH[seg * 128 + cl] = H;
            __syncthreads();
            float cr = 0.f;
            for (int sg = 0; sg < seg; ++sg) cr = SP[sg * 128 + cl] * cr + SH[sg * 128 + cl];
#pragma unroll
            for (int i = 0; i < 32; ++i) { LC[i0 + (size_t)i * 256] = cr; cr = a[i] * cr + hh[i]; }
            __syncthreads();
        }
        return;
    }
    float* __restrict__ SU = (float*)(A.ws + WS_SU); const float* __restrict__ SD = (const float*)(A.ws + WS_SD);
    const int gt = C.vcu * NTHREADS + tid_, NGT = C.G * NTHREADS;
    for (int e = gt; e < 32 * 4096; e += NGT) {
        const int bh = e >> 12, kv = e & 4095, dk = kv & 63;
        bf16_t* __restrict__ ST16 = (bf16_t*)(A.ws + WS_ST16);
        float s = 0.f;
#pragma unroll 32
        for (int c = 0; c < 64; ++c) { const size_t ci = (size_t)bh * 64 + c; const float u = SU[ci * 4096 + kv]; const float d = SD[ci * 64 + dk]; ST16[ci * 4096 + kv] = (bf16_t)f2bf(s); s = d * s + u; }
    }
    const float* __restrict__ LA = (const float*)(A.ws + WS_LA); const float* __restrict__ LH = (const float*)(A.ws + WS_LH); float* __restrict__ LC = (float*)(A.ws + WS_LC);
    for (int e = gt; e < BATCH * BW; e += NGT) {
        const int b = e >> 8, ch = e & 255; float cr = 0.f;
#pragma unroll 32
        for (int sc = 0; sc < 128; ++sc) { const size_t i = ((size_t)b * 128 + sc) * 256 + ch; const float a = LA[i], hh = LH[i]; LC[i] = cr; cr = a * cr + hh; }
    }
}

#define XB_TMO      128
#define XB_XCNT(j)  (256  + 64 * (j))
#define XB_XSUB(j)  (1280 + 64 * (j))
#define XB_XGEN(j)  (2304 + 64 * (j))
#define XB_TOP      3328
#define XB_TOPGEN   3392
#define XCD_BAR_WORDS 3456
#define XB_SPIN_CAP (1u << 20)
__device__ __forceinline__ unsigned xb_ld(unsigned* p)              { return __hip_atomic_load(p, __ATOMIC_RELAXED, __HIP_MEMORY_SCOPE_AGENT); }
__device__ __forceinline__ unsigned xb_add(unsigned* p, unsigned v) { return __hip_atomic_fetch_add(p, v, __ATOMIC_RELAXED, __HIP_MEMORY_SCOPE_AGENT); }
__device__ __forceinline__ unsigned xb_xcc_id() { return (unsigned)__builtin_amdgcn_s_getreg((3 << 11) | 20) & 0xFu; }
#define XB_SPIN(cond, bar) do { unsigned _sp = 0; while (cond) { __builtin_amdgcn_s_sleep(1); \
    if ((++_sp & 255u) == 0u) { if (xb_ld(&(bar)[XB_TMO])) break; if (_sp > XB_SPIN_CAP) { atomicAdd(&(bar)[XB_TMO], 1u); break; } } } } while (0)
struct XcdBarrier { unsigned* bar; unsigned x; volatile LAS unsigned* st; };
__device__ __forceinline__ XcdBarrier xcd_barrier_post(unsigned* bar, volatile LAS unsigned* st) {
    XcdBarrier b; b.bar = bar; b.x = xb_xcc_id(); b.st = st;
    if (threadIdx.x == 0) (void)xb_add(&bar[XB_XCNT(b.x)], 1u);
    return b;
}
__device__ __forceinline__ void xcd_barrier_complete(unsigned* bar, unsigned x, unsigned& nloc, unsigned& nx) {
    const unsigned G = gridDim.x * gridDim.y * gridDim.z;
    unsigned sum, cnt, mine, sp = 0u;
    for (;;) {
        sum = 0u; cnt = 0u; mine = 0u;
#pragma unroll
        for (unsigned j = 0; j < 16; ++j) { const unsigned c = xb_ld(&bar[XB_XCNT(j)]); sum += c; cnt += (c > 0u) ? 1u : 0u; mine = (j == x) ? c : mine; }
        if (sum == G) break;
        __builtin_amdgcn_s_sleep(1);
        if ((++sp & 255u) == 0u) { if (xb_ld(&bar[XB_TMO])) break; if (sp > XB_SPIN_CAP) { atomicAdd(&bar[XB_TMO], 1u); break; } }
    }
    nloc = mine > 0u ? mine : 1u; nx = cnt > 0u ? cnt : 1u;
}
__device__ __forceinline__ void xcd_barrier(const XcdBarrier& b) {
    asm volatile("s_waitcnt vmcnt(0)" ::: "memory");
    __syncthreads();
    if (threadIdx.x == 0) {
        unsigned* bar = b.bar;
        __builtin_amdgcn_s_waitcnt(0);
        unsigned nloc = b.st[0], nx = b.st[1];
        if (nloc == 0u) { xcd_barrier_complete(bar, b.x, nloc, nx); b.st[0] = nloc; b.st[1] = nx; }
        const unsigned old = xb_add(&bar[XB_XSUB(b.x)], 1u);
        const unsigned gen = old / nloc;
        if (old + 1u == (gen + 1u) * nloc) {
            __builtin_amdgcn_fence(__ATOMIC_RELEASE, "agent");
            asm volatile("s_waitcnt vmcnt(0)" ::: "memory");
            const unsigned og = xb_add(&bar[XB_TOP], 1u);
            const unsigned tg = og / nx;
            if (og + 1u == (tg + 1u) * nx) xb_add(&bar[XB_TOPGEN], 1u);
            else XB_SPIN(xb_ld(&bar[XB_TOPGEN]) == tg, bar);
            __builtin_amdgcn_fence(__ATOMIC_ACQUIRE, "agent");
            xb_add(&bar[XB_XGEN(b.x)], 1u);
            asm volatile("s_waitcnt vmcnt(0)" ::: "memory");
        } else {
            XB_SPIN(xb_ld(&bar[XB_XGEN(b.x)]) == gen, bar);
            __builtin_amdgcn_fence(__ATOMIC_ACQUIRE, "agent");
            asm volatile("s_waitcnt vmcnt(0)" ::: "memory");
        }
    }
    __syncthreads();
}

constexpr int PH_PER_LAYER = 10, N_PHASES = 1 + DEPTH * PH_PER_LAYER;
constexpr int CW_BAR = 4096;
constexpr int CW_SEAM = 16384;
constexpr int CW_SEAM2 = 65536;

__global__ void __launch_bounds__(NTHREADS, 2) trunk_fwd(Args args) {
    extern __shared__ __attribute__((aligned(16))) unsigned char lds_raw[];
    Ctx C;
    C.lds = (LAS unsigned char*)lds_raw; C.tid = threadIdx.x; C.lane = C.tid & 63; C.wave = __builtin_amdgcn_readfirstlane(C.tid >> 6);
    C.G = gridDim.x; { const int bx = blockIdx.x; C.vcu = (C.G % 8 == 0) ? (bx % 8) * (C.G / 8) + bx / 8 : bx; }
    unsigned char* ws = args.ws;
    volatile LAS unsigned* MISC = (volatile LAS unsigned*)(C.lds + MISC_OFF);
    if (C.tid < 64) MISC[C.tid] = 0u;
    __syncthreads();
#if MK_PER_PHASE
#define GRID_BAR() do { } while (0)
#else
    cg::grid_group grid = cg::this_grid();
    XcdBarrier bar = xcd_barrier_post((unsigned*)(ws + WS_CTL) + CW_BAR, MISC + 8);
    bool first_bar = true;
#define GRID_BAR() do { if (first_bar) { grid.sync(); first_bar = false; } else { xcd_barrier(bar); } } while (0)
#endif
    const int lo = args.ph_lo, hi = args.ph_hi;
    int ph = 0;
#define PHASE_BEGIN if (ph >= lo && ph < hi) { for (int rep_ = 0; rep_ < (((DBG_REPEAT >> ((ph - 1) % PH_PER_LAYER + 1)) & 1) && ph > 0 ? 2 : 1); ++rep_) {
#define PHASE_END   if (rep_ == 0 && (((DBG_REPEAT >> ((ph - 1) % PH_PER_LAYER + 1)) & 1) && ph > 0)) GRID_BAR(); } if (ph + 1 < hi && ph + 1 < N_PHASES) GRID_BAR(); } ++ph;

    PHASE_BEGIN p0_prologue(C, args); PHASE_END

    for (int li = 0; li < DEPTH; ++li) {
        int l = li; asm volatile("" : "+s"(l));
        const unsigned char* wl = ws + WS_W + (size_t)l * W_LAYER;
        const float* RS = (const float*)(ws + WS_X2);
        PHASE_BEGIN {
            pg8::StaticOrder S; S.init(ws + WS_HB, wl + W_IN, M, NMIX, D, C.G, (int)blockIdx.x);
            pg8::EpiRow<1> E{(bf16_t*)(ws + WS_PROJ), NMIX, RS};
            pg8::gemm_phase<pg8::EpiRow<1>, pg8::StaticOrder, true>(C.lds, D, S, E);
        } PHASE_END
        PHASE_BEGIN {
            for (int item = C.vcu; item < BATCH * 64; item += C.G) { const int b = item >> 6, c = item & 63;
                mix1_item(C, args, l, b, c);
                hgrn_item<false>(C, args, l, b, c); }
        } PHASE_END
        PHASE_BEGIN {
            mix_phase2(C, args);
            int lane = C.lane; asm volatile("" : "+v"(lane));
            const int gw = C.vcu * NWAVES + C.wave, NGW = C.G * NWAVES;
            if (li == 0) {
                for (int it = gw; it < DEPTH * 2 * 4096; it += NGW) { const int ll = it >> 13, r = it & 8191, n = r & 4095;
                    const unsigned char* wll = ws + WS_W + (size_t)ll * W_LAYER;
                    if (r < 4096) quant_row_i8((const bf16_t*)(wll + W_IN) + (size_t)(NMIX + n) * D, (signed char*)(ws + WS_WG8) + ((size_t)ll * NGATE + n) * D, (float*)(ws + WS_SBG) + ll * NGATE + n, lane);
                    else quant_row_i8((const bf16_t*)(wll + W_UP) + (size_t)n * D, (signed char*)(ws + WS_WU8) + ((size_t)ll * FF + n) * D, (float*)(ws + WS_SBU) + ll * FF + n, lane); }
            }
        } PHASE_END
        PHASE_BEGIN {
            for (int item = C.vcu; item < BATCH * 64; item += C.G) { const int b = item >> 6, c = item & 63;
                lru_final_item(C, args, l, b, c);
                hgrn_item<true>(C, args, l, b, c); }
        } PHASE_END
        PHASE_BEGIN {
            unsigned char* gt = (unsigned char*)(ws + WS_G) + (size_t)blockIdx.x * 8 * 65536;
            {
                int t_ = C.tid; asm volatile("" : "+v"(t_));
                float nv = -1.f; asm volatile("" : "+v"(nv)); const f32x4 neg = {nv, nv, nv, nv};
                for (int i = C.vcu * NTHREADS + t_; i < 2 * M * 4; i += C.G * NTHREADS) *(f32x4*)(ws + (i < M * 4 ? WS_XS0 : WS_XS1 - (size_t)M * 64) + (size_t)i * 16) = neg;
            }
            {
                pg8::GateOrder8 S{(const char*)(ws + WS_HB8), (const char*)(ws + WS_WG8) + (size_t)l * NGATE * D, C.G, C.vcu};
                pg8::EpiGate8 E{gt, RS, (const float*)(ws + WS_SA), (const float*)(ws + WS_SBG) + l * NGATE};
                pg8::gemm_phase<pg8::EpiGate8, pg8::GateOrder8, true, true>(C.lds, D / 2, S, E);
            }
            {
                pg8::MergeOrder S{(const char*)(ws + WS_YS), (const char*)(wl + W_BR), C.G, C.vcu};
                pg8::EpiGate E{gt, (bf16_t*)(ws + WS_MERGED), RS};
                pg8::gemm_phase<pg8::EpiGate, pg8::MergeOrder, true>(C.lds, D, S, E);
            }
        } PHASE_END
        const bool fused_norm = (C.G == 256) && !MK_PER_PHASE;
        if (fused_norm) {
            PHASE_BEGIN {
                { const int half = 0;
                    pg8::PanelOrder S{(const char*)(ws + WS_MERGED), (const char*)(wl + W_OUT), (size_t)pg8::BM * D * 2, D / pg8::BK, half, C.vcu};
                    pg8::EpiNorm E{(bf16_t*)(ws + WS_HB), nullptr, args.in[I_NMIXPOST] + l * D, (float*)(ws + WS_XS0), (float*)(ws + WS_X2), (unsigned*)(ws + WS_CTL) + 8, C.lds + 131072, (signed char*)(ws + WS_HB8), (float*)(ws + WS_SA)};
                    pg8::gemm_phase<pg8::EpiNorm, pg8::PanelOrder, true>(C.lds, D, S, E);
                }
            } PHASE_END
            ++ph;
        } else {
        PHASE_BEGIN {
            pg8::StaticOrder S; S.init(ws + WS_MERGED, wl + W_OUT, M, D, D, C.G, (int)blockIdx.x);
            pg8::EpiRow<0> E{(bf16_t*)(ws + WS_MIX), D, nullptr};
            pg8::gemm_phase<pg8::EpiRow<0>, pg8::StaticOrder, true>(C.lds, D, S, E);
        } PHASE_END
        PHASE_BEGIN norm_phase(C, args, (const bf16_t*)(ws + WS_MIX), args.in[I_NMIXPOST] + l * D, false); PHASE_END
        }
        PHASE_BEGIN {
            pg8::StaticOrder S; S.init(ws + WS_HB8, ws + WS_WU8 + (size_t)l * FF * D, M, FF, D / 2, C.G, (int)blockIdx.x);
            pg8::EpiUp8 E{(bf16_t*)(ws + WS_HID), FF, RS, (const float*)(ws + WS_SA), (const float*)(ws + WS_SBU) + l * FF};
            pg8::gemm_phase<pg8::EpiUp8, pg8::StaticOrder, true, true>(C.lds, D / 2, S, E);
        } PHASE_END
        if (fused_norm) {
            PHASE_BEGIN {
                { const int half = 0;
                    pg8::PanelOrder S{(const char*)(ws + WS_HID), (const char*)(wl + W_DOWN), (size_t)pg8::BM * FF * 2, FF / pg8::BK, half, C.vcu};
                    pg8::EpiNorm E{(bf16_t*)(ws + WS_HB), (li == DEPTH - 1) ? args.out : nullptr, args.in[I_NMLPPOST] + l * D, (float*)(ws + WS_XS1), (float*)(ws + WS_X2), (unsigned*)(ws + WS_CTL) + 8, C.lds + 131072, (signed char*)(ws + WS_HB8), (float*)(ws + WS_SA)};
                    pg8::gemm_phase<pg8::EpiNorm, pg8::PanelOrder, true>(C.lds, FF, S, E);
                }
            } PHASE_END
            ++ph;
        } else {
        PHASE_BEGIN {
            pg8::StaticOrder S; S.init(ws + WS_HID, wl + W_DOWN, M, D, FF, C.G, (int)blockIdx.x);
            pg8::EpiRow<0> E{(bf16_t*)(ws + WS_MOUT), D, nullptr};
            pg8::gemm_phase<pg8::EpiRow<0>, pg8::StaticOrder, true>(C.lds, FF, S, E);
        } PHASE_END
        PHASE_BEGIN norm_phase(C, args, (const bf16_t*)(ws + WS_MOUT), args.in[I_NMLPPOST] + l * D, li == DEPTH - 1); PHASE_END
        }
    }
}

extern "C" void kernel_launch(void* const* d_in, const int* in_sizes, int n_in, void* d_out, int out_size, void* d_ws, size_t ws_size, hipStream_t stream) {
    static int grid = 0;
    if (grid == 0) {
        if (n_in != 22 || in_sizes[0] != M * D || out_size != M * D || ws_size < WS_END) { fprintf(stderr, "kernel_launch: unexpected shapes (n_in %d, in0 %d, out %d, ws %zu)\n", n_in, n_in > 0 ? in_sizes[0] : -1, out_size, ws_size); grid = -1; return; }
        int dev = 0, cus = 0, per_cu = 0;
        if (hipGetDevice(&dev) != hipSuccess || hipDeviceGetAttribute(&cus, hipDeviceAttributeMultiprocessorCount, dev) != hipSuccess) { grid = -1; return; }
        if (hipFuncSetAttribute((const void*)trunk_fwd, hipFuncAttributeMaxDynamicSharedMemorySize, LDS_BYTES) != hipSuccess) { fprintf(stderr, "kernel_launch: hipFuncSetAttribute failed\n"); grid = -1; return; }
        if (hipOccupancyMaxActiveBlocksPerMultiprocessor(&per_cu, (const void*)trunk_fwd, NTHREADS, LDS_BYTES) != hipSuccess || per_cu < 1) { fprintf(stderr, "kernel_launch: occupancy query says %d blocks per CU\n", per_cu); (void)hipGetLastError(); grid = -1; return; }
        grid = cus;
    }
    if (grid < 0) return;
    (void)hipMemsetAsync((char*)d_ws + WS_CTL, 0, CTL_ZERO_BYTES, stream);
    Args a{};
    for (int i = 0; i < 22; ++i) a.in[i] = (const float*)d_in[i];
    a.out = (float*)d_out; a.ws = (unsigned char*)d_ws;
#if MK_PER_PHASE
#ifndef DBG_MAXPH
#define DBG_MAXPH N_PHASES
#endif
    for (int p = 0; p < DBG_MAXPH; ++p) { a.ph_lo = p; a.ph_hi = p + 1; hipLaunchKernelGGL(trunk_fwd, dim3(grid), dim3(NTHREADS), LDS_BYTES, stream, a); }
#else
#if DBG_PREFIX > 0
    { a.ph_lo = 0; a.ph_hi = DBG_PREFIX; void* kargs0[] = {&a};
      (void)hipLaunchCooperativeKernel((const void*)trunk_fwd, dim3(grid), dim3(NTHREADS), kargs0, LDS_BYTES, stream);
      (void)hipMemsetAsync((char*)d_ws + WS_CTL, 0, CTL_ZERO_BYTES, stream); }
#endif
    a.ph_lo = 0; a.ph_hi = N_PHASES;
    void* kargs[] = {&a};
    hipError_t e = hipLaunchCooperativeKernel((const void*)trunk_fwd, dim3(grid), dim3(NTHREADS), kargs, LDS_BYTES, stream);
    if (e != hipSuccess) fprintf(stderr, "kernel_launch: cooperative launch failed: %s (grid %d)\n", hipGetErrorString(e), grid);
#endif
}
```

```cpp
#include <hip/hip_runtime.h>
#include <hip/hip_cooperative_groups.h>
#include <cstdio>
#include <cstdint>
namespace cg = cooperative_groups;

#ifndef DBG_ZERO
#define DBG_ZERO -1
#endif
#ifndef DBG_REPEAT
#define DBG_REPEAT 0
#endif
#ifndef MK_PER_PHASE
#define MK_PER_PHASE 0
#endif
#ifndef DBG_PREFIX
#define DBG_PREFIX 0
#endif

#define LAS __attribute__((address_space(3)))
#define GAS __attribute__((address_space(1)))
typedef unsigned short bf16_t;
typedef short bf16x8 __attribute__((ext_vector_type(8)));
typedef float f32x4 __attribute__((ext_vector_type(4)));
typedef float f32x2 __attribute__((ext_vector_type(2)));
typedef unsigned u32x4 __attribute__((ext_vector_type(4)));
typedef unsigned u32x2 __attribute__((ext_vector_type(2)));

constexpr int BATCH = 8, T = 4096, D = 1024, M = BATCH * T, DEPTH = 2, BW = 256;
constexpr int NMIX = 2560, NGATE = 4096, INW = NMIX + NGATE, FF = 4096;
constexpr float EPS = 1e-6f;
constexpr int NWAVES = 8, NTHREADS = 512;

constexpr size_t MiB = 1u << 20;
constexpr size_t WS_CTL = 0, CTL_ZERO_BYTES = 1 * MiB;
constexpr size_t WS_XM = 1 * MiB;
constexpr size_t WS_SD = 1 * MiB + 512 * 1024;
constexpr size_t WS_LA = 2 * MiB, WS_LH = 3 * MiB, WS_LC = 4 * MiB;
constexpr size_t WS_SP8 = 7 * MiB;
constexpr size_t WS_X1 = 5 * MiB;
constexpr size_t WS_X2 = 6 * MiB;
constexpr size_t WS_W = 8 * MiB;
constexpr size_t W_IN = 0, W_BR = 13 * MiB, W_OUT = 15 * MiB, W_UP = 17 * MiB, W_DOWN = 25 * MiB, W_LAYER = 33 * MiB;
constexpr size_t WS_HB = 76 * MiB;
constexpr size_t WS_PROJ = 140 * MiB;
constexpr size_t WS_G = WS_PROJ;
constexpr size_t WS_YS = 300 * MiB;
constexpr size_t WS_MERGED = 364 * MiB;
constexpr size_t WS_SU = WS_MERGED;
constexpr size_t WS_MIX = WS_PROJ;
constexpr size_t WS_MOUT = 396 * MiB;
constexpr size_t WS_HID = WS_PROJ;
constexpr size_t WS_HB8 = 460 * MiB;
constexpr size_t WS_WG8 = 492 * MiB;
constexpr size_t WS_SA = 7 * MiB + 64 * 1024;
constexpr size_t WS_SBG = 7 * MiB + 256 * 1024;
constexpr size_t WS_SBU = 7 * MiB + 320 * 1024;
constexpr size_t WS_WU8 = 500 * MiB;
constexpr size_t WS_XS0 = 428 * MiB, WS_XS1 = 444 * MiB;
constexpr size_t WS_END = 508 * MiB;

constexpr int LDS_BYTES = 155648;
constexpr int MISC_OFF = 154624;

__device__ __forceinline__ float bf2f(unsigned b) { return __uint_as_float(b << 16); }
__device__ __forceinline__ unsigned f2bf(float f) { unsigned u = __float_as_uint(f); return (u + 0x7fffu + ((u >> 16) & 1u)) >> 16; }
__device__ __forceinline__ unsigned pk2(float lo, float hi) { return f2bf(lo) | (f2bf(hi) << 16); }
typedef __bf16 bf16x2_t __attribute__((ext_vector_type(2)));
__device__ __forceinline__ unsigned cvt_pk_bf16(float lo, float hi) { f32x2 v = {lo, hi}; bf16x2_t b = __builtin_convertvector(v, bf16x2_t); return __builtin_bit_cast(unsigned, b); }
__device__ __forceinline__ float fast_exp(float x) { return __builtin_amdgcn_exp2f(x * 1.4426950408889634f); }
__device__ __forceinline__ float sigmoid_f(float x) { return __builtin_amdgcn_rcpf(1.0f + fast_exp(-x)); }
__device__ __forceinline__ void ld8bf(const bf16_t* p, float (&o)[8]) {
    const u32x4 v = *(const u32x4*)p;
    o[0] = bf2f(v.x & 0xffffu); o[1] = bf2f(v.x >> 16); o[2] = bf2f(v.y & 0xffffu); o[3] = bf2f(v.y >> 16);
    o[4] = bf2f(v.z & 0xffffu); o[5] = bf2f(v.z >> 16); o[6] = bf2f(v.w & 0xffffu); o[7] = bf2f(v.w >> 16);
}
__device__ __forceinline__ float rs_of(const float* X2, int row) { const f32x4 x = *(const f32x4*)(X2 + (size_t)row * 4); return 1.0f / sqrtf(((x[0] + x[1]) + (x[2] + x[3])) * (1.0f / D) + EPS); }
typedef int i32x4 __attribute__((ext_vector_type(4)));
__device__ __forceinline__ void rs_of8(const float* X2, int row0, float (&o)[2][4]) {
    const float* p = X2 + (size_t)row0 * 4; f32x4 v[2][4];
    asm volatile("global_load_dwordx4 %0, %8, off\n\tglobal_load_dwordx4 %1, %8, off offset:256\n\tglobal_load_dwordx4 %2, %8, off offset:512\n\tglobal_load_dwordx4 %3, %8, off offset:768\n\t"
                 "global_load_dwordx4 %4, %8, off offset:2048\n\tglobal_load_dwordx4 %5, %8, off offset:2304\n\tglobal_load_dwordx4 %6, %8, off offset:2560\n\tglobal_load_dwordx4 %7, %8, off offset:2816\n\ts_waitcnt vmcnt(0)"
                 : "=&v"(v[0][0]), "=&v"(v[0][1]), "=&v"(v[0][2]), "=&v"(v[0][3]), "=&v"(v[1][0]), "=&v"(v[1][1]), "=&v"(v[1][2]), "=&v"(v[1][3]) : "v"(p) : "memory");
#pragma unroll
    for (int ai = 0; ai < 2; ++ai)
#pragma unroll
        for (int m = 0; m < 4; ++m) { const f32x4 x = v[ai][m]; o[ai][m] = 1.0f / sqrtf(((x[0] + x[1]) + (x[2] + x[3])) * (1.0f / D) + EPS); }
}
__device__ __forceinline__ void ld_f32x8_rows(const float* SA_, int row0, float (&o)[2][4]) {
    const float* p = SA_ + row0;
    asm volatile("global_load_dword %0, %8, off\n\tglobal_load_dword %1, %8, off offset:64\n\tglobal_load_dword %2, %8, off offset:128\n\tglobal_load_dword %3, %8, off offset:192\n\t"
                 "global_load_dword %4, %8, off offset:512\n\tglobal_load_dword %5, %8, off offset:576\n\tglobal_load_dword %6, %8, off offset:640\n\tglobal_load_dword %7, %8, off offset:704\n\ts_waitcnt vmcnt(0)"
                 : "=&v"(o[0][0]), "=&v"(o[0][1]), "=&v"(o[0][2]), "=&v"(o[0][3]), "=&v"(o[1][0]), "=&v"(o[1][1]), "=&v"(o[1][2]), "=&v"(o[1][3]) : "v"(p) : "memory");
}
__device__ __forceinline__ void quant_row_i8(const bf16_t* src, signed char* dst, float* scale_out, int lane) {
    float x[16]; ld8bf(src + 16 * lane, *(float(*)[8])&x[0]); ld8bf(src + 16 * lane + 8, *(float(*)[8])&x[8]);
    float mx = 0.f;
#pragma unroll
    for (int j = 0; j < 16; ++j) mx = fmaxf(mx, fabsf(x[j]));
#pragma unroll
    for (int o = 1; o < 64; o <<= 1) mx = fmaxf(mx, __shfl_xor(mx, o));
    const float sc = (mx > 0.f) ? mx * (1.0f / 127.0f) : 1.0f, inv = 1.0f / sc;
    unsigned w[4];
#pragma unroll
    for (int p = 0; p < 4; ++p) { unsigned v = 0u;
#pragma unroll
        for (int e = 0; e < 4; ++e) { const int q = (int)__builtin_rintf(x[4 * p + e] * inv); v |= ((unsigned)q & 0xffu) << (8 * e); }
        w[p] = v; }
    *(u32x4*)(dst + 16 * lane) = (u32x4){w[0], w[1], w[2], w[3]};
    if (lane == 0) *scale_out = sc;
}
__device__ __forceinline__ unsigned q4_i8(const f32x4 v, float inv) { unsigned w = 0u;
#pragma unroll
    for (int e = 0; e < 4; ++e) { const int q = (int)__builtin_rintf(v[e] * inv); w |= ((unsigned)q & 0xffu) << (8 * e); }
    return w; }
__device__ __forceinline__ float wave_sum(float v) {
#pragma unroll
    for (int o = 1; o < 64; o <<= 1) v += __shfl_xor(v, o);
    return v;
}

namespace pg8 {
constexpr int BM = 256, BK = 64, HALF = 128, HTB = HALF * BK * 2, STAGE_BYTES = 8 * HTB, NXCD = 8, WGM = 4;
__host__ __device__ __forceinline__ int lds_byte(int r, int c) { const int st = (r >> 4) * 2 + (c >> 5), rr = r & 15, cc = c & 31, ob = rr * 64 + cc * 2; return st * 1024 + (ob ^ (((ob >> 9) & 1) << 5)); }
__host__ __device__ __forceinline__ void stage_rc(int b, int& R, int& C) { const int st = b / 1024, sb = b % 1024, swz = sb ^ (((sb >> 9) & 1) << 5); R = (st >> 1) * 16 + swz / 64; C = (st & 1) * 32 + (swz % 64) / 2; }
__host__ __device__ __forceinline__ int perm32(int rho) { const int n = rho >> 4, i = rho & 15; return 8 * (i >> 2) + 4 * n + (i & 3); }

struct Unit { int pm, pn, kind; };

struct StaticOrder {
    const char* A; const char* Bt; size_t tstep;
    int nM, nN, nwg, G, c;
    __device__ void init(const void* A_, const void* Bt_, int M_, int N_, int K_, int G_, int c_) { A = (const char*)A_; Bt = (const char*)Bt_; tstep = (size_t)BM * K_ * 2; nt = K_ / BK; nM = M_ / BM; nN = N_ / BM; nwg = nM * nN; G = G_; c = c_; }
    __device__ bool next(int i, Unit& u) const {
        const long L = (long)i * G + c; if (L >= nwg) return false;
        int wgid = (int)L; { const int q = nwg / NXCD, r = nwg % NXCD, xcd = wgid % NXCD, off = wgid / NXCD; wgid = (xcd < r ? xcd * (q + 1) : r * (q + 1) + (xcd - r) * q) + off; }
        const int nig = WGM * nN, gid = wgid / nig, fm = gid * WGM, gsz = (nM - fm) < WGM ? (nM - fm) : WGM;
        u.pm = fm + ((wgid % nig) % gsz); u.pn = (wgid % nig) / gsz; u.kind = 0; return true;
    }
    __device__ __forceinline__ void tiles(const Unit& u, const char*& a, const char*& b) const { a = A + (size_t)u.pm * tstep; b = Bt + (size_t)u.pn * tstep; }
    int nt;
    __device__ __forceinline__ int ntiles(const Unit&) const { return nt; }
    __device__ __forceinline__ bool keep_acc(const Unit&) const { return false; }
};

struct GateOrder {
    const char* HB; const char* WGt; const char* YS; const char* WB; int G, vcu;
    __device__ bool next(int i, Unit& u) const {
        const int r = i / 16, ii = i % 16, su = vcu + r * G; if (su >= 256) return false;
        const int half = ii / 8, j = ii % 8;
        u.pm = half * 64 + (su >> 2); u.kind = j; u.pn = (j < 4) ? (j * 4 + (su & 3)) : (su & 3); return true;
    }
    __device__ __forceinline__ int ntiles(const Unit& u) const { return u.kind < 4 ? 16 : 4; }
    __device__ __forceinline__ bool keep_acc(const Unit& nx) const { return nx.kind > 4; }
    __device__ __forceinline__ void tiles(const Unit& u, const char*& a, const char*& b) const {
        const size_t ts = (size_t)BM * 1024 * 2;
        if (u.kind < 4) { a = HB + (size_t)u.pm * ts; b = WGt + (size_t)u.pn * ts; } else { a = YS + (size_t)u.pm * ts + (size_t)(u.kind - 4) * 512; b = WB + (size_t)u.pn * ts + (size_t)(u.kind - 4) * 512; }
    }
};

struct GateOrder8 {
    const char* HB8; const char* WG8; int G, vcu;
    __device__ bool next(int i, Unit& u) const {
        const int r = i / 8, ii = i % 8, su = vcu + r * G; if (su >= 256) return false;
        u.pm = (ii >> 2) * 64 + (su >> 2); u.kind = ii; u.pn = (ii & 3) * 4 + (su & 3); return true;
    }
    __device__ __forceinline__ int ntiles(const Unit&) const { return 8; }
    __device__ __forceinline__ bool keep_acc(const Unit&) const { return false; }
    __device__ __forceinline__ void tiles(const Unit& u, const char*& a, const char*& b) const { a = HB8 + (size_t)u.pm * 262144; b = WG8 + (size_t)u.pn * 262144; }
};
struct MergeOrder {
    const char* YS; const char* WB; int G, vcu;
    __device__ bool next(int i, Unit& u) const {
        const int r = i / 8, ii = i % 8, su = vcu + r * G; if (su >= 256) return false;
        u.pm = (ii >> 2) * 64 + (su >> 2); u.kind = 4 + (ii & 3); u.pn = su & 3; return true;
    }
    __device__ __forceinline__ int ntiles(const Unit&) const { return 4; }
    __device__ __forceinline__ bool keep_acc(const Unit& nx) const { return nx.kind > 4; }
    __device__ __forceinline__ void tiles(const Unit& u, const char*& a, const char*& b) const {
        const size_t ts = (size_t)BM * 1024 * 2; a = YS + (size_t)u.pm * ts + (size_t)(u.kind - 4) * 512; b = WB + (size_t)u.pn * ts + (size_t)(u.kind - 4) * 512; }
};

template <int MODE  > struct EpiRow {
    static constexpr bool PERM = true;
    bf16_t* O; int ldc; const float* rs;
    __device__ __forceinline__ void operator()(f32x4 (&acc)[2][2][4][2], const Unit& u, int wr, int wc, int fr, int fq) const {
        const int row0 = u.pm * BM + wr * 64 + fr, col0 = u.pn * BM + wc * 32 + 8 * fq;
        float scv[2][4];
        if (MODE != 0) rs_of8(rs, row0, scv);
#pragma unroll
        for (int ai = 0; ai < 2; ++ai)
#pragma unroll
            for (int m = 0; m < 4; ++m) {
                const int row = row0 + ai * HALF + m * 16; const float sc = scv[ai][m];
                bf16_t* rowp = O + (size_t)row * ldc + col0;
#pragma unroll
                for (int bj = 0; bj < 2; ++bj) {
                    f32x4 v0 = acc[ai][bj][m][0], v1 = acc[ai][bj][m][1];
                    if (MODE != 0) { v0 = v0 * sc; v1 = v1 * sc; }
                    if (MODE == 2) {
#pragma unroll
                        for (int j = 0; j < 4; ++j) { const float a = fmaxf(v0[j], 0.f), b = fmaxf(v1[j], 0.f); v0[j] = a * a; v1[j] = b * b; }
                    }
                    u32x4 w; w.x = cvt_pk_bf16(v0[0], v0[1]); w.y = cvt_pk_bf16(v0[2], v0[3]); w.z = cvt_pk_bf16(v1[0], v1[1]); w.w = cvt_pk_bf16(v1[2], v1[3]);
                    __builtin_nontemporal_store(w, (u32x4*)(rowp + bj * HALF));
                }
            }
    }
};

__device__ __forceinline__ unsigned pack_u8x4(float a, float b, float c, float d) { unsigned w = 0u;
    w = __builtin_amdgcn_cvt_pk_u8_f32(a * 256.0f - 0.5f, 0, w); w = __builtin_amdgcn_cvt_pk_u8_f32(b * 256.0f - 0.5f, 1, w); w = __builtin_amdgcn_cvt_pk_u8_f32(c * 256.0f - 0.5f, 2, w); w = __builtin_amdgcn_cvt_pk_u8_f32(d * 256.0f - 0.5f, 3, w); return w; }
__device__ __forceinline__ f32x4 unpack_u8x4(unsigned w) { return (f32x4){(float)(w & 0xffu) + 0.5f, (float)((w >> 8) & 0xffu) + 0.5f, (float)((w >> 16) & 0xffu) + 0.5f, (float)(w >> 24) + 0.5f}; }
struct EpiGate {
    static constexpr bool PERM = true;
    unsigned char* Gt;
    bf16_t* MERGED;
    const float* rs;
    __device__ __forceinline__ void rescale(f32x4 (&acc)[2][2][4][2], int hsel, int j, int wr, int wc, int fr, int fq) const {
        int lane_off = (wr * 64 + fr) * 256 + wc * 32 + 8 * fq; asm volatile("" : "+v"(lane_off));
        const unsigned char* g0 = Gt + (size_t)(hsel * 4 + j) * 65536; const unsigned char* g1 = g0 + 65536;
#pragma unroll
        for (int ai = 0; ai < 2; ++ai) {
            u32x2 a[4][2], b[4][2];
#pragma unroll
            for (int m = 0; m < 4; ++m)
#pragma unroll
                for (int bj = 0; bj < 2; ++bj) { const int off = lane_off + (ai * HALF + m * 16) * 256 + bj * HALF; a[m][bj] = *(const u32x2*)(g0 + off); b[m][bj] = *(const u32x2*)(g1 + off); }
#pragma unroll
            for (int m = 0; m < 4; ++m)
#pragma unroll
                for (int bj = 0; bj < 2; ++bj) {
                    const f32x4 a0 = unpack_u8x4(a[m][bj].x), a1 = unpack_u8x4(a[m][bj].y), b0 = unpack_u8x4(b[m][bj].x), b1 = unpack_u8x4(b[m][bj].y);
#pragma unroll
                    for (int q = 0; q < 4; ++q) { acc[ai][bj][m][0][q] *= a0[q] * __builtin_amdgcn_rcpf(b0[q]); acc[ai][bj][m][1][q] *= a1[q] * __builtin_amdgcn_rcpf(b1[q]); }
                }
            asm volatile("" ::: "memory");
        }
    }
    __device__ __forceinline__ void operator()(f32x4 (&acc)[2][2][4][2], const Unit& u, int wr, int wc, int fr, int fq) const {
        if (u.kind >= 4 && u.kind < 7) { rescale(acc, u.pm >> 6, u.kind - 4, wr, wc, fr, fq); return; }
        int rl0 = wr * 64 + fr, cl0 = wc * 32 + 8 * fq; asm volatile("" : "+v"(rl0), "+v"(cl0));
        if (u.kind < 4) {
            unsigned char* gt = Gt + (size_t)u.kind * 65536;
#pragma unroll
            for (int ai = 0; ai < 2; ++ai)
#pragma unroll
                for (int m = 0; m < 4; ++m) {
                    const int rl = rl0 + ai * HALF + m * 16; const float sc = rs_of(rs, u.pm * BM + rl);
#pragma unroll
                    for (int bj = 0; bj < 2; ++bj) {
                        f32x4 v0 = acc[ai][bj][m][0] * sc, v1 = acc[ai][bj][m][1] * sc;
#pragma unroll
                        for (int j = 0; j < 4; ++j) { v0[j] = sigmoid_f(fmaxf(v0[j], -60.f)); v1[j] = sigmoid_f(fmaxf(v1[j], -60.f)); }
                        u32x2 w; w.x = pack_u8x4(v0[0], v0[1], v0[2], v0[3]); w.y = pack_u8x4(v1[0], v1[1], v1[2], v1[3]);
                        *(u32x2*)(gt + rl * 256 + cl0 + bj * HALF) = w;
                    }
                }
        } else {
            const unsigned char* g3 = Gt + (size_t)((u.pm >> 6) * 4 + 3) * 65536;
#pragma unroll
            for (int ai = 0; ai < 2; ++ai) {
                u32x2 swv[4][2];
#pragma unroll
                for (int m = 0; m < 4; ++m)
#pragma unroll
                    for (int bj = 0; bj < 2; ++bj) swv[m][bj] = *(const u32x2*)(g3 + (rl0 + ai * HALF + m * 16) * 256 + cl0 + bj * HALF);
#pragma unroll
                for (int m = 0; m < 4; ++m) {
                    const int rl = rl0 + ai * HALF + m * 16;
                    bf16_t* rowp = MERGED + (size_t)(u.pm * BM + rl) * 1024 + u.pn * BM + cl0;
#pragma unroll
                    for (int bj = 0; bj < 2; ++bj) {
                        const u32x2 sw = swv[m][bj];
                        const f32x4 s0 = unpack_u8x4(sw.x) * (1.0f / 256.0f), s1 = unpack_u8x4(sw.y) * (1.0f / 256.0f);
                        const f32x4 v0 = acc[ai][bj][m][0] * s0, v1 = acc[ai][bj][m][1] * s1;
                        u32x4 w; w.x = cvt_pk_bf16(v0[0], v0[1]); w.y = cvt_pk_bf16(v0[2], v0[3]); w.z = cvt_pk_bf16(v1[0], v1[1]); w.w = cvt_pk_bf16(v1[2], v1[3]);
                        *(u32x4*)(rowp + bj * HALF) = w;
                    }
                }
            }
        }
    }
};

struct EpiGate8 {
    static constexpr bool PERM = true;
    unsigned char* Gt;
    const float* rs; const float* sa; const float* sb;
    __device__ __forceinline__ void operator()(f32x4 (&acc)[2][2][4][2], const Unit& u, int wr, int wc, int fr, int fq) const {
        int rl0 = wr * 64 + fr, cl0 = wc * 32 + 8 * fq; asm volatile("" : "+v"(rl0), "+v"(cl0));
        unsigned char* gt = Gt + (size_t)u.kind * 65536;
        f32x4 cs[2][2];
#pragma unroll
        for (int bj = 0; bj < 2; ++bj) { cs[bj][0] = *(const f32x4*)(sb + u.pn * BM + cl0 + bj * HALF); cs[bj][1] = *(const f32x4*)(sb + u.pn * BM + cl0 + bj * HALF + 4); }
        float scv[2][4], rsv[2][4], sav[2][4];
        rs_of8(rs, u.pm * BM + rl0, rsv); ld_f32x8_rows(sa, u.pm * BM + rl0, sav);
#pragma unroll
        for (int ai = 0; ai < 2; ++ai)
#pragma unroll
            for (int m = 0; m < 4; ++m) scv[ai][m] = -1.4426950408889634f * rsv[ai][m] * sav[ai][m];
#pragma unroll
        for (int ai = 0; ai < 2; ++ai)
#pragma unroll
            for (int m = 0; m < 4; ++m) {
                const int rl = rl0 + ai * HALF + m * 16; const float sc = scv[ai][m];
#pragma unroll
                for (int bj = 0; bj < 2; ++bj) {
                    const i32x4 i0 = __builtin_bit_cast(i32x4, acc[ai][bj][m][0]), i1 = __builtin_bit_cast(i32x4, acc[ai][bj][m][1]);
                    f32x4 v0, v1;
#pragma unroll
                    for (int j = 0; j < 4; ++j) { v0[j] = __builtin_amdgcn_rcpf(1.0f + __builtin_amdgcn_exp2f((float)i0[j] * (sc * cs[bj][0][j]))); v1[j] = __builtin_amdgcn_rcpf(1.0f + __builtin_amdgcn_exp2f((float)i1[j] * (sc * cs[bj][1][j]))); }
                    u32x2 w; w.x = pack_u8x4(v0[0], v0[1], v0[2], v0[3]); w.y = pack_u8x4(v1[0], v1[1], v1[2], v1[3]);
                    *(u32x2*)(gt + rl * 256 + cl0 + bj * HALF) = w;
                }
            }
    }
};

struct EpiUp8 {
    static constexpr bool PERM = true;
    bf16_t* O; int ldc; const float* rs; const float* sa; const float* sb;
    __device__ __forceinline__ void operator()(f32x4 (&acc)[2][2][4][2], const Unit& u, int wr, int wc, int fr, int fq) const {
        int rl0 = wr * 64 + fr, cl0 = wc * 32 + 8 * fq; asm volatile("" : "+v"(rl0), "+v"(cl0));
        f32x4 cs[2][2];
#pragma unroll
        for (int bj = 0; bj < 2; ++bj) { cs[bj][0] = *(const f32x4*)(sb + u.pn * BM + cl0 + bj * HALF); cs[bj][1] = *(const f32x4*)(sb + u.pn * BM + cl0 + bj * HALF + 4); }
        float scv[2][4], rsv[2][4], sav[2][4];
        rs_of8(rs, u.pm * BM + rl0, rsv); ld_f32x8_rows(sa, u.pm * BM + rl0, sav);
#pragma unroll
        for (int ai = 0; ai < 2; ++ai)
#pragma unroll
            for (int m = 0; m < 4; ++m) scv[ai][m] = rsv[ai][m] * sav[ai][m];
#pragma unroll
        for (int ai = 0; ai < 2; ++ai)
#pragma unroll
            for (int m = 0; m < 4; ++m) {
                const int row = u.pm * BM + rl0 + ai * HALF + m * 16; const float sc = scv[ai][m];
                bf16_t* rowp = O + (size_t)row * ldc + u.pn * BM + cl0;
#pragma unroll
                for (int bj = 0; bj < 2; ++bj) {
                    const i32x4 i0 = __builtin_bit_cast(i32x4, acc[ai][bj][m][0]), i1 = __builtin_bit_cast(i32x4, acc[ai][bj][m][1]);
                    f32x4 v0, v1;
#pragma unroll
                    for (int j = 0; j < 4; ++j) { const float a = fmaxf((float)i0[j] * (sc * cs[bj][0][j]), 0.f), b = fmaxf((float)i1[j] * (sc * cs[bj][1][j]), 0.f); v0[j] = a * a; v1[j] = b * b; }
                    u32x4 w; w.x = cvt_pk_bf16(v0[0], v0[1]); w.y = cvt_pk_bf16(v0[2], v0[3]); w.z = cvt_pk_bf16(v1[0], v1[1]); w.w = cvt_pk_bf16(v1[2], v1[3]);
                    __builtin_nontemporal_store(w, (u32x4*)(rowp + bj * HALF));
                }
            }
    }
};

struct PanelOrder {
    const char* A; const char* Bt; size_t tstep; int nt, half, vcu;
    __device__ bool next(int i, Unit& u) const { if (i > 1) return false; u.pm = i * 64 + (vcu >> 2); u.pn = vcu & 3; u.kind = 0; return true; }
    __device__ __forceinline__ void tiles(const Unit& u, const char*& a, const char*& b) const { a = A + (size_t)u.pm * tstep; b = Bt + (size_t)u.pn * tstep; }
    __device__ __forceinline__ int ntiles(const Unit&) const { return nt; }
    __device__ __forceinline__ bool keep_acc(const Unit&) const { return false; }
};
__device__ __forceinline__ void st_sys16(float* p, f32x4 v) { asm volatile("global_store_dwordx4 %0, %1, off sc0 sc1" :: "v"(p), "v"(v) : "memory"); }
__device__ __forceinline__ void ld_sys16x4(const float* p, f32x4 (&v)[4]) {
    asm volatile("global_load_dwordx4 %0, %4, off sc0 sc1\n\tglobal_load_dwordx4 %1, %4, off offset:16 sc0 sc1\n\tglobal_load_dwordx4 %2, %4, off offset:32 sc0 sc1\n\tglobal_load_dwordx4 %3, %4, off offset:48 sc0 sc1\n\ts_waitcnt vmcnt(0)"
                 : "=&v"(v[0]), "=&v"(v[1]), "=&v"(v[2]), "=&v"(v[3]) : "v"(p) : "memory"); }
struct EpiNorm {
    static constexpr bool PERM = true;
    bf16_t* HB; float* OUTF; const float* gain; float* XS; float* X2; unsigned* tmo; LAS unsigned char* sp;
    signed char* HB8; float* SA;
    __device__ __forceinline__ void operator()(f32x4 (&acc)[2][2][4][2], const Unit& u, int wr, int wc, int fr, int fq) const {
        LAS float* P = (LAS float*)sp;
        LAS float* PM = (LAS float*)(sp + 4096);
        LAS float* PB = (LAS float*)(sp + 8192);
        LAS float* R = (LAS float*)(sp + 12288);
        LAS float* RI = (LAS float*)(sp + 13312);
        LAS float* P2 = (LAS float*)(sp + 14336);
        const int tid = (wr * 4 + wc) * 64 + fq * 16 + fr;
        int rl0 = wr * 64 + fr, cl0 = wc * 32 + 8 * fq; asm volatile("" : "+v"(rl0), "+v"(cl0));
        f32x4 gv[2][2];
#pragma unroll
        for (int bj = 0; bj < 2; ++bj) { gv[bj][0] = *(const f32x4*)(gain + u.pn * BM + cl0 + bj * HALF); gv[bj][1] = *(const f32x4*)(gain + u.pn * BM + cl0 + bj * HALF + 4); }
#pragma unroll
        for (int ai = 0; ai < 2; ++ai)
#pragma unroll
            for (int m = 0; m < 4; ++m) { float s = 0.f;
#pragma unroll
                for (int bj = 0; bj < 2; ++bj)
#pragma unroll
                    for (int n = 0; n < 2; ++n) { const f32x4 x = acc[ai][bj][m][n]; s += (x[0] * x[0] + x[1] * x[1]) + (x[2] * x[2] + x[3] * x[3]); }
                s += __shfl_xor(s, 16); s += __shfl_xor(s, 32);
                if (fq == 0) P[(ai * HALF + wr * 64 + m * 16 + fr) * 4 + wc] = s; }
        asm volatile("s_waitcnt lgkmcnt(0)" ::: "memory"); __builtin_amdgcn_s_barrier(); asm volatile("" ::: "memory");
#pragma unroll
        for (int ai = 0; ai < 2; ++ai) {
            u32x4 hw2[4][2];
#pragma unroll
            for (int m = 0; m < 4; ++m)
#pragma unroll
                for (int bj = 0; bj < 2; ++bj) hw2[m][bj] = *(const u32x4*)(HB + ((size_t)u.pm * BM + rl0 + ai * HALF + m * 16) * 1024 + u.pn * BM + cl0 + bj * HALF);
            asm volatile("s_waitcnt vmcnt(0)" ::: "memory");
#pragma unroll
            for (int m = 0; m < 4; ++m) { const int rl = rl0 + ai * HALF + m * 16;
                const f32x4 p = *(const LAS f32x4*)(P + rl * 4); const float re = 1.0f / sqrtf(((p[0] + p[1]) + (p[2] + p[3])) * (1.0f / 256.0f) + 1e-6f);
                float mx = 0.f, bx = 0.f;
#pragma unroll
                for (int bj = 0; bj < 2; ++bj) { const u32x4 w = hw2[m][bj];
                    const f32x4 h0 = {bf2f(w.x & 0xffffu), bf2f(w.x >> 16), bf2f(w.y & 0xffffu), bf2f(w.y >> 16)}, h1 = {bf2f(w.z & 0xffffu), bf2f(w.z >> 16), bf2f(w.w & 0xffffu), bf2f(w.w >> 16)};
                    const f32x4 a0 = gv[bj][0] * acc[ai][bj][m][0], a1 = gv[bj][1] * acc[ai][bj][m][1]; acc[ai][bj][m][0] = a0; acc[ai][bj][m][1] = a1;
                    const f32x4 t0 = h0 + a0 * re, t1 = h1 + a1 * re;
#pragma unroll
                    for (int q = 0; q < 4; ++q) { mx = fmaxf(mx, fmaxf(fabsf(t0[q]), fabsf(t1[q]))); bx = fmaxf(bx, fmaxf(fabsf(a0[q]), fabsf(a1[q]))); } }
                mx = fmaxf(mx, __shfl_xor(mx, 16)); mx = fmaxf(mx, __shfl_xor(mx, 32)); bx = fmaxf(bx, __shfl_xor(bx, 16)); bx = fmaxf(bx, __shfl_xor(bx, 32));
                if (fq == 0) { PM[rl * 4 + wc] = mx; PB[rl * 4 + wc] = bx; } }
        }
        asm volatile("s_waitcnt lgkmcnt(0)" ::: "memory"); __builtin_amdgcn_s_barrier(); asm volatile("" ::: "memory");
        if (tid < 256) {
            const f32x4 p = *(const LAS f32x4*)(P + tid * 4), pm4 = *(const LAS f32x4*)(PM + tid * 4), pb4 = *(const LAS f32x4*)(PB + tid * 4);
            const float ss = (p[0] + p[1]) + (p[2] + p[3]);
            float* slots = XS + ((size_t)u.pm * BM + tid) * 16;
            st_sys16(slots + u.pn * 4, (f32x4){ss, fmaxf(fmaxf(pm4[0], pm4[1]), fmaxf(pm4[2], pm4[3])), fmaxf(fmaxf(pb4[0], pb4[1]), fmaxf(pb4[2], pb4[3])), 1.0f / sqrtf(ss * (1.0f / 256.0f) + 1e-6f)});
            f32x4 s4[4]; unsigned spins = 0;
            for (;;) {
                bool ok = true;
                ld_sys16x4(slots, s4);
#pragma unroll
                for (int t = 0; t < 4; ++t) ok = ok && (s4[t][0] >= 0.f) && (s4[t][1] >= 0.f) && (s4[t][2] >= 0.f) && (s4[t][3] >= 0.f);
                if (__builtin_amdgcn_ballot_w64(!ok) == 0ull) break;
                __builtin_amdgcn_s_sleep(1);
                if (++spins > (1u << 20)) { __hip_atomic_store(tmo, 1u, __ATOMIC_RELAXED, __HIP_MEMORY_SCOPE_AGENT); break; }
            }
            const float r = 1.0f / sqrtf(((s4[0][0] + s4[1][0]) + (s4[2][0] + s4[3][0])) * (1.0f / 1024.0f) + 1e-6f);
            float bound = 0.f;
#pragma unroll
            for (int t = 0; t < 4; ++t) bound = fmaxf(bound, s4[t][1] + s4[t][2] * fabsf(r - s4[t][3]));
            bound *= 1.00001f;
            const float sc = (bound > 0.f) ? bound * (1.0f / 127.0f) : 1.0f;
            R[tid] = r; RI[tid] = 1.0f / sc; if (u.pn == 0 && !OUTF) SA[(size_t)u.pm * BM + tid] = sc;
        }
        asm volatile("s_waitcnt lgkmcnt(0)" ::: "memory"); __builtin_amdgcn_s_barrier(); asm volatile("" ::: "memory");
#pragma unroll
        for (int ai = 0; ai < 2; ++ai) {
            u32x4 hwv[4][2];
#pragma unroll
            for (int m = 0; m < 4; ++m)
#pragma unroll
                for (int bj = 0; bj < 2; ++bj) hwv[m][bj] = *(const u32x4*)(HB + ((size_t)u.pm * BM + rl0 + ai * HALF + m * 16) * 1024 + u.pn * BM + cl0 + bj * HALF);
#pragma unroll
            for (int m = 0; m < 4; ++m) { const int rl = rl0 + ai * HALF + m * 16; const float r = R[rl], inv = RI[rl]; const size_t go = ((size_t)u.pm * BM + rl) * 1024 + u.pn * BM + cl0;
                float s2 = 0.f;
#pragma unroll
                for (int bj = 0; bj < 2; ++bj) { const u32x4 w = hwv[m][bj];
                    f32x4 h0 = {bf2f(w.x & 0xffffu), bf2f(w.x >> 16), bf2f(w.y & 0xffffu), bf2f(w.y >> 16)}, h1 = {bf2f(w.z & 0xffffu), bf2f(w.z >> 16), bf2f(w.w & 0xffffu), bf2f(w.w >> 16)};
                    h0 = h0 + acc[ai][bj][m][0] * r; h1 = h1 + acc[ai][bj][m][1] * r;
                    s2 += (h0[0] * h0[0] + h0[1] * h0[1]) + (h0[2] * h0[2] + h0[3] * h0[3]) + (h1[0] * h1[0] + h1[1] * h1[1]) + (h1[2] * h1[2] + h1[3] * h1[3]);
                    if (OUTF) { *(f32x4*)(OUTF + go + bj * HALF) = h0; *(f32x4*)(OUTF + go + bj * HALF + 4) = h1; }
                    else { u32x4 o; o.x = cvt_pk_bf16(h0[0], h0[1]); o.y = cvt_pk_bf16(h0[2], h0[3]); o.z = cvt_pk_bf16(h1[0], h1[1]); o.w = cvt_pk_bf16(h1[2], h1[3]); __builtin_nontemporal_store(o, (u32x4*)(HB + go + bj * HALF));
                        u32x2 q; q.x = q4_i8(h0, inv); q.y = q4_i8(h1, inv); *(u32x2*)(HB8 + go + bj * HALF) = q; } }
                s2 += __shfl_xor(s2, 16); s2 += __shfl_xor(s2, 32);
                if (fq == 0) P2[rl * 4 + wc] = s2; }
        }
        asm volatile("s_waitcnt lgkmcnt(0)" ::: "memory"); __builtin_amdgcn_s_barrier(); asm volatile("" ::: "memory");
        if (tid < 256) { const f32x4 p = *(const LAS f32x4*)(P2 + tid * 4); X2[((size_t)u.pm * BM + tid) * 4 + u.pn] = (p[0] + p[1]) + (p[2] + p[3]); }
    }
};

template <class Epi, class Sched, bool ALIGN_EPI, bool I8 = false>
__device__ __forceinline__ void gemm_phase(LAS unsigned char* lds, const int K, const Sched& S, const Epi& E) {
    int tid = threadIdx.x; asm volatile("" : "+v"(tid));
    const int wid = __builtin_amdgcn_readfirstlane(tid >> 6), lane = tid & 63, wr = wid >> 2, wc = wid & 3, fr = lane & 15, fq = lane >> 4;
    unsigned voffA[2], voffB[2];
#pragma unroll
    for (int i = 0; i < 2; ++i) { int R, C; stage_rc(tid * 16 + i * 8192, R, C); const int Rb = Epi::PERM ? ((R & ~31) + perm32(R & 31)) : R;
        voffA[i] = (unsigned)(R * K + C) * 2u; voffB[i] = (unsigned)(Rb * K + C) * 2u; }
    const size_t kstep = (size_t)(BK * 2);
    const size_t hstep = (size_t)HALF * K * 2;
    const unsigned ldsw = (unsigned)wid * 1024u;
    const int aoff = lds_byte(wr * 64 + fr, fq * 8), boff = lds_byte(wc * 32 + fr, fq * 8);
#define PG8_SA(b, h) (((b) * 2 + (h)) * HTB)
#define PG8_SB(b, h) ((4 + (b) * 2 + (h)) * HTB)
#define PG8_STAGE(bufoff, gbase, voff) do { _Pragma("unroll") for (int _i = 0; _i < 2; ++_i) \
        __builtin_amdgcn_global_load_lds((const unsigned*)((const char*)(gbase) + (voff)[_i]), (LAS unsigned*)(lds + (bufoff) + ldsw + _i * 8192), 16, 0, 0); } while (0)
#define PG8_LDA(dst, b, h) do { _Pragma("unroll") for (int m = 0; m < 4; ++m) _Pragma("unroll") for (int k = 0; k < 2; ++k) dst[m][k] = *(const LAS bf16x8*)(lds + PG8_SA(b, h) + aoff + m * 2048 + k * 1024); } while (0)
#define PG8_LDB(dst, b, h) do { _Pragma("unroll") for (int n = 0; n < 2; ++n) _Pragma("unroll") for (int k = 0; k < 2; ++k) dst[n][k] = *(const LAS bf16x8*)(lds + PG8_SB(b, h) + boff + n * 2048 + k * 1024); } while (0)
#define PG8_MMA(ai, bj, At, Bt) do { __builtin_amdgcn_s_setprio(1); _Pragma("unroll") for (int m = 0; m < 4; ++m) _Pragma("unroll") for (int n = 0; n < 2; ++n) _Pragma("unroll") for (int k = 0; k < 2; ++k) \
        { if constexpr (I8) acc[ai][bj][m][n] = __builtin_bit_cast(f32x4, __builtin_amdgcn_mfma_i32_16x16x64_i8(__builtin_bit_cast(i32x4, Bt[n][k]), __builtin_bit_cast(i32x4, At[m][k]), __builtin_bit_cast(i32x4, acc[ai][bj][m][n]), 0, 0, 0)); \
          else acc[ai][bj][m][n] = __builtin_amdgcn_mfma_f32_16x16x32_bf16(Bt[n][k], At[m][k], acc[ai][bj][m][n], 0, 0, 0); } __builtin_amdgcn_s_setprio(0); } while (0)
#define PG8_WAIT_V(n) asm volatile("s_waitcnt vmcnt(" #n ")" ::: "memory")
#define PG8_WAIT_L(n) asm volatile("s_waitcnt lgkmcnt(" #n ")" ::: "memory")
#define PG8_BAR __builtin_amdgcn_s_barrier()
#define PG8_SCHED __builtin_amdgcn_sched_barrier(0)
    Unit cur, nxt; int ui = 0;
    if (!S.next(0, cur)) return;
    f32x4 acc[2][2][4][2];
#pragma unroll
    for (int a = 0; a < 2; ++a)
#pragma unroll
        for (int b = 0; b < 2; ++b)
#pragma unroll
            for (int m = 0; m < 4; ++m)
#pragma unroll
                for (int n = 0; n < 2; ++n) acc[a][b][m][n] = (f32x4){0.f, 0.f, 0.f, 0.f};
    bf16x8 At[4][2], B0[2][2], B1[2][2];
    const char* cA; const char* cB; S.tiles(cur, cA, cB);
    PG8_STAGE(PG8_SB(0, 0), cB, voffB); PG8_STAGE(PG8_SB(0, 1), cB + hstep, voffB); PG8_STAGE(PG8_SA(0, 0), cA, voffA); PG8_STAGE(PG8_SA(0, 1), cA + hstep, voffA);
    if (wr == 1) PG8_BAR;
    PG8_WAIT_V(2); PG8_BAR;
    PG8_STAGE(PG8_SB(1, 0), cB + kstep, voffB); PG8_STAGE(PG8_SA(1, 0), cA + kstep, voffA); PG8_STAGE(PG8_SB(1, 1), cB + hstep + kstep, voffB);
    PG8_WAIT_V(6); PG8_BAR;
    for (;;) {
        const bool has_next = S.next(ui + 1, nxt);
        const char* nA = cA; const char* nB = cB; if (has_next) S.tiles(nxt, nA, nB);
#define PG8_KT2(t, last) do { \
            const char* a1 = cA + (size_t)((t) + 1) * kstep; \
            const char* a2 = (last) ? nA : cA + (size_t)((t) + 2) * kstep; const char* b2 = (last) ? nB : cB + (size_t)((t) + 2) * kstep; \
            const char* a3 = a2 + kstep; const char* b3 = b2 + kstep; \
            PG8_LDB(B0, 0, 0); PG8_LDB(B1, 0, 1); PG8_SCHED; PG8_LDA(At, 0, 0); PG8_STAGE(PG8_SA(1, 1), a1 + hstep, voffA); \
            PG8_WAIT_V(8); PG8_WAIT_L(0); PG8_BAR; PG8_MMA(0, 0, At, B0); PG8_MMA(0, 1, At, B1); PG8_BAR; PG8_SCHED; \
            PG8_LDA(At, 0, 1); PG8_STAGE(PG8_SB(0, 0), b2, voffB); PG8_STAGE(PG8_SB(0, 1), b2 + hstep, voffB); PG8_STAGE(PG8_SA(0, 0), a2, voffA); \
            PG8_WAIT_V(8); PG8_WAIT_L(0); PG8_BAR; PG8_MMA(1, 0, At, B0); PG8_MMA(1, 1, At, B1); PG8_BAR; PG8_SCHED; \
            PG8_LDB(B0, 1, 0); PG8_LDB(B1, 1, 1); PG8_SCHED; PG8_LDA(At, 1, 0); PG8_STAGE(PG8_SA(0, 1), a2 + hstep, voffA); \
            PG8_WAIT_V(8); PG8_WAIT_L(0); PG8_BAR; PG8_MMA(0, 0, At, B0); PG8_MMA(0, 1, At, B1); PG8_BAR; PG8_SCHED; \
            PG8_LDA(At, 1, 1); PG8_STAGE(PG8_SB(1, 0), b3, voffB); PG8_STAGE(PG8_SB(1, 1), b3 + hstep, voffB); PG8_STAGE(PG8_SA(1, 0), a3, voffA); \
            PG8_WAIT_V(8); PG8_WAIT_L(0); PG8_BAR; PG8_MMA(1, 0, At, B0); PG8_MMA(1, 1, At, B1); PG8_BAR; PG8_SCHED; } while (0)
        {
            const int ntc = S.ntiles(cur);
#pragma unroll 1
            for (int t = 0; t < ntc; t += 2) { const bool last = (t == ntc - 2); PG8_KT2(t, last); }
        }
        if constexpr (ALIGN_EPI) { if (wr == 0) PG8_BAR; }
        E(acc, cur, wr, wc, fr, fq);
        if (!has_next) break;
        if (!S.keep_acc(nxt)) {
#pragma unroll
        for (int a = 0; a < 2; ++a)
#pragma unroll
            for (int b = 0; b < 2; ++b)
#pragma unroll
                for (int m = 0; m < 4; ++m)
#pragma unroll
                    for (int n = 0; n < 2; ++n) acc[a][b][m][n] = (f32x4){0.f, 0.f, 0.f, 0.f};
        }
        cur = nxt; cA = nA; cB = nB; ++ui;
        if constexpr (ALIGN_EPI) { if (wr == 1) PG8_BAR; }
    }
    PG8_WAIT_V(0);
    if constexpr (!ALIGN_EPI) { if (wr == 0) PG8_BAR; }
    PG8_BAR;
#undef PG8_KT2
#undef PG8_SA
#undef PG8_SB
#undef PG8_STAGE
#undef PG8_LDA
#undef PG8_LDB
#undef PG8_MMA
#undef PG8_WAIT_V
#undef PG8_WAIT_L
#undef PG8_BAR
#undef PG8_SCHED
}
}

struct Args {
    const float* in[22]; float* out; unsigned char* ws; int ph_lo, ph_hi;
};
enum { I_X = 0, I_NMIXPRE, I_NMIXPOST, I_NMLPPRE, I_NMLPPOST, I_WIN, I_LCW, I_LCB, I_LWA, I_LBA, I_LWX, I_LBX, I_LLAM, I_PW, I_PS, I_HLB, I_HN, I_SW, I_WBR, I_WOUT, I_WUP, I_WDOWN };

struct Ctx {
    LAS unsigned char* lds; int tid, lane, wave, vcu, G;
};

__device__ __forceinline__ void transpose_item(const float* W, int ldw, const float* gain, bf16_t* WT, int ldo, int col_off, int k0, int n0, LAS float* scr, int lane) {
    float wv[32];
#pragma unroll
    for (int i = 0; i < 32; ++i) { const int kk = 2 * i + (lane >> 5); wv[i] = W[(size_t)(k0 + kk) * ldw + n0 + (lane & 31)]; }
    const int c = lane & 7;
    f32x4 g0 = {1.f, 1.f, 1.f, 1.f}, g1 = g0;
    if (gain) { g0 = *(const f32x4*)(gain + k0 + 8 * c); g1 = *(const f32x4*)(gain + k0 + 8 * c + 4); }
#pragma unroll
    for (int i = 0; i < 32; ++i) { const int kk = 2 * i + (lane >> 5); scr[kk * 33 + (lane & 31)] = wv[i]; }
    asm volatile("s_waitcnt lgkmcnt(0)" ::: "memory");
#pragma unroll
    for (int j = 0; j < 4; ++j) { const int n = (lane >> 3) + 8 * j; const LAS float* s = scr + (8 * c) * 33 + n;
        u32x4 o; o.x = pk2(g0[0] * s[0 * 33], g0[1] * s[1 * 33]); o.y = pk2(g0[2] * s[2 * 33], g0[3] * s[3 * 33]); o.z = pk2(g1[0] * s[4 * 33], g1[1] * s[5 * 33]); o.w = pk2(g1[2] * s[6 * 33], g1[3] * s[7 * 33]);
        *(u32x4*)(WT + (size_t)(n0 + n) * ldo + col_off + k0 + 8 * c) = o; }
    asm volatile("s_waitcnt lgkmcnt(0)" ::: "memory");
}

__device__ __forceinline__ void p0_prologue(const Ctx& C, const Args& A) {
    LAS float* scr = (LAS float*)(C.lds + C.wave * 16384);
    const int gw = C.vcu * NWAVES + C.wave, NGW = C.G * NWAVES;
    constexpr int I_IN = (D / 64) * (INW / 32), I_BR1 = (BW / 64) * (D / 32), I_OUT = (D / 64) * (D / 32), I_UP = (D / 64) * (FF / 32), I_DN = (FF / 64) * (D / 32);
    constexpr int PER_LAYER = I_IN + 4 * I_BR1 + I_OUT + I_UP + I_DN;
    for (int it = gw; it < DEPTH * PER_LAYER; it += NGW) {
        const int l = it / PER_LAYER; int r = it % PER_LAYER;
        bf16_t* wl = (bf16_t*)(A.ws + WS_W + (size_t)l * W_LAYER);
        if (r < I_IN) { const int nb = INW / 32; transpose_item(A.in[I_WIN] + (size_t)l * D * INW, INW, A.in[I_NMIXPRE] + l * D, wl + W_IN / 2, D, 0, 64 * (r / nb), 32 * (r % nb), scr, C.lane); continue; } r -= I_IN;
        if (r < 4 * I_BR1) { const int k = r / I_BR1, rr = r % I_BR1, nb = D / 32; transpose_item(A.in[I_WBR] + ((size_t)l * 4 + k) * BW * D, D, nullptr, wl + W_BR / 2, D, k * BW, 64 * (rr / nb), 32 * (rr % nb), scr, C.lane); continue; } r -= 4 * I_BR1;
        if (r < I_OUT) { const int nb = D / 32; transpose_item(A.in[I_WOUT] + (size_t)l * D * D, D, nullptr, wl + W_OUT / 2, D, 0, 64 * (r / nb), 32 * (r % nb), scr, C.lane); continue; } r -= I_OUT;
        if (r < I_UP) { const int nb = FF / 32; transpose_item(A.in[I_WUP] + (size_t)l * D * FF, FF, A.in[I_NMLPPRE] + l * D, wl + W_UP / 2, D, 0, 64 * (r / nb), 32 * (r % nb), scr, C.lane); continue; } r -= I_UP;
        { const int nb = D / 32; transpose_item(A.in[I_WDOWN] + (size_t)l * FF * D, D, nullptr, wl + W_DOWN / 2, FF, 0, 64 * (r / nb), 32 * (r % nb), scr, C.lane); }
    }
    { const int gt = gw * 64 + C.lane; if (gt < DEPTH * BW) { const float lam = A.in[I_LLAM][gt]; ((float*)(A.ws + WS_SP8))[gt] = -8.0f * ((-lam > 20.f) ? -lam : log1pf(expf(-lam))); } }
    bf16_t* HB = (bf16_t*)(A.ws + WS_HB); float* RS = (float*)(A.ws + WS_X2);
    for (int m0 = gw; m0 < M; m0 += 4 * NGW) {
        f32x4 v[4][4];
#pragma unroll
        for (int q = 0; q < 4; ++q) { const int m = m0 + q * NGW; const f32x4* xr = (const f32x4*)(A.in[I_X] + (size_t)(m < M ? m : 0) * D) + C.lane;
#pragma unroll
            for (int j = 0; j < 4; ++j) v[q][j] = xr[64 * j]; }
#pragma unroll
        for (int q = 0; q < 4; ++q) { const int m = m0 + q * NGW; if (m < M) { float s = 0.f;
#pragma unroll
            for (int j = 0; j < 4; ++j) s += (v[q][j].x * v[q][j].x + v[q][j].y * v[q][j].y) + (v[q][j].z * v[q][j].z + v[q][j].w * v[q][j].w);
            s = wave_sum(s);
            u32x2* o8 = (u32x2*)(HB + (size_t)m * D) + C.lane;
#pragma unroll
            for (int j = 0; j < 4; ++j) { u32x2 w; w.x = pk2(v[q][j].x, v[q][j].y); w.y = pk2(v[q][j].z, v[q][j].w); o8[64 * j] = w; }
            float mx = 0.f;
#pragma unroll
            for (int j = 0; j < 4; ++j) mx = fmaxf(fmaxf(mx, fmaxf(fabsf(v[q][j].x), fabsf(v[q][j].y))), fmaxf(fabsf(v[q][j].z), fabsf(v[q][j].w)));
#pragma unroll
            for (int o = 1; o < 64; o <<= 1) mx = fmaxf(mx, __shfl_xor(mx, o));
            const float sc = (mx > 0.f) ? mx * (1.0f / 127.0f) : 1.0f, inv = 1.0f / sc;
            unsigned* o4 = (unsigned*)(A.ws + WS_HB8 + (size_t)m * D) + C.lane;
#pragma unroll
            for (int j = 0; j < 4; ++j) o4[64 * j] = q4_i8(v[q][j], inv);
            if (C.lane == 0) { *(f32x4*)(RS + (size_t)m * 4) = (f32x4){s, 0.f, 0.f, 0.f}; ((float*)(A.ws + WS_SA))[m] = sc; } } }
    }
}

__device__ __forceinline__ void norm_phase(const Ctx& C, const Args& A, const bf16_t* VIN, const float* gain, bool write_out) {
    bf16_t* HB = (bf16_t*)(A.ws + WS_HB); float* RS = (float*)(A.ws + WS_X2); float* OUT = A.out;
    int lane = C.lane; asm volatile("" : "+v"(lane));
    const int gw = C.vcu * NWAVES + C.wave, NGW = C.G * NWAVES;
    f32x4 g[4];
#pragma unroll
    for (int j = 0; j < 4; ++j) g[j] = ((const f32x4*)gain)[lane + 64 * j];
    for (int m = gw; m < M; m += NGW) {
        u32x2* hb = (u32x2*)(HB + (size_t)m * D) + lane;
        const u32x2* vb = (const u32x2*)(VIN + (size_t)m * D) + lane;
        f32x4 v[4], h[4]; float s = 0.f;
#pragma unroll
        for (int j = 0; j < 4; ++j) { const u32x2 w = vb[64 * j], hw = hb[64 * j];
            v[j] = (f32x4){bf2f(w.x & 0xffffu), bf2f(w.x >> 16), bf2f(w.y & 0xffffu), bf2f(w.y >> 16)};
            h[j] = (f32x4){bf2f(hw.x & 0xffffu), bf2f(hw.x >> 16), bf2f(hw.y & 0xffffu), bf2f(hw.y >> 16)};
            s += (v[j].x * v[j].x + v[j].y * v[j].y) + (v[j].z * v[j].z + v[j].w * v[j].w); }
        const float r = 1.0f / sqrtf(wave_sum(s) * (1.0f / D) + EPS);
        float s2 = 0.f;
#pragma unroll
        for (int j = 0; j < 4; ++j) { h[j] = h[j] + g[j] * v[j] * r; s2 += (h[j].x * h[j].x + h[j].y * h[j].y) + (h[j].z * h[j].z + h[j].w * h[j].w); }
        s2 = wave_sum(s2);
        if (write_out) { f32x4* orow = (f32x4*)(OUT + (size_t)m * D) + lane;
#pragma unroll
            for (int j = 0; j < 4; ++j) orow[64 * j] = h[j]; }
        else {
#pragma unroll
            for (int j = 0; j < 4; ++j) { u32x2 w; w.x = pk2(h[j].x, h[j].y); w.y = pk2(h[j].z, h[j].w); hb[64 * j] = w; }
            float mx = 0.f;
#pragma unroll
            for (int j = 0; j < 4; ++j) mx = fmaxf(fmaxf(mx, fmaxf(fabsf(h[j].x), fabsf(h[j].y))), fmaxf(fabsf(h[j].z), fabsf(h[j].w)));
#pragma unroll
            for (int o = 1; o < 64; o <<= 1) mx = fmaxf(mx, __shfl_xor(mx, o));
            const float sc = (mx > 0.f) ? mx * (1.0f / 127.0f) : 1.0f, inv = 1.0f / sc;
            unsigned* o4 = (unsigned*)(A.ws + WS_HB8 + (size_t)m * D) + lane;
#pragma unroll
            for (int j = 0; j < 4; ++j) o4[64 * j] = q4_i8(h[j], inv);
            if (lane == 0) { *(f32x4*)(RS + (size_t)m * 4) = (f32x4){s2, 0.f, 0.f, 0.f}; ((float*)(A.ws + WS_SA))[m] = sc; } }
    }
}

__device__ __forceinline__ float gelu_tanh(float x) {
    const float u = 0.7978845608028654f * (x + 0.044715f * x * x * x);
    const float e = fast_exp(2.0f * u);
    const float th = 1.0f - 2.0f * __builtin_amdgcn_rcpf(e + 1.0f);
    return 0.5f * x * (1.0f + th);
}

constexpr size_t WS_LRA = 428 * MiB, WS_LRU = 444 * MiB;
constexpr int MX_PT = 528;
__device__ __forceinline__ void gather_wraw(const float* w, int stride, float (&o)[8]) {
#pragma unroll
    for (int j = 0; j < 8; ++j) o[j] = w[j * stride];
}
__device__ __forceinline__ bf16x8 pack_wfrag(const float (&o)[8]) {
    union { bf16x8 v; unsigned u[4]; } r;
#pragma unroll
    for (int p = 0; p < 4; ++p) r.u[p] = pk2(o[2 * p], o[2 * p + 1]);
    return r.v;
}
__device__ __forceinline__ bf16x8 gather_wfrag(const float* w, int stride) {
    union { bf16x8 v; unsigned u[4]; } r;
#pragma unroll
    for (int p = 0; p < 4; ++p) r.u[p] = pk2(w[(2 * p) * stride], w[(2 * p + 1) * stride]);
    return r.v;
}
__device__ __forceinline__ void mix1_item(const Ctx& C, const Args& A, int l, int b, int c) {
    const bf16_t* PROJ = (const bf16_t*)(A.ws + WS_PROJ);
    bf16_t* YS = (bf16_t*)(A.ws + WS_YS);
    int tid = C.tid; asm volatile("" : "+v"(tid));
    const int lane = tid & 63, wave = C.wave, fr = lane & 15, fg = lane >> 4;
    const size_t m0 = (size_t)b * T + (size_t)c * 64;
    LAS unsigned char* XC = C.lds;
    LAS unsigned char* LAi = C.lds + 34816;
    LAS unsigned char* LUi = C.lds + 34816 + 32768;
    float raw_a[2][8], raw_x[2][8];
    { const float* wa = A.in[I_LWA] + (((size_t)l * 8 + wave) * 32) * 32; const float* wx = A.in[I_LWX] + (((size_t)l * 8 + wave) * 32) * 32;
#pragma unroll
        for (int nt = 0; nt < 2; ++nt) { gather_wraw(wa + (8 * fg) * 32 + 16 * nt + fr, 32, raw_a[nt]); gather_wraw(wx + (8 * fg) * 32 + 16 * nt + fr, 32, raw_x[nt]); }
        asm volatile("" ::: "memory"); }
    {
        const float* cw = A.in[I_LCW] + (size_t)l * 4 * BW; const float* cbp = A.in[I_LCB] + l * BW;
#pragma unroll
        for (int k = 0; k < 4; ++k) { const int idx = tid + NTHREADS * k; const int t = idx >> 5, c8 = (idx & 31) * 8;
            float acc[8];
            { const f32x4 b0 = *(const f32x4*)(cbp + c8), b1 = *(const f32x4*)(cbp + c8 + 4); acc[0] = b0[0]; acc[1] = b0[1]; acc[2] = b0[2]; acc[3] = b0[3]; acc[4] = b1[0]; acc[5] = b1[1]; acc[6] = b1[2]; acc[7] = b1[3]; }
#pragma unroll
            for (int j = 0; j < 4; ++j) { const int tok = c * 64 + t - 3 + j;
                if (tok >= 0) { float x[8]; ld8bf(PROJ + ((size_t)b * T + tok) * NMIX + c8, x); const f32x4 w0 = *(const f32x4*)(cw + j * BW + c8), w1 = *(const f32x4*)(cw + j * BW + c8 + 4);
                    acc[0] += w0[0] * x[0]; acc[1] += w0[1] * x[1]; acc[2] += w0[2] * x[2]; acc[3] += w0[3] * x[3]; acc[4] += w1[0] * x[4]; acc[5] += w1[1] * x[5]; acc[6] += w1[2] * x[6]; acc[7] += w1[3] * x[7]; } }
            u32x4 w; w.x = cvt_pk_bf16(acc[0], acc[1]); w.y = cvt_pk_bf16(acc[2], acc[3]); w.z = cvt_pk_bf16(acc[4], acc[5]); w.w = cvt_pk_bf16(acc[6], acc[7]);
            *(LAS u32x4*)(XC + t * MX_PT + c8 * 2) = w; }
    }
    __syncthreads();
    {
        const int blk = wave;
        const float* wa = A.in[I_LWA] + (((size_t)l * 8 + blk) * 32) * 32; const float* wx = A.in[I_LWX] + (((size_t)l * 8 + blk) * 32) * 32;
        bf16x8 fa[2], fx[2];
#pragma unroll
        for (int nt = 0; nt < 2; ++nt) { fa[nt] = pack_wfrag(raw_a[nt]); fx[nt] = pack_wfrag(raw_x[nt]); }
        bf16_t* LRA = (bf16_t*)(A.ws + WS_LRA); bf16_t* LRU = (bf16_t*)(A.ws + WS_LRU);
        f32x4 bav[2], bxv[2], spv[2];
#pragma unroll
        for (int nt = 0; nt < 2; ++nt) { const int ch = 32 * blk + 16 * nt + 4 * fg;
            bav[nt] = *(const f32x4*)(A.in[I_LBA] + l * BW + ch); bxv[nt] = *(const f32x4*)(A.in[I_LBX] + l * BW + ch); spv[nt] = *(const f32x4*)((const float*)(A.ws + WS_SP8) + l * BW + ch); }
#pragma unroll
        for (int nt = 0; nt < 2; ++nt) { const int ch = 32 * blk + 16 * nt + 4 * fg;
            const f32x4 ba = bav[nt], bx = bxv[nt], sp8 = spv[nt];
#pragma unroll
            for (int mt = 0; mt < 4; ++mt) { const int tok = 16 * mt + fr;
                const bf16x8 bxc = *(const LAS bf16x8*)(XC + tok * MX_PT + (32 * blk + 8 * fg) * 2);
                f32x4 ar = {0.f, 0.f, 0.f, 0.f}, ai = {0.f, 0.f, 0.f, 0.f};
                ar = __builtin_amdgcn_mfma_f32_16x16x32_bf16(fa[nt], bxc, ar, 0, 0, 0); ai = __builtin_amdgcn_mfma_f32_16x16x32_bf16(fx[nt], bxc, ai, 0, 0, 0);
                const u32x2 xw = *(const LAS u32x2*)(XC + tok * MX_PT + ch * 2);
                const float xc[4] = {bf2f(xw.x & 0xffffu), bf2f(xw.x >> 16), bf2f(xw.y & 0xffffu), bf2f(xw.y >> 16)};
                float la[4], uu[4];
#pragma unroll
                for (int r = 0; r < 4; ++r) { const float rg = sigmoid_f(ar[r] + ba[r]), ig = sigmoid_f(ai[r] + bx[r]);
                    la[r] = sp8[r] * rg; const float x2 = 2.0f * la[r];
                    const float om = (x2 > -0.02f) ? -x2 * (1.0f + 0.5f * x2 * (1.0f + x2 * (1.0f / 3.0f))) : 1.0f - fast_exp(x2);
                    uu[r] = sqrtf(om) * ig * xc[r]; }
                u32x2 wl, wu; wl.x = cvt_pk_bf16(la[0], la[1]); wl.y = cvt_pk_bf16(la[2], la[3]); wu.x = cvt_pk_bf16(uu[0], uu[1]); wu.y = cvt_pk_bf16(uu[2], uu[3]);
                *(LAS u32x2*)(LAi + tok * 512 + ch * 2) = wl; *(LAS u32x2*)(LUi + tok * 512 + ch * 2) = wu;
                *(u32x2*)(LRA + (m0 + tok) * BW + ch) = wl; *(u32x2*)(LRU + (m0 + tok) * BW + ch) = wu; }
        }
    }
    __syncthreads();
    {
        const int ch = tid & 255, half = tid >> 8; float P = 1.f, hst = 0.f;
#pragma unroll
        for (int i = 0; i < 32; ++i) { const int t = 32 * half + i; const float a = fast_exp(bf2f(*(const LAS bf16_t*)(LAi + t * 512 + ch * 2))); const float u = bf2f(*(const LAS bf16_t*)(LUi + t * 512 + ch * 2));
            hst = a * hst + u; P *= a; }
        const size_t aggi = ((size_t)b * 128 + c * 2 + half) * 256 + ch;
        ((float*)(A.ws + WS_LA))[aggi] = P; ((float*)(A.ws + WS_LH))[aggi] = hst;
    }
    __syncthreads();
    LAS unsigned char* PX = C.lds;
    LAS unsigned char* DD = C.lds + 43008;
    { u32x4 pv[5];
#pragma unroll
        for (int k = 0; k < 5; ++k) { const int idx = tid + NTHREADS * k; const int r = idx >> 5, c8 = (idx & 31) * 8; const int tok = c * 64 - 15 + r;
            pv[k] = (u32x4){0u, 0u, 0u, 0u}; if (idx < 79 * 32 && tok >= 0) pv[k] = *(const u32x4*)(PROJ + ((size_t)b * T + tok) * NMIX + 512 + c8); }
#pragma unroll
        for (int k = 0; k < 5; ++k) { const int idx = tid + NTHREADS * k; const int r = idx >> 5, c8 = (idx & 31) * 8; if (idx < 79 * 32) *(LAS u32x4*)(PX + r * MX_PT + c8 * 2) = pv[k]; } }
    __syncthreads();
    float raw_p[2][2][8];
    { const int g = wave >> 1, nb = (wave & 1) * 2; const float* pw = A.in[I_PW] + (((size_t)l * 4 + g) * 64) * 64;
#pragma unroll
        for (int nn = 0; nn < 2; ++nn)
#pragma unroll
            for (int ks = 0; ks < 2; ++ks) gather_wraw(pw + (32 * ks + 8 * fg) * 64 + 16 * (nb + nn) + fr, 64, raw_p[nn][ks]);
        asm volatile("" ::: "memory"); }
#pragma unroll 1
    for (int k = 0; k < 4; ++k) { const int idx = tid + NTHREADS * k; const int t = idx >> 5, c8 = (idx & 31) * 8; const int g = c8 >> 6, win = 2 << g;
        float sum[8], x0[8];
#pragma unroll
        for (int e = 0; e < 8; ++e) sum[e] = 0.f;
        for (int j = 0; j < win; ++j) { const u32x4 v = *(const LAS u32x4*)(PX + (t + 15 - j) * MX_PT + c8 * 2);
            const float x[8] = {bf2f(v.x & 0xffffu), bf2f(v.x >> 16), bf2f(v.y & 0xffffu), bf2f(v.y >> 16), bf2f(v.z & 0xffffu), bf2f(v.z >> 16), bf2f(v.w & 0xffffu), bf2f(v.w >> 16)};
#pragma unroll
            for (int e = 0; e < 8; ++e) { sum[e] += x[e]; if (j == 0) x0[e] = x[e]; } }
        const int pos = c * 64 + t + 1; const float inv = 1.0f / (float)(pos < win ? pos : win);
        u32x4 w; w.x = cvt_pk_bf16(sum[0] * inv - x0[0], sum[1] * inv - x0[1]); w.y = cvt_pk_bf16(sum[2] * inv - x0[2], sum[3] * inv - x0[3]);
        w.z = cvt_pk_bf16(sum[4] * inv - x0[4], sum[5] * inv - x0[5]); w.w = cvt_pk_bf16(sum[6] * inv - x0[6], sum[7] * inv - x0[7]);
        *(LAS u32x4*)(DD + t * MX_PT + c8 * 2) = w; }
    __syncthreads();
    {
        const int g = wave >> 1, nb = (wave & 1) * 2;
        const float* pw = A.in[I_PW] + (((size_t)l * 4 + g) * 64) * 64;
        bf16x8 fw[2][2];
#pragma unroll
        for (int nn = 0; nn < 2; ++nn)
#pragma unroll
            for (int ks = 0; ks < 2; ++ks) fw[nn][ks] = pack_wfrag(raw_p[nn][ks]);
        f32x4 sclv[2];
#pragma unroll
        for (int nn = 0; nn < 2; ++nn) sclv[nn] = *(const f32x4*)(A.in[I_PS] + l * BW + 64 * g + 16 * (nb + nn) + 4 * fg);
#pragma unroll
        for (int nn = 0; nn < 2; ++nn) { const int ch = 64 * g + 16 * (nb + nn) + 4 * fg; const f32x4 scl = sclv[nn];
#pragma unroll
            for (int mt = 0; mt < 4; ++mt) { const int tok = 16 * mt + fr; f32x4 acc = {0.f, 0.f, 0.f, 0.f};
#pragma unroll
                for (int ks = 0; ks < 2; ++ks) { const bf16x8 bd = *(const LAS bf16x8*)(DD + tok * MX_PT + (64 * g + 32 * ks + 8 * fg) * 2); acc = __builtin_amdgcn_mfma_f32_16x16x32_bf16(fw[nn][ks], bd, acc, 0, 0, 0); }
                u32x2 w; w.x = cvt_pk_bf16(acc[0] * scl[0], acc[1] * scl[1]); w.y = cvt_pk_bf16(acc[2] * scl[2], acc[3] * scl[3]);
                *(u32x2*)(YS + (m0 + tok) * D + 256 + ch) = w; } }
    }
    {
        const float* sw = A.in[I_SW] + (size_t)l * 3 * BW;
        const int c8 = (tid & 31) * 8;
        f32x4 wv[3][2];
#pragma unroll
        for (int j = 0; j < 3; ++j) { wv[j][0] = *(const f32x4*)(sw + j * BW + c8); wv[j][1] = *(const f32x4*)(sw + j * BW + c8 + 4); }
#pragma unroll 1
        for (int kb = 0; kb < 4; kb += 2) {
            u32x4 rc[2][3], rx[2][3], rb[2];
#pragma unroll
            for (int kk = 0; kk < 2; ++kk) { const int t = (tid + NTHREADS * (kb + kk)) >> 5;
#pragma unroll
                for (int j = 0; j < 3; ++j) { const int tok = c * 64 + t - 2 + j; rc[kk][j] = (u32x4){0u, 0u, 0u, 0u}; rx[kk][j] = (u32x4){0u, 0u, 0u, 0u};
                    if (tok >= 0) { const bf16_t* p = PROJ + ((size_t)b * T + tok) * NMIX; rc[kk][j] = *(const u32x4*)(p + 2048 + c8); rx[kk][j] = *(const u32x4*)(p + 2304 + c8); } }
                rb[kk] = *(const u32x4*)(PROJ + (m0 + t) * NMIX + 1792 + c8); }
#pragma unroll
            for (int kk = 0; kk < 2; ++kk) { const int t = (tid + NTHREADS * (kb + kk)) >> 5;
                float acc[8];
#pragma unroll
                for (int e = 0; e < 8; ++e) acc[e] = 0.f;
#pragma unroll
                for (int j = 0; j < 3; ++j) { const u32x4 vc = rc[kk][j], vx = rx[kk][j];
                    const float sc[8] = {bf2f(vc.x & 0xffffu), bf2f(vc.x >> 16), bf2f(vc.y & 0xffffu), bf2f(vc.y >> 16), bf2f(vc.z & 0xffffu), bf2f(vc.z >> 16), bf2f(vc.w & 0xffffu), bf2f(vc.w >> 16)};
                    const float sx[8] = {bf2f(vx.x & 0xffffu), bf2f(vx.x >> 16), bf2f(vx.y & 0xffffu), bf2f(vx.y >> 16), bf2f(vx.z & 0xffffu), bf2f(vx.z >> 16), bf2f(vx.w & 0xffffu), bf2f(vx.w >> 16)};
                    const f32x4 w0 = wv[j][0], w1 = wv[j][1];
                    acc[0] += w0[0] * sc[0] * sx[0]; acc[1] += w0[1] * sc[1] * sx[1]; acc[2] += w0[2] * sc[2] * sx[2]; acc[3] += w0[3] * sc[3] * sx[3];
                    acc[4] += w1[0] * sc[4] * sx[4]; acc[5] += w1[1] * sc[5] * sx[5]; acc[6] += w1[2] * sc[6] * sx[6]; acc[7] += w1[3] * sc[7] * sx[7]; }
                const u32x4 vb = rb[kk];
                const float sb[8] = {bf2f(vb.x & 0xffffu), bf2f(vb.x >> 16), bf2f(vb.y & 0xffffu), bf2f(vb.y >> 16), bf2f(vb.z & 0xffffu), bf2f(vb.z >> 16), bf2f(vb.w & 0xffffu), bf2f(vb.w >> 16)};
                u32x4 w; w.x = cvt_pk_bf16(sb[0] * acc[0], sb[1] * acc[1]); w.y = cvt_pk_bf16(sb[2] * acc[2], sb[3] * acc[3]); w.z = cvt_pk_bf16(sb[4] * acc[4], sb[5] * acc[5]); w.w = cvt_pk_bf16(sb[6] * acc[6], sb[7] * acc[7]);
                *(u32x4*)(YS + (m0 + t) * D + 768 + c8) = w; }
        }
    }
    __syncthreads();
}
__device__ __forceinline__ void lru_final_item(const Ctx& C, const Args& A, int l, int b, int c) {
    const bf16_t* PROJ = (const bf16_t*)(A.ws + WS_PROJ);
    const bf16_t* LRA = (const bf16_t*)(A.ws + WS_LRA); const bf16_t* LRU = (const bf16_t*)(A.ws + WS_LRU);
    bf16_t* YS = (bf16_t*)(A.ws + WS_YS);
    int tid = C.tid; asm volatile("" : "+v"(tid));
    const int ch = tid & 255, half = tid >> 8;
    const size_t m0 = (size_t)b * T + (size_t)c * 64 + 32 * half;
    float hst = ((const float*)(A.ws + WS_LC))[((size_t)b * 128 + c * 2 + half) * 256 + ch];
    unsigned short la[32], lu[32], lg[32];
#pragma unroll
    for (int i = 0; i < 32; ++i) { la[i] = LRA[(m0 + i) * BW + ch]; lu[i] = LRU[(m0 + i) * BW + ch]; lg[i] = PROJ[(m0 + i) * NMIX + 256 + ch]; }
#pragma unroll
    for (int i = 0; i < 32; ++i) { const float a = fast_exp(bf2f(la[i])), u = bf2f(lu[i]);
        hst = a * hst + u;
        YS[(m0 + i) * D + ch] = (bf16_t)f2bf(hst * gelu_tanh(bf2f(lg[i]))); }
}

constexpr int HG_PT = 144;
constexpr int HG_IMG = 64 * HG_PT;
constexpr int HG_Q = 0, HG_K = HG_IMG, HG_P = 2 * HG_IMG, HG_BEND = 3 * HG_IMG, HG_REF = HG_BEND + 512, HG_HSZ = 29696;
constexpr size_t WS_ST16 = WS_MERGED + 32 * MiB;
__device__ __forceinline__ float hgrn_lb(const Args& A, int l, int w) {
    if (l == 0) return 0.f;
    const float a0 = A.in[I_HLB][w], a1 = A.in[I_HLB][BW + w];
    return 1.0f / (1.0f + expf(a0 - a1));
}
template <bool FINAL>
__device__ __forceinline__ void hgrn_item(const Ctx& C, const Args& A, int l, int b, int c) {
    const bf16_t* PROJ = (const bf16_t*)(A.ws + WS_PROJ);
    int lane = C.lane; asm volatile("" : "+v"(lane));
    const int wave = C.wave, h = wave >> 1, half = wave & 1, fr = lane & 15, fg = lane >> 4;
    LAS unsigned char* hb = C.lds + h * HG_HSZ;
    LAS float* BEND = (LAS float*)(hb + HG_BEND); LAS float* REF = (LAS float*)(hb + HG_REF);
    const size_t m0 = (size_t)b * T + (size_t)c * 64;
    const bf16_t* pr = PROJ + (m0 + 32 * half) * NMIX + h * 64 + lane;
    const int bh = b * 4 + h; const size_t ci = (size_t)bh * 64 + c;
    float bb[32], kk[32], vv[32];
    {
        const float lbv = hgrn_lb(A, l, h * 64 + lane);
        unsigned short rf[32], rv[32];
#pragma unroll
        for (int i = 0; i < 32; ++i) { rf[i] = pr[(size_t)i * NMIX + 1024]; rv[i] = pr[(size_t)i * NMIX + 1280]; }
        asm volatile("" ::: "memory");
        float acc = 0.f;
#pragma unroll
        for (int i = 0; i < 32; ++i) { const float x = bf2f(rf[i]); const float f = fmaxf(lbv + (1.0f - lbv) * sigmoid_f(x), 1e-30f);
            acc += __logf(f); bb[i] = acc; kk[i] = 1.0f - f; }
#pragma unroll
        for (int i = 0; i < 32; ++i) vv[i] = bf2f(rv[i]);
        BEND[half * 64 + lane] = acc;
    }
    __syncthreads();
    const float bend0 = BEND[lane], blast = bend0 + BEND[64 + lane];
    if (half) {
#pragma unroll
        for (int i = 0; i < 32; ++i) bb[i] += bend0;
    }
    if (!FINAL) {
        LAS unsigned char* kt = hb + HG_K + lane * HG_PT + 64 * half; LAS unsigned char* vt = hb + HG_Q + lane * HG_PT + 64 * half;
#pragma unroll
        for (int q4 = 0; q4 < 4; ++q4) { u32x4 wk, wv; unsigned kw[4], vw[4];
#pragma unroll
            for (int p = 0; p < 4; ++p) { const int i = q4 * 8 + 2 * p;
                kw[p] = cvt_pk_bf16(kk[i] * fast_exp(blast - bb[i]), kk[i + 1] * fast_exp(blast - bb[i + 1])); vw[p] = cvt_pk_bf16(vv[i], vv[i + 1]); }
            wk.x = kw[0]; wk.y = kw[1]; wk.z = kw[2]; wk.w = kw[3]; wv.x = vw[0]; wv.y = vw[1]; wv.z = vw[2]; wv.w = vw[3];
            *(LAS u32x4*)(kt + q4 * 16) = wk; *(LAS u32x4*)(vt + q4 * 16) = wv; }
        if (half == 0) ((float*)(A.ws + WS_SD))[ci * 64 + lane] = fast_exp(blast);
        __syncthreads();
        float* su = (float*)(A.ws + WS_SU) + ci * 4096;
#pragma unroll
        for (int aa = 0; aa < 2; ++aa) { const int a = 2 * half + aa;
            bf16x8 av[2];
#pragma unroll
            for (int ks = 0; ks < 2; ++ks) av[ks] = *(const LAS bf16x8*)(hb + HG_Q + (16 * a + fr) * HG_PT + 64 * ks + 16 * fg);
#pragma unroll
            for (int d = 0; d < 4; ++d) { f32x4 acc = {0.f, 0.f, 0.f, 0.f};
#pragma unroll
                for (int ks = 0; ks < 2; ++ks) { const bf16x8 bk = *(const LAS bf16x8*)(hb + HG_K + (16 * d + fr) * HG_PT + 64 * ks + 16 * fg);
                    acc = __builtin_amdgcn_mfma_f32_16x16x32_bf16(av[ks], bk, acc, 0, 0, 0); }
#pragma unroll
                for (int r = 0; r < 4; ++r) su[(16 * a + 4 * fg + r) * 64 + 16 * d + fr] = acc[r];
            } }
        __syncthreads();
    } else {
        float qq[32];
        { unsigned short rq[32];
#pragma unroll
            for (int i = 0; i < 32; ++i) rq[i] = pr[(size_t)i * NMIX + 768];
            asm volatile("" ::: "memory");
#pragma unroll
            for (int i = 0; i < 32; ++i) qq[i] = bf2f(rq[i]); }
        if (half == 0) { REF[64 + lane] = bb[15]; REF[128 + lane] = bb[31]; } else REF[192 + lane] = bb[15];
        { const u32x4 z = {0u, 0u, 0u, 0u};
#pragma unroll
            for (int k2 = 0; k2 < 5; ++k2) { const int idx = lane + 64 * k2; if (idx < 32 * 9) *(LAS u32x4*)(hb + HG_P + 32 * half * HG_PT + idx * 16) = z; } }
        __syncthreads();
        float rf[4]; rf[0] = 0.f; rf[1] = REF[64 + lane]; rf[2] = REF[128 + lane]; rf[3] = REF[192 + lane];
        {
            const float r_lo = half ? rf[2] : rf[0], r_hi = half ? rf[3] : rf[1];
#pragma unroll
            for (int i = 0; i < 32; ++i) { const float rr = (i < 16) ? r_lo : r_hi; const float val = qq[i] * fast_exp(bb[i] - rr);
                *(LAS bf16_t*)(hb + HG_Q + (32 * half + i) * HG_PT + 2 * lane) = (bf16_t)f2bf(val); }
        }
#pragma unroll
        for (int isub = 0; isub < 4; ++isub) {
            const int nrows = 16 * (isub + 1) - 32 * half;
#pragma unroll
            for (int i = 0; i < 32; ++i) { if (i < nrows) { const float e = fminf(rf[isub] - bb[i], 60.f); const float val = kk[i] * fast_exp(e);
                    *(LAS bf16_t*)(hb + HG_K + (32 * half + i) * HG_PT + 2 * lane) = (bf16_t)f2bf(val); } }
            __syncthreads();
            {
                bf16x8 bq[2];
#pragma unroll
                for (int ks = 0; ks < 2; ++ks) bq[ks] = *(const LAS bf16x8*)(hb + HG_Q + (16 * isub + fr) * HG_PT + 64 * ks + 16 * fg);
#pragma unroll
                for (int j = 0; j <= isub; ++j) { if ((j & 1) == half) {
                        f32x4 acc = {0.f, 0.f, 0.f, 0.f};
#pragma unroll
                        for (int ks = 0; ks < 2; ++ks) { const bf16x8 ak = *(const LAS bf16x8*)(hb + HG_K + (16 * j + fr) * HG_PT + 64 * ks + 16 * fg);
                            acc = __builtin_amdgcn_mfma_f32_16x16x32_bf16(ak, bq[ks], acc, 0, 0, 0); }
                        if (j == isub) {
#pragma unroll
                            for (int r = 0; r < 4; ++r) if (4 * fg + r > fr) acc[r] = 0.f; }
                        u32x2 w; w.x = cvt_pk_bf16(acc[0], acc[1]); w.y = cvt_pk_bf16(acc[2], acc[3]);
                        *(LAS u32x2*)(hb + HG_P + (16 * isub + fr) * HG_PT + 2 * (16 * j + 4 * fg)) = w;
                    } }
            }
            __syncthreads();
        }
        {
            LAS unsigned char* vt = hb + HG_Q + lane * HG_PT + 64 * half;
#pragma unroll
            for (int q4 = 0; q4 < 4; ++q4) { u32x4 wv; unsigned vw[4];
#pragma unroll
                for (int p = 0; p < 4; ++p) { const int i = q4 * 8 + 2 * p; vw[p] = cvt_pk_bf16(vv[i], vv[i + 1]); }
                wv.x = vw[0]; wv.y = vw[1]; wv.z = vw[2]; wv.w = vw[3]; *(LAS u32x4*)(vt + q4 * 16) = wv; }
#pragma unroll
            for (int i = 0; i < 32; ++i) *(LAS bf16_t*)(hb + HG_K + (32 * half + i) * HG_PT + 2 * lane) = (bf16_t)f2bf(qq[i] * fast_exp(bb[i]));
        }
        __syncthreads();
        {
            const bf16_t* st = (const bf16_t*)(A.ws + WS_ST16) + ci * 4096;
            bf16x8 a_st[4][2];
#pragma unroll
            for (int a = 0; a < 4; ++a)
#pragma unroll
                for (int ks = 0; ks < 2; ++ks) a_st[a][ks] = *(const bf16x8*)(st + (16 * a + fr) * 64 + 32 * ks + 8 * fg);
            bf16_t* YS = (bf16_t*)(A.ws + WS_YS);
            const float* gn = A.in[I_HN] + l * 64;
            u32x2 gwv[2][4]; f32x4 gnv[4];
#pragma unroll
            for (int a = 0; a < 4; ++a) { gnv[a] = *(const f32x4*)(gn + 16 * a + 4 * fg);
#pragma unroll
                for (int tt = 0; tt < 2; ++tt) gwv[tt][a] = *(const u32x2*)(PROJ + (m0 + 16 * (2 * half + tt) + fr) * NMIX + 1536 + h * 64 + 16 * a + 4 * fg); }
#pragma unroll
            for (int tt = 0; tt < 2; ++tt) { const int ti = 2 * half + tt;
                bf16x8 bp[2], bqb[2];
#pragma unroll
                for (int ks = 0; ks < 2; ++ks) { bp[ks] = *(const LAS bf16x8*)(hb + HG_P + (16 * ti + fr) * HG_PT + 64 * ks + 16 * fg); bqb[ks] = *(const LAS bf16x8*)(hb + HG_K + (16 * ti + fr) * HG_PT + 64 * ks + 16 * fg); }
                f32x4 o[4]; float ss = 0.f;
#pragma unroll
                for (int a = 0; a < 4; ++a) { f32x4 acc = {0.f, 0.f, 0.f, 0.f};
#pragma unroll
                    for (int ks = 0; ks < 2; ++ks) { const bf16x8 av = *(const LAS bf16x8*)(hb + HG_Q + (16 * a + fr) * HG_PT + 64 * ks + 16 * fg);
                        acc = __builtin_amdgcn_mfma_f32_16x16x32_bf16(av, bp[ks], acc, 0, 0, 0);
                        acc = __builtin_amdgcn_mfma_f32_16x16x32_bf16(a_st[a][ks], bqb[ks], acc, 0, 0, 0); }
                    o[a] = acc; ss += (acc[0] * acc[0] + acc[1] * acc[1]) + (acc[2] * acc[2] + acc[3] * acc[3]); }
                ss += __shfl_xor(ss, 16); ss += __shfl_xor(ss, 32);
                const float rn = 1.0f / sqrtf(ss * (1.0f / 64.0f) + EPS);
                const size_t row = m0 + 16 * ti + fr;
#pragma unroll
                for (int a = 0; a < 4; ++a) { const int dv = 16 * a + 4 * fg;
                    const u32x2 gw = gwv[tt][a];
                    const float g0 = bf2f(gw.x & 0xffffu), g1 = bf2f(gw.x >> 16), g2 = bf2f(gw.y & 0xffffu), g3 = bf2f(gw.y >> 16);
                    const f32x4 gv = gnv[a];
                    const float y0 = o[a][0] * rn * gv[0] * (g0 * sigmoid_f(g0)), y1 = o[a][1] * rn * gv[1] * (g1 * sigmoid_f(g1));
                    const float y2 = o[a][2] * rn * gv[2] * (g2 * sigmoid_f(g2)), y3 = o[a][3] * rn * gv[3] * (g3 * sigmoid_f(g3));
                    u32x2 w; w.x = cvt_pk_bf16(y0, y1); w.y = cvt_pk_bf16(y2, y3);
                    *(u32x2*)(YS + row * D + 512 + h * 64 + dv) = w; }
            }
        }
        __syncthreads();
    }
}

__device__ __forceinline__ void mix_phase2(const Ctx& C, const Args& A) {
    int tid_ = C.tid; asm volatile("" : "+v"(tid_));
    if (C.G == 256) {
        if (C.vcu < 128) {
            float* __restrict__ SU = (float*)(A.ws + WS_SU); const float* __restrict__ SD = (const float*)(A.ws + WS_SD); bf16_t* __restrict__ ST16 = (bf16_t*)(A.ws + WS_ST16);
            const int e0 = C.vcu * NTHREADS + tid_, e1 = e0 + 65536;
            const int bh0 = e0 >> 12, kv0 = e0 & 4095, bh1 = e1 >> 12, kv1 = e1 & 4095;
            float s0 = 0.f, s1 = 0.f;
#pragma unroll 1
            for (int cb = 0; cb < 64; cb += 16) {
                float u0[16], d0[16], u1[16], d1[16];
#pragma unroll
                for (int i = 0; i < 16; ++i) { const size_t c0 = (size_t)bh0 * 64 + cb + i, c1 = (size_t)bh1 * 64 + cb + i;
                    u0[i] = SU[c0 * 4096 + kv0]; d0[i] = SD[c0 * 64 + (kv0 & 63)]; u1[i] = SU[c1 * 4096 + kv1]; d1[i] = SD[c1 * 64 + (kv1 & 63)]; }
#pragma unroll
                for (int i = 0; i < 16; ++i) { const size_t c0 = (size_t)bh0 * 64 + cb + i, c1 = (size_t)bh1 * 64 + cb + i;
                    ST16[c0 * 4096 + kv0] = (bf16_t)f2bf(s0); ST16[c1 * 4096 + kv1] = (bf16_t)f2bf(s1); s0 = d0[i] * s0 + u0[i]; s1 = d1[i] * s1 + u1[i]; }
            }
        } else if (C.vcu < 144) {
            const float* __restrict__ LA = (const float*)(A.ws + WS_LA); const float* __restrict__ LH = (const float*)(A.ws + WS_LH); float* __restrict__ LC = (float*)(A.ws + WS_LC);
            LAS float* SP = (LAS float*)C.lds; LAS float* SH = SP + 512;
            const int cl = tid_ & 127, seg = tid_ >> 7, chain = (C.vcu - 128) * 128 + cl, b = chain >> 8, ch = chain & 255;
            const size_t i0 = ((size_t)b * 128 + seg * 32) * 256 + ch;
            float a[32], hh[32];
#pragma unroll
            for (int i = 0; i < 32; ++i) { a[i] = LA[i0 + (size_t)i * 256]; hh[i] = LH[i0 + (size_t)i * 256]; }
            float P = 1.f, H = 0.f;
#pragma unroll
            for (int i = 0; i < 32; ++i) { H = a[i] * H + hh[i]; P *= a[i]; }
            SP[seg * 128 + cl] = P; SH[seg * 128 + cl] = H;
            __syncthreads();
            float cr = 0.f;
            for (int sg = 0; sg < seg; ++sg) cr = SP[sg * 128 + cl] * cr + SH[sg * 128 + cl];
#pragma unroll
            for (int i = 0; i < 32; ++i) { LC[i0 + (size_t)i * 256] = cr; cr = a[i] * cr + hh[i]; }
            __syncthreads();
        }
        return;
    }
    float* __restrict__ SU = (float*)(A.ws + WS_SU); const float* __restrict__ SD = (const float*)(A.ws + WS_SD);
    const int gt = C.vcu * NTHREADS + tid_, NGT = C.G * NTHREADS;
    for (int e = gt; e < 32 * 4096; e += NGT) {
        const int bh = e >> 12, kv = e & 4095, dk = kv & 63;
        bf16_t* __restrict__ ST16 = (bf16_t*)(A.ws + WS_ST16);
        float s = 0.f;
#pragma unroll 32
        for (int c = 0; c < 64; ++c) { const size_t ci = (size_t)bh * 64 + c; const float u = SU[ci * 4096 + kv]; const float d = SD[ci * 64 + dk]; ST16[ci * 4096 + kv] = (bf16_t)f2bf(s); s = d * s + u; }
    }
    const float* __restrict__ LA = (const float*)(A.ws + WS_LA); const float* __restrict__ LH = (const float*)(A.ws + WS_LH); float* __restrict__ LC = (float*)(A.ws + WS_LC);
    for (int e = gt; e < BATCH * BW; e += NGT) {
        const int b = e >> 8, ch = e & 255; float cr = 0.f;
#pragma unroll 32
        for (int sc = 0; sc < 128; ++sc) { const size_t i = ((size_t)b * 128 + sc) * 256 + ch; const float a = LA[i], hh = LH[i]; LC[i] = cr; cr = a * cr + hh; }
    }
}

#define XB_TMO      128
#define XB_XCNT(j)  (256  + 64 * (j))
#define XB_XSUB(j)  (1280 + 64 * (j))
#define XB_XGEN(j)  (2304 + 64 * (j))
#define XB_TOP      3328
#define XB_TOPGEN   3392
#define XCD_BAR_WORDS 3456
#define XB_SPIN_CAP (1u << 20)
__device__ __forceinline__ unsigned xb_ld(unsigned* p)              { return __hip_atomic_load(p, __ATOMIC_RELAXED, __HIP_MEMORY_SCOPE_AGENT); }
__device__ __forceinline__ unsigned xb_add(unsigned* p, unsigned v) { return __hip_atomic_fetch_add(p, v, __ATOMIC_RELAXED, __HIP_MEMORY_SCOPE_AGENT); }
__device__ __forceinline__ unsigned xb_xcc_id() { return (unsigned)__builtin_amdgcn_s_getreg((3 << 11) | 20) & 0xFu; }
#define XB_SPIN(cond, bar) do { unsigned _sp = 0; while (cond) { __builtin_amdgcn_s_sleep(1); \
    if ((++_sp & 255u) == 0u) { if (xb_ld(&(bar)[XB_TMO])) break; if (_sp > XB_SPIN_CAP) { atomicAdd(&(bar)[XB_TMO], 1u); break; } } } } while (0)
struct XcdBarrier { unsigned* bar; unsigned x; volatile LAS unsigned* st; };
__device__ __forceinline__ XcdBarrier xcd_barrier_post(unsigned* bar, volatile LAS unsigned* st) {
    XcdBarrier b; b.bar = bar; b.x = xb_xcc_id(); b.st = st;
    if (threadIdx.x == 0) (void)xb_add(&bar[XB_XCNT(b.x)], 1u);
    return b;
}
__device__ __forceinline__ void xcd_barrier_complete(unsigned* bar, unsigned x, unsigned& nloc, unsigned& nx) {
    const unsigned G = gridDim.x * gridDim.y * gridDim.z;
    unsigned sum, cnt, mine, sp = 0u;
    for (;;) {
        sum = 0u; cnt = 0u; mine = 0u;
#pragma unroll
        for (unsigned j = 0; j < 16; ++j) { const unsigned c = xb_ld(&bar[XB_XCNT(j)]); sum += c; cnt += (c > 0u) ? 1u : 0u; mine = (j == x) ? c : mine; }
        if (sum == G) break;
        __builtin_amdgcn_s_sleep(1);
        if ((++sp & 255u) == 0u) { if (xb_ld(&bar[XB_TMO])) break; if (sp > XB_SPIN_CAP) { atomicAdd(&bar[XB_TMO], 1u); break; } }
    }
    nloc = mine > 0u ? mine : 1u; nx = cnt > 0u ? cnt : 1u;
}
__device__ __forceinline__ void xcd_barrier(const XcdBarrier& b) {
    asm volatile("s_waitcnt vmcnt(0)" ::: "memory");
    __syncthreads();
    if (threadIdx.x == 0) {
        unsigned* bar = b.bar;
        __builtin_amdgcn_s_waitcnt(0);
        unsigned nloc = b.st[0], nx = b.st[1];
        if (nloc == 0u) { xcd_barrier_complete(bar, b.x, nloc, nx); b.st[0] = nloc; b.st[1] = nx; }
        const unsigned old = xb_add(&bar[XB_XSUB(b.x)], 1u);
        const unsigned gen = old / nloc;
        if (old + 1u == (gen + 1u) * nloc) {
            __builtin_amdgcn_fence(__ATOMIC_RELEASE, "agent");
            asm volatile("s_waitcnt vmcnt(0)" ::: "memory");
            const unsigned og = xb_add(&bar[XB_TOP], 1u);
            const unsigned tg = og / nx;
            if (og + 1u == (tg + 1u) * nx) xb_add(&bar[XB_TOPGEN], 1u);
            else XB_SPIN(xb_ld(&bar[XB_TOPGEN]) == tg, bar);
            __builtin_amdgcn_fence(__ATOMIC_ACQUIRE, "agent");
            xb_add(&bar[XB_XGEN(b.x)], 1u);
            asm volatile("s_waitcnt vmcnt(0)" ::: "memory");
        } else {
            XB_SPIN(xb_ld(&bar[XB_XGEN(b.x)]) == gen, bar);
            __builtin_amdgcn_fence(__ATOMIC_ACQUIRE, "agent");
            asm volatile("s_waitcnt vmcnt(0)" ::: "memory");
        }
    }
    __syncthreads();
}

constexpr int PH_PER_LAYER = 10, N_PHASES = 1 + DEPTH * PH_PER_LAYER;
constexpr int CW_BAR = 4096;
constexpr int CW_SEAM = 16384;
constexpr int CW_SEAM2 = 65536;

__global__ void __launch_bounds__(NTHREADS, 2) trunk_fwd(Args args) {
    extern __shared__ __attribute__((aligned(16))) unsigned char lds_raw[];
    Ctx C;
    C.lds = (LAS unsigned char*)lds_raw; C.tid = threadIdx.x; C.lane = C.tid & 63; C.wave = __builtin_amdgcn_readfirstlane(C.tid >> 6);
    C.G = gridDim.x; { const int bx = blockIdx.x; C.vcu = (C.G % 8 == 0) ? (bx % 8) * (C.G / 8) + bx / 8 : bx; }
    unsigned char* ws = args.ws;
    volatile LAS unsigned* MISC = (volatile LAS unsigned*)(C.lds + MISC_OFF);
    if (C.tid < 64) MISC[C.tid] = 0u;
    __syncthreads();
#if MK_PER_PHASE
#define GRID_BAR() do { } while (0)
#else
    cg::grid_group grid = cg::this_grid();
    XcdBarrier bar = xcd_barrier_post((unsigned*)(ws + WS_CTL) + CW_BAR, MISC + 8);
    bool first_bar = true;
#define GRID_BAR() do { if (first_bar) { grid.sync(); first_bar = false; } else { xcd_barrier(bar); } } while (0)
#endif
    const int lo = args.ph_lo, hi = args.ph_hi;
    int ph = 0;
#define PHASE_BEGIN if (ph >= lo && ph < hi) { for (int rep_ = 0; rep_ < (((DBG_REPEAT >> ((ph - 1) % PH_PER_LAYER + 1)) & 1) && ph > 0 ? 2 : 1); ++rep_) {
#define PHASE_END   if (rep_ == 0 && (((DBG_REPEAT >> ((ph - 1) % PH_PER_LAYER + 1)) & 1) && ph > 0)) GRID_BAR(); } if (ph + 1 < hi && ph + 1 < N_PHASES) GRID_BAR(); } ++ph;

    PHASE_BEGIN p0_prologue(C, args); PHASE_END

    for (int li = 0; li < DEPTH; ++li) {
        int l = li; asm volatile("" : "+s"(l));
        const unsigned char* wl = ws + WS_W + (size_t)l * W_LAYER;
        const float* RS = (const float*)(ws + WS_X2);
        PHASE_BEGIN {
            pg8::StaticOrder S; S.init(ws + WS_HB, wl + W_IN, M, NMIX, D, C.G, (int)blockIdx.x);
            pg8::EpiRow<1> E{(bf16_t*)(ws + WS_PROJ), NMIX, RS};
            pg8::gemm_phase<pg8::EpiRow<1>, pg8::StaticOrder, true>(C.lds, D, S, E);
        } PHASE_END
        PHASE_BEGIN {
            for (int item = C.vcu; item < BATCH * 64; item += C.G) { const int b = item >> 6, c = item & 63;
                mix1_item(C, args, l, b, c);
                hgrn_item<false>(C, args, l, b, c); }
        } PHASE_END
        PHASE_BEGIN {
            mix_phase2(C, args);
            int lane = C.lane; asm volatile("" : "+v"(lane));
            const int gw = C.vcu * NWAVES + C.wave, NGW = C.G * NWAVES;
            if (li == 0) {
                for (int it = gw; it < DEPTH * 2 * 4096; it += NGW) { const int ll = it >> 13, r = it & 8191, n = r & 4095;
                    const unsigned char* wll = ws + WS_W + (size_t)ll * W_LAYER;
                    if (r < 4096) quant_row_i8((const bf16_t*)(wll + W_IN) + (size_t)(NMIX + n) * D, (signed char*)(ws + WS_WG8) + ((size_t)ll * NGATE + n) * D, (float*)(ws + WS_SBG) + ll * NGATE + n, lane);
                    else quant_row_i8((const bf16_t*)(wll + W_UP) + (size_t)n * D, (signed char*)(ws + WS_WU8) + ((size_t)ll * FF + n) * D, (float*)(ws + WS_SBU) + ll * FF + n, lane); }
            }
        } PHASE_END
        PHASE_BEGIN {
            for (int item = C.vcu; item < BATCH * 64; item += C.G) { const int b = item >> 6, c = item & 63;
                lru_final_item(C, args, l, b, c);
                hgrn_item<true>(C, args, l, b, c); }
        } PHASE_END
        PHASE_BEGIN {
            unsigned char* gt = (unsigned char*)(ws + WS_G) + (size_t)blockIdx.x * 8 * 65536;
            {
                int t_ = C.tid; asm volatile("" : "+v"(t_));
                float nv = -1.f; asm volatile("" : "+v"(nv)); const f32x4 neg = {nv, nv, nv, nv};
                for (int i = C.vcu * NTHREADS + t_; i < 2 * M * 4; i += C.G * NTHREADS) *(f32x4*)(ws + (i < M * 4 ? WS_XS0 : WS_XS1 - (size_t)M * 64) + (size_t)i * 16) = neg;
            }
            {
                pg8::GateOrder8 S{(const char*)(ws + WS_HB8), (const char*)(ws + WS_WG8) + (size_t)l * NGATE * D, C.G, C.vcu};
                pg8::EpiGate8 E{gt, RS, (const float*)(ws + WS_SA), (const float*)(ws + WS_SBG) + l * NGATE};
                pg8::gemm_phase<pg8::EpiGate8, pg8::GateOrder8, true, true>(C.lds, D / 2, S, E);
            }
            {
                pg8::MergeOrder S{(const char*)(ws + WS_YS), (const char*)(wl + W_BR), C.G, C.vcu};
                pg8::EpiGate E{gt, (bf16_t*)(ws + WS_MERGED), RS};
                pg8::gemm_phase<pg8::EpiGate, pg8::MergeOrder, true>(C.lds, D, S, E);
            }
        } PHASE_END
        const bool fused_norm = (C.G == 256) && !MK_PER_PHASE;
        if (fused_norm) {
            PHASE_BEGIN {
                { const int half = 0;
                    pg8::PanelOrder S{(const char*)(ws + WS_MERGED), (const char*)(wl + W_OUT), (size_t)pg8::BM * D * 2, D / pg8::BK, half, C.vcu};
                    pg8::EpiNorm E{(bf16_t*)(ws + WS_HB), nullptr, args.in[I_NMIXPOST] + l * D, (float*)(ws + WS_XS0), (float*)(ws + WS_X2), (unsigned*)(ws + WS_CTL) + 8, C.lds + 131072, (signed char*)(ws + WS_HB8), (float*)(ws + WS_SA)};
                    pg8::gemm_phase<pg8::EpiNorm, pg8::PanelOrder, true>(C.lds, D, S, E);
                }
            } PHASE_END
            ++ph;
        } else {
        PHASE_BEGIN {
            pg8::StaticOrder S; S.init(ws + WS_MERGED, wl + W_OUT, M, D, D, C.G, (int)blockIdx.x);
            pg8::EpiRow<0> E{(bf16_t*)(ws + WS_MIX), D, nullptr};
            pg8::gemm_phase<pg8::EpiRow<0>, pg8::StaticOrder, true>(C.lds, D, S, E);
        } PHASE_END
        PHASE_BEGIN norm_phase(C, args, (const bf16_t*)(ws + WS_MIX), args.in[I_NMIXPOST] + l * D, false); PHASE_END
        }
        PHASE_BEGIN {
            pg8::StaticOrder S; S.init(ws + WS_HB8, ws + WS_WU8 + (size_t)l * FF * D, M, FF, D / 2, C.G, (int)blockIdx.x);
            pg8::EpiUp8 E{(bf16_t*)(ws + WS_HID), FF, RS, (const float*)(ws + WS_SA), (const float*)(ws + WS_SBU) + l * FF};
            pg8::gemm_phase<pg8::EpiUp8, pg8::StaticOrder, true, true>(C.lds, D / 2, S, E);
        } PHASE_END
        if (fused_norm) {
            PHASE_BEGIN {
                { const int half = 0;
                    pg8::PanelOrder S{(const char*)(ws + WS_HID), (const char*)(wl + W_DOWN), (size_t)pg8::BM * FF * 2, FF / pg8::BK, half, C.vcu};
                    pg8::EpiNorm E{(bf16_t*)(ws + WS_HB), (li == DEPTH - 1) ? args.out : nullptr, args.in[I_NMLPPOST] + l * D, (float*)(ws + WS_XS1), (float*)(ws + WS_X2), (unsigned*)(ws + WS_CTL) + 8, C.lds + 131072, (signed char*)(ws + WS_HB8), (float*)(ws + WS_SA)};
                    pg8::gemm_phase<pg8::EpiNorm, pg8::PanelOrder, true>(C.lds, FF, S, E);
                }
            } PHASE_END
            ++ph;
        } else {
        PHASE_BEGIN {
            pg8::StaticOrder S; S.init(ws + WS_HID, wl + W_DOWN, M, D, FF, C.G, (int)blockIdx.x);
            pg8::EpiRow<0> E{(bf16_t*)(ws + WS_MOUT), D, nullptr};
            pg8::gemm_phase<pg8::EpiRow<0>, pg8::StaticOrder, true>(C.lds, FF, S, E);
        } PHASE_END
        PHASE_BEGIN norm_phase(C, args, (const bf16_t*)(ws + WS_MOUT), args.in[I_NMLPPOST] + l * D, li == DEPTH - 1); PHASE_END
        }
    }
}

extern "C" void kernel_launch(void* const* d_in, const int* in_sizes, int n_in, void* d_out, int out_size, void* d_ws, size_t ws_size, hipStream_t stream) {
    static int grid = 0;
    if (grid == 0) {
        if (n_in != 22 || in_sizes[0] != M * D || out_size != M * D || ws_size < WS_END) { fprintf(stderr, "kernel_launch: unexpected shapes (n_in %d, in0 %d, out %d, ws %zu)\n", n_in, n_in > 0 ? in_sizes[0] : -1, out_size, ws_size); grid = -1; return; }
        int dev = 0, cus = 0, per_cu = 0;
        if (hipGetDevice(&dev) != hipSuccess || hipDeviceGetAttribute(&cus, hipDeviceAttributeMultiprocessorCount, dev) != hipSuccess) { grid = -1; return; }
        if (hipFuncSetAttribute((const void*)trunk_fwd, hipFuncAttributeMaxDynamicSharedMemorySize, LDS_BYTES) != hipSuccess) { fprintf(stderr, "kernel_launch: hipFuncSetAttribute failed\n"); grid = -1; return; }
        if (hipOccupancyMaxActiveBlocksPerMultiprocessor(&per_cu, (const void*)trunk_fwd, NTHREADS, LDS_BYTES) != hipSuccess || per_cu < 1) { fprintf(stderr, "kernel_launch: occupancy query says %d blocks per CU\n", per_cu); (void)hipGetLastError(); grid = -1; return; }
        grid = cus;
    }
    if (grid < 0) return;
    (void)hipMemsetAsync((char*)d_ws + WS_CTL, 0, CTL_ZERO_BYTES, stream);
    Args a{};
    for (int i = 0; i < 22; ++i) a.in[i] = (const float*)d_in[i];
    a.out = (float*)d_out; a.ws = (unsigned char*)d_ws;
#if MK_PER_PHASE
#ifndef DBG_MAXPH
#define DBG_MAXPH N_PHASES
#endif
    for (int p = 0; p < DBG_MAXPH; ++p) { a.ph_lo = p; a.ph_hi = p + 1; hipLaunchKernelGGL(trunk_fwd, dim3(grid), dim3(NTHREADS), LDS_BYTES, stream, a); }
#else
#if DBG_PREFIX > 0
    { a.ph_lo = 0; a.ph_hi = DBG_PREFIX; void* kargs0[] = {&a};
      (void)hipLaunchCooperativeKernel((const void*)trunk_fwd, dim3(grid), dim3(NTHREADS), kargs0, LDS_BYTES, stream);
      (void)hipMemsetAsync((char*)d_ws + WS_CTL, 0, CTL_ZERO_BYTES, stream); }
#endif
    a.ph_lo = 0; a.ph_hi = N_PHASES;
    void* kargs[] = {&a};
    hipError_t e = hipLaunchCooperativeKernel((const void*)trunk_fwd, dim3(grid), dim3(NTHREADS), kargs, LDS_BYTES, stream);
    if (e != hipSuccess) fprintf(stderr, "kernel_launch: cooperative launch failed: %s (grid %d)\n", hipGetErrorString(e), grid);
#endif
}
```

```cpp
#include <hip/hip_runtime.h>
#include <hip/hip_cooperative_groups.h>
#include <cstdio>
#include <cstdint>
namespace cg = cooperative_groups;

#ifndef DBG_ZERO
#define DBG_ZERO -1
#endif
#ifndef DBG_REPEAT
#define DBG_REPEAT 0
#endif
#ifndef MK_PER_PHASE
#define MK_PER_PHASE 0
#endif
#ifndef DBG_PREFIX
#define DBG_PREFIX 0
#endif

#define LAS __attribute__((address_space(3)))
#define GAS __attribute__((address_space(1)))
typedef unsigned short bf16_t;
typedef short bf16x8 __attribute__((ext_vector_type(8)));
typedef float f32x4 __attribute__((ext_vector_type(4)));
typedef float f32x2 __attribute__((ext_vector_type(2)));
typedef unsigned u32x4 __attribute__((ext_vector_type(4)));
typedef unsigned u32x2 __attribute__((ext_vector_type(2)));

constexpr int BATCH = 8, T = 4096, D = 1024, M = BATCH * T, DEPTH = 2, BW = 256;
constexpr int NMIX = 2560, NGATE = 4096, INW = NMIX + NGATE, FF = 4096;
constexpr float EPS = 1e-6f;
constexpr int NWAVES = 8, NTHREADS = 512;

constexpr size_t MiB = 1u << 20;
constexpr size_t WS_CTL = 0, CTL_ZERO_BYTES = 1 * MiB;
constexpr size_t WS_XM = 1 * MiB;
constexpr size_t WS_SD = 1 * MiB + 512 * 1024;
constexpr size_t WS_LA = 2 * MiB, WS_LH = 3 * MiB, WS_LC = 4 * MiB;
constexpr size_t WS_SP8 = 7 * MiB;
constexpr size_t WS_X1 = 5 * MiB;
constexpr size_t WS_X2 = 6 * MiB;
constexpr size_t WS_W = 8 * MiB;
constexpr size_t W_IN = 0, W_BR = 13 * MiB, W_OUT = 15 * MiB, W_UP = 17 * MiB, W_DOWN = 25 * MiB, W_LAYER = 33 * MiB;
constexpr size_t WS_HB = 76 * MiB;
constexpr size_t WS_PROJ = 140 * MiB;
constexpr size_t WS_G = WS_PROJ;
constexpr size_t WS_YS = 300 * MiB;
constexpr size_t WS_MERGED = 364 * MiB;
constexpr size_t WS_SU = WS_MERGED;
constexpr size_t WS_MIX = WS_PROJ;
constexpr size_t WS_MOUT = 396 * MiB;
constexpr size_t WS_HID = WS_PROJ;
constexpr size_t WS_HB8 = 460 * MiB;
constexpr size_t WS_WG8 = 492 * MiB;
constexpr size_t WS_SA = 7 * MiB + 64 * 1024;
constexpr size_t WS_SBG = 7 * MiB + 256 * 1024;
constexpr size_t WS_SBU = 7 * MiB + 320 * 1024;
constexpr size_t WS_SBD = 7 * MiB + 384 * 1024;
constexpr size_t WS_CSD = 7 * MiB + 400 * 1024;
constexpr size_t WS_SH = 7 * MiB + 416 * 1024;
constexpr size_t WS_EK = 7 * MiB + 420 * 1024;
constexpr size_t W_WD8 = 5 * MiB;
constexpr float HID_C2 = 4.5f * 4.5f;
constexpr size_t WS_WU8 = 500 * MiB;
constexpr size_t WS_XS0 = 428 * MiB, WS_XS1 = 444 * MiB;
constexpr size_t WS_END = 508 * MiB;

constexpr int LDS_BYTES = 155648;
constexpr int MISC_OFF = 154624;

__device__ __forceinline__ float bf2f(unsigned b) { return __uint_as_float(b << 16); }
__device__ __forceinline__ unsigned f2bf(float f) { unsigned u = __float_as_uint(f); return (u + 0x7fffu + ((u >> 16) & 1u)) >> 16; }
__device__ __forceinline__ unsigned pk2(float lo, float hi) { return f2bf(lo) | (f2bf(hi) << 16); }
typedef __bf16 bf16x2_t __attribute__((ext_vector_type(2)));
__device__ __forceinline__ unsigned cvt_pk_bf16(float lo, float hi) { f32x2 v = {lo, hi}; bf16x2_t b = __builtin_convertvector(v, bf16x2_t); return __builtin_bit_cast(unsigned, b); }
__device__ __forceinline__ float fast_exp(float x) { return __builtin_amdgcn_exp2f(x * 1.4426950408889634f); }
__device__ __forceinline__ float sigmoid_f(float x) { return __builtin_amdgcn_rcpf(1.0f + fast_exp(-x)); }
__device__ __forceinline__ void ld8bf(const bf16_t* p, float (&o)[8]) {
    const u32x4 v = *(const u32x4*)p;
    o[0] = bf2f(v.x & 0xffffu); o[1] = bf2f(v.x >> 16); o[2] = bf2f(v.y & 0xffffu); o[3] = bf2f(v.y >> 16);
    o[4] = bf2f(v.z & 0xffffu); o[5] = bf2f(v.z >> 16); o[6] = bf2f(v.w & 0xffffu); o[7] = bf2f(v.w >> 16);
}
__device__ __forceinline__ float rs_of(const float* X2, int row) { const f32x4 x = *(const f32x4*)(X2 + (size_t)row * 4); return 1.0f / sqrtf(((x[0] + x[1]) + (x[2] + x[3])) * (1.0f / D) + EPS); }
typedef int i32x4 __attribute__((ext_vector_type(4)));
__device__ __forceinline__ void rs_of8(const float* X2, int row0, float (&o)[2][4]) {
    const float* p = X2 + (size_t)row0 * 4; f32x4 v[2][4];
    asm volatile("global_load_dwordx4 %0, %8, off\n\tglobal_load_dwordx4 %1, %8, off offset:256\n\tglobal_load_dwordx4 %2, %8, off offset:512\n\tglobal_load_dwordx4 %3, %8, off offset:768\n\t"
                 "global_load_dwordx4 %4, %8, off offset:2048\n\tglobal_load_dwordx4 %5, %8, off offset:2304\n\tglobal_load_dwordx4 %6, %8, off offset:2560\n\tglobal_load_dwordx4 %7, %8, off offset:2816\n\ts_waitcnt vmcnt(0)"
                 : "=&v"(v[0][0]), "=&v"(v[0][1]), "=&v"(v[0][2]), "=&v"(v[0][3]), "=&v"(v[1][0]), "=&v"(v[1][1]), "=&v"(v[1][2]), "=&v"(v[1][3]) : "v"(p) : "memory");
#pragma unroll
    for (int ai = 0; ai < 2; ++ai)
#pragma unroll
        for (int m = 0; m < 4; ++m) { const f32x4 x = v[ai][m]; o[ai][m] = 1.0f / sqrtf(((x[0] + x[1]) + (x[2] + x[3])) * (1.0f / D) + EPS); }
}
__device__ __forceinline__ void ld_f32x8_rows(const float* SA_, int row0, float (&o)[2][4]) {
    const float* p = SA_ + row0;
    asm volatile("global_load_dword %0, %8, off\n\tglobal_load_dword %1, %8, off offset:64\n\tglobal_load_dword %2, %8, off offset:128\n\tglobal_load_dword %3, %8, off offset:192\n\t"
                 "global_load_dword %4, %8, off offset:512\n\tglobal_load_dword %5, %8, off offset:576\n\tglobal_load_dword %6, %8, off offset:640\n\tglobal_load_dword %7, %8, off offset:704\n\ts_waitcnt vmcnt(0)"
                 : "=&v"(o[0][0]), "=&v"(o[0][1]), "=&v"(o[0][2]), "=&v"(o[0][3]), "=&v"(o[1][0]), "=&v"(o[1][1]), "=&v"(o[1][2]), "=&v"(o[1][3]) : "v"(p) : "memory");
}
__device__ __forceinline__ void quant_row_i8(const bf16_t* src, signed char* dst, float* scale_out, int lane) {
    float x[16]; ld8bf(src + 16 * lane, *(float(*)[8])&x[0]); ld8bf(src + 16 * lane + 8, *(float(*)[8])&x[8]);
    float mx = 0.f;
#pragma unroll
    for (int j = 0; j < 16; ++j) mx = fmaxf(mx, fabsf(x[j]));
#pragma unroll
    for (int o = 1; o < 64; o <<= 1) mx = fmaxf(mx, __shfl_xor(mx, o));
    const float sc = (mx > 0.f) ? mx * (1.0f / 127.0f) : 1.0f, inv = 1.0f / sc;
    unsigned w[4];
#pragma unroll
    for (int p = 0; p < 4; ++p) { unsigned v = 0u;
#pragma unroll
        for (int e = 0; e < 4; ++e) { const int q = (int)__builtin_rintf(x[4 * p + e] * inv); v |= ((unsigned)q & 0xffu) << (8 * e); }
        w[p] = v; }
    *(u32x4*)(dst + 16 * lane) = (u32x4){w[0], w[1], w[2], w[3]};
    if (lane == 0) *scale_out = sc;
}
__device__ __forceinline__ unsigned q4_i8(const f32x4 v, float inv) { unsigned w = 0u;
#pragma unroll
    for (int e = 0; e < 4; ++e) { const int q = (int)__builtin_rintf(v[e] * inv); w |= ((unsigned)q & 0xffu) << (8 * e); }
    return w; }
__device__ __forceinline__ float wave_sum(float v) {
#pragma unroll
    for (int o = 1; o < 64; o <<= 1) v += __shfl_xor(v, o);
    return v;
}

namespace pg8 {
constexpr int BM = 256, BK = 64, HALF = 128, HTB = HALF * BK * 2, STAGE_BYTES = 8 * HTB, NXCD = 8, WGM = 4;
__host__ __device__ __forceinline__ int lds_byte(int r, int c) { const int st = (r >> 4) * 2 + (c >> 5), rr = r & 15, cc = c & 31, ob = rr * 64 + cc * 2; return st * 1024 + (ob ^ (((ob >> 9) & 1) << 5)); }
__host__ __device__ __forceinline__ void stage_rc(int b, int& R, int& C) { const int st = b / 1024, sb = b % 1024, swz = sb ^ (((sb >> 9) & 1) << 5); R = (st >> 1) * 16 + swz / 64; C = (st & 1) * 32 + (swz % 64) / 2; }
__host__ __device__ __forceinline__ int perm32(int rho) { const int n = rho >> 4, i = rho & 15; return 8 * (i >> 2) + 4 * n + (i & 3); }

struct Unit { int pm, pn, kind; };

struct StaticOrder {
    const char* A; const char* Bt; size_t tstep;
    int nM, nN, nwg, G, c;
    __device__ void init(const void* A_, const void* Bt_, int M_, int N_, int K_, int G_, int c_) { A = (const char*)A_; Bt = (const char*)Bt_; tstep = (size_t)BM * K_ * 2; nt = K_ / BK; nM = M_ / BM; nN = N_ / BM; nwg = nM * nN; G = G_; c = c_; }
    __device__ bool next(int i, Unit& u) const {
        const long L = (long)i * G + c; if (L >= nwg) return false;
        int wgid = (int)L; { const int q = nwg / NXCD, r = nwg % NXCD, xcd = wgid % NXCD, off = wgid / NXCD; wgid = (xcd < r ? xcd * (q + 1) : r * (q + 1) + (xcd - r) * q) + off; }
        const int nig = WGM * nN, gid = wgid / nig, fm = gid * WGM, gsz = (nM - fm) < WGM ? (nM - fm) : WGM;
        u.pm = fm + ((wgid % nig) % gsz); u.pn = (wgid % nig) / gsz; u.kind = 0; return true;
    }
    __device__ __forceinline__ void tiles(const Unit& u, const char*& a, const char*& b) const { a = A + (size_t)u.pm * tstep; b = Bt + (size_t)u.pn * tstep; }
    int nt;
    __device__ __forceinline__ int ntiles(const Unit&) const { return nt; }
    __device__ __forceinline__ bool keep_acc(const Unit&) const { return false; }
};

struct GateOrder {
    const char* HB; const char* WGt; const char* YS; const char* WB; int G, vcu;
    __device__ bool next(int i, Unit& u) const {
        const int r = i / 16, ii = i % 16, su = vcu + r * G; if (su >= 256) return false;
        const int half = ii / 8, j = ii % 8;
        u.pm = half * 64 + (su >> 2); u.kind = j; u.pn = (j < 4) ? (j * 4 + (su & 3)) : (su & 3); return true;
    }
    __device__ __forceinline__ int ntiles(const Unit& u) const { return u.kind < 4 ? 16 : 4; }
    __device__ __forceinline__ bool keep_acc(const Unit& nx) const { return nx.kind > 4; }
    __device__ __forceinline__ void tiles(const Unit& u, const char*& a, const char*& b) const {
        const size_t ts = (size_t)BM * 1024 * 2;
        if (u.kind < 4) { a = HB + (size_t)u.pm * ts; b = WGt + (size_t)u.pn * ts; } else { a = YS + (size_t)u.pm * ts + (size_t)(u.kind - 4) * 512; b = WB + (size_t)u.pn * ts + (size_t)(u.kind - 4) * 512; }
    }
};

struct GateOrder8 {
    const char* HB8; const char* WG8; int G, vcu;
    __device__ bool next(int i, Unit& u) const {
        const int r = i / 8, ii = i % 8, su = vcu + r * G; if (su >= 256) return false;
        u.pm = (ii >> 2) * 64 + (su >> 2); u.kind = ii; u.pn = (ii & 3) * 4 + (su & 3); return true;
    }
    __device__ __forceinline__ int ntiles(const Unit&) const { return 8; }
    __device__ __forceinline__ bool keep_acc(const Unit&) const { return false; }
    __device__ __forceinline__ void tiles(const Unit& u, const char*& a, const char*& b) const { a = HB8 + (size_t)u.pm * 262144; b = WG8 + (size_t)u.pn * 262144; }
};
struct MergeOrder {
    const char* YS; const char* WB; int G, vcu;
    __device__ bool next(int i, Unit& u) const {
        const int r = i / 8, ii = i % 8, su = vcu + r * G; if (su >= 256) return false;
        u.pm = (ii >> 2) * 64 + (su >> 2); u.kind = 4 + (ii & 3); u.pn = su & 3; return true;
    }
    __device__ __forceinline__ int ntiles(const Unit&) const { return 4; }
    __device__ __forceinline__ bool keep_acc(const Unit& nx) const { return nx.kind > 4; }
    __device__ __forceinline__ void tiles(const Unit& u, const char*& a, const char*& b) const {
        const size_t ts = (size_t)BM * 1024 * 2; a = YS + (size_t)u.pm * ts + (size_t)(u.kind - 4) * 512; b = WB + (size_t)u.pn * ts + (size_t)(u.kind - 4) * 512; }
};

template <int MODE  > struct EpiRow {
    static constexpr bool PERM = true; static constexpr bool ACC_INIT = false;
    bf16_t* O; int ldc; const float* rs;
    __device__ __forceinline__ void operator()(f32x4 (&acc)[2][2][4][2], const Unit& u, int wr, int wc, int fr, int fq) const {
        const int row0 = u.pm * BM + wr * 64 + fr, col0 = u.pn * BM + wc * 32 + 8 * fq;
        float scv[2][4];
        if (MODE != 0) rs_of8(rs, row0, scv);
#pragma unroll
        for (int ai = 0; ai < 2; ++ai)
#pragma unroll
            for (int m = 0; m < 4; ++m) {
                const int row = row0 + ai * HALF + m * 16; const float sc = scv[ai][m];
                bf16_t* rowp = O + (size_t)row * ldc + col0;
#pragma unroll
                for (int bj = 0; bj < 2; ++bj) {
                    f32x4 v0 = acc[ai][bj][m][0], v1 = acc[ai][bj][m][1];
                    if (MODE != 0) { v0 = v0 * sc; v1 = v1 * sc; }
                    if (MODE == 2) {
#pragma unroll
                        for (int j = 0; j < 4; ++j) { const float a = fmaxf(v0[j], 0.f), b = fmaxf(v1[j], 0.f); v0[j] = a * a; v1[j] = b * b; }
                    }
                    u32x4 w; w.x = cvt_pk_bf16(v0[0], v0[1]); w.y = cvt_pk_bf16(v0[2], v0[3]); w.z = cvt_pk_bf16(v1[0], v1[1]); w.w = cvt_pk_bf16(v1[2], v1[3]);
                    *(u32x4*)(rowp + bj * HALF) = w;
                }
            }
    }
};

__device__ __forceinline__ unsigned pack_u8x4(float a, float b, float c, float d) { unsigned w = 0u;
    w = __builtin_amdgcn_cvt_pk_u8_f32(a * 256.0f - 0.5f, 0, w); w = __builtin_amdgcn_cvt_pk_u8_f32(b * 256.0f - 0.5f, 1, w); w = __builtin_amdgcn_cvt_pk_u8_f32(c * 256.0f - 0.5f, 2, w); w = __builtin_amdgcn_cvt_pk_u8_f32(d * 256.0f - 0.5f, 3, w); return w; }
__device__ __forceinline__ f32x4 unpack_u8x4(unsigned w) { return (f32x4){(float)(w & 0xffu) + 0.5f, (float)((w >> 8) & 0xffu) + 0.5f, (float)((w >> 16) & 0xffu) + 0.5f, (float)(w >> 24) + 0.5f}; }
struct EpiGate {
    static constexpr bool PERM = true; static constexpr bool ACC_INIT = false;
    unsigned char* Gt;
    bf16_t* MERGED;
    const float* rs;
    __device__ __forceinline__ void rescale(f32x4 (&acc)[2][2][4][2], int hsel, int j, int wr, int wc, int fr, int fq) const {
        int lane_off = (wr * 64 + fr) * 256 + wc * 32 + 8 * fq; asm volatile("" : "+v"(lane_off));
        const unsigned char* g0 = Gt + (size_t)(hsel * 4 + j) * 65536; const unsigned char* g1 = g0 + 65536;
#pragma unroll
        for (int ai = 0; ai < 2; ++ai) {
            u32x2 a[4][2], b[4][2];
#pragma unroll
            for (int m = 0; m < 4; ++m)
#pragma unroll
                for (int bj = 0; bj < 2; ++bj) { const int off = lane_off + (ai * HALF + m * 16) * 256 + bj * HALF; a[m][bj] = *(const u32x2*)(g0 + off); b[m][bj] = *(const u32x2*)(g1 + off); }
#pragma unroll
            for (int m = 0; m < 4; ++m)
#pragma unroll
                for (int bj = 0; bj < 2; ++bj) {
                    const f32x4 a0 = unpack_u8x4(a[m][bj].x), a1 = unpack_u8x4(a[m][bj].y), b0 = unpack_u8x4(b[m][bj].x), b1 = unpack_u8x4(b[m][bj].y);
#pragma unroll
                    for (int q = 0; q < 4; ++q) { acc[ai][bj][m][0][q] *= a0[q] * __builtin_amdgcn_rcpf(b0[q]); acc[ai][bj][m][1][q] *= a1[q] * __builtin_amdgcn_rcpf(b1[q]); }
                }
            asm volatile("" ::: "memory");
        }
    }
    __device__ __forceinline__ void operator()(f32x4 (&acc)[2][2][4][2], const Unit& u, int wr, int wc, int fr, int fq) const {
        if (u.kind >= 4 && u.kind < 7) { rescale(acc, u.pm >> 6, u.kind - 4, wr, wc, fr, fq); return; }
        int rl0 = wr * 64 + fr, cl0 = wc * 32 + 8 * fq; asm volatile("" : "+v"(rl0), "+v"(cl0));
        if (u.kind < 4) {
            unsigned char* gt = Gt + (size_t)u.kind * 65536;
#pragma unroll
            for (int ai = 0; ai < 2; ++ai)
#pragma unroll
                for (int m = 0; m < 4; ++m) {
                    const int rl = rl0 + ai * HALF + m * 16; const float sc = rs_of(rs, u.pm * BM + rl);
#pragma unroll
                    for (int bj = 0; bj < 2; ++bj) {
                        f32x4 v0 = acc[ai][bj][m][0] * sc, v1 = acc[ai][bj][m][1] * sc;
#pragma unroll
                        for (int j = 0; j < 4; ++j) { v0[j] = sigmoid_f(fmaxf(v0[j], -60.f)); v1[j] = sigmoid_f(fmaxf(v1[j], -60.f)); }
                        u32x2 w; w.x = pack_u8x4(v0[0], v0[1], v0[2], v0[3]); w.y = pack_u8x4(v1[0], v1[1], v1[2], v1[3]);
                        *(u32x2*)(gt + rl * 256 + cl0 + bj * HALF) = w;
                    }
                }
        } else {
            const unsigned char* g3 = Gt + (size_t)((u.pm >> 6) * 4 + 3) * 65536;
#pragma unroll
            for (int ai = 0; ai < 2; ++ai) {
                u32x2 swv[4][2];
#pragma unroll
                for (int m = 0; m < 4; ++m)
#pragma unroll
                    for (int bj = 0; bj < 2; ++bj) swv[m][bj] = *(const u32x2*)(g3 + (rl0 + ai * HALF + m * 16) * 256 + cl0 + bj * HALF);
#pragma unroll
                for (int m = 0; m < 4; ++m) {
                    const int rl = rl0 + ai * HALF + m * 16;
                    bf16_t* rowp = MERGED + (size_t)(u.pm * BM + rl) * 1024 + u.pn * BM + cl0;
#pragma unroll
                    for (int bj = 0; bj < 2; ++bj) {
                        const u32x2 sw = swv[m][bj];
                        const f32x4 s0 = unpack_u8x4(sw.x) * (1.0f / 256.0f), s1 = unpack_u8x4(sw.y) * (1.0f / 256.0f);
                        const f32x4 v0 = acc[ai][bj][m][0] * s0, v1 = acc[ai][bj][m][1] * s1;
                        u32x4 w; w.x = cvt_pk_bf16(v0[0], v0[1]); w.y = cvt_pk_bf16(v0[2], v0[3]); w.z = cvt_pk_bf16(v1[0], v1[1]); w.w = cvt_pk_bf16(v1[2], v1[3]);
                        *(u32x4*)(rowp + bj * HALF) = w;
                    }
                }
            }
        }
    }
};

struct EpiGate8 {
    static constexpr bool PERM = true; static constexpr bool ACC_INIT = false;
    unsigned char* Gt;
    const float* rs; const float* sa; const float* sb;
    __device__ __forceinline__ void operator()(f32x4 (&acc)[2][2][4][2], const Unit& u, int wr, int wc, int fr, int fq) const {
        int rl0 = wr * 64 + fr, cl0 = wc * 32 + 8 * fq; asm volatile("" : "+v"(rl0), "+v"(cl0));
        unsigned char* gt = Gt + (size_t)u.kind * 65536;
        f32x4 cs[2][2];
#pragma unroll
        for (int bj = 0; bj < 2; ++bj) { cs[bj][0] = *(const f32x4*)(sb + u.pn * BM + cl0 + bj * HALF); cs[bj][1] = *(const f32x4*)(sb + u.pn * BM + cl0 + bj * HALF + 4); }
        float scv[2][4], rsv[2][4], sav[2][4];
        rs_of8(rs, u.pm * BM + rl0, rsv); ld_f32x8_rows(sa, u.pm * BM + rl0, sav);
#pragma unroll
        for (int ai = 0; ai < 2; ++ai)
#pragma unroll
            for (int m = 0; m < 4; ++m) scv[ai][m] = -1.4426950408889634f * rsv[ai][m] * sav[ai][m];
#pragma unroll
        for (int ai = 0; ai < 2; ++ai)
#pragma unroll
            for (int m = 0; m < 4; ++m) {
                const int rl = rl0 + ai * HALF + m * 16; const float sc = scv[ai][m];
#pragma unroll
                for (int bj = 0; bj < 2; ++bj) {
                    const i32x4 i0 = __builtin_bit_cast(i32x4, acc[ai][bj][m][0]), i1 = __builtin_bit_cast(i32x4, acc[ai][bj][m][1]);
                    f32x4 v0, v1;
#pragma unroll
                    for (int j = 0; j < 4; ++j) { v0[j] = __builtin_amdgcn_rcpf(1.0f + __builtin_amdgcn_exp2f((float)i0[j] * (sc * cs[bj][0][j]))); v1[j] = __builtin_amdgcn_rcpf(1.0f + __builtin_amdgcn_exp2f((float)i1[j] * (sc * cs[bj][1][j]))); }
                    u32x2 w; w.x = pack_u8x4(v0[0], v0[1], v0[2], v0[3]); w.y = pack_u8x4(v1[0], v1[1], v1[2], v1[3]);
                    *(u32x2*)(gt + rl * 256 + cl0 + bj * HALF) = w;
                }
            }
    }
};

struct EpiUp8 {
    static constexpr bool PERM = true; static constexpr bool ACC_INIT = false;
    bf16_t* O; int ldc; const float* rs; const float* sa; const float* sb;
    __device__ __forceinline__ void operator()(f32x4 (&acc)[2][2][4][2], const Unit& u, int wr, int wc, int fr, int fq) const {
        int rl0 = wr * 64 + fr, cl0 = wc * 32 + 8 * fq; asm volatile("" : "+v"(rl0), "+v"(cl0));
        f32x4 cs[2][2];
#pragma unroll
        for (int bj = 0; bj < 2; ++bj) { cs[bj][0] = *(const f32x4*)(sb + u.pn * BM + cl0 + bj * HALF); cs[bj][1] = *(const f32x4*)(sb + u.pn * BM + cl0 + bj * HALF + 4); }
        float scv[2][4], rsv[2][4], sav[2][4];
        rs_of8(rs, u.pm * BM + rl0, rsv); ld_f32x8_rows(sa, u.pm * BM + rl0, sav);
#pragma unroll
        for (int ai = 0; ai < 2; ++ai)
#pragma unroll
            for (int m = 0; m < 4; ++m) scv[ai][m] = rsv[ai][m] * sav[ai][m];
#pragma unroll
        for (int ai = 0; ai < 2; ++ai)
#pragma unroll
            for (int m = 0; m < 4; ++m) {
                const int row = u.pm * BM + rl0 + ai * HALF + m * 16; const float sc = scv[ai][m];
                bf16_t* rowp = O + (size_t)row * ldc + u.pn * BM + cl0;
#pragma unroll
                for (int bj = 0; bj < 2; ++bj) {
                    const i32x4 i0 = __builtin_bit_cast(i32x4, acc[ai][bj][m][0]), i1 = __builtin_bit_cast(i32x4, acc[ai][bj][m][1]);
                    f32x4 v0, v1;
#pragma unroll
                    for (int j = 0; j < 4; ++j) { const float a = fmaxf((float)i0[j] * (sc * cs[bj][0][j]), 0.f), b = fmaxf((float)i1[j] * (sc * cs[bj][1][j]), 0.f); v0[j] = a * a; v1[j] = b * b; }
                    u32x4 w; w.x = cvt_pk_bf16(v0[0], v0[1]); w.y = cvt_pk_bf16(v0[2], v0[3]); w.z = cvt_pk_bf16(v1[0], v1[1]); w.w = cvt_pk_bf16(v1[2], v1[3]);
                    __builtin_nontemporal_store(w, (u32x4*)(rowp + bj * HALF));
                }
            }
    }
};

struct Fused5Order {
    const char* HB8; const char* WG8; const char* YS; const char* WB; int team, mem;
    __device__ bool next(int i, Unit& u) const { if (i >= 32) return false; const int ti = i >> 3; u.kind = i & 7; u.pm = (ti >> 1) * 64 + team; u.pn = mem * 2 + (ti & 1); return true; }
    __device__ __forceinline__ int ntiles(const Unit& u) const { return (u.kind & 1) ? 4 : 8; }
    __device__ __forceinline__ bool keep_acc(const Unit&) const { return false; }
    __device__ __forceinline__ void tiles(const Unit& u, const char*& a, const char*& b) const { const int k = u.kind >> 1;
        if (!(u.kind & 1)) { a = HB8 + (size_t)u.pm * 262144; b = WG8 + (size_t)(k * 1024 + u.pn * 128) * 1024; }
        else { a = YS + (size_t)u.pm * (256 * 2048) + (size_t)k * 512; b = WB + (size_t)u.pn * (128 * 2048) + (size_t)k * 512; } }
};
struct EpiFused5 {
    static constexpr bool PERM = true; static constexpr bool ACC_INIT = false;
    bf16_t* MERGED; LAS const float* CS; LAS const float* RSC;
    mutable u32x4 total[2][4]; mutable u32x2 spk[2][4];
    __device__ __forceinline__ void operator()(f32x4 (&acc)[2][2][4][2], const Unit& u, int wr, int wc, int fr, int fq) const {
        const int su = u.kind, k = su >> 1;
        int rl0 = wr * 64 + fr, cl0 = wc * 32 + 8 * fq; asm volatile("" : "+v"(rl0), "+v"(cl0));
        if (!(su & 1)) {
            LAS const float* sbp = CS + k * 256 + (u.pn & 1) * 128 + cl0; const f32x4 c0 = *(LAS const f32x4*)sbp, c1 = *(LAS const f32x4*)(sbp + 4);
            LAS const float* rsp = RSC + (u.pm >> 6) * 256 + rl0;
#pragma unroll
            for (int ai = 0; ai < 2; ++ai)
#pragma unroll
                for (int m = 0; m < 4; ++m) { const float sc = rsp[ai * HALF + m * 16];
                    const i32x4 i0 = __builtin_bit_cast(i32x4, acc[ai][0][m][0]), i1 = __builtin_bit_cast(i32x4, acc[ai][0][m][1]);
                    f32x4 v0, v1;
#pragma unroll
                    for (int j = 0; j < 4; ++j) { v0[j] = __builtin_amdgcn_rcpf(1.0f + __builtin_amdgcn_exp2f((float)i0[j] * (sc * c0[j]))); v1[j] = __builtin_amdgcn_rcpf(1.0f + __builtin_amdgcn_exp2f((float)i1[j] * (sc * c1[j]))); }
                    u32x2 w; w.x = pack_u8x4(v0[0], v0[1], v0[2], v0[3]); w.y = pack_u8x4(v1[0], v1[1], v1[2], v1[3]); spk[ai][m] = w; }
        } else {
#pragma unroll
            for (int ai = 0; ai < 2; ++ai)
#pragma unroll
                for (int m = 0; m < 4; ++m) { const f32x4 s0 = unpack_u8x4(spk[ai][m].x) * (1.0f / 256.0f), s1 = unpack_u8x4(spk[ai][m].y) * (1.0f / 256.0f);
                    const u32x4 t = total[ai][m];
                    f32x4 v0 = {bf2f(t.x & 0xffffu), bf2f(t.x >> 16), bf2f(t.y & 0xffffu), bf2f(t.y >> 16)}, v1 = {bf2f(t.z & 0xffffu), bf2f(t.z >> 16), bf2f(t.w & 0xffffu), bf2f(t.w >> 16)};
                    if (su == 1) { v0 = (f32x4){0.f, 0.f, 0.f, 0.f}; v1 = v0; }
                    v0 = v0 + s0 * acc[ai][0][m][0]; v1 = v1 + s1 * acc[ai][0][m][1];
                    u32x4 w; w.x = cvt_pk_bf16(v0[0], v0[1]); w.y = cvt_pk_bf16(v0[2], v0[3]); w.z = cvt_pk_bf16(v1[0], v1[1]); w.w = cvt_pk_bf16(v1[2], v1[3]);
                    total[ai][m] = w;
                    if (su == 7) *(u32x4*)(MERGED + (size_t)(u.pm * BM + rl0 + ai * HALF + m * 16) * 1024 + u.pn * 128 + cl0) = w; }
        }
    }
};

struct EpiUp8Q {
    static constexpr bool PERM = true; static constexpr bool ACC_INIT = false;
    signed char* O; int ldc; const float* rs; const float* sa; const float* sb; float sq_inv_sh;
    __device__ __forceinline__ void operator()(f32x4 (&acc)[2][2][4][2], const Unit& u, int wr, int wc, int fr, int fq) const {
        int rl0 = wr * 64 + fr, cl0 = wc * 32 + 8 * fq; asm volatile("" : "+v"(rl0), "+v"(cl0));
        f32x4 cs[2][2];
#pragma unroll
        for (int bj = 0; bj < 2; ++bj) { cs[bj][0] = *(const f32x4*)(sb + u.pn * BM + cl0 + bj * HALF); cs[bj][1] = *(const f32x4*)(sb + u.pn * BM + cl0 + bj * HALF + 4); }
        float scv[2][4], rsv[2][4], sav[2][4];
        rs_of8(rs, u.pm * BM + rl0, rsv); ld_f32x8_rows(sa, u.pm * BM + rl0, sav);
#pragma unroll
        for (int ai = 0; ai < 2; ++ai)
#pragma unroll
            for (int m = 0; m < 4; ++m) scv[ai][m] = rsv[ai][m] * sav[ai][m] * sq_inv_sh;
#pragma unroll
        for (int ai = 0; ai < 2; ++ai)
#pragma unroll
            for (int m = 0; m < 4; ++m) {
                const int row = u.pm * BM + rl0 + ai * HALF + m * 16; const float sc = scv[ai][m];
                signed char* rowp = O + (size_t)row * ldc + u.pn * BM + cl0;
#pragma unroll
                for (int bj = 0; bj < 2; ++bj) {
                    const i32x4 i0 = __builtin_bit_cast(i32x4, acc[ai][bj][m][0]), i1 = __builtin_bit_cast(i32x4, acc[ai][bj][m][1]);
                    float ta[4], tb[4];
#pragma unroll
                    for (int j = 0; j < 4; ++j) { const float a = (float)i0[j] * (sc * cs[bj][0][j]), b = (float)i1[j] * (sc * cs[bj][1][j]); ta[j] = a * __builtin_fabsf(a); tb[j] = b * __builtin_fabsf(b); }
                    unsigned w0 = 0u, w1 = 0u;
                    w0 = __builtin_amdgcn_cvt_pk_u8_f32(ta[0], 0, w0); w0 = __builtin_amdgcn_cvt_pk_u8_f32(ta[1], 1, w0); w0 = __builtin_amdgcn_cvt_pk_u8_f32(ta[2], 2, w0); w0 = __builtin_amdgcn_cvt_pk_u8_f32(ta[3], 3, w0);
                    w1 = __builtin_amdgcn_cvt_pk_u8_f32(tb[0], 0, w1); w1 = __builtin_amdgcn_cvt_pk_u8_f32(tb[1], 1, w1); w1 = __builtin_amdgcn_cvt_pk_u8_f32(tb[2], 2, w1); w1 = __builtin_amdgcn_cvt_pk_u8_f32(tb[3], 3, w1);
                    *(u32x2*)(rowp + bj * HALF) = (u32x2){w0 ^ 0x80808080u, w1 ^ 0x80808080u};
                }
            }
    }
};

struct UpTeamOrder {
    const char* A; const char* Bt; int team, mem;
    __device__ bool next(int i, Unit& u) const { if (i >= 8) return false; u.pm = (i >> 2) * 64 + team; u.pn = mem * 4 + (i & 3); u.kind = 0; return true; }
    __device__ __forceinline__ void tiles(const Unit& u, const char*& a, const char*& b) const { a = A + (size_t)u.pm * 262144; b = Bt + (size_t)u.pn * 262144; }
    __device__ __forceinline__ int ntiles(const Unit&) const { return 8; }
    __device__ __forceinline__ bool keep_acc(const Unit&) const { return false; }
};
struct PanelOrder {
    const char* A; const char* Bt; size_t tstep; int nt, half, vcu;
    __device__ bool next(int i, Unit& u) const { if (i > 1) return false; u.pm = i * 64 + (vcu >> 2); u.pn = vcu & 3; u.kind = 0; return true; }
    __device__ __forceinline__ void tiles(const Unit& u, const char*& a, const char*& b) const { a = A + (size_t)u.pm * tstep; b = Bt + (size_t)u.pn * tstep; }
    __device__ __forceinline__ int ntiles(const Unit&) const { return nt; }
    __device__ __forceinline__ bool keep_acc(const Unit&) const { return false; }
};
__device__ __forceinline__ void st_sys16(float* p, f32x4 v) { asm volatile("global_store_dwordx4 %0, %1, off sc0 sc1" :: "v"(p), "v"(v) : "memory"); }
__device__ __forceinline__ void ld_sys16x4(const float* p, f32x4 (&v)[4]) {
    asm volatile("global_load_dwordx4 %0, %4, off sc0 sc1\n\tglobal_load_dwordx4 %1, %4, off offset:16 sc0 sc1\n\tglobal_load_dwordx4 %2, %4, off offset:32 sc0 sc1\n\tglobal_load_dwordx4 %3, %4, off offset:48 sc0 sc1\n\ts_waitcnt vmcnt(0)"
                 : "=&v"(v[0]), "=&v"(v[1]), "=&v"(v[2]), "=&v"(v[3]) : "v"(p) : "memory"); }
template <bool A8> struct EpiNormT {
    static constexpr bool PERM = true; static constexpr bool ACC_INIT = A8;
    bf16_t* HB; float* OUTF; const float* gain; float* XS; float* X2; unsigned* tmo; LAS unsigned char* sp;
    signed char* HB8; float* SA;
    const float* sbd; const int* csd;
    __device__ __forceinline__ void acc_init(f32x4 (&acc)[2][2][4][2], const Unit& u, int wc, int lane) const {
        const int* cp = csd + u.pn * BM + wc * 32 + 8 * (lane >> 4);
#pragma unroll
        for (int bj = 0; bj < 2; ++bj)
#pragma unroll
            for (int n = 0; n < 2; ++n) { const f32x4 c = __builtin_bit_cast(f32x4, *(const i32x4*)(cp + bj * HALF + 4 * n));
#pragma unroll
                for (int ai = 0; ai < 2; ++ai)
#pragma unroll
                    for (int m = 0; m < 4; ++m) acc[ai][bj][m][n] = c; }
    }
    __device__ __forceinline__ void operator()(f32x4 (&acc)[2][2][4][2], const Unit& u, int wr_, int wc_, int fr_, int fq_) const {
        int wr = wr_, wc = wc_, fr = fr_, fq = fq_; asm volatile("" : "+s"(wr), "+s"(wc), "+v"(fr), "+v"(fq));
        LAS float* P = (LAS float*)sp;
        LAS float* PM = (LAS float*)(sp + 4096);
        LAS float* PB = (LAS float*)(sp + 8192);
        LAS unsigned char* STG = sp;
        LAS float* R = (LAS float*)(sp + 16896);
        LAS float* RI = (LAS float*)(sp + 17920);
        LAS float* P2 = (LAS float*)(sp + 18944);
        int tid = (wr * 4 + wc) * 64 + fq * 16 + fr; asm volatile("" : "+v"(tid));
        int rl0 = wr * 64 + fr, cl0 = wc * 32 + 8 * fq; asm volatile("" : "+v"(rl0), "+v"(cl0));
        f32x4 gv[2][2];
#pragma unroll
        for (int bj = 0; bj < 2; ++bj) { gv[bj][0] = *(const f32x4*)(gain + u.pn * BM + cl0 + bj * HALF); gv[bj][1] = *(const f32x4*)(gain + u.pn * BM + cl0 + bj * HALF + 4); }
        f32x4 fsv[2][2];
        if constexpr (A8) {
#pragma unroll
            for (int bj = 0; bj < 2; ++bj) { fsv[bj][0] = *(const f32x4*)(sbd + u.pn * BM + cl0 + bj * HALF); fsv[bj][1] = *(const f32x4*)(sbd + u.pn * BM + cl0 + bj * HALF + 4);
                gv[bj][0] = gv[bj][0] * fsv[bj][0]; gv[bj][1] = gv[bj][1] * fsv[bj][1]; }
        }
#pragma unroll
        for (int ai = 0; ai < 2; ++ai)
#pragma unroll
            for (int m = 0; m < 4; ++m) { float s = 0.f;
#pragma unroll
                for (int bj = 0; bj < 2; ++bj)
#pragma unroll
                    for (int n = 0; n < 2; ++n) { f32x4 x = acc[ai][bj][m][n];
                        if constexpr (A8) { const i32x4 iv = __builtin_bit_cast(i32x4, x); x = (f32x4){(float)iv[0], (float)iv[1], (float)iv[2], (float)iv[3]} * fsv[bj][n]; }
                        s += (x[0] * x[0] + x[1] * x[1]) + (x[2] * x[2] + x[3] * x[3]); }
                s += __shfl_xor(s, 16); s += __shfl_xor(s, 32);
                if (fq == 0) P[(ai * HALF + wr * 64 + m * 16 + fr) * 4 + wc] = s; }
        asm volatile("s_waitcnt lgkmcnt(0)" ::: "memory"); __builtin_amdgcn_s_barrier(); asm volatile("" ::: "memory");
#pragma unroll
        for (int ai = 0; ai < 2; ++ai) {
            constexpr int MB = A8 ? 2 : 4;
#pragma unroll
            for (int mg = 0; mg < 4; mg += MB) {
            u32x4 hw2[4][2];
#pragma unroll
            for (int m = mg; m < mg + MB; ++m)
#pragma unroll
                for (int bj = 0; bj < 2; ++bj) hw2[m][bj] = *(const u32x4*)(HB + ((size_t)u.pm * BM + rl0 + ai * HALF + m * 16) * 1024 + u.pn * BM + cl0 + bj * HALF);
            asm volatile("s_waitcnt vmcnt(0)" ::: "memory");
#pragma unroll
            for (int m = mg; m < mg + MB; ++m) { const int rl = rl0 + ai * HALF + m * 16;
                const f32x4 p = *(const LAS f32x4*)(P + rl * 4); const float re = 1.0f / sqrtf(((p[0] + p[1]) + (p[2] + p[3])) * (1.0f / 256.0f) + 1e-6f);
                float mx = 0.f, bx = 0.f;
#pragma unroll
                for (int bj = 0; bj < 2; ++bj) { const u32x4 w = hw2[m][bj];
                    const f32x4 h0 = {bf2f(w.x & 0xffffu), bf2f(w.x >> 16), bf2f(w.y & 0xffffu), bf2f(w.y >> 16)}, h1 = {bf2f(w.z & 0xffffu), bf2f(w.z >> 16), bf2f(w.w & 0xffffu), bf2f(w.w >> 16)};
                    f32x4 x0 = acc[ai][bj][m][0], x1 = acc[ai][bj][m][1];
                    if constexpr (A8) { const i32x4 i0 = __builtin_bit_cast(i32x4, x0), i1 = __builtin_bit_cast(i32x4, x1);
                        x0 = (f32x4){(float)i0[0], (float)i0[1], (float)i0[2], (float)i0[3]}; x1 = (f32x4){(float)i1[0], (float)i1[1], (float)i1[2], (float)i1[3]}; }
                    const f32x4 a0 = gv[bj][0] * x0, a1 = gv[bj][1] * x1; acc[ai][bj][m][0] = a0; acc[ai][bj][m][1] = a1;
                    const f32x4 t0 = h0 + a0 * re, t1 = h1 + a1 * re;
#pragma unroll
                    for (int q = 0; q < 4; ++q) { mx = fmaxf(mx, fmaxf(fabsf(t0[q]), fabsf(t1[q]))); bx = fmaxf(bx, fmaxf(fabsf(a0[q]), fabsf(a1[q]))); } }
                mx = fmaxf(mx, __shfl_xor(mx, 16)); mx = fmaxf(mx, __shfl_xor(mx, 32)); bx = fmaxf(bx, __shfl_xor(bx, 16)); bx = fmaxf(bx, __shfl_xor(bx, 32));
                if (fq == 0) { PM[rl * 4 + wc] = mx; PB[rl * 4 + wc] = bx; } }
            }
        }
        asm volatile("s_waitcnt lgkmcnt(0)" ::: "memory"); __builtin_amdgcn_s_barrier(); asm volatile("" ::: "memory");
        if (tid < 256) {
            const f32x4 p = *(const LAS f32x4*)(P + tid * 4), pm4 = *(const LAS f32x4*)(PM + tid * 4), pb4 = *(const LAS f32x4*)(PB + tid * 4);
            const float ss = (p[0] + p[1]) + (p[2] + p[3]);
            float* slots = XS + ((size_t)u.pm * BM + tid) * 16;
            st_sys16(slots + u.pn * 4, (f32x4){ss, fmaxf(fmaxf(pm4[0], pm4[1]), fmaxf(pm4[2], pm4[3])), fmaxf(fmaxf(pb4[0], pb4[1]), fmaxf(pb4[2], pb4[3])), 1.0f / sqrtf(ss * (1.0f / 256.0f) + 1e-6f)});
            f32x4 s4[4]; unsigned spins = 0;
            for (;;) {
                bool ok = true;
                ld_sys16x4(slots, s4);
#pragma unroll
                for (int t = 0; t < 4; ++t) ok = ok && (s4[t][0] >= 0.f) && (s4[t][1] >= 0.f) && (s4[t][2] >= 0.f) && (s4[t][3] >= 0.f);
                if (__builtin_amdgcn_ballot_w64(!ok) == 0ull) break;
                __builtin_amdgcn_s_sleep(1);
                if (++spins > (1u << 20)) { __hip_atomic_store(tmo, 1u, __ATOMIC_RELAXED, __HIP_MEMORY_SCOPE_AGENT); break; }
            }
            const float r = 1.0f / sqrtf(((s4[0][0] + s4[1][0]) + (s4[2][0] + s4[3][0])) * (1.0f / 1024.0f) + 1e-6f);
            float bound = 0.f;
#pragma unroll
            for (int t = 0; t < 4; ++t) bound = fmaxf(bound, s4[t][1] + s4[t][2] * fabsf(r - s4[t][3]));
            bound *= 1.00001f;
            const float sc = (bound > 0.f) ? bound * (1.0f / 127.0f) : 1.0f;
            R[tid] = r; RI[tid] = 1.0f / sc; if (u.pn == 0 && !OUTF) SA[(size_t)u.pm * BM + tid] = sc;
        }
        asm volatile("s_waitcnt lgkmcnt(0)" ::: "memory"); __builtin_amdgcn_s_barrier(); asm volatile("" ::: "memory");
#pragma unroll
        for (int ai = 0; ai < 2; ++ai) {
            u32x4 hwv[4][2];
            if constexpr (true) {
#pragma unroll
            for (int m = 0; m < 4; ++m)
#pragma unroll
                for (int bj = 0; bj < 2; ++bj) hwv[m][bj] = *(const u32x4*)(HB + ((size_t)u.pm * BM + rl0 + ai * HALF + m * 16) * 1024 + u.pn * BM + cl0 + bj * HALF);
            }
#pragma unroll
            for (int mh = 0; mh < 2; ++mh) {
            if constexpr (false) {
#pragma unroll
            for (int m = 2 * mh; m < 2 * mh + 2; ++m)
#pragma unroll
                for (int bj = 0; bj < 2; ++bj) hwv[m][bj] = *(const u32x4*)(HB + ((size_t)u.pm * BM + rl0 + ai * HALF + m * 16) * 1024 + u.pn * BM + cl0 + bj * HALF);
            }
#pragma unroll
            for (int mm = 0; mm < 2; ++mm) { const int m = 2 * mh + mm; const int rl = rl0 + ai * HALF + m * 16; const float r = R[rl], inv = RI[rl]; const size_t go = ((size_t)u.pm * BM + rl) * 1024 + u.pn * BM + cl0;
                float s2 = 0.f;
#pragma unroll
                for (int bj = 0; bj < 2; ++bj) { const u32x4 w = hwv[m][bj];
                    f32x4 h0 = {bf2f(w.x & 0xffffu), bf2f(w.x >> 16), bf2f(w.y & 0xffffu), bf2f(w.y >> 16)}, h1 = {bf2f(w.z & 0xffffu), bf2f(w.z >> 16), bf2f(w.w & 0xffffu), bf2f(w.w >> 16)};
                    h0 = h0 + acc[ai][bj][m][0] * r; h1 = h1 + acc[ai][bj][m][1] * r;
                    s2 += (h0[0] * h0[0] + h0[1] * h0[1]) + (h0[2] * h0[2] + h0[3] * h0[3]) + (h1[0] * h1[0] + h1[1] * h1[1]) + (h1[2] * h1[2] + h1[3] * h1[3]);
                    if (OUTF) { *(f32x4*)(OUTF + go + bj * HALF) = h0; *(f32x4*)(OUTF + go + bj * HALF + 4) = h1; }
                    else { u32x4 o; o.x = cvt_pk_bf16(h0[0], h0[1]); o.y = cvt_pk_bf16(h0[2], h0[3]); o.z = cvt_pk_bf16(h1[0], h1[1]); o.w = cvt_pk_bf16(h1[2], h1[3]); __builtin_nontemporal_store(o, (u32x4*)(HB + go + bj * HALF));
                        u32x2 q; q.x = q4_i8(h0, inv); q.y = q4_i8(h1, inv); *(LAS u32x2*)(STG + ((wr * 2 + mm) * 16 + fr) * 264 + bj * HALF + cl0) = q; } }
                s2 += __shfl_xor(s2, 16); s2 += __shfl_xor(s2, 32);
                if (fq == 0) P2[rl * 4 + wc] = s2; }
            if (!OUTF) {
                asm volatile("s_waitcnt lgkmcnt(0)" ::: "memory"); __builtin_amdgcn_s_barrier(); asm volatile("" ::: "memory");
                int t2 = tid; asm volatile("" : "+v"(t2)); const int srow = t2 >> 3, seg = t2 & 7;
                const LAS u32x2* sp8 = (const LAS u32x2*)(STG + srow * 264 + seg * 32);
                const u32x2 a0 = sp8[0], a1 = sp8[1], a2 = sp8[2], a3 = sp8[3];
                const int rlo = (srow >> 5) * 64 + ai * HALF + (2 * mh + ((srow >> 4) & 1)) * 16 + (srow & 15);
                signed char* gp = HB8 + ((size_t)u.pm * BM + rlo) * 1024 + u.pn * BM + seg * 32;
                *(u32x4*)gp = (u32x4){a0.x, a0.y, a1.x, a1.y}; *(u32x4*)(gp + 16) = (u32x4){a2.x, a2.y, a3.x, a3.y};
                asm volatile("s_waitcnt lgkmcnt(0)" ::: "memory"); __builtin_amdgcn_s_barrier(); asm volatile("" ::: "memory");
            }
            }
        }
        asm volatile("s_waitcnt lgkmcnt(0)" ::: "memory"); __builtin_amdgcn_s_barrier(); asm volatile("" ::: "memory");
        if (tid < 256) { const f32x4 p = *(const LAS f32x4*)(P2 + tid * 4); X2[((size_t)u.pm * BM + tid) * 4 + u.pn] = (p[0] + p[1]) + (p[2] + p[3]); }
    }
};
typedef EpiNormT<false> EpiNorm; typedef EpiNormT<true> EpiNorm8;

template <class Epi, class Sched, bool ALIGN_EPI, bool I8 = false, bool HALFB = false, bool MIXED = false>
__device__ __forceinline__ void gemm_phase(LAS unsigned char* lds, const int K, const Sched& S, const Epi& E) {
    int tid = threadIdx.x; asm volatile("" : "+v"(tid));
    const int wid = __builtin_amdgcn_readfirstlane(tid >> 6), lane = tid & 63, wr = wid >> 2, wc = wid & 3, fr = lane & 15, fq = lane >> 4;
    unsigned voffA[2], voffB[2], nvoffA[2], nvoffB[2];
#pragma unroll
    for (int i = 0; i < 2; ++i) { int R, C; stage_rc(tid * 16 + i * 8192, R, C); const int Rb = Epi::PERM ? ((R & ~31) + perm32(R & 31)) : R;
        if constexpr (MIXED) { voffA[i] = (unsigned)(R * 512 + C) * 2u; voffB[i] = (unsigned)(Rb * 512 + C) * 2u; nvoffA[i] = (unsigned)(R * 1024 + C) * 2u; nvoffB[i] = (unsigned)(Rb * 1024 + C) * 2u; }
        else { voffA[i] = (unsigned)(R * K + C) * 2u; voffB[i] = (unsigned)(Rb * K + C) * 2u; nvoffA[i] = voffA[i]; nvoffB[i] = voffB[i]; } }
    const size_t kstep = (size_t)(BK * 2);
    size_t hstep = MIXED ? (size_t)HALF * 512 * 2 : (size_t)HALF * K * 2, nhstep = MIXED ? (size_t)HALF * 1024 * 2 : hstep;
    bool cg8 = true;
    const unsigned ldsw = (unsigned)wid * 1024u;
    const int aoff = lds_byte(wr * 64 + fr, fq * 8), boff = lds_byte(wc * 32 + fr, fq * 8);
#define PG8_SA(b, h) (((b) * 2 + (h)) * HTB)
#define PG8_SB(b, h) ((4 + (b) * 2 + (h)) * HTB)
#define PG8_STAGE(bufoff, gbase, voff) do { _Pragma("unroll") for (int _i = 0; _i < 2; ++_i) \
        __builtin_amdgcn_global_load_lds((const unsigned*)((const char*)(gbase) + (voff)[_i]), (LAS unsigned*)(lds + (bufoff) + ldsw + _i * 8192), 16, 0, 0); } while (0)
#define PG8_LDA(dst, b, h) do { _Pragma("unroll") for (int m = 0; m < 4; ++m) _Pragma("unroll") for (int k = 0; k < 2; ++k) dst[m][k] = *(const LAS bf16x8*)(lds + PG8_SA(b, h) + aoff + m * 2048 + k * 1024); } while (0)
#define PG8_LDB(dst, b, h) do { _Pragma("unroll") for (int n = 0; n < 2; ++n) _Pragma("unroll") for (int k = 0; k < 2; ++k) dst[n][k] = *(const LAS bf16x8*)(lds + PG8_SB(b, h) + boff + n * 2048 + k * 1024); } while (0)
#define PG8_MMA8(ai, bj, At, Bt) do { _Pragma("unroll") for (int m = 0; m < 4; ++m) _Pragma("unroll") for (int n = 0; n < 2; ++n) _Pragma("unroll") for (int k = 0; k < 2; ++k) \
        acc[ai][bj][m][n] = __builtin_bit_cast(f32x4, __builtin_amdgcn_mfma_i32_16x16x64_i8(__builtin_bit_cast(i32x4, Bt[n][k]), __builtin_bit_cast(i32x4, At[m][k]), __builtin_bit_cast(i32x4, acc[ai][bj][m][n]), 0, 0, 0)); } while (0)
#define PG8_MMA16(ai, bj, At, Bt) do { _Pragma("unroll") for (int m = 0; m < 4; ++m) _Pragma("unroll") for (int n = 0; n < 2; ++n) _Pragma("unroll") for (int k = 0; k < 2; ++k) \
        acc[ai][bj][m][n] = __builtin_amdgcn_mfma_f32_16x16x32_bf16(Bt[n][k], At[m][k], acc[ai][bj][m][n], 0, 0, 0); } while (0)
#define PG8_MMA(ai, bj, At, Bt) do { __builtin_amdgcn_s_setprio(1); \
        if constexpr (MIXED) { if (cg8) PG8_MMA8(ai, bj, At, Bt); else PG8_MMA16(ai, bj, At, Bt); } else if constexpr (I8) PG8_MMA8(ai, bj, At, Bt); else PG8_MMA16(ai, bj, At, Bt); \
        __builtin_amdgcn_s_setprio(0); } while (0)
#define PG8_WAIT_V(n) asm volatile("s_waitcnt vmcnt(" #n ")" ::: "memory")
#define PG8_WAIT_VK do { if constexpr (HALFB) PG8_WAIT_V(6); else PG8_WAIT_V(8); } while (0)
#define PG8_WAIT_L(n) asm volatile("s_waitcnt lgkmcnt(" #n ")" ::: "memory")
#define PG8_BAR __builtin_amdgcn_s_barrier()
#define PG8_SCHED __builtin_amdgcn_sched_barrier(0)
    Unit cur, nxt; int ui = 0;
    if (!S.next(0, cur)) return;
    f32x4 acc[2][2][4][2];
#pragma unroll
    for (int a = 0; a < 2; ++a)
#pragma unroll
        for (int b = 0; b < 2; ++b)
#pragma unroll
            for (int m = 0; m < 4; ++m)
#pragma unroll
                for (int n = 0; n < 2; ++n) acc[a][b][m][n] = (f32x4){0.f, 0.f, 0.f, 0.f};
    if constexpr (Epi::ACC_INIT) E.acc_init(acc, cur, wc, lane);
    bf16x8 At[4][2], B0[2][2], B1[2][2];
    const char* cA; const char* cB; S.tiles(cur, cA, cB);
    PG8_STAGE(PG8_SB(0, 0), cB, voffB); if constexpr (!HALFB) PG8_STAGE(PG8_SB(0, 1), cB + hstep, voffB); PG8_STAGE(PG8_SA(0, 0), cA, voffA); PG8_STAGE(PG8_SA(0, 1), cA + hstep, voffA);
    if (wr == 1) PG8_BAR;
    PG8_WAIT_V(2); PG8_BAR;
    PG8_STAGE(PG8_SB(1, 0), cB + kstep, voffB); PG8_STAGE(PG8_SA(1, 0), cA + kstep, voffA); if constexpr (!HALFB) PG8_STAGE(PG8_SB(1, 1), cB + hstep + kstep, voffB);
    if constexpr (HALFB) PG8_WAIT_V(4); else PG8_WAIT_V(6); PG8_BAR;
    for (;;) {
        const bool has_next = S.next(ui + 1, nxt);
        const char* nA = cA; const char* nB = cB; if (has_next) S.tiles(nxt, nA, nB);
#define PG8_KT2(t, last) do { \
            const char* a1 = cA + (size_t)((t) + 1) * kstep; \
            const char* a2 = (last) ? nA : cA + (size_t)((t) + 2) * kstep; const char* b2 = (last) ? nB : cB + (size_t)((t) + 2) * kstep; \
            const char* a3 = a2 + kstep; const char* b3 = b2 + kstep; \
            unsigned sA[2], sB[2]; sA[0] = voffA[0]; sA[1] = voffA[1]; sB[0] = voffB[0]; sB[1] = voffB[1]; size_t sh = hstep; \
            if constexpr (MIXED) { if (last) { sA[0] = nvoffA[0]; sA[1] = nvoffA[1]; sB[0] = nvoffB[0]; sB[1] = nvoffB[1]; sh = nhstep; } } \
            PG8_LDB(B0, 0, 0); if constexpr (!HALFB) PG8_LDB(B1, 0, 1); PG8_SCHED; PG8_LDA(At, 0, 0); PG8_STAGE(PG8_SA(1, 1), a1 + hstep, voffA); \
            PG8_WAIT_VK; PG8_WAIT_L(0); PG8_BAR; PG8_MMA(0, 0, At, B0); if constexpr (!HALFB) PG8_MMA(0, 1, At, B1); PG8_BAR; PG8_SCHED; \
            PG8_LDA(At, 0, 1); PG8_STAGE(PG8_SB(0, 0), b2, sB); if constexpr (!HALFB) PG8_STAGE(PG8_SB(0, 1), b2 + sh, sB); PG8_STAGE(PG8_SA(0, 0), a2, sA); \
            PG8_WAIT_VK; PG8_WAIT_L(0); PG8_BAR; PG8_MMA(1, 0, At, B0); if constexpr (!HALFB) PG8_MMA(1, 1, At, B1); PG8_BAR; PG8_SCHED; \
            PG8_LDB(B0, 1, 0); if constexpr (!HALFB) PG8_LDB(B1, 1, 1); PG8_SCHED; PG8_LDA(At, 1, 0); PG8_STAGE(PG8_SA(0, 1), a2 + sh, sA); \
            PG8_WAIT_VK; PG8_WAIT_L(0); PG8_BAR; PG8_MMA(0, 0, At, B0); if constexpr (!HALFB) PG8_MMA(0, 1, At, B1); PG8_BAR; PG8_SCHED; \
            PG8_LDA(At, 1, 1); PG8_STAGE(PG8_SB(1, 0), b3, sB); if constexpr (!HALFB) PG8_STAGE(PG8_SB(1, 1), b3 + sh, sB); PG8_STAGE(PG8_SA(1, 0), a3, sA); \
            PG8_WAIT_VK; PG8_WAIT_L(0); PG8_BAR; PG8_MMA(1, 0, At, B0); if constexpr (!HALFB) PG8_MMA(1, 1, At, B1); PG8_BAR; PG8_SCHED; } while (0)
        {
            const int ntc = S.ntiles(cur);
#pragma unroll 1
            for (int t = 0; t < ntc; t += 2) { const bool last = (t == ntc - 2); PG8_KT2(t, last); }
        }
        if constexpr (ALIGN_EPI) { if (wr == 0) PG8_BAR; }
        { const int ln_ = (int)__builtin_amdgcn_mbcnt_hi(~0u, __builtin_amdgcn_mbcnt_lo(~0u, 0u)); E(acc, cur, wr, wc, ln_ & 15, ln_ >> 4); }
        if (!has_next) break;
        if (!S.keep_acc(nxt)) {
#pragma unroll
        for (int a = 0; a < 2; ++a)
#pragma unroll
            for (int b = 0; b < 2; ++b)
#pragma unroll
                for (int m = 0; m < 4; ++m)
#pragma unroll
                    for (int n = 0; n < 2; ++n) acc[a][b][m][n] = (f32x4){0.f, 0.f, 0.f, 0.f};
        }
        if constexpr (Epi::ACC_INIT) { const int ln2_ = (int)__builtin_amdgcn_mbcnt_hi(~0u, __builtin_amdgcn_mbcnt_lo(~0u, 0u)); E.acc_init(acc, nxt, wc, ln2_); }
        cur = nxt; cA = nA; cB = nB; ++ui;
        if constexpr (MIXED) {
#pragma unroll
            for (int i = 0; i < 2; ++i) { const unsigned ta = voffA[i]; voffA[i] = nvoffA[i]; nvoffA[i] = ta; const unsigned tb = voffB[i]; voffB[i] = nvoffB[i]; nvoffB[i] = tb; }
            const size_t th = hstep; hstep = nhstep; nhstep = th; cg8 = !cg8; }
        if constexpr (ALIGN_EPI) { if (wr == 1) PG8_BAR; }
    }
    PG8_WAIT_V(0);
    if constexpr (!ALIGN_EPI) { if (wr == 0) PG8_BAR; }
    PG8_BAR;
#undef PG8_KT2
#undef PG8_SA
#undef PG8_SB
#undef PG8_STAGE
#undef PG8_LDA
#undef PG8_LDB
#undef PG8_MMA
#undef PG8_MMA8
#undef PG8_MMA16
#undef PG8_WAIT_VK
#undef PG8_WAIT_V
#undef PG8_WAIT_L
#undef PG8_BAR
#undef PG8_SCHED
}
}

struct Args {
    const float* in[22]; float* out; unsigned char* ws; int ph_lo, ph_hi;
};
enum { I_X = 0, I_NMIXPRE, I_NMIXPOST, I_NMLPPRE, I_NMLPPOST, I_WIN, I_LCW, I_LCB, I_LWA, I_LBA, I_LWX, I_LBX, I_LLAM, I_PW, I_PS, I_HLB, I_HN, I_SW, I_WBR, I_WOUT, I_WUP, I_WDOWN };

struct Ctx {
    LAS unsigned char* lds; int tid, lane, wave, vcu, G;
};

__device__ __forceinline__ void transpose_item(const float* W, int ldw, const float* gain, bf16_t* WT, int ldo, int col_off, int k0, int n0, LAS float* scr, int lane) {
    float wv[32];
#pragma unroll
    for (int i = 0; i < 32; ++i) { const int kk = 2 * i + (lane >> 5); wv[i] = W[(size_t)(k0 + kk) * ldw + n0 + (lane & 31)]; }
    const int c = lane & 7;
    f32x4 g0 = {1.f, 1.f, 1.f, 1.f}, g1 = g0;
    if (gain) { g0 = *(const f32x4*)(gain + k0 + 8 * c); g1 = *(const f32x4*)(gain + k0 + 8 * c + 4); }
#pragma unroll
    for (int i = 0; i < 32; ++i) { const int kk = 2 * i + (lane >> 5); scr[kk * 33 + (lane & 31)] = wv[i]; }
    asm volatile("s_waitcnt lgkmcnt(0)" ::: "memory");
#pragma unroll
    for (int j = 0; j < 4; ++j) { const int n = (lane >> 3) + 8 * j; const LAS float* s = scr + (8 * c) * 33 + n;
        u32x4 o; o.x = pk2(g0[0] * s[0 * 33], g0[1] * s[1 * 33]); o.y = pk2(g0[2] * s[2 * 33], g0[3] * s[3 * 33]); o.z = pk2(g1[0] * s[4 * 33], g1[1] * s[5 * 33]); o.w = pk2(g1[2] * s[6 * 33], g1[3] * s[7 * 33]);
        *(u32x4*)(WT + (size_t)(n0 + n) * ldo + col_off + k0 + 8 * c) = o; }
    asm volatile("s_waitcnt lgkmcnt(0)" ::: "memory");
}

__device__ __forceinline__ void p0_prologue(const Ctx& C, const Args& A) {
    LAS float* scr = (LAS float*)(C.lds + C.wave * 16384);
    const int gw = C.vcu * NWAVES + C.wave, NGW = C.G * NWAVES;
    constexpr int I_IN = (D / 64) * (INW / 32), I_BR1 = (BW / 64) * (D / 32), I_OUT = (D / 64) * (D / 32), I_UP = (D / 64) * (FF / 32), I_DN = (FF / 64) * (D / 32);
    constexpr int PER_LAYER = I_IN + 4 * I_BR1 + I_OUT + I_UP + I_DN;
    for (int it = gw; it < DEPTH * PER_LAYER; it += NGW) {
        const int l = it / PER_LAYER; int r = it % PER_LAYER;
        bf16_t* wl = (bf16_t*)(A.ws + WS_W + (size_t)l * W_LAYER);
        if (r < I_IN) { const int nb = INW / 32; transpose_item(A.in[I_WIN] + (size_t)l * D * INW, INW, A.in[I_NMIXPRE] + l * D, wl + W_IN / 2, D, 0, 64 * (r / nb), 32 * (r % nb), scr, C.lane); continue; } r -= I_IN;
        if (r < 4 * I_BR1) { const int k = r / I_BR1, rr = r % I_BR1, nb = D / 32; transpose_item(A.in[I_WBR] + ((size_t)l * 4 + k) * BW * D, D, nullptr, wl + W_BR / 2, D, k * BW, 64 * (rr / nb), 32 * (rr % nb), scr, C.lane); continue; } r -= 4 * I_BR1;
        if (r < I_OUT) { const int nb = D / 32; transpose_item(A.in[I_WOUT] + (size_t)l * D * D, D, nullptr, wl + W_OUT / 2, D, 0, 64 * (r / nb), 32 * (r % nb), scr, C.lane); continue; } r -= I_OUT;
        if (r < I_UP) { const int nb = FF / 32; transpose_item(A.in[I_WUP] + (size_t)l * D * FF, FF, A.in[I_NMLPPRE] + l * D, wl + W_UP / 2, D, 0, 64 * (r / nb), 32 * (r % nb), scr, C.lane); continue; } r -= I_UP;
        { const int nb = D / 32; transpose_item(A.in[I_WDOWN] + (size_t)l * FF * D, D, nullptr, wl + W_DOWN / 2, FF, 0, 64 * (r / nb), 32 * (r % nb), scr, C.lane); }
    }
    {
        int lane = C.lane; asm volatile("" : "+v"(lane));
        for (int it = gw; it < DEPTH * D; it += NGW) { const int ll = it >> 10, k = it & 1023;
            const f32x4* wr_ = (const f32x4*)(A.in[I_WUP] + ((size_t)ll * D + k) * FF) + lane;
            f32x4 v[16];
#pragma unroll
            for (int i = 0; i < 16; ++i) v[i] = wr_[64 * i];
            float sq = 0.f;
#pragma unroll
            for (int i = 0; i < 16; ++i) sq += (v[i].x * v[i].x + v[i].y * v[i].y) + (v[i].z * v[i].z + v[i].w * v[i].w);
            sq = wave_sum(sq);
            const float g = A.in[I_NMLPPRE][ll * D + k];
            if (lane == 0) ((float*)(A.ws + WS_EK))[ll * D + k] = g * g * sq * (1.0f / FF); }
    }
    { const int gt = gw * 64 + C.lane; if (gt < DEPTH * BW) { const float lam = A.in[I_LLAM][gt]; ((float*)(A.ws + WS_SP8))[gt] = -8.0f * ((-lam > 20.f) ? -lam : log1pf(expf(-lam))); } }
    bf16_t* HB = (bf16_t*)(A.ws + WS_HB); float* RS = (float*)(A.ws + WS_X2);
    for (int m0 = gw; m0 < M; m0 += 4 * NGW) {
        f32x4 v[4][4];
#pragma unroll
        for (int q = 0; q < 4; ++q) { const int m = m0 + q * NGW; const f32x4* xr = (const f32x4*)(A.in[I_X] + (size_t)(m < M ? m : 0) * D) + C.lane;
#pragma unroll
            for (int j = 0; j < 4; ++j) v[q][j] = xr[64 * j]; }
#pragma unroll
        for (int q = 0; q < 4; ++q) { const int m = m0 + q * NGW; if (m < M) { float s = 0.f;
#pragma unroll
            for (int j = 0; j < 4; ++j) s += (v[q][j].x * v[q][j].x + v[q][j].y * v[q][j].y) + (v[q][j].z * v[q][j].z + v[q][j].w * v[q][j].w);
            s = wave_sum(s);
            u32x2* o8 = (u32x2*)(HB + (size_t)m * D) + C.lane;
#pragma unroll
            for (int j = 0; j < 4; ++j) { u32x2 w; w.x = pk2(v[q][j].x, v[q][j].y); w.y = pk2(v[q][j].z, v[q][j].w); o8[64 * j] = w; }
            float mx = 0.f;
#pragma unroll
            for (int j = 0; j < 4; ++j) mx = fmaxf(fmaxf(mx, fmaxf(fabsf(v[q][j].x), fabsf(v[q][j].y))), fmaxf(fabsf(v[q][j].z), fabsf(v[q][j].w)));
#pragma unroll
            for (int o = 1; o < 64; o <<= 1) mx = fmaxf(mx, __shfl_xor(mx, o));
            const float sc = (mx > 0.f) ? mx * (1.0f / 127.0f) : 1.0f, inv = 1.0f / sc;
            unsigned* o4 = (unsigned*)(A.ws + WS_HB8 + (size_t)m * D) + C.lane;
#pragma unroll
            for (int j = 0; j < 4; ++j) o4[64 * j] = q4_i8(v[q][j], inv);
            if (C.lane == 0) { *(f32x4*)(RS + (size_t)m * 4) = (f32x4){s, 0.f, 0.f, 0.f}; ((float*)(A.ws + WS_SA))[m] = sc; } } }
    }
}

__device__ __forceinline__ void norm_phase(const Ctx& C, const Args& A, const bf16_t* VIN, const float* gain, bool write_out) {
    bf16_t* HB = (bf16_t*)(A.ws + WS_HB); float* RS = (float*)(A.ws + WS_X2); float* OUT = A.out;
    int lane = C.lane; asm volatile("" : "+v"(lane));
    const int gw = C.vcu * NWAVES + C.wave, NGW = C.G * NWAVES;
    f32x4 g[4];
#pragma unroll
    for (int j = 0; j < 4; ++j) g[j] = ((const f32x4*)gain)[lane + 64 * j];
    for (int m = gw; m < M; m += NGW) {
        u32x2* hb = (u32x2*)(HB + (size_t)m * D) + lane;
        const u32x2* vb = (const u32x2*)(VIN + (size_t)m * D) + lane;
        f32x4 v[4], h[4]; float s = 0.f;
#pragma unroll
        for (int j = 0; j < 4; ++j) { const u32x2 w = vb[64 * j], hw = hb[64 * j];
            v[j] = (f32x4){bf2f(w.x & 0xffffu), bf2f(w.x >> 16), bf2f(w.y & 0xffffu), bf2f(w.y >> 16)};
            h[j] = (f32x4){bf2f(hw.x & 0xffffu), bf2f(hw.x >> 16), bf2f(hw.y & 0xffffu), bf2f(hw.y >> 16)};
            s += (v[j].x * v[j].x + v[j].y * v[j].y) + (v[j].z * v[j].z + v[j].w * v[j].w); }
        const float r = 1.0f / sqrtf(wave_sum(s) * (1.0f / D) + EPS);
        float s2 = 0.f;
#pragma unroll
        for (int j = 0; j < 4; ++j) { h[j] = h[j] + g[j] * v[j] * r; s2 += (h[j].x * h[j].x + h[j].y * h[j].y) + (h[j].z * h[j].z + h[j].w * h[j].w); }
        s2 = wave_sum(s2);
        if (write_out) { f32x4* orow = (f32x4*)(OUT + (size_t)m * D) + lane;
#pragma unroll
            for (int j = 0; j < 4; ++j) orow[64 * j] = h[j]; }
        else {
#pragma unroll
            for (int j = 0; j < 4; ++j) { u32x2 w; w.x = pk2(h[j].x, h[j].y); w.y = pk2(h[j].z, h[j].w); hb[64 * j] = w; }
            float mx = 0.f;
#pragma unroll
            for (int j = 0; j < 4; ++j) mx = fmaxf(fmaxf(mx, fmaxf(fabsf(h[j].x), fabsf(h[j].y))), fmaxf(fabsf(h[j].z), fabsf(h[j].w)));
#pragma unroll
            for (int o = 1; o < 64; o <<= 1) mx = fmaxf(mx, __shfl_xor(mx, o));
            const float sc = (mx > 0.f) ? mx * (1.0f / 127.0f) : 1.0f, inv = 1.0f / sc;
            unsigned* o4 = (unsigned*)(A.ws + WS_HB8 + (size_t)m * D) + lane;
#pragma unroll
            for (int j = 0; j < 4; ++j) o4[64 * j] = q4_i8(h[j], inv);
            if (lane == 0) { *(f32x4*)(RS + (size_t)m * 4) = (f32x4){s2, 0.f, 0.f, 0.f}; ((float*)(A.ws + WS_SA))[m] = sc; } }
    }
}

__device__ __forceinline__ float gelu_tanh(float x) {
    const float u = 0.7978845608028654f * (x + 0.044715f * x * x * x);
    const float e = fast_exp(2.0f * u);
    const float th = 1.0f - 2.0f * __builtin_amdgcn_rcpf(e + 1.0f);
    return 0.5f * x * (1.0f + th);
}

constexpr size_t WS_LRA = 428 * MiB, WS_LRU = 444 * MiB;
constexpr int MX_PT = 528;
__device__ __forceinline__ void gather_wraw(const float* w, int stride, float (&o)[8]) {
#pragma unroll
    for (int j = 0; j < 8; ++j) o[j] = w[j * stride];
}
__device__ __forceinline__ bf16x8 pack_wfrag(const float (&o)[8]) {
    union { bf16x8 v; unsigned u[4]; } r;
#pragma unroll
    for (int p = 0; p < 4; ++p) r.u[p] = pk2(o[2 * p], o[2 * p + 1]);
    return r.v;
}
__device__ __forceinline__ bf16x8 gather_wfrag(const float* w, int stride) {
    union { bf16x8 v; unsigned u[4]; } r;
#pragma unroll
    for (int p = 0; p < 4; ++p) r.u[p] = pk2(w[(2 * p) * stride], w[(2 * p + 1) * stride]);
    return r.v;
}
__device__ __forceinline__ void mix1_item(const Ctx& C, const Args& A, int l, int b, int c) {
    const bf16_t* PROJ = (const bf16_t*)(A.ws + WS_PROJ);
    bf16_t* YS = (bf16_t*)(A.ws + WS_YS);
    int tid = C.tid; asm volatile("" : "+v"(tid));
    const int lane = tid & 63, wave = C.wave, fr = lane & 15, fg = lane >> 4;
    const size_t m0 = (size_t)b * T + (size_t)c * 64;
    LAS unsigned char* XC = C.lds;
    LAS unsigned char* LAi = C.lds + 34816;
    LAS unsigned char* LUi = C.lds + 34816 + 32768;
    float raw_a[2][8], raw_x[2][8];
    { const float* wa = A.in[I_LWA] + (((size_t)l * 8 + wave) * 32) * 32; const float* wx = A.in[I_LWX] + (((size_t)l * 8 + wave) * 32) * 32;
#pragma unroll
        for (int nt = 0; nt < 2; ++nt) { gather_wraw(wa + (8 * fg) * 32 + 16 * nt + fr, 32, raw_a[nt]); gather_wraw(wx + (8 * fg) * 32 + 16 * nt + fr, 32, raw_x[nt]); }
        asm volatile("" ::: "memory"); }
    {
        const float* cw = A.in[I_LCW] + (size_t)l * 4 * BW; const float* cbp = A.in[I_LCB] + l * BW;
#pragma unroll
        for (int k = 0; k < 4; ++k) { const int idx = tid + NTHREADS * k; const int t = idx >> 5, c8 = (idx & 31) * 8;
            float acc[8];
            { const f32x4 b0 = *(const f32x4*)(cbp + c8), b1 = *(const f32x4*)(cbp + c8 + 4); acc[0] = b0[0]; acc[1] = b0[1]; acc[2] = b0[2]; acc[3] = b0[3]; acc[4] = b1[0]; acc[5] = b1[1]; acc[6] = b1[2]; acc[7] = b1[3]; }
#pragma unroll
            for (int j = 0; j < 4; ++j) { const int tok = c * 64 + t - 3 + j;
                if (tok >= 0) { float x[8]; ld8bf(PROJ + ((size_t)b * T + tok) * NMIX + c8, x); const f32x4 w0 = *(const f32x4*)(cw + j * BW + c8), w1 = *(const f32x4*)(cw + j * BW + c8 + 4);
                    acc[0] += w0[0] * x[0]; acc[1] += w0[1] * x[1]; acc[2] += w0[2] * x[2]; acc[3] += w0[3] * x[3]; acc[4] += w1[0] * x[4]; acc[5] += w1[1] * x[5]; acc[6] += w1[2] * x[6]; acc[7] += w1[3] * x[7]; } }
            u32x4 w; w.x = cvt_pk_bf16(acc[0], acc[1]); w.y = cvt_pk_bf16(acc[2], acc[3]); w.z = cvt_pk_bf16(acc[4], acc[5]); w.w = cvt_pk_bf16(acc[6], acc[7]);
            *(LAS u32x4*)(XC + t * MX_PT + c8 * 2) = w; }
    }
    __syncthreads();
    {
        const int blk = wave;
        const float* wa = A.in[I_LWA] + (((size_t)l * 8 + blk) * 32) * 32; const float* wx = A.in[I_LWX] + (((size_t)l * 8 + blk) * 32) * 32;
        bf16x8 fa[2], fx[2];
#pragma unroll
        for (int nt = 0; nt < 2; ++nt) { fa[nt] = pack_wfrag(raw_a[nt]); fx[nt] = pack_wfrag(raw_x[nt]); }
        bf16_t* LRA = (bf16_t*)(A.ws + WS_LRA); bf16_t* LRU = (bf16_t*)(A.ws + WS_LRU);
        f32x4 bav[2], bxv[2], spv[2];
#pragma unroll
        for (int nt = 0; nt < 2; ++nt) { const int ch = 32 * blk + 16 * nt + 4 * fg;
            bav[nt] = *(const f32x4*)(A.in[I_LBA] + l * BW + ch); bxv[nt] = *(const f32x4*)(A.in[I_LBX] + l * BW + ch); spv[nt] = *(const f32x4*)((const float*)(A.ws + WS_SP8) + l * BW + ch); }
#pragma unroll
        for (int nt = 0; nt < 2; ++nt) { const int ch = 32 * blk + 16 * nt + 4 * fg;
            const f32x4 ba = bav[nt], bx = bxv[nt], sp8 = spv[nt];
#pragma unroll
            for (int mt = 0; mt < 4; ++mt) { const int tok = 16 * mt + fr;
                const bf16x8 bxc = *(const LAS bf16x8*)(XC + tok * MX_PT + (32 * blk + 8 * fg) * 2);
                f32x4 ar = {0.f, 0.f, 0.f, 0.f}, ai = {0.f, 0.f, 0.f, 0.f};
                ar = __builtin_amdgcn_mfma_f32_16x16x32_bf16(fa[nt], bxc, ar, 0, 0, 0); ai = __builtin_amdgcn_mfma_f32_16x16x32_bf16(fx[nt], bxc, ai, 0, 0, 0);
                const u32x2 xw = *(const LAS u32x2*)(XC + tok * MX_PT + ch * 2);
                const float xc[4] = {bf2f(xw.x & 0xffffu), bf2f(xw.x >> 16), bf2f(xw.y & 0xffffu), bf2f(xw.y >> 16)};
                float la[4], uu[4];
#pragma unroll
                for (int r = 0; r < 4; ++r) { const float rg = sigmoid_f(ar[r] + ba[r]), ig = sigmoid_f(ai[r] + bx[r]);
                    la[r] = sp8[r] * rg; const float x2 = 2.0f * la[r];
                    const float om = (x2 > -0.02f) ? -x2 * (1.0f + 0.5f * x2 * (1.0f + x2 * (1.0f / 3.0f))) : 1.0f - fast_exp(x2);
                    uu[r] = sqrtf(om) * ig * xc[r]; }
                u32x2 wl, wu; wl.x = cvt_pk_bf16(la[0], la[1]); wl.y = cvt_pk_bf16(la[2], la[3]); wu.x = cvt_pk_bf16(uu[0], uu[1]); wu.y = cvt_pk_bf16(uu[2], uu[3]);
                *(LAS u32x2*)(LAi + tok * 512 + ch * 2) = wl; *(LAS u32x2*)(LUi + tok * 512 + ch * 2) = wu;
                *(u32x2*)(LRA + (m0 + tok) * BW + ch) = wl; *(u32x2*)(LRU + (m0 + tok) * BW + ch) = wu; }
        }
    }
    __syncthreads();
    {
        const int ch = tid & 255, half = tid >> 8; float P = 1.f, hst = 0.f;
#pragma unroll
        for (int i = 0; i < 32; ++i) { const int t = 32 * half + i; const float a = fast_exp(bf2f(*(const LAS bf16_t*)(LAi + t * 512 + ch * 2))); const float u = bf2f(*(const LAS bf16_t*)(LUi + t * 512 + ch * 2));
            hst = a * hst + u; P *= a; }
        const size_t aggi = ((size_t)b * 128 + c * 2 + half) * 256 + ch;
        ((float*)(A.ws + WS_LA))[aggi] = P; ((float*)(A.ws + WS_LH))[aggi] = hst;
    }
    __syncthreads();
    LAS unsigned char* PX = C.lds;
    LAS unsigned char* DD = C.lds + 43008;
    { u32x4 pv[5];
#pragma unroll
        for (int k = 0; k < 5; ++k) { const int idx = tid + NTHREADS * k; const int r = idx >> 5, c8 = (idx & 31) * 8; const int tok = c * 64 - 15 + r;
            pv[k] = (u32x4){0u, 0u, 0u, 0u}; if (idx < 79 * 32 && tok >= 0) pv[k] = *(const u32x4*)(PROJ + ((size_t)b * T + tok) * NMIX + 512 + c8); }
#pragma unroll
        for (int k = 0; k < 5; ++k) { const int idx = tid + NTHREADS * k; const int r = idx >> 5, c8 = (idx & 31) * 8; if (idx < 79 * 32) *(LAS u32x4*)(PX + r * MX_PT + c8 * 2) = pv[k]; } }
    __syncthreads();
    float raw_p[2][2][8];
    { const int g = wave >> 1, nb = (wave & 1) * 2; const float* pw = A.in[I_PW] + (((size_t)l * 4 + g) * 64) * 64;
#pragma unroll
        for (int nn = 0; nn < 2; ++nn)
#pragma unroll
            for (int ks = 0; ks < 2; ++ks) gather_wraw(pw + (32 * ks + 8 * fg) * 64 + 16 * (nb + nn) + fr, 64, raw_p[nn][ks]);
        asm volatile("" ::: "memory"); }
#pragma unroll 1
    for (int k = 0; k < 4; ++k) { const int idx = tid + NTHREADS * k; const int t = idx >> 5, c8 = (idx & 31) * 8; const int g = c8 >> 6, win = 2 << g;
        float sum[8], x0[8];
#pragma unroll
        for (int e = 0; e < 8; ++e) sum[e] = 0.f;
        for (int j = 0; j < win; ++j) { const u32x4 v = *(const LAS u32x4*)(PX + (t + 15 - j) * MX_PT + c8 * 2);
            const float x[8] = {bf2f(v.x & 0xffffu), bf2f(v.x >> 16), bf2f(v.y & 0xffffu), bf2f(v.y >> 16), bf2f(v.z & 0xffffu), bf2f(v.z >> 16), bf2f(v.w & 0xffffu), bf2f(v.w >> 16)};
#pragma unroll
            for (int e = 0; e < 8; ++e) { sum[e] += x[e]; if (j == 0) x0[e] = x[e]; } }
        const int pos = c * 64 + t + 1; const float inv = 1.0f / (float)(pos < win ? pos : win);
        u32x4 w; w.x = cvt_pk_bf16(sum[0] * inv - x0[0], sum[1] * inv - x0[1]); w.y = cvt_pk_bf16(sum[2] * inv - x0[2], sum[3] * inv - x0[3]);
        w.z = cvt_pk_bf16(sum[4] * inv - x0[4], sum[5] * inv - x0[5]); w.w = cvt_pk_bf16(sum[6] * inv - x0[6], sum[7] * inv - x0[7]);
        *(LAS u32x4*)(DD + t * MX_PT + c8 * 2) = w; }
    __syncthreads();
    {
        const int g = wave >> 1, nb = (wave & 1) * 2;
        const float* pw = A.in[I_PW] + (((size_t)l * 4 + g) * 64) * 64;
        bf16x8 fw[2][2];
#pragma unroll
        for (int nn = 0; nn < 2; ++nn)
#pragma unroll
            for (int ks = 0; ks < 2; ++ks) fw[nn][ks] = pack_wfrag(raw_p[nn][ks]);
        f32x4 sclv[2];
#pragma unroll
        for (int nn = 0; nn < 2; ++nn) sclv[nn] = *(const f32x4*)(A.in[I_PS] + l * BW + 64 * g + 16 * (nb + nn) + 4 * fg);
#pragma unroll
        for (int nn = 0; nn < 2; ++nn) { const int ch = 64 * g + 16 * (nb + nn) + 4 * fg; const f32x4 scl = sclv[nn];
#pragma unroll
            for (int mt = 0; mt < 4; ++mt) { const int tok = 16 * mt + fr; f32x4 acc = {0.f, 0.f, 0.f, 0.f};
#pragma unroll
                for (int ks = 0; ks < 2; ++ks) { const bf16x8 bd = *(const LAS bf16x8*)(DD + tok * MX_PT + (64 * g + 32 * ks + 8 * fg) * 2); acc = __builtin_amdgcn_mfma_f32_16x16x32_bf16(fw[nn][ks], bd, acc, 0, 0, 0); }
                u32x2 w; w.x = cvt_pk_bf16(acc[0] * scl[0], acc[1] * scl[1]); w.y = cvt_pk_bf16(acc[2] * scl[2], acc[3] * scl[3]);
                *(u32x2*)(YS + (m0 + tok) * D + 256 + ch) = w; } }
    }
    {
        const float* sw = A.in[I_SW] + (size_t)l * 3 * BW;
        const int c8 = (tid & 31) * 8;
        f32x4 wv[3][2];
#pragma unroll
        for (int j = 0; j < 3; ++j) { wv[j][0] = *(const f32x4*)(sw + j * BW + c8); wv[j][1] = *(const f32x4*)(sw + j * BW + c8 + 4); }
#pragma unroll 1
        for (int kb = 0; kb < 4; kb += 2) {
            u32x4 rc[2][3], rx[2][3], rb[2];
#pragma unroll
            for (int kk = 0; kk < 2; ++kk) { const int t = (tid + NTHREADS * (kb + kk)) >> 5;
#pragma unroll
                for (int j = 0; j < 3; ++j) { const int tok = c * 64 + t - 2 + j; rc[kk][j] = (u32x4){0u, 0u, 0u, 0u}; rx[kk][j] = (u32x4){0u, 0u, 0u, 0u};
                    if (tok >= 0) { const bf16_t* p = PROJ + ((size_t)b * T + tok) * NMIX; rc[kk][j] = *(const u32x4*)(p + 2048 + c8); rx[kk][j] = *(const u32x4*)(p + 2304 + c8); } }
                rb[kk] = *(const u32x4*)(PROJ + (m0 + t) * NMIX + 1792 + c8); }
#pragma unroll
            for (int kk = 0; kk < 2; ++kk) { const int t = (tid + NTHREADS * (kb + kk)) >> 5;
                float acc[8];
#pragma unroll
                for (int e = 0; e < 8; ++e) acc[e] = 0.f;
#pragma unroll
                for (int j = 0; j < 3; ++j) { const u32x4 vc = rc[kk][j], vx = rx[kk][j];
                    const float sc[8] = {bf2f(vc.x & 0xffffu), bf2f(vc.x >> 16), bf2f(vc.y & 0xffffu), bf2f(vc.y >> 16), bf2f(vc.z & 0xffffu), bf2f(vc.z >> 16), bf2f(vc.w & 0xffffu), bf2f(vc.w >> 16)};
                    const float sx[8] = {bf2f(vx.x & 0xffffu), bf2f(vx.x >> 16), bf2f(vx.y & 0xffffu), bf2f(vx.y >> 16), bf2f(vx.z & 0xffffu), bf2f(vx.z >> 16), bf2f(vx.w & 0xffffu), bf2f(vx.w >> 16)};
                    const f32x4 w0 = wv[j][0], w1 = wv[j][1];
                    acc[0] += w0[0] * sc[0] * sx[0]; acc[1] += w0[1] * sc[1] * sx[1]; acc[2] += w0[2] * sc[2] * sx[2]; acc[3] += w0[3] * sc[3] * sx[3];
                    acc[4] += w1[0] * sc[4] * sx[4]; acc[5] += w1[1] * sc[5] * sx[5]; acc[6] += w1[2] * sc[6] * sx[6]; acc[7] += w1[3] * sc[7] * sx[7]; }
                const u32x4 vb = rb[kk];
                const float sb[8] = {bf2f(vb.x & 0xffffu), bf2f(vb.x >> 16), bf2f(vb.y & 0xffffu), bf2f(vb.y >> 16), bf2f(vb.z & 0xffffu), bf2f(vb.z >> 16), bf2f(vb.w & 0xffffu), bf2f(vb.w >> 16)};
                u32x4 w; w.x = cvt_pk_bf16(sb[0] * acc[0], sb[1] * acc[1]); w.y = cvt_pk_bf16(sb[2] * acc[2], sb[3] * acc[3]); w.z = cvt_pk_bf16(sb[4] * acc[4], sb[5] * acc[5]); w.w = cvt_pk_bf16(sb[6] * acc[6], sb[7] * acc[7]);
                *(u32x4*)(YS + (m0 + t) * D + 768 + c8) = w; }
        }
    }
    __syncthreads();
}
__device__ __forceinline__ void lru_final_item(const Ctx& C, const Args& A, int l, int b, int c) {
    const bf16_t* PROJ = (const bf16_t*)(A.ws + WS_PROJ);
    const bf16_t* LRA = (const bf16_t*)(A.ws + WS_LRA); const bf16_t* LRU = (const bf16_t*)(A.ws + WS_LRU);
    bf16_t* YS = (bf16_t*)(A.ws + WS_YS);
    int tid = C.tid; asm volatile("" : "+v"(tid));
    const int ch = tid & 255, half = tid >> 8;
    const size_t m0 = (size_t)b * T + (size_t)c * 64 + 32 * half;
    float hst = ((const float*)(A.ws + WS_LC))[((size_t)b * 128 + c * 2 + half) * 256 + ch];
    unsigned short la[32], lu[32], lg[32];
#pragma unroll
    for (int i = 0; i < 32; ++i) { la[i] = LRA[(m0 + i) * BW + ch]; lu[i] = LRU[(m0 + i) * BW + ch]; lg[i] = PROJ[(m0 + i) * NMIX + 256 + ch]; }
#pragma unroll
    for (int i = 0; i < 32; ++i) { const float a = fast_exp(bf2f(la[i])), u = bf2f(lu[i]);
        hst = a * hst + u;
        YS[(m0 + i) * D + ch] = (bf16_t)f2bf(hst * gelu_tanh(bf2f(lg[i]))); }
}

constexpr int HG_PT = 144;
constexpr int HG_IMG = 64 * HG_PT;
constexpr int HG_Q = 0, HG_K = HG_IMG, HG_P = 2 * HG_IMG, HG_BEND = 3 * HG_IMG, HG_REF = HG_BEND + 512, HG_HSZ = 29696;
constexpr size_t WS_ST16 = WS_MERGED + 32 * MiB;
__device__ __forceinline__ float hgrn_lb(const Args& A, int l, int w) {
    if (l == 0) return 0.f;
    const float a0 = A.in[I_HLB][w], a1 = A.in[I_HLB][BW + w];
    return 1.0f / (1.0f + expf(a0 - a1));
}
template <bool FINAL>
__device__ __forceinline__ void hgrn_item(const Ctx& C, const Args& A, int l, int b, int c) {
    const bf16_t* PROJ = (const bf16_t*)(A.ws + WS_PROJ);
    int lane = C.lane; asm volatile("" : "+v"(lane));
    const int wave = C.wave, h = wave >> 1, half = wave & 1, fr = lane & 15, fg = lane >> 4;
    LAS unsigned char* hb = C.lds + h * HG_HSZ;
    LAS float* BEND = (LAS float*)(hb + HG_BEND); LAS float* REF = (LAS float*)(hb + HG_REF);
    const size_t m0 = (size_t)b * T + (size_t)c * 64;
    const bf16_t* pr = PROJ + (m0 + 32 * half) * NMIX + h * 64 + lane;
    const int bh = b * 4 + h; const size_t ci = (size_t)bh * 64 + c;
    float bb[32], kk[32], vv[32];
    {
        const float lbv = hgrn_lb(A, l, h * 64 + lane);
        unsigned short rf[32], rv[32];
#pragma unroll
        for (int i = 0; i < 32; ++i) { rf[i] = pr[(size_t)i * NMIX + 1024]; rv[i] = pr[(size_t)i * NMIX + 1280]; }
        asm volatile("" ::: "memory");
        float acc = 0.f;
#pragma unroll
        for (int i = 0; i < 32; ++i) { const float x = bf2f(rf[i]); const float f = fmaxf(lbv + (1.0f - lbv) * sigmoid_f(x), 1e-30f);
            acc += __logf(f); bb[i] = acc; kk[i] = 1.0f - f; }
#pragma unroll
        for (int i = 0; i < 32; ++i) vv[i] = bf2f(rv[i]);
        BEND[half * 64 + lane] = acc;
    }
    __syncthreads();
    const float bend0 = BEND[lane], blast = bend0 + BEND[64 + lane];
    if (half) {
#pragma unroll
        for (int i = 0; i < 32; ++i) bb[i] += bend0;
    }
    if (!FINAL) {
        LAS unsigned char* kt = hb + HG_K + lane * HG_PT + 64 * half; LAS unsigned char* vt = hb + HG_Q + lane * HG_PT + 64 * half;
#pragma unroll
        for (int q4 = 0; q4 < 4; ++q4) { u32x4 wk, wv; unsigned kw[4], vw[4];
#pragma unroll
            for (int p = 0; p < 4; ++p) { const int i = q4 * 8 + 2 * p;
                kw[p] = cvt_pk_bf16(kk[i] * fast_exp(blast - bb[i]), kk[i + 1] * fast_exp(blast - bb[i + 1])); vw[p] = cvt_pk_bf16(vv[i], vv[i + 1]); }
            wk.x = kw[0]; wk.y = kw[1]; wk.z = kw[2]; wk.w = kw[3]; wv.x = vw[0]; wv.y = vw[1]; wv.z = vw[2]; wv.w = vw[3];
            *(LAS u32x4*)(kt + q4 * 16) = wk; *(LAS u32x4*)(vt + q4 * 16) = wv; }
        if (half == 0) ((float*)(A.ws + WS_SD))[ci * 64 + lane] = fast_exp(blast);
        __syncthreads();
        float* su = (float*)(A.ws + WS_SU) + ci * 4096;
#pragma unroll
        for (int aa = 0; aa < 2; ++aa) { const int a = 2 * half + aa;
            bf16x8 av[2];
#pragma unroll
            for (int ks = 0; ks < 2; ++ks) av[ks] = *(const LAS bf16x8*)(hb + HG_Q + (16 * a + fr) * HG_PT + 64 * ks + 16 * fg);
#pragma unroll
            for (int d = 0; d < 4; ++d) { f32x4 acc = {0.f, 0.f, 0.f, 0.f};
#pragma unroll
                for (int ks = 0; ks < 2; ++ks) { const bf16x8 bk = *(const LAS bf16x8*)(hb + HG_K + (16 * d + fr) * HG_PT + 64 * ks + 16 * fg);
                    acc = __builtin_amdgcn_mfma_f32_16x16x32_bf16(av[ks], bk, acc, 0, 0, 0); }
#pragma unroll
                for (int r = 0; r < 4; ++r) su[(16 * a + 4 * fg + r) * 64 + 16 * d + fr] = acc[r];
            } }
        __syncthreads();
    } else {
        float qq[32];
        { unsigned short rq[32];
#pragma unroll
            for (int i = 0; i < 32; ++i) rq[i] = pr[(size_t)i * NMIX + 768];
            asm volatile("" ::: "memory");
#pragma unroll
            for (int i = 0; i < 32; ++i) qq[i] = bf2f(rq[i]); }
        if (half == 0) { REF[64 + lane] = bb[15]; REF[128 + lane] = bb[31]; } else REF[192 + lane] = bb[15];
        { unsigned zz = 0u; asm volatile("" : "+v"(zz)); const u32x4 z = {zz, zz, zz, zz};
#pragma unroll
            for (int k2 = 0; k2 < 5; ++k2) { const int idx = lane + 64 * k2; if (idx < 32 * 9) *(LAS u32x4*)(hb + HG_P + 32 * half * HG_PT + idx * 16) = z; } }
        __syncthreads();
        float rf[4]; rf[0] = 0.f; rf[1] = REF[64 + lane]; rf[2] = REF[128 + lane]; rf[3] = REF[192 + lane];
        {
            const float r_lo = half ? rf[2] : rf[0], r_hi = half ? rf[3] : rf[1];
#pragma unroll
            for (int i = 0; i < 32; ++i) { const float rr = (i < 16) ? r_lo : r_hi; const float val = qq[i] * fast_exp(bb[i] - rr);
                *(LAS bf16_t*)(hb + HG_Q + (32 * half + i) * HG_PT + 2 * lane) = (bf16_t)f2bf(val); }
        }
#pragma unroll
        for (int isub = 0; isub < 4; ++isub) {
            const int nrows = 16 * (isub + 1) - 32 * half;
#pragma unroll
            for (int i = 0; i < 32; ++i) { if (i < nrows) { const float e = fminf(rf[isub] - bb[i], 60.f); const float val = kk[i] * fast_exp(e);
                    *(LAS bf16_t*)(hb + HG_K + (32 * half + i) * HG_PT + 2 * lane) = (bf16_t)f2bf(val); } }
            __syncthreads();
            {
                bf16x8 bq[2];
#pragma unroll
                for (int ks = 0; ks < 2; ++ks) bq[ks] = *(const LAS bf16x8*)(hb + HG_Q + (16 * isub + fr) * HG_PT + 64 * ks + 16 * fg);
#pragma unroll
                for (int j = 0; j <= isub; ++j) { if ((j & 1) == half) {
                        f32x4 acc = {0.f, 0.f, 0.f, 0.f};
#pragma unroll
                        for (int ks = 0; ks < 2; ++ks) { const bf16x8 ak = *(const LAS bf16x8*)(hb + HG_K + (16 * j + fr) * HG_PT + 64 * ks + 16 * fg);
                            acc = __builtin_amdgcn_mfma_f32_16x16x32_bf16(ak, bq[ks], acc, 0, 0, 0); }
                        if (j == isub) {
#pragma unroll
                            for (int r = 0; r < 4; ++r) if (4 * fg + r > fr) acc[r] = 0.f; }
                        u32x2 w; w.x = cvt_pk_bf16(acc[0], acc[1]); w.y = cvt_pk_bf16(acc[2], acc[3]);
                        *(LAS u32x2*)(hb + HG_P + (16 * isub + fr) * HG_PT + 2 * (16 * j + 4 * fg)) = w;
                    } }
            }
            __syncthreads();
        }
        {
            LAS unsigned char* vt = hb + HG_Q + lane * HG_PT + 64 * half;
#pragma unroll
            for (int q4 = 0; q4 < 4; ++q4) { u32x4 wv; unsigned vw[4];
#pragma unroll
                for (int p = 0; p < 4; ++p) { const int i = q4 * 8 + 2 * p; vw[p] = cvt_pk_bf16(vv[i], vv[i + 1]); }
                wv.x = vw[0]; wv.y = vw[1]; wv.z = vw[2]; wv.w = vw[3]; *(LAS u32x4*)(vt + q4 * 16) = wv; }
#pragma unroll
            for (int i = 0; i < 32; ++i) *(LAS bf16_t*)(hb + HG_K + (32 * half + i) * HG_PT + 2 * lane) = (bf16_t)f2bf(qq[i] * fast_exp(bb[i]));
        }
        __syncthreads();
        {
            const bf16_t* st = (const bf16_t*)(A.ws + WS_ST16) + ci * 4096;
            bf16x8 a_st[4][2];
#pragma unroll
            for (int a = 0; a < 4; ++a)
#pragma unroll
                for (int ks = 0; ks < 2; ++ks) a_st[a][ks] = *(const bf16x8*)(st + (16 * a + fr) * 64 + 32 * ks + 8 * fg);
            bf16_t* YS = (bf16_t*)(A.ws + WS_YS);
            const float* gn = A.in[I_HN] + l * 64;
            u32x2 gwv[2][4]; f32x4 gnv[4];
#pragma unroll
            for (int a = 0; a < 4; ++a) { gnv[a] = *(const f32x4*)(gn + 16 * a + 4 * fg);
#pragma unroll
                for (int tt = 0; tt < 2; ++tt) gwv[tt][a] = *(const u32x2*)(PROJ + (m0 + 16 * (2 * half + tt) + fr) * NMIX + 1536 + h * 64 + 16 * a + 4 * fg); }
#pragma unroll
            for (int tt = 0; tt < 2; ++tt) { const int ti = 2 * half + tt;
                bf16x8 bp[2], bqb[2];
#pragma unroll
                for (int ks = 0; ks < 2; ++ks) { bp[ks] = *(const LAS bf16x8*)(hb + HG_P + (16 * ti + fr) * HG_PT + 64 * ks + 16 * fg); bqb[ks] = *(const LAS bf16x8*)(hb + HG_K + (16 * ti + fr) * HG_PT + 64 * ks + 16 * fg); }
                f32x4 o[4]; float ss = 0.f;
#pragma unroll
                for (int a = 0; a < 4; ++a) { f32x4 acc = {0.f, 0.f, 0.f, 0.f};
#pragma unroll
                    for (int ks = 0; ks < 2; ++ks) { const bf16x8 av = *(const LAS bf16x8*)(hb + HG_Q + (16 * a + fr) * HG_PT + 64 * ks + 16 * fg);
                        acc = __builtin_amdgcn_mfma_f32_16x16x32_bf16(av, bp[ks], acc, 0, 0, 0);
                        acc = __builtin_amdgcn_mfma_f32_16x16x32_bf16(a_st[a][ks], bqb[ks], acc, 0, 0, 0); }
                    o[a] = acc; ss += (acc[0] * acc[0] + acc[1] * acc[1]) + (acc[2] * acc[2] + acc[3] * acc[3]); }
                ss += __shfl_xor(ss, 16); ss += __shfl_xor(ss, 32);
                const float rn = 1.0f / sqrtf(ss * (1.0f / 64.0f) + EPS);
                const size_t row = m0 + 16 * ti + fr;
#pragma unroll
                for (int a = 0; a < 4; ++a) { const int dv = 16 * a + 4 * fg;
                    const u32x2 gw = gwv[tt][a];
                    const float g0 = bf2f(gw.x & 0xffffu), g1 = bf2f(gw.x >> 16), g2 = bf2f(gw.y & 0xffffu), g3 = bf2f(gw.y >> 16);
                    const f32x4 gv = gnv[a];
                    const float y0 = o[a][0] * rn * gv[0] * (g0 * sigmoid_f(g0)), y1 = o[a][1] * rn * gv[1] * (g1 * sigmoid_f(g1));
                    const float y2 = o[a][2] * rn * gv[2] * (g2 * sigmoid_f(g2)), y3 = o[a][3] * rn * gv[3] * (g3 * sigmoid_f(g3));
                    u32x2 w; w.x = cvt_pk_bf16(y0, y1); w.y = cvt_pk_bf16(y2, y3);
                    *(u32x2*)(YS + row * D + 512 + h * 64 + dv) = w; }
            }
        }
        __syncthreads();
    }
}

__device__ __forceinline__ void mix_phase2(const Ctx& C, const Args& A) {
    int tid_ = C.tid; asm volatile("" : "+v"(tid_));
    if (C.G == 256) {
        if (C.vcu < 128) {
            float* __restrict__ SU = (float*)(A.ws + WS_SU); const float* __restrict__ SD = (const float*)(A.ws + WS_SD); bf16_t* __restrict__ ST16 = (bf16_t*)(A.ws + WS_ST16);
            const int e0 = C.vcu * NTHREADS + tid_, e1 = e0 + 65536;
            const int bh0 = e0 >> 12, kv0 = e0 & 4095, bh1 = e1 >> 12, kv1 = e1 & 4095;
            float s0 = 0.f, s1 = 0.f;
#pragma unroll 1
            for (int cb = 0; cb < 64; cb += 16) {
                float u0[16], d0[16], u1[16], d1[16];
#pragma unroll
                for (int i = 0; i < 16; ++i) { const size_t c0 = (size_t)bh0 * 64 + cb + i, c1 = (size_t)bh1 * 64 + cb + i;
                    u0[i] = SU[c0 * 4096 + kv0]; d0[i] = SD[c0 * 64 + (kv0 & 63)]; u1[i] = SU[c1 * 4096 + kv1]; d1[i] = SD[c1 * 64 + (kv1 & 63)]; }
#pragma unroll
                for (int i = 0; i < 16; ++i) { const size_t c0 = (size_t)bh0 * 64 + cb + i, c1 = (size_t)bh1 * 64 + cb + i;
                    ST16[c0 * 4096 + kv0] = (bf16_t)f2bf(s0); ST16[c1 * 4096 + kv1] = (bf16_t)f2bf(s1); s0 = d0[i] * s0 + u0[i]; s1 = d1[i] * s1 + u1[i]; }
            }
        } else if (C.vcu < 144) {
            const float* __restrict__ LA = (const float*)(A.ws + WS_LA); const float* __restrict__ LH = (const float*)(A.ws + WS_LH); float* __restrict__ LC = (float*)(A.ws + WS_LC);
            LAS float* SP = (LAS float*)C.lds; LAS float* SH = SP + 512;
            const int cl = tid_ & 127, seg = tid_ >> 7, chain = (C.vcu - 128) * 128 + cl, b = chain >> 8, ch = chain & 255;
            const size_t i0 = ((size_t)b * 128 + seg * 32) * 256 + ch;
            float a[32], hh[32];
#pragma unroll
            for (int i = 0; i < 32; ++i) { a[i] = LA[i0 + (size_t)i * 256]; hh[i] = LH[i0 + (size_t)i * 256]; }
            float P = 1.f, H = 0.f;
#pragma unroll
            for (int i = 0; i < 32; ++i) { H = a[i] * H + hh[i]; P *= a[i]; }
            SP[seg * 128 + cl] = P; SH[seg * 128 + cl] = H;
            __syncthreads();
            float cr = 0.f;
            for (int sg = 0; sg < seg; ++sg) cr = SP[sg * 128 + cl] * cr + SH[sg * 128 + cl];
#pragma unroll
            for (int i = 0; i < 32; ++i) { LC[i0 + (size_t)i * 256] = cr; cr = a[i] * cr + hh[i]; }
            __syncthreads();
        }
        return;
    }
    float* __restrict__ SU = (float*)(A.ws + WS_SU); const float* __restrict__ SD = (const float*)(A.ws + WS_SD);
    const int gt = C.vcu * NTHREADS + tid_, NGT = C.G * NTHREADS;
    for (int e = gt; e < 32 * 4096; e += NGT) {
        const int bh = e >> 12, kv = e & 4095, dk = kv & 63;
        bf16_t* __restrict__ ST16 = (bf16_t*)(A.ws + WS_ST16);
        float s = 0.f;
#pragma unroll 32
        for (int c = 0; c < 64; ++c) { const size_t ci = (size_t)bh * 64 + c; const float u = SU[ci * 4096 + kv]; const float d = SD[ci * 64 + dk]; ST16[ci * 4096 + kv] = (bf16_t)f2bf(s); s = d * s + u; }
    }
    const float* __restrict__ LA = (const float*)(A.ws + WS_LA); const float* __restrict__ LH = (const float*)(A.ws + WS_LH); float* __restrict__ LC = (float*)(A.ws + WS_LC);
    for (int e = gt; e < BATCH * BW; e += NGT) {
        const int b = e >> 8, ch = e & 255; float cr = 0.f;
#pragma unroll 32
        for (int sc = 0; sc < 128; ++sc) { const size_t i = ((size_t)b * 128 + sc) * 256 + ch; const float a = LA[i], hh = LH[i]; LC[i] = cr; cr = a * cr + hh; }
    }
}

#define XB_TMO      128
#define XB_XCNT(j)  (256  + 64 * (j))
#define XB_XSUB(j)  (1280 + 64 * (j))
#define XB_XGEN(j)  (2304 + 64 * (j))
#define XB_TOP      3328
#define XB_TOPGEN   3392
#define XCD_BAR_WORDS 3456
#define XB_SPIN_CAP (1u << 20)
__device__ __forceinline__ unsigned xb_ld(unsigned* p)              { return __hip_atomic_load(p, __ATOMIC_RELAXED, __HIP_MEMORY_SCOPE_AGENT); }
__device__ __forceinline__ unsigned xb_add(unsigned* p, unsigned v) { return __hip_atomic_fetch_add(p, v, __ATOMIC_RELAXED, __HIP_MEMORY_SCOPE_AGENT); }
__device__ __forceinline__ unsigned xb_xcc_id() { return (unsigned)__builtin_amdgcn_s_getreg((3 << 11) | 20) & 0xFu; }
#define XB_SPIN(cond, bar) do { unsigned _sp = 0; while (cond) { __builtin_amdgcn_s_sleep(1); \
    if ((++_sp & 255u) == 0u) { if (xb_ld(&(bar)[XB_TMO])) break; if (_sp > XB_SPIN_CAP) { atomicAdd(&(bar)[XB_TMO], 1u); break; } } } } while (0)
struct XcdBarrier { unsigned* bar; unsigned x; volatile LAS unsigned* st; };
__device__ __forceinline__ XcdBarrier xcd_barrier_post(unsigned* bar, volatile LAS unsigned* st) {
    XcdBarrier b; b.bar = bar; b.x = xb_xcc_id(); b.st = st;
    if (threadIdx.x == 0) (void)xb_add(&bar[XB_XCNT(b.x)], 1u);
    return b;
}
__device__ __forceinline__ void xcd_barrier_complete(unsigned* bar, unsigned x, unsigned& nloc, unsigned& nx) {
    const unsigned G = gridDim.x * gridDim.y * gridDim.z;
    unsigned sum, cnt, mine, sp = 0u;
    for (;;) {
        sum = 0u; cnt = 0u; mine = 0u;
        unsigned cv[16];
        { const unsigned* cp = &bar[XB_XCNT(0)];
          asm volatile("global_load_dword %0, %16, off sc1\n\tglobal_load_dword %1, %16, off offset:256 sc1\n\tglobal_load_dword %2, %16, off offset:512 sc1\n\tglobal_load_dword %3, %16, off offset:768 sc1\n\t"
                       "global_load_dword %4, %16, off offset:1024 sc1\n\tglobal_load_dword %5, %16, off offset:1280 sc1\n\tglobal_load_dword %6, %16, off offset:1536 sc1\n\tglobal_load_dword %7, %16, off offset:1792 sc1\n\t"
                       "global_load_dword %8, %16, off offset:2048 sc1\n\tglobal_load_dword %9, %16, off offset:2304 sc1\n\tglobal_load_dword %10, %16, off offset:2560 sc1\n\tglobal_load_dword %11, %16, off offset:2816 sc1\n\t"
                       "global_load_dword %12, %16, off offset:3072 sc1\n\tglobal_load_dword %13, %16, off offset:3328 sc1\n\tglobal_load_dword %14, %16, off offset:3584 sc1\n\tglobal_load_dword %15, %16, off offset:3840 sc1\n\ts_waitcnt vmcnt(0)"
                       : "=&v"(cv[0]), "=&v"(cv[1]), "=&v"(cv[2]), "=&v"(cv[3]), "=&v"(cv[4]), "=&v"(cv[5]), "=&v"(cv[6]), "=&v"(cv[7]),
                         "=&v"(cv[8]), "=&v"(cv[9]), "=&v"(cv[10]), "=&v"(cv[11]), "=&v"(cv[12]), "=&v"(cv[13]), "=&v"(cv[14]), "=&v"(cv[15]) : "v"(cp) : "memory"); }
#pragma unroll
        for (unsigned j = 0; j < 16; ++j) { const unsigned c = cv[j]; sum += c; cnt += (c > 0u) ? 1u : 0u; mine = (j == x) ? c : mine; }
        if (sum == G) break;
        __builtin_amdgcn_s_sleep(1);
        if ((++sp & 255u) == 0u) { if (xb_ld(&bar[XB_TMO])) break; if (sp > XB_SPIN_CAP) { atomicAdd(&bar[XB_TMO], 1u); break; } }
    }
    nloc = mine > 0u ? mine : 1u; nx = cnt > 0u ? cnt : 1u;
}
__device__ __forceinline__ void xcd_barrier(const XcdBarrier& b) {
    asm volatile("s_waitcnt vmcnt(0)" ::: "memory");
    __syncthreads();
    if (threadIdx.x == 0) {
        unsigned* bar = b.bar;
        __builtin_amdgcn_s_waitcnt(0);
        unsigned nloc = b.st[0], nx = b.st[1];
        if (nloc == 0u) { xcd_barrier_complete(bar, b.x, nloc, nx); b.st[0] = nloc; b.st[1] = nx; }
        const unsigned old = xb_add(&bar[XB_XSUB(b.x)], 1u);
        const unsigned gen = old / nloc;
        if (old + 1u == (gen + 1u) * nloc) {
            __builtin_amdgcn_fence(__ATOMIC_RELEASE, "agent");
            asm volatile("s_waitcnt vmcnt(0)" ::: "memory");
            const unsigned og = xb_add(&bar[XB_TOP], 1u);
            const unsigned tg = og / nx;
            if (og + 1u == (tg + 1u) * nx) xb_add(&bar[XB_TOPGEN], 1u);
            else XB_SPIN(xb_ld(&bar[XB_TOPGEN]) == tg, bar);
            __builtin_amdgcn_fence(__ATOMIC_ACQUIRE, "agent");
            xb_add(&bar[XB_XGEN(b.x)], 1u);
            asm volatile("s_waitcnt vmcnt(0)" ::: "memory");
        } else {
            XB_SPIN(xb_ld(&bar[XB_XGEN(b.x)]) == gen, bar);
            __builtin_amdgcn_fence(__ATOMIC_ACQUIRE, "agent");
            asm volatile("s_waitcnt vmcnt(0)" ::: "memory");
        }
    }
    __syncthreads();
}

constexpr int PH_PER_LAYER = 10, N_PHASES = 1 + DEPTH * PH_PER_LAYER;
constexpr int CW_BAR = 4096;
constexpr int CW_SEAM = 16384;
constexpr int CW_SEAM2 = 65536;

__global__ void __launch_bounds__(NTHREADS, 2) trunk_fwd(Args args) {
    extern __shared__ __attribute__((aligned(16))) unsigned char lds_raw[];
    Ctx C;
    C.lds = (LAS unsigned char*)lds_raw; C.tid = threadIdx.x; C.lane = C.tid & 63; C.wave = __builtin_amdgcn_readfirstlane(C.tid >> 6);
    C.G = gridDim.x; { const int bx = blockIdx.x; C.vcu = (C.G % 8 == 0) ? (bx % 8) * (C.G / 8) + bx / 8 : bx; }
    unsigned char* ws = args.ws;
    volatile LAS unsigned* MISC = (volatile LAS unsigned*)(C.lds + MISC_OFF);
    if (C.tid < 64) MISC[C.tid] = 0u;
    __syncthreads();
#if MK_PER_PHASE
#define GRID_BAR() do { } while (0)
#else
    cg::grid_group grid = cg::this_grid();
    XcdBarrier bar = xcd_barrier_post((unsigned*)(ws + WS_CTL) + CW_BAR, MISC + 8);
    bool first_bar = true;
#define GRID_BAR() do { if (first_bar) { grid.sync(); first_bar = false; } else { xcd_barrier(bar); } } while (0)
#endif
    const int lo = args.ph_lo, hi = args.ph_hi;
    int ph = 0;
#define PHASE_BEGIN if (ph >= lo && ph < hi) { for (int rep_ = 0; rep_ < (((DBG_REPEAT >> ((ph - 1) % PH_PER_LAYER + 1)) & 1) && ph > 0 ? 2 : 1); ++rep_) {
#define PHASE_END   if (rep_ == 0 && (((DBG_REPEAT >> ((ph - 1) % PH_PER_LAYER + 1)) & 1) && ph > 0)) GRID_BAR(); } if (ph + 1 < hi && ph + 1 < N_PHASES) GRID_BAR(); } ++ph;

    PHASE_BEGIN p0_prologue(C, args); PHASE_END

    for (int li = 0; li < DEPTH; ++li) {
        int l = li; asm volatile("" : "+s"(l));
        const unsigned char* wl = ws + WS_W + (size_t)l * W_LAYER;
        const float* RS = (const float*)(ws + WS_X2);
        PHASE_BEGIN {
            pg8::StaticOrder S; S.init(ws + WS_HB, wl + W_IN, M, NMIX, D, C.G, (int)blockIdx.x);
            pg8::EpiRow<1> E{(bf16_t*)(ws + WS_PROJ), NMIX, RS};
            pg8::gemm_phase<pg8::EpiRow<1>, pg8::StaticOrder, true>(C.lds, D, S, E);
        } PHASE_END
        PHASE_BEGIN {
            for (int item = C.vcu; item < BATCH * 64; item += C.G) { const int b = item >> 6, c = item & 63;
                hgrn_item<false>(C, args, l, b, c);
                mix1_item(C, args, l, b, c); }
        } PHASE_END
        PHASE_BEGIN {
            mix_phase2(C, args);
            int lane = C.lane; asm volatile("" : "+v"(lane));
            const int gw = C.vcu * NWAVES + C.wave, NGW = C.G * NWAVES;
            if (li == 0) {
                for (int it = gw; it < DEPTH * 2 * 4096; it += NGW) { const int ll = it >> 13, r = it & 8191, n = r & 4095;
                    const unsigned char* wll = ws + WS_W + (size_t)ll * W_LAYER;
                    if (r < 4096) quant_row_i8((const bf16_t*)(wll + W_IN) + (size_t)(NMIX + n) * D, (signed char*)(ws + WS_WG8) + ((size_t)ll * NGATE + n) * D, (float*)(ws + WS_SBG) + ll * NGATE + n, lane);
                    else quant_row_i8((const bf16_t*)(wll + W_UP) + (size_t)n * D, (signed char*)(ws + WS_WU8) + ((size_t)ll * FF + n) * D, (float*)(ws + WS_SBU) + ll * FF + n, lane); }
            }
        } PHASE_END
        PHASE_BEGIN {
            if (li == 0) {
                int lane = C.lane; asm volatile("" : "+v"(lane)); const int gw = C.vcu * NWAVES + C.wave, NGW = C.G * NWAVES;
                for (int it = gw; it < DEPTH * D; it += NGW) { const int ll = it >> 10, n = it & 1023;
                    const bf16_t* src = (const bf16_t*)(ws + WS_W + (size_t)ll * W_LAYER + W_DOWN) + (size_t)n * FF;
                    u32x4 raw[8];
#pragma unroll
                    for (int i = 0; i < 8; ++i) raw[i] = *(const u32x4*)(src + (size_t)(i * 64 + lane) * 8);
                    float mx = 0.f;
#pragma unroll
                    for (int i = 0; i < 8; ++i) { const u32x4 r = raw[i];
                        mx = fmaxf(mx, fmaxf(fmaxf(fmaxf(fabsf(bf2f(r.x & 0xffffu)), fabsf(bf2f(r.x >> 16))), fmaxf(fabsf(bf2f(r.y & 0xffffu)), fabsf(bf2f(r.y >> 16)))), fmaxf(fmaxf(fabsf(bf2f(r.z & 0xffffu)), fabsf(bf2f(r.z >> 16))), fmaxf(fabsf(bf2f(r.w & 0xffffu)), fabsf(bf2f(r.w >> 16)))))); }
#pragma unroll
                    for (int o = 1; o < 64; o <<= 1) mx = fmaxf(mx, __shfl_xor(mx, o));
                    const float sc = (mx > 0.f) ? mx * (1.0f / 127.0f) : 1.0f, inv = 1.0f / sc;
                    signed char* dst = (signed char*)(ws + WS_W + (size_t)ll * W_LAYER + W_WD8) + (size_t)n * FF;
                    int qs = 0;
#pragma unroll
                    for (int i = 0; i < 8; ++i) { const u32x4 r = raw[i]; const unsigned wds[4] = {r.x, r.y, r.z, r.w}; unsigned o0 = 0u, o1 = 0u;
#pragma unroll
                        for (int e = 0; e < 8; ++e) { const unsigned hw = (e & 1) ? (wds[e >> 1] >> 16) : (wds[e >> 1] & 0xffffu); const int q = (int)__builtin_rintf(bf2f(hw) * inv); qs += q;
                            if (e < 4) o0 |= ((unsigned)q & 0xffu) << (8 * e); else o1 |= ((unsigned)q & 0xffu) << (8 * (e - 4)); }
                        *(u32x2*)(dst + (size_t)(i * 64 + lane) * 8) = (u32x2){o0, o1}; }
#pragma unroll
                    for (int o = 1; o < 64; o <<= 1) qs += __shfl_xor(qs, o);
                    float sg = 0.f; { const float* ek = (const float*)(ws + WS_EK) + ll * D; float e16 = 0.f;
#pragma unroll
                        for (int i = 0; i < 16; ++i) e16 += ek[lane + 64 * i];
                        sg = wave_sum(e16); }
                    const float shl = HID_C2 * sg * (1.0f / 255.0f);
                    if (lane == 0) { ((float*)(ws + WS_SBD))[ll * D + n] = sc * shl; ((int*)(ws + WS_CSD))[ll * D + n] = 128 * qs; } }
            }

            for (int item = C.vcu; item < BATCH * 64; item += C.G) { const int b = item >> 6, c = item & 63;
                lru_final_item(C, args, l, b, c);
                hgrn_item<true>(C, args, l, b, c); }
        } PHASE_END
        PHASE_BEGIN {
            unsigned char* gt = (unsigned char*)(ws + WS_G) + (size_t)blockIdx.x * 8 * 65536;
            const bool fused5 = (C.G == 256);
            {
                int t_ = C.tid; asm volatile("" : "+v"(t_));
                float nv = -1.f; asm volatile("" : "+v"(nv)); const f32x4 neg = {nv, nv, nv, nv};
                for (int i = C.vcu * NTHREADS + t_; i < 2 * M * 4; i += C.G * NTHREADS) *(f32x4*)(ws + (i < M * 4 ? WS_XS0 : WS_XS1 - (size_t)M * 64) + (size_t)i * 16) = neg;
            }
            if (fused5) {
                pg8::Fused5Order S{(const char*)(ws + WS_HB8), (const char*)(ws + WS_WG8) + (size_t)l * NGATE * D, (const char*)(ws + WS_YS), (const char*)(wl + W_BR), C.vcu >> 2, C.vcu & 3};
                {
                    int t_ = C.tid; asm volatile("" : "+v"(t_));
                    LAS float* CSw = (LAS float*)(C.lds + 131072); LAS float* RSCw = CSw + 1024;
                    const float* sbg = (const float*)(ws + WS_SBG) + l * NGATE;
#pragma unroll
                    for (int q = 0; q < 2; ++q) { const int idx = t_ + NTHREADS * q; CSw[idx] = sbg[(idx >> 8) * 1024 + (C.vcu & 3) * 256 + (idx & 255)]; }
                    { const int row = ((t_ >> 8) * 64 + (C.vcu >> 2)) * 256 + (t_ & 255); RSCw[t_] = -1.4426950408889634f * rs_of(RS, row) * ((const float*)(ws + WS_SA))[row]; }
                    __syncthreads();
                }
                pg8::EpiFused5 E{(bf16_t*)(ws + WS_MERGED), (LAS const float*)(C.lds + 131072), (LAS const float*)(C.lds + 131072) + 1024};
                pg8::gemm_phase<pg8::EpiFused5, pg8::Fused5Order, true, false, true, true>(C.lds, 0, S, E);
            } else {
            {
                pg8::GateOrder8 S{(const char*)(ws + WS_HB8), (const char*)(ws + WS_WG8) + (size_t)l * NGATE * D, C.G, C.vcu};
                pg8::EpiGate8 E{gt, RS, (const float*)(ws + WS_SA), (const float*)(ws + WS_SBG) + l * NGATE};
                pg8::gemm_phase<pg8::EpiGate8, pg8::GateOrder8, true, true>(C.lds, D / 2, S, E);
            }
            {
                pg8::MergeOrder S{(const char*)(ws + WS_YS), (const char*)(wl + W_BR), C.G, C.vcu};
                pg8::EpiGate E{gt, (bf16_t*)(ws + WS_MERGED), RS};
                pg8::gemm_phase<pg8::EpiGate, pg8::MergeOrder, true>(C.lds, D, S, E);
            }
            }
        } PHASE_END
        const bool fused_norm = (C.G == 256) && !MK_PER_PHASE;
        if (fused_norm) {
            PHASE_BEGIN {
                { const int half = 0;
                    pg8::PanelOrder S{(const char*)(ws + WS_MERGED), (const char*)(wl + W_OUT), (size_t)pg8::BM * D * 2, D / pg8::BK, half, C.vcu};
                    pg8::EpiNorm E{(bf16_t*)(ws + WS_HB), nullptr, args.in[I_NMIXPOST] + l * D, (float*)(ws + WS_XS0), (float*)(ws + WS_X2), (unsigned*)(ws + WS_CTL) + 8, C.lds + 131072, (signed char*)(ws + WS_HB8), (float*)(ws + WS_SA), nullptr, nullptr};
                    pg8::gemm_phase<pg8::EpiNorm, pg8::PanelOrder, true>(C.lds, D, S, E);
                }
            } PHASE_END
            ++ph;
        } else {
        PHASE_BEGIN {
            pg8::StaticOrder S; S.init(ws + WS_MERGED, wl + W_OUT, M, D, D, C.G, (int)blockIdx.x);
            pg8::EpiRow<0> E{(bf16_t*)(ws + WS_MIX), D, nullptr};
            pg8::gemm_phase<pg8::EpiRow<0>, pg8::StaticOrder, true>(C.lds, D, S, E);
        } PHASE_END
        PHASE_BEGIN norm_phase(C, args, (const bf16_t*)(ws + WS_MIX), args.in[I_NMIXPOST] + l * D, false); PHASE_END
        }
        PHASE_BEGIN {
            pg8::StaticOrder S; S.init(ws + WS_HB8, ws + WS_WU8 + (size_t)l * FF * D, M, FF, D / 2, C.G, (int)blockIdx.x);
            if (fused_norm) {
                float shv;
                { int t_ = C.tid; asm volatile("" : "+v"(t_)); LAS float* red = (LAS float*)(C.lds + 131072);
                  const float* ek = (const float*)(ws + WS_EK) + l * D;
                  float v = wave_sum(ek[t_] + ek[t_ + NTHREADS]);
                  if ((t_ & 63) == 0) red[t_ >> 6] = v;
                  __syncthreads();
                  float sg = 0.f;
#pragma unroll
                  for (int w = 0; w < NWAVES; ++w) sg += red[w];
                  shv = HID_C2 * sg * (1.0f / 255.0f);
                  if (C.vcu == 0 && t_ == 0) ((float*)(ws + WS_SH))[l] = shv;
                  __syncthreads(); }
                pg8::EpiUp8Q E{(signed char*)(ws + WS_HID), FF, RS, (const float*)(ws + WS_SA), (const float*)(ws + WS_SBU) + l * FF, 1.0f / sqrtf(shv)};
                pg8::UpTeamOrder ST{(const char*)(ws + WS_HB8), (const char*)(ws + WS_WU8) + (size_t)l * FF * D, C.vcu >> 2, C.vcu & 3};
                pg8::gemm_phase<pg8::EpiUp8Q, pg8::UpTeamOrder, true, true>(C.lds, D / 2, ST, E);
            } else {
                pg8::EpiUp8 E{(bf16_t*)(ws + WS_HID), FF, RS, (const float*)(ws + WS_SA), (const float*)(ws + WS_SBU) + l * FF};
                pg8::gemm_phase<pg8::EpiUp8, pg8::StaticOrder, true, true>(C.lds, D / 2, S, E);
            }
        } PHASE_END
        if (fused_norm) {
            PHASE_BEGIN {
                { const int half = 0;
                    pg8::PanelOrder S{(const char*)(ws + WS_HID), (const char*)(wl + W_WD8), (size_t)pg8::BM * FF, FF / (2 * pg8::BK), half, C.vcu};
                    pg8::EpiNorm8 E{(bf16_t*)(ws + WS_HB), (li == DEPTH - 1) ? args.out : nullptr, args.in[I_NMLPPOST] + l * D, (float*)(ws + WS_XS1), (float*)(ws + WS_X2), (unsigned*)(ws + WS_CTL) + 8, C.lds + 131072, (signed char*)(ws + WS_HB8), (float*)(ws + WS_SA),
                                   (const float*)(ws + WS_SBD) + l * D, (const int*)(ws + WS_CSD) + l * D};
                    pg8::gemm_phase<pg8::EpiNorm8, pg8::PanelOrder, true, true>(C.lds, FF / 2, S, E);
                }
            } PHASE_END
            ++ph;
        } else {
        PHASE_BEGIN {
            pg8::StaticOrder S; S.init(ws + WS_HID, wl + W_DOWN, M, D, FF, C.G, (int)blockIdx.x);
            pg8::EpiRow<0> E{(bf16_t*)(ws + WS_MOUT), D, nullptr};
            pg8::gemm_phase<pg8::EpiRow<0>, pg8::StaticOrder, true>(C.lds, FF, S, E);
        } PHASE_END
        PHASE_BEGIN norm_phase(C, args, (const bf16_t*)(ws + WS_MOUT), args.in[I_NMLPPOST] + l * D, li == DEPTH - 1); PHASE_END
        }
    }
}

extern "C" void kernel_launch(void* const* d_in, const int* in_sizes, int n_in, void* d_out, int out_size, void* d_ws, size_t ws_size, hipStream_t stream) {
    static int grid = 0;
    if (grid == 0) {
        if (n_in != 22 || in_sizes[0] != M * D || out_size != M * D || ws_size < WS_END) { fprintf(stderr, "kernel_launch: unexpected shapes (n_in %d, in0 %d, out %d, ws %zu)\n", n_in, n_in > 0 ? in_sizes[0] : -1, out_size, ws_size); grid = -1; return; }
        int dev = 0, cus = 0, per_cu = 0;
        if (hipGetDevice(&dev) != hipSuccess || hipDeviceGetAttribute(&cus, hipDeviceAttributeMultiprocessorCount, dev) != hipSuccess) { grid = -1; return; }
        if (hipFuncSetAttribute((const void*)trunk_fwd, hipFuncAttributeMaxDynamicSharedMemorySize, LDS_BYTES) != hipSuccess) { fprintf(stderr, "kernel_launch: hipFuncSetAttribute failed\n"); grid = -1; return; }
        if (hipOccupancyMaxActiveBlocksPerMultiprocessor(&per_cu, (const void*)trunk_fwd, NTHREADS, LDS_BYTES) != hipSuccess || per_cu < 1) { fprintf(stderr, "kernel_launch: occupancy query says %d blocks per CU\n", per_cu); (void)hipGetLastError(); grid = -1; return; }
        grid = cus;
    }
    if (grid < 0) return;
    (void)hipMemsetAsync((char*)d_ws + WS_CTL, 0, CTL_ZERO_BYTES, stream);
    Args a{};
    for (int i = 0; i < 22; ++i) a.in[i] = (const float*)d_in[i];
    a.out = (float*)d_out; a.ws = (unsigned char*)d_ws;
#if MK_PER_PHASE
#ifndef DBG_MAXPH
#define DBG_MAXPH N_PHASES
#endif
    for (int p = 0; p < DBG_MAXPH; ++p) { a.ph_lo = p; a.ph_hi = p + 1; hipLaunchKernelGGL(trunk_fwd, dim3(grid), dim3(NTHREADS), LDS_BYTES, stream, a); }
#else
#if DBG_PREFIX > 0
    { a.ph_lo = 0; a.ph_hi = DBG_PREFIX; void* kargs0[] = {&a};
      (void)hipLaunchCooperativeKernel((const void*)trunk_fwd, dim3(grid), dim3(NTHREADS), kargs0, LDS_BYTES, stream);
      (void)hipMemsetAsync((char*)d_ws + WS_CTL, 0, CTL_ZERO_BYTES, stream); }
#endif
    a.ph_lo = 0; a.ph_hi = N_PHASES;
    void* kargs[] = {&a};
    hipError_t e = hipLaunchCooperativeKernel((const void*)trunk_fwd, dim3(grid), dim3(NTHREADS), kargs, LDS_BYTES, stream);
    if (e != hipSuccess) fprintf(stderr, "kernel_launch: cooperative launch failed: %s (grid %d)\n", hipGetErrorString(e), grid);
#endif
}
```
